# Optimizing an MI355X kernel written in HIP

```python
import math
import jax
import jax.numpy as jnp
from jax import lax
import numpy as np

D_MODEL = 1024
BATCH = 4
SEQ = 8192
DEPTH = 1

D_MIX = D_MODEL
D_CONV = D_MIX // 2
CONV_GROUPS = 8
CONV_GROUP_DIM = D_CONV // CONV_GROUPS
CONV_K_MIX = 3
DN_HEADS = 4
DN_HEAD_DIM = (D_MIX - D_CONV) // DN_HEADS
DN_QK = DN_HEADS * DN_HEAD_DIM
DN_V = DN_HEADS * DN_HEAD_DIM
CONV_K_QKV = 4
CHUNK = 64
FFN_HIDDEN = ((8 * D_MODEL // 3 + 255) // 256) * 256
N_MOD = 6
EPS = 1e-6
P_IN = 3 * D_CONV + 2 * DN_QK + 2 * DN_V + 2 * DN_HEADS

kernel_name = 'hybrid_conv_deltanet_adaln_layer'


def rms_norm(x, gain, eps=EPS):
    x32 = x.astype(jnp.float32)
    y = x32 * lax.rsqrt(jnp.mean(x32 * x32, axis=-1, keepdims=True) + eps)
    return y.astype(x.dtype) * gain


def l2_normalize(x, eps=EPS):
    x32 = x.astype(jnp.float32)
    return (x32 * lax.rsqrt(jnp.sum(x32 * x32, axis=-1, keepdims=True) + eps)).astype(x.dtype)


def adaln(x, gain, shift, scale):
    return rms_norm(x, gain) * (1 + scale[:, None, :]) + shift[:, None, :]


def causal_depthwise_conv(u, w):
    k = w.shape[0]
    s = u.shape[1]
    up = jnp.pad(u, ((0, 0), (k - 1, 0), (0, 0)))
    out = up[:, 0:s] * w[0]
    for j in range(1, k):
        out = out + up[:, j:j + s] * w[j]
    return out


def chunked_gated_delta_rule(q, k, v, g, beta):
    out_dtype = v.dtype
    f32 = jnp.float32
    b, h, t, dk = q.shape
    dv = v.shape[-1]
    n = t // CHUNK

    def blocks(a):
        return a.astype(f32).reshape(b, h, n, CHUNK, *a.shape[3:])

    q = blocks(q) * (dk ** -0.5)
    k = blocks(k)
    v = blocks(v)
    beta = blocks(beta)
    g = jnp.cumsum(blocks(g), axis=-1)
    idx = jnp.arange(CHUNK)
    causal = idx[:, None] >= idx[None, :]
    strict = idx[:, None] > idx[None, :]
    decay = jnp.exp(jnp.where(causal, g[..., :, None] - g[..., None, :], -jnp.inf))
    k_beta = k * beta[..., None]
    lower = jnp.where(strict, jnp.einsum('bhncd,bhnsd->bhncs', k_beta, k) * decay, 0.0)
    tri = lower + jnp.eye(CHUNK, dtype=f32)
    rhs = jnp.concatenate([v * beta[..., None], k_beta * jnp.exp(g)[..., None]], axis=-1)
    sol = lax.linalg.triangular_solve(tri, rhs, left_side=True, lower=True, unit_diagonal=True)
    u = sol[..., :dv]
    w = sol[..., dv:]
    attn = jnp.where(causal, jnp.einsum('bhncd,bhnsd->bhncs', q, k) * decay, 0.0)
    g_last = g[..., -1]
    q_dec = q * jnp.exp(g)[..., None]
    k_dec = k * jnp.exp(g_last[..., None] - g)[..., None]

    def step(state, inp):
        attn_c, u_c, w_c, q_c, k_c, gl_c = inp
        v_new = u_c - jnp.einsum('bhck,bhkv->bhcv', w_c, state)
        o_c = jnp.einsum('bhck,bhkv->bhcv', q_c, state) + jnp.einsum('bhcs,bhsv->bhcv', attn_c, v_new)
        state = state * jnp.exp(gl_c)[..., None, None] + jnp.einsum('bhck,bhcv->bhkv', k_c, v_new)
        return state, o_c

    xs = tuple(jnp.moveaxis(a, 2, 0) for a in (attn, u, w, q_dec, k_dec, g_last))
    s0 = jnp.zeros((b, h, dk, dv), f32)
    _, o = lax.scan(step, s0, xs)
    o = jnp.moveaxis(o, 0, 2).reshape(b, h, t, dv)
    return o.astype(out_dtype)


def setup_inputs(seed: int = 0) -> dict:
    key = jax.random.key(seed)
    ks = jax.random.split(key, 20)
    f32 = jnp.float32
    L, D = DEPTH, D_MODEL

    def normal(k, shape, scale):
        return jax.random.normal(k, shape, f32) * scale

    dt = jnp.exp(jax.random.uniform(ks[12], (L, DN_HEADS), f32) * (math.log(0.1) - math.log(0.001)) + math.log(0.001))
    return {
        'x': normal(ks[0], (BATCH, SEQ, D), 1.0),
        'c': normal(ks[1], (BATCH, D), 1.0),
        'w_ada': normal(ks[2], (L, D, N_MOD * D), 0.5 * D ** -0.5),
        'b_ada': normal(ks[3], (L, N_MOD * D), 0.02),
        'w_ada_final': normal(ks[4], (D, 2 * D), 0.5 * D ** -0.5),
        'b_ada_final': normal(ks[5], (2 * D,), 0.02),
        'g_norm_mix': 1.0 + normal(ks[6], (L, D), 0.1),
        'g_norm_ffn': 1.0 + normal(ks[7], (L, D), 0.1),
        'g_norm_final': 1.0 + normal(ks[8], (D,), 0.1),
        'w_in': normal(ks[9], (L, D, P_IN), D ** -0.5),
        'conv_w_mix': normal(ks[10], (L, CONV_K_MIX, D_CONV), CONV_K_MIX ** -0.5),
        'conv_w_qkv': normal(ks[11], (L, CONV_K_QKV, 2 * DN_QK + DN_V), CONV_K_QKV ** -0.5),
        'a_log': jnp.log(jax.random.uniform(ks[13], (L, DN_HEADS), f32, minval=1.0, maxval=16.0)),
        'dt_bias': dt + jnp.log(-jnp.expm1(-dt)),
        'g_conv_out': 1.0 + normal(ks[14], (L, D_CONV), 0.1),
        'g_dn_out': 1.0 + normal(ks[15], (L, DN_HEAD_DIM), 0.1),
        'w_out': normal(ks[16], (L, D_MIX, D), D_MIX ** -0.5),
        'w_gate_up': normal(ks[17], (L, D, 2 * FFN_HIDDEN), D ** -0.5),
        'w_down': normal(ks[18], (L, FFN_HIDDEN, D), FFN_HIDDEN ** -0.5),
    }


def reference(x, c, w_ada, b_ada, w_ada_final, b_ada_final, g_norm_mix, g_norm_ffn, g_norm_final,
              w_in, conv_w_mix, conv_w_qkv, a_log, dt_bias, g_conv_out, g_dn_out, w_out, w_gate_up, w_down):
    b, s, _ = x.shape
    c_act = jax.nn.silu(c)
    split_at = [D_CONV, 2 * D_CONV, 3 * D_CONV,
                3 * D_CONV + DN_QK, 3 * D_CONV + 2 * DN_QK,
                3 * D_CONV + 2 * DN_QK + DN_V, 3 * D_CONV + 2 * DN_QK + 2 * DN_V,
                3 * D_CONV + 2 * DN_QK + 2 * DN_V + DN_HEADS]
    for layer in range(DEPTH):
        mod = c_act @ w_ada[layer] + b_ada[layer]
        shift_m, scale_m, gate_m, shift_f, scale_f, gate_f = jnp.split(mod, N_MOD, axis=-1)

        h = adaln(x, g_norm_mix[layer], shift_m, scale_m)
        p = h @ w_in[layer]
        gate_b, gate_c, h_conv, q, k, v, z, a, bt = jnp.split(p, split_at, axis=-1)

        ya = gate_b * causal_depthwise_conv(gate_c * h_conv, conv_w_mix[layer])
        ya = rms_norm(ya.reshape(b, s, CONV_GROUPS, CONV_GROUP_DIM),
                      g_conv_out[layer].reshape(CONV_GROUPS, CONV_GROUP_DIM)).reshape(b, s, D_CONV)

        qkv = jax.nn.silu(causal_depthwise_conv(jnp.concatenate([q, k, v], axis=-1), conv_w_qkv[layer]))
        q, k, v = jnp.split(qkv, [DN_QK, 2 * DN_QK], axis=-1)

        def heads(t):
            return t.reshape(b, s, DN_HEADS, DN_HEAD_DIM).transpose(0, 2, 1, 3)

        q = l2_normalize(heads(q))
        k = l2_normalize(heads(k))
        v = heads(v)
        beta = jax.nn.sigmoid(bt.astype(jnp.float32)).transpose(0, 2, 1)
        g_dec = (-jnp.exp(a_log[layer].astype(jnp.float32))
                 * jax.nn.softplus(a.astype(jnp.float32) + dt_bias[layer].astype(jnp.float32))).transpose(0, 2, 1)
        o = chunked_gated_delta_rule(q, k, v, g_dec, beta).transpose(0, 2, 1, 3)
        o = rms_norm(o, g_dn_out[layer]) * jax.nn.silu(z.reshape(b, s, DN_HEADS, DN_HEAD_DIM))
        yb = o.reshape(b, s, DN_V)

        y = jnp.concatenate([ya, yb], axis=-1) @ w_out[layer]
        x = x + gate_m[:, None, :] * y

        h = adaln(x, g_norm_ffn[layer], shift_f, scale_f)
        gt, up = jnp.split(h @ w_gate_up[layer], 2, axis=-1)
        x = x + gate_f[:, None, :] * ((jax.nn.silu(gt) * up) @ w_down[layer])

    shift_o, scale_o = jnp.split(c_act @ w_ada_final + b_ada_final, 2, axis=-1)
    return adaln(x, g_norm_final, shift_o, scale_o)
```

```cpp
#include <hip/hip_runtime.h>
#include <hip/hip_cooperative_groups.h>
#include <cstdio>
#include <cstdint>
namespace cg = cooperative_groups;
#ifndef MK_N_LAUNCHES
#define MK_N_LAUNCHES 1
#endif
#ifndef DN_NAIVE
#define DN_NAIVE 0
#endif
namespace pg8 {
#define PG8_LAS __attribute__((address_space(3)))
typedef unsigned short bf16_t;
typedef short bf16x8 __attribute__((ext_vector_type(8)));
typedef float f32x4 __attribute__((ext_vector_type(4)));
typedef unsigned u32x4 __attribute__((ext_vector_type(4)));
constexpr int BM = 256, BK = 64, HALF = 128, HTB = HALF * BK * 2  , STAGE_BYTES = 8 * HTB, NXCD = 8, WGM = 8;

__host__ __device__ __forceinline__ int lds_byte(int r, int c) { const int st = (r >> 4) * 2 + (c >> 5), rr = r & 15, cc = c & 31, ob = rr * 64 + cc * 2; return st * 1024 + (ob ^ (((ob >> 9) & 1) << 5)); }
__host__ __device__ __forceinline__ void stage_rc(int b, int& R, int& C) { const int st = b / 1024, sb = b % 1024, swz = sb ^ (((sb >> 9) & 1) << 5); R = (st >> 1) * 16 + swz / 64; C = (st & 1) * 32 + (swz % 64) / 2; }
__host__ __device__ __forceinline__ int perm32(int rho) { const int n = rho >> 4, i = rho & 15; return 8 * (i >> 2) + 4 * n + (i & 3); }

struct Unit { int pm, pn; };
struct Gemm { const bf16_t* A; const bf16_t* Bt; int M, N, K; };

struct StaticOrder {
    int nM, nN, nwg, G, c;
    __host__ __device__ void init(int M, int N, int G_, int c_) { nM = M / BM; nN = N / BM; nwg = nM * nN; G = G_; c = c_; }
    __host__ __device__ bool next(int i, Unit& u) const {
        const long L = (long)i * G + c; if (L >= nwg) return false;
        int wgid = (int)L; { const int q = nwg / NXCD, r = nwg % NXCD, xcd = wgid % NXCD, off = wgid / NXCD; wgid = (xcd < r ? xcd * (q + 1) : r * (q + 1) + (xcd - r) * q) + off; }
        const int nig = WGM * nN, gid = wgid / nig, fm = gid * WGM, gsz = (nM - fm) < WGM ? (nM - fm) : WGM;
        u.pm = fm + ((wgid % nig) % gsz); u.pn = (wgid % nig) / gsz; return true;
    }
    __device__ __forceinline__ void a_ready(const Unit&) const {}
    __device__ __forceinline__ void done(const Unit&) const {}
};

typedef float f32x2 __attribute__((ext_vector_type(2)));
typedef __bf16 bf16x2v __attribute__((ext_vector_type(2)));
__device__ __forceinline__ unsigned cvt_pk_bf16(float lo, float hi) { f32x2 v = {lo, hi}; bf16x2v r = __builtin_convertvector(v, bf16x2v); return __builtin_bit_cast(unsigned, r); }
__device__ __forceinline__ float silu_f(float x) { return x * __builtin_amdgcn_rcpf(1.0f + __builtin_amdgcn_exp2f(-1.4426950408889634f * x)); }

struct EpiBf16 {
    static constexpr bool PERM = true, AFTER_DRAIN = false;
    bf16_t* O; int ldc;
    __device__ __forceinline__ void operator()(const f32x4 (&acc)[2][2][4][2], const Unit& u, int wr, int wc, int fr, int fq) const {
        const int row0 = u.pm * BM + wr * 64 + fr; const int col0 = u.pn * BM + wc * 32 + 8 * fq;
#pragma unroll
        for (int ai = 0; ai < 2; ++ai)
#pragma unroll
            for (int m = 0; m < 4; ++m) { bf16_t* rowp = O + (size_t)(row0 + ai * HALF + m * 16) * ldc + col0;
#pragma unroll
                for (int bj = 0; bj < 2; ++bj) { const f32x4 v0 = acc[ai][bj][m][0], v1 = acc[ai][bj][m][1];
                    u32x4 w; w.x = cvt_pk_bf16(v0[0], v0[1]); w.y = cvt_pk_bf16(v0[2], v0[3]); w.z = cvt_pk_bf16(v1[0], v1[1]); w.w = cvt_pk_bf16(v1[2], v1[3]);
                    *(u32x4*)(rowp + bj * HALF) = w; } }
    }
};
struct EpiSwiglu {
    static constexpr bool PERM = true, AFTER_DRAIN = false;
    bf16_t* O; int ldc;
    __device__ __forceinline__ void operator()(const f32x4 (&acc)[2][2][4][2], const Unit& u, int wr, int wc, int fr, int fq) const {
        const int row0 = u.pm * BM + wr * 64 + fr; const int col0 = u.pn * HALF + wc * 32 + 8 * fq;
#pragma unroll
        for (int ai = 0; ai < 2; ++ai)
#pragma unroll
            for (int m = 0; m < 4; ++m) { bf16_t* rowp = O + (size_t)(row0 + ai * HALF + m * 16) * ldc + col0;
                const f32x4 g0 = acc[ai][0][m][0], g1 = acc[ai][0][m][1], u0 = acc[ai][1][m][0], u1 = acc[ai][1][m][1];
                u32x4 w; w.x = cvt_pk_bf16(silu_f(g0[0]) * u0[0], silu_f(g0[1]) * u0[1]); w.y = cvt_pk_bf16(silu_f(g0[2]) * u0[2], silu_f(g0[3]) * u0[3]);
                w.z = cvt_pk_bf16(silu_f(g1[0]) * u1[0], silu_f(g1[1]) * u1[1]); w.w = cvt_pk_bf16(silu_f(g1[2]) * u1[2], silu_f(g1[3]) * u1[3]);
                *(u32x4*)rowp = w; }
    }
};
struct EpiResGate {
    static constexpr bool PERM = false, AFTER_DRAIN = false;
    const float* base; float* out; const float* gate;
    int gstride;
    __device__ __forceinline__ void operator()(const f32x4 (&acc)[2][2][4][2], const Unit& u, int wr, int wc, int fr, int fq) const {
        const int b = u.pm >> 5;
        const int col0 = u.pn * BM + wc * 32 + 4 * fq; const float* gp = gate + (size_t)b * gstride + col0;
        f32x4 gv[2][2];
#pragma unroll
        for (int bj = 0; bj < 2; ++bj)
#pragma unroll
            for (int n = 0; n < 2; ++n) gv[bj][n] = *(const f32x4*)(gp + bj * HALF + n * 16);
#pragma unroll
        for (int ai = 0; ai < 2; ++ai)
#pragma unroll
            for (int m = 0; m < 4; ++m) { const size_t off = (size_t)(u.pm * BM + ai * HALF + wr * 64 + m * 16 + fr) * 1024 + col0;
#pragma unroll
                for (int bj = 0; bj < 2; ++bj)
#pragma unroll
                    for (int n = 0; n < 2; ++n) { const f32x4 bs = *(const f32x4*)(base + off + bj * HALF + n * 16);
                        *(f32x4*)(out + off + bj * HALF + n * 16) = bs + gv[bj][n] * acc[ai][bj][m][n]; } }
    }
};

template <class Epi, class Sched, bool ALIGN_EPI = false, bool SP2 = false>
__device__ __forceinline__ void gemm_phase(PG8_LAS unsigned char* lds, const Gemm g, const Sched& S, const Epi& E) {
    const int tid = threadIdx.x, wid = __builtin_amdgcn_readfirstlane(tid >> 6), lane = tid & 63, wr = wid >> 2, wc = wid & 3, fr = lane & 15, fq = lane >> 4;
    const int K = g.K, nt = K / BK;
    unsigned voffA[2], voffB[2];
#pragma unroll
    for (int i = 0; i < 2; ++i) { int R, C; stage_rc(tid * 16 + i * 8192, R, C); const int Rb = Epi::PERM ? ((R & ~31) + perm32(R & 31)) : R;
        voffA[i] = (unsigned)(R * K + C) * 2u; voffB[i] = (unsigned)(Rb * K + C) * 2u; }
    const size_t kstep = (size_t)(BK * 2);
    const size_t hstep = (size_t)HALF * K * 2;
    const size_t tstep = 2 * hstep;
    const unsigned ldsw = (unsigned)wid * 1024u;
    const int aoff = lds_byte(wr * 64 + fr, fq * 8), boff = lds_byte(wc * 32 + fr, fq * 8);
#define PG8_SA(b, h) (((b) * 2 + (h)) * HTB)
#define PG8_SB(b, h) ((4 + (b) * 2 + (h)) * HTB)
#define PG8_STAGE(bufoff, gbase, voff) do { _Pragma("unroll") for (int _i = 0; _i < 2; ++_i) \
        __builtin_amdgcn_global_load_lds((const unsigned*)((const char*)(gbase) + (voff)[_i]), (PG8_LAS unsigned*)(lds + (bufoff) + ldsw + _i * 8192), 16, 0, 0); } while (0)
#define PG8_LDA(dst, b, h) do { _Pragma("unroll") for (int m = 0; m < 4; ++m) _Pragma("unroll") for (int k = 0; k < 2; ++k) dst[m][k] = *(const PG8_LAS bf16x8*)(lds + PG8_SA(b, h) + aoff + m * 2048 + k * 1024); } while (0)
#define PG8_LDB(dst, b, h) do { _Pragma("unroll") for (int n = 0; n < 2; ++n) _Pragma("unroll") for (int k = 0; k < 2; ++k) dst[n][k] = *(const PG8_LAS bf16x8*)(lds + PG8_SB(b, h) + boff + n * 2048 + k * 1024); } while (0)
#define PG8_MMA(ai, bj, At, Bt) do { __builtin_amdgcn_s_setprio(1); _Pragma("unroll") for (int m = 0; m < 4; ++m) _Pragma("unroll") for (int n = 0; n < 2; ++n) _Pragma("unroll") for (int k = 0; k < 2; ++k) \
        acc[ai][bj][m][n] = __builtin_amdgcn_mfma_f32_16x16x32_bf16(Bt[n][k], At[m][k], acc[ai][bj][m][n], 0, 0, 0); __builtin_amdgcn_s_setprio(0); } while (0)
#define PG8_WAIT_V(n) asm volatile("s_waitcnt vmcnt(" #n ")" ::: "memory")
#define PG8_WAIT_L(n) asm volatile("s_waitcnt lgkmcnt(" #n ")" ::: "memory")
#define PG8_BAR __builtin_amdgcn_s_barrier()
#define PG8_SCHED __builtin_amdgcn_sched_barrier(0)
    Unit cur, nxt; int ui = 0;
    if (!S.next(0, cur)) return;
    f32x4 acc[2][2][4][2];
#pragma unroll
    for (int a = 0; a < 2; ++a)
#pragma unroll
        for (int b = 0; b < 2; ++b)
#pragma unroll
            for (int m = 0; m < 4; ++m)
#pragma unroll
                for (int n = 0; n < 2; ++n) acc[a][b][m][n] = (f32x4){0.f, 0.f, 0.f, 0.f};
    bf16x8 At[4][2], B0[2][2], B1[2][2];
    const char* cA = (const char*)g.A + (size_t)cur.pm * tstep; const char* cB = (const char*)g.Bt + (size_t)cur.pn * tstep;
    S.a_ready(cur);
    if constexpr (SP2) {
        PG8_STAGE(PG8_SB(0, 0), cB, voffB); PG8_STAGE(PG8_SB(0, 1), cB + hstep, voffB); PG8_STAGE(PG8_SA(0, 0), cA, voffA); PG8_STAGE(PG8_SA(0, 1), cA + hstep, voffA);
        if (wr == 1) PG8_BAR;
        PG8_WAIT_V(2); PG8_BAR;
        PG8_STAGE(PG8_SB(1, 0), cB + kstep, voffB); PG8_STAGE(PG8_SA(1, 0), cA + kstep, voffA); PG8_STAGE(PG8_SB(1, 1), cB + hstep + kstep, voffB);
        PG8_WAIT_V(6); PG8_BAR;
    } else {
        PG8_STAGE(PG8_SB(0, 0), cB, voffB); PG8_STAGE(PG8_SA(0, 0), cA, voffA); PG8_STAGE(PG8_SB(0, 1), cB + hstep, voffB); PG8_STAGE(PG8_SA(0, 1), cA + hstep, voffA);
        if (wr == 1) PG8_BAR;
        PG8_WAIT_V(4); PG8_BAR;
        PG8_STAGE(PG8_SB(1, 0), cB + kstep, voffB); PG8_STAGE(PG8_SA(1, 0), cA + kstep, voffA); PG8_STAGE(PG8_SB(1, 1), cB + hstep + kstep, voffB);
        PG8_WAIT_V(6); PG8_BAR;
    }
    for (;;) {
        const bool has_next = S.next(ui + 1, nxt);
        const char* nA = has_next ? (const char*)g.A + (size_t)nxt.pm * tstep : cA; const char* nB = has_next ? (const char*)g.Bt + (size_t)nxt.pn * tstep : cB;
        for (int t = 0; t < nt; t += 2) {
            const bool last = (t == nt - 2);
            const char* a1 = cA + (size_t)(t + 1) * kstep;
            const char* a2 = last ? nA : cA + (size_t)(t + 2) * kstep; const char* b2 = last ? nB : cB + (size_t)(t + 2) * kstep;
            const char* a3 = a2 + kstep; const char* b3 = b2 + kstep;
            if (last && has_next) S.a_ready(nxt);
            if constexpr (SP2) {
            PG8_LDB(B0, 0, 0); PG8_LDB(B1, 0, 1); PG8_SCHED; PG8_LDA(At, 0, 0); PG8_STAGE(PG8_SA(1, 1), a1 + hstep, voffA);
            PG8_WAIT_V(8); PG8_WAIT_L(0); PG8_BAR; PG8_MMA(0, 0, At, B0); PG8_MMA(0, 1, At, B1); PG8_BAR; PG8_SCHED;
            PG8_LDA(At, 0, 1); PG8_STAGE(PG8_SB(0, 0), b2, voffB); PG8_STAGE(PG8_SB(0, 1), b2 + hstep, voffB); PG8_STAGE(PG8_SA(0, 0), a2, voffA);
            PG8_WAIT_V(8); PG8_WAIT_L(0); PG8_BAR; PG8_MMA(1, 0, At, B0); PG8_MMA(1, 1, At, B1); PG8_BAR; PG8_SCHED;
            PG8_LDB(B0, 1, 0); PG8_LDB(B1, 1, 1); PG8_SCHED; PG8_LDA(At, 1, 0); PG8_STAGE(PG8_SA(0, 1), a2 + hstep, voffA);
            PG8_WAIT_V(8); PG8_WAIT_L(0); PG8_BAR; PG8_MMA(0, 0, At, B0); PG8_MMA(0, 1, At, B1); PG8_BAR; PG8_SCHED;
            PG8_LDA(At, 1, 1); PG8_STAGE(PG8_SB(1, 0), b3, voffB); PG8_STAGE(PG8_SB(1, 1), b3 + hstep, voffB); PG8_STAGE(PG8_SA(1, 0), a3, voffA);
            PG8_WAIT_V(8); PG8_WAIT_L(0); PG8_BAR; PG8_MMA(1, 0, At, B0); PG8_MMA(1, 1, At, B1); PG8_BAR; PG8_SCHED;
            } else {
            PG8_LDB(B0, 0, 0); PG8_SCHED; PG8_LDA(At, 0, 0); PG8_STAGE(PG8_SA(1, 1), a1 + hstep, voffA);
            PG8_WAIT_L(8); PG8_BAR; PG8_WAIT_L(0); PG8_MMA(0, 0, At, B0); PG8_BAR; PG8_SCHED;
            PG8_LDB(B1, 0, 1); PG8_STAGE(PG8_SB(0, 0), b2, voffB);
            PG8_BAR; PG8_WAIT_L(0); PG8_MMA(0, 1, At, B1); PG8_BAR;
            PG8_LDA(At, 0, 1); PG8_STAGE(PG8_SA(0, 0), a2, voffA);
            PG8_BAR; PG8_WAIT_L(0); PG8_MMA(1, 0, At, B0); PG8_BAR; PG8_SCHED;
            PG8_STAGE(PG8_SB(0, 1), b2 + hstep, voffB);
            PG8_WAIT_V(6); PG8_BAR; PG8_MMA(1, 1, At, B1); PG8_BAR;
            PG8_LDB(B0, 1, 0); PG8_SCHED; PG8_LDA(At, 1, 0); PG8_STAGE(PG8_SA(0, 1), a2 + hstep, voffA);
            PG8_WAIT_L(8); PG8_BAR; PG8_WAIT_L(0); PG8_MMA(0, 0, At, B0); PG8_BAR; PG8_SCHED;
            PG8_LDB(B1, 1, 1); PG8_STAGE(PG8_SB(1, 0), b3, voffB);
            PG8_BAR; PG8_WAIT_L(0); PG8_MMA(0, 1, At, B1); PG8_BAR;
            PG8_LDA(At, 1, 1); PG8_STAGE(PG8_SA(1, 0), a3, voffA);
            PG8_BAR; PG8_WAIT_L(0); PG8_MMA(1, 0, At, B0); PG8_BAR; PG8_SCHED;
            PG8_STAGE(PG8_SB(1, 1), b3 + hstep, voffB);
            PG8_WAIT_V(6); PG8_BAR; PG8_MMA(1, 1, At, B1); PG8_BAR;
            }
        }
        if constexpr (ALIGN_EPI) { if (wr == 0) PG8_BAR; }
        if constexpr (!Epi::AFTER_DRAIN) { E(acc, cur, wr, wc, fr, fq); S.done(cur); }
        if (!has_next) break;
#pragma unroll
        for (int a = 0; a < 2; ++a)
#pragma unroll
            for (int b = 0; b < 2; ++b)
#pragma unroll
                for (int m = 0; m < 4; ++m)
#pragma unroll
                    for (int n = 0; n < 2; ++n) acc[a][b][m][n] = (f32x4){0.f, 0.f, 0.f, 0.f};
        cur = nxt; cA = nA; cB = nB; ++ui;
        if constexpr (ALIGN_EPI) { if (wr == 1) PG8_BAR; }
    }
    PG8_WAIT_V(0);
    if constexpr (!ALIGN_EPI) { if (wr == 0) PG8_BAR; }
    PG8_BAR;
    if constexpr (Epi::AFTER_DRAIN) { E.fused(acc, cur, wr, wc, fr, fq, lds, wid, lane); S.done(cur); }
#undef PG8_SA
#undef PG8_SB
#undef PG8_STAGE
#undef PG8_LDA
#undef PG8_LDB
#undef PG8_MMA
#undef PG8_WAIT_V
#undef PG8_WAIT_L
#undef PG8_BAR
#undef PG8_SCHED
}
}

constexpr int NWAVES = 8;
constexpr int BATCH = 4, SEQ = 8192, D = 1024, M = BATCH * SEQ;
constexpr int PIN = 3592, NP = 3584;
constexpr int FF = 2816, NCH = 128, NBH = 16;
constexpr int PH_END = 12;
constexpr float EPS = 1e-6f;
constexpr size_t MiB = 1u << 20;
constexpr size_t WS_MOD = 1 * MiB;
constexpr size_t WS_GB = 2 * MiB;
constexpr size_t WS_EGL = 3 * MiB;
constexpr size_t WS_WIN = 4 * MiB, WS_WO = 11 * MiB, WS_WGU = 13 * MiB, WS_WD = 24 * MiB;
constexpr size_t WS_H = 32 * MiB;
constexpr size_t WS_CH = 32 * MiB;
constexpr size_t WS_P = 208 * MiB;
constexpr size_t WS_YC = 432 * MiB;
constexpr size_t WS_END = 496 * MiB;
constexpr int REC = 90112;
constexpr int REC_A = 57344;
constexpr int LDS_BYTES = 147456;

#define LAS __attribute__((address_space(3)))
typedef unsigned short bf16;
typedef unsigned v4u __attribute__((ext_vector_type(4)));
typedef unsigned v2u __attribute__((ext_vector_type(2)));
typedef float f32x4 __attribute__((ext_vector_type(4)));
typedef float f32x16 __attribute__((ext_vector_type(16)));
typedef short bf16x8 __attribute__((ext_vector_type(8)));
#define LDS_WAIT() asm volatile("s_waitcnt lgkmcnt(0)" ::: "memory")
using pg8::cvt_pk_bf16; using pg8::silu_f;
__device__ __forceinline__ float bf2f(unsigned short u) { return __uint_as_float((unsigned)u << 16); }
__device__ __forceinline__ float bflo(unsigned w) { return __uint_as_float(w << 16); }
__device__ __forceinline__ float bfhi(unsigned w) { return __uint_as_float(w & 0xffff0000u); }
__device__ __forceinline__ float wave_sum(float v) {
#pragma unroll
    for (int o = 1; o < 64; o <<= 1) v += __shfl_xor(v, o);
    return v;
}
__device__ __forceinline__ void unpack8(v4u w, float (&f)[8]) { f[0] = bflo(w.x); f[1] = bfhi(w.x); f[2] = bflo(w.y); f[3] = bfhi(w.y); f[4] = bflo(w.z); f[5] = bfhi(w.z); f[6] = bflo(w.w); f[7] = bfhi(w.w); }
__device__ __forceinline__ v4u pack8(const float (&f)[8]) { v4u w; w.x = cvt_pk_bf16(f[0], f[1]); w.y = cvt_pk_bf16(f[2], f[3]); w.z = cvt_pk_bf16(f[4], f[5]); w.w = cvt_pk_bf16(f[6], f[7]); return w; }

struct Args { const float* in[19]; float* out; unsigned char* ws; int ph_lo, ph_hi; };
enum { I_X = 0, I_C, I_WADA, I_BADA, I_WADAF, I_BADAF, I_GMIX, I_GFFN, I_GFIN, I_WIN, I_CWM, I_CWQ, I_ALOG, I_DTB, I_GCO, I_GDN, I_WOUT, I_WGU, I_WDN };

template <int MODE>
__device__ __forceinline__ void p0_transpose_item(const float* W, int K, int ld, int nblk, bf16* WT, LAS float* scr, int item, int lane) {
    const int kb = item / nblk, nb = item % nblk, k0 = 64 * kb, n0 = 32 * nb;
#pragma unroll 8
    for (int i = 0; i < 32; ++i) { const int kk = 2 * i + (lane >> 5); scr[kk * 33 + (lane & 31)] = W[(size_t)(k0 + kk) * ld + n0 + (lane & 31)]; }
    LDS_WAIT(); asm volatile("" ::: "memory");
    int r0 = n0;
    if (MODE == 1) { r0 = n0 < FF ? 256 * (n0 / 128) + (n0 % 128) : 256 * ((n0 - FF) / 128) + 128 + ((n0 - FF) % 128); }
    const int c = lane & 7;
#pragma unroll
    for (int j = 0; j < 4; ++j) { const int n = (lane >> 3) + 8 * j; const LAS float* s = scr + (8 * c) * 33 + n;
        v4u o; o.x = cvt_pk_bf16(s[0 * 33], s[1 * 33]); o.y = cvt_pk_bf16(s[2 * 33], s[3 * 33]); o.z = cvt_pk_bf16(s[4 * 33], s[5 * 33]); o.w = cvt_pk_bf16(s[6 * 33], s[7 * 33]);
        *(v4u*)(WT + (size_t)(r0 + n) * K + k0 + 8 * c) = o; }
    LDS_WAIT(); asm volatile("" ::: "memory");
}
__device__ __forceinline__ void p0_mod_item(const Args& a, float* MOD, LAS float* red, int item, int tid) {
    const int cl = tid & 31, ks = tid >> 5, col = item * 32 + cl;
    const bool fin = col >= 6144; const float* W = fin ? a.in[I_WADAF] : a.in[I_WADA]; const int ld = fin ? 2048 : 6144, c = fin ? col - 6144 : col;
    const float* cin = a.in[I_C];
    float acc[4] = {0.f, 0.f, 0.f, 0.f};
    for (int kk = 0; kk < 64; ++kk) { const int k = ks * 64 + kk; const float wv = W[(size_t)k * ld + c];
#pragma unroll
        for (int b = 0; b < 4; ++b) { const float cv = cin[b * 1024 + k]; acc[b] += (cv / (1.0f + __expf(-cv))) * wv; } }
#pragma unroll
    for (int b = 0; b < 4; ++b) red[(ks * 4 + b) * 32 + cl] = acc[b];
    __syncthreads();
    if (tid < 128) { const int b = tid >> 5; float s = 0.f;
#pragma unroll
        for (int k = 0; k < 16; ++k) s += red[(k * 4 + b) * 32 + cl];
        s += fin ? a.in[I_BADAF][c] : a.in[I_BADA][c];
        if (fin) MOD[4 * 6144 + b * 2048 + c] = s; else MOD[b * 6144 + c] = s; }
    __syncthreads();
}

template <int MODE>
__device__ __forceinline__ void adaln_rows(const float* X, const float* gain, const float* shiftp, const float* scalep, int mstride, bf16* Hout, float* Fout,
                                           const float* w_in, const float* a_log, const float* dt_bias, float* GB, int gw, int NGW, int lane) {
    for (int m = gw; m < M; m += NGW) {
        const int b = m >> 13;
        const f32x4* xr = (const f32x4*)(X + (size_t)m * D) + lane;
        f32x4 v[4]; float ss = 0.f;
#pragma unroll
        for (int j = 0; j < 4; ++j) { v[j] = xr[64 * j]; ss += (v[j].x * v[j].x + v[j].y * v[j].y) + (v[j].z * v[j].z + v[j].w * v[j].w); }
        const float rinv = 1.0f / sqrtf(wave_sum(ss) * (1.0f / D) + EPS);
        const f32x4* g4 = (const f32x4*)gain + lane; const f32x4* sh4 = (const f32x4*)(shiftp + (size_t)b * mstride) + lane; const f32x4* sc4 = (const f32x4*)(scalep + (size_t)b * mstride) + lane;
#pragma unroll
        for (int j = 0; j < 4; ++j) v[j] = (v[j] * rinv) * g4[64 * j] * (1.0f + sc4[64 * j]) + sh4[64 * j];
        if (MODE == 2) { f32x4* o = (f32x4*)(Fout + (size_t)m * D) + lane;
#pragma unroll
            for (int j = 0; j < 4; ++j) o[64 * j] = v[j];
        } else { v2u* o = (v2u*)(Hout + (size_t)m * D) + lane;
#pragma unroll
            for (int j = 0; j < 4; ++j) { v2u w; w.x = cvt_pk_bf16(v[j].x, v[j].y); w.y = cvt_pk_bf16(v[j].z, v[j].w); o[64 * j] = w; } }
        if (MODE == 0) {
            float d[8] = {0.f, 0.f, 0.f, 0.f, 0.f, 0.f, 0.f, 0.f};
#pragma unroll
            for (int j = 0; j < 4; ++j)
#pragma unroll
                for (int e = 0; e < 4; ++e) { const int k = 4 * (lane + 64 * j) + e; const f32x4* wp = (const f32x4*)(w_in + (size_t)k * PIN + NP); const f32x4 wa = wp[0], wb = wp[1]; const float hv = v[j][e];
                    d[0] += hv * wa.x; d[1] += hv * wa.y; d[2] += hv * wa.z; d[3] += hv * wa.w; d[4] += hv * wb.x; d[5] += hv * wb.y; d[6] += hv * wb.z; d[7] += hv * wb.w; }
            float k4[4], k2[2], k1;
            { const bool hi = (lane & 32) != 0;
#pragma unroll
              for (int i = 0; i < 4; ++i) { const float snd = hi ? d[i] : d[4 + i]; const float kp = hi ? d[4 + i] : d[i]; k4[i] = kp + __shfl_xor(snd, 32); } }
            { const bool hi = (lane & 16) != 0;
#pragma unroll
              for (int i = 0; i < 2; ++i) { const float snd = hi ? k4[i] : k4[2 + i]; const float kp = hi ? k4[2 + i] : k4[i]; k2[i] = kp + __shfl_xor(snd, 16); } }
            { const bool hi = (lane & 8) != 0; const float snd = hi ? k2[0] : k2[1]; const float kp = hi ? k2[1] : k2[0]; k1 = kp + __shfl_xor(snd, 8); }
            k1 += __shfl_xor(k1, 4); k1 += __shfl_xor(k1, 2); k1 += __shfl_xor(k1, 1);
            if ((lane & 7) == 0) { const int e = lane >> 3; float r;
                if (e < 4) { const float xx = k1 + dt_bias[e]; const float sp = fmaxf(xx, 0.f) + log1pf(__expf(-fabsf(xx))); r = -__expf(a_log[e]) * sp; }
                else r = 1.0f / (1.0f + __expf(-k1));
                GB[(size_t)m * 8 + e] = r; }
        }
    }
}

__device__ __forceinline__ void conv_qkv(const bf16* P, const float* cwq, bf16* QKV, int X, int t0, bool first, int lane) {
    const int colp = 1536 + 512 * X + 8 * lane, colo = 512 * X + 8 * lane;
    float w0[8], w1[8], w2[8], w3[8], h3[8], h2[8], h1[8];
#pragma unroll
    for (int e = 0; e < 8; ++e) { w0[e] = cwq[0 * 1536 + colo + e]; w1[e] = cwq[1 * 1536 + colo + e]; w2[e] = cwq[2 * 1536 + colo + e]; w3[e] = cwq[3 * 1536 + colo + e]; h3[e] = 0.f; h2[e] = 0.f; h1[e] = 0.f; }
    if (!first) { unpack8(*(const v4u*)(P + (size_t)(t0 - 3) * NP + colp), h3); unpack8(*(const v4u*)(P + (size_t)(t0 - 2) * NP + colp), h2); unpack8(*(const v4u*)(P + (size_t)(t0 - 1) * NP + colp), h1); }
    for (int t = 0; t < 16; ++t) { const int m = t0 + t; float x[8], y[8]; unpack8(*(const v4u*)(P + (size_t)m * NP + colp), x); float ss = 0.f;
#pragma unroll
        for (int e = 0; e < 8; ++e) { const float c = w0[e] * h3[e] + w1[e] * h2[e] + w2[e] * h1[e] + w3[e] * x[e]; y[e] = silu_f(c); ss += y[e] * y[e]; h3[e] = h2[e]; h2[e] = h1[e]; h1[e] = x[e]; }
        if (X < 2) { ss += __shfl_xor(ss, 1); ss += __shfl_xor(ss, 2); ss += __shfl_xor(ss, 4); ss += __shfl_xor(ss, 8);
            float r = 1.0f / sqrtf(ss + EPS); if (X == 0) r *= 0.08838834764831845f;
#pragma unroll
            for (int e = 0; e < 8; ++e) y[e] *= r; }
        *(v4u*)(QKV + (size_t)m * 1536 + colo) = pack8(y); }
}
__device__ __forceinline__ void conv_pass(const bf16* P, const float* cwm, const float* cwq, const float* gco, bf16* YC, bf16* QKV, int gw, int NGW, int lane) {
    for (int run = gw; run < M / 16; run += NGW) {
        const int t0 = run * 16; const bool first = (t0 & (SEQ - 1)) == 0;
        { float w0[8], w1[8], w2[8], gc[8], u2[8], u1[8]; const int c0 = 8 * lane;
#pragma unroll
          for (int e = 0; e < 8; ++e) { w0[e] = cwm[c0 + e]; w1[e] = cwm[512 + c0 + e]; w2[e] = cwm[1024 + c0 + e]; gc[e] = gco[c0 + e]; u2[e] = 0.f; u1[e] = 0.f; }
          if (!first) { float a[8], b[8]; unpack8(*(const v4u*)(P + (size_t)(t0 - 2) * NP + 512 + c0), a); unpack8(*(const v4u*)(P + (size_t)(t0 - 2) * NP + 1024 + c0), b);
#pragma unroll
              for (int e = 0; e < 8; ++e) u2[e] = a[e] * b[e];
              unpack8(*(const v4u*)(P + (size_t)(t0 - 1) * NP + 512 + c0), a); unpack8(*(const v4u*)(P + (size_t)(t0 - 1) * NP + 1024 + c0), b);
#pragma unroll
              for (int e = 0; e < 8; ++e) u1[e] = a[e] * b[e]; }
          for (int t = 0; t < 16; ++t) { const int m = t0 + t; float gb[8], a[8], b[8], y[8]; const bf16* pr = P + (size_t)m * NP + c0;
              unpack8(*(const v4u*)pr, gb); unpack8(*(const v4u*)(pr + 512), a); unpack8(*(const v4u*)(pr + 1024), b); float ss = 0.f;
#pragma unroll
              for (int e = 0; e < 8; ++e) { const float u0 = a[e] * b[e]; y[e] = gb[e] * (w0[e] * u2[e] + w1[e] * u1[e] + w2[e] * u0); ss += y[e] * y[e]; u2[e] = u1[e]; u1[e] = u0; }
              ss += __shfl_xor(ss, 1); ss += __shfl_xor(ss, 2); ss += __shfl_xor(ss, 4);
              const float r = 1.0f / sqrtf(ss * (1.0f / 64.0f) + EPS);
#pragma unroll
              for (int e = 0; e < 8; ++e) y[e] = y[e] * r * gc[e];
              *(v4u*)(YC + (size_t)m * D + c0) = pack8(y); } }
        conv_qkv(P, cwq, QKV, 0, t0, first, lane); conv_qkv(P, cwq, QKV, 1, t0, first, lane); conv_qkv(P, cwq, QKV, 2, t0, first, lane);
    }
}

constexpr int PREP_HALF = 69632, PK_KN = 0, PK_QN = 17408, PK_VV = 34816, PK_LM = 52224, PK_GC = 68608, PK_BT = 68864, PK_EG = 69120, PROW = 272;
template <bool SC>
__device__ __forceinline__ v4u afrag_piece_rows(const LAS unsigned char* tile, const LAS float* sc, int p) {
    const int f = p >> 6, ln = p & 63, mt = f >> 3, kt = (f >> 1) & 3, s = f & 1, r = ln & 31, hh = ln >> 5, row = 32 * mt + r, kb = 32 * kt + 16 * s + 4 * hh;
    const v2u a = *(const LAS v2u*)(tile + row * PROW + kb * 2), b = *(const LAS v2u*)(tile + row * PROW + (kb + 8) * 2);
    float scv = 1.0f; if (SC) scv = sc[row];
    v4u o; o.x = cvt_pk_bf16(bflo(a.x) * scv, bfhi(a.x) * scv); o.y = cvt_pk_bf16(bflo(a.y) * scv, bfhi(a.y) * scv); o.z = cvt_pk_bf16(bflo(b.x) * scv, bfhi(b.x) * scv); o.w = cvt_pk_bf16(bflo(b.y) * scv, bfhi(b.y) * scv);
    return o;
}
__device__ __forceinline__ void prep_phase(LAS unsigned char* lds, const bf16* QKV, const float* GB, float* EGL, unsigned char* CH, int tid) {
    const int half = tid >> 8, t = tid & 255, lane = tid & 63, w = (tid >> 6) & 3, r = lane & 31, hh = lane >> 5;
    LAS unsigned char* L = lds + half * PREP_HALF;
    LAS float* LM = (LAS float*)(L + PK_LM); LAS float* GC = (LAS float*)(L + PK_GC); LAS float* BT = (LAS float*)(L + PK_BT); LAS float* EG = (LAS float*)(L + PK_EG);
    for (int pu = blockIdx.x; pu < NBH * NCH / 2; pu += gridDim.x) {
        const int cid = 2 * pu + half, bh = cid >> 7, n = cid & 127, b = bh >> 2, h = bh & 3, m0 = b * SEQ + n * 64;
        unsigned char* rec = CH + (size_t)cid * REC;
        __syncthreads();
#pragma unroll
        for (int X = 0; X < 3; ++X)
#pragma unroll
            for (int i = 0; i < 4; ++i) { const int p = t + 256 * i, row = p >> 4, c16 = p & 15;
                const v4u v = *(const v4u*)(QKV + (size_t)(m0 + row) * 1536 + 512 * X + 128 * h + 8 * c16);
                *(LAS v4u*)(L + (X == 0 ? PK_QN : (X == 1 ? PK_KN : PK_VV)) + row * PROW + c16 * 16) = v; }
        if (w == 0) { float g = GB[(size_t)(m0 + lane) * 8 + h];
#pragma unroll
            for (int d = 1; d < 64; d <<= 1) { const float o = __shfl_up(g, d); if (lane >= d) g += o; }
            GC[lane] = g; EG[lane] = __expf(g); BT[lane] = GB[(size_t)(m0 + lane) * 8 + 4 + h];
            if (lane == 63) EGL[cid] = __expf(g); }
        __syncthreads();
        { const int mi = w >> 1, nj = w & 1;
          f32x16 kk, qk;
#pragma unroll
          for (int i = 0; i < 16; ++i) { kk[i] = 0.f; qk[i] = 0.f; }
#pragma unroll
          for (int st = 0; st < 8; ++st) {
              const bf16x8 ka = *(const LAS bf16x8*)(L + PK_KN + (32 * mi + r) * PROW + (16 * st + 8 * hh) * 2);
              const bf16x8 kb = *(const LAS bf16x8*)(L + PK_KN + (32 * nj + r) * PROW + (16 * st + 8 * hh) * 2);
              const bf16x8 qb = *(const LAS bf16x8*)(L + PK_QN + (32 * mi + r) * PROW + (16 * st + 8 * hh) * 2);
              kk = __builtin_amdgcn_mfma_f32_32x32x16_bf16(ka, kb, kk, 0, 0, 0);
              qk = __builtin_amdgcn_mfma_f32_32x32x16_bf16(kb, qb, qk, 0, 0, 0);
          }
          const float gj = GC[32 * nj + r], gq = GC[32 * mi + r];
          float av[16];
#pragma unroll
          for (int reg = 0; reg < 16; ++reg) { const int cr = (reg & 3) + 8 * (reg >> 2) + 4 * hh;
              const int i = 32 * mi + cr, j = 32 * nj + r;
              LM[i * 64 + j] = (i > j) ? BT[i] * kk[reg] * __expf(GC[i] - gj) : 0.f;
              const int key = 32 * nj + cr, qr = 32 * mi + r;
              av[reg] = (qr >= key) ? qk[reg] * __expf(gq - GC[key]) : 0.f; }
#pragma unroll
          for (int s = 0; s < 2; ++s) { v4u o; o.x = cvt_pk_bf16(av[8 * s], av[8 * s + 1]); o.y = cvt_pk_bf16(av[8 * s + 2], av[8 * s + 3]); o.z = cvt_pk_bf16(av[8 * s + 4], av[8 * s + 5]); o.w = cvt_pk_bf16(av[8 * s + 6], av[8 * s + 7]);
              *(v4u*)(rec + 49152 + ((mi * 2 + nj) * 2 + s) * 1024 + lane * 16) = o; }
        }
#pragma unroll
        for (int i = 0; i < 4; ++i) { const int p = t + 256 * i; *(v4u*)(rec + 16384 + p * 16) = afrag_piece_rows<true>(L + PK_QN, EG, p); }
        { const float gl = GC[63];
#pragma unroll
          for (int i = 0; i < 4; ++i) { const int p = t + 256 * i, f = p >> 6, ln = p & 63, mt = f >> 2, ct = (f >> 1) & 1, s = f & 1, dk = 32 * mt + (ln & 31), cb = 32 * ct + 16 * s + 4 * (ln >> 5);
              float e[8];
#pragma unroll
              for (int j = 0; j < 8; ++j) { const int c = cb + 8 * (j >> 2) + (j & 3); e[j] = bf2f(*(const LAS unsigned short*)(L + PK_KN + c * PROW + dk * 2)) * __expf(gl - GC[c]); }
              *(v4u*)(rec + 32768 + p * 16) = pack8(e); } }
        __syncthreads();
        { float X[64]; const bool isu = t < 128; const int col = t & 127;
          const LAS unsigned char* src = L + (isu ? PK_VV : PK_KN) + col * 2;
#pragma unroll
          for (int i = 0; i < 64; ++i) {
              const float egi = EG[i]; const float rhs = bf2f(*(const LAS unsigned short*)(src + i * PROW)) * BT[i] * (isu ? 1.0f : egi);
              float a0 = 0.f, a1 = 0.f, a2 = 0.f, a3 = 0.f;
#pragma unroll
              for (int j4 = 0; j4 < (i + 3) / 4; ++j4) { const f32x4 l = *(const LAS f32x4*)(LM + i * 64 + 4 * j4);
                  if (4 * j4 + 0 < i) a0 += l.x * X[4 * j4 + 0]; if (4 * j4 + 1 < i) a1 += l.y * X[4 * j4 + 1]; if (4 * j4 + 2 < i) a2 += l.z * X[4 * j4 + 2]; if (4 * j4 + 3 < i) a3 += l.w * X[4 * j4 + 3]; }
              X[i] = rhs - ((a0 + a1) + (a2 + a3)); asm volatile("" : "+v"(X[i]) :: "memory"); }
          __syncthreads();
          if (isu) { const int vs = col >> 5, dvl = col & 31;
#pragma unroll
              for (int mt = 0; mt < 2; ++mt)
#pragma unroll
                  for (int h2 = 0; h2 < 2; ++h2) { f32x4* dst = (f32x4*)(rec + REC_A + (size_t)(((vs * 2 + mt) * 64 + dvl + 32 * h2) * 16) * 4);
#pragma unroll
                      for (int a = 0; a < 4; ++a) { const int i0 = 32 * mt + 4 * h2 + 8 * a; dst[a] = (f32x4){X[i0], X[i0 + 1], X[i0 + 2], X[i0 + 3]}; } }
          } else {
#pragma unroll
              for (int i = 0; i < 64; ++i) *(LAS unsigned short*)(L + PK_VV + i * PROW + col * 2) = (unsigned short)(cvt_pk_bf16(-X[i], 0.f) & 0xffffu);
          }
        }
        __syncthreads();
#pragma unroll
        for (int i = 0; i < 4; ++i) { const int p = t + 256 * i; *(v4u*)(rec + p * 16) = afrag_piece_rows<false>(L + PK_VV, EG, p); }
    }
}

__device__ __forceinline__ bf16x8 pack_acc(const f32x16& x, int s) {
    v4u p; p.x = cvt_pk_bf16(x[8 * s], x[8 * s + 1]); p.y = cvt_pk_bf16(x[8 * s + 2], x[8 * s + 3]); p.z = cvt_pk_bf16(x[8 * s + 4], x[8 * s + 5]); p.w = cvt_pk_bf16(x[8 * s + 6], x[8 * s + 7]);
    return __builtin_bit_cast(bf16x8, p);
}
#define MFMA32(a, b, c) __builtin_amdgcn_mfma_f32_32x32x16_bf16((a), (b), (c), 0, 0, 0)
__device__ __forceinline__ void chain_phase(LAS unsigned char* lds, const unsigned char* CH, const float* EGL, float* Oraw, int bh, int tid) {
    const int wid = __builtin_amdgcn_readfirstlane(tid >> 6), lane = tid & 63, b = bh >> 2, h = bh & 3, vs = wid & 3;
    const unsigned char* rec0 = CH + (size_t)bh * NCH * REC;
    const bool comp = wid < 4;
#define CH_STAGE(n, buf) do { _Pragma("unroll") for (int _i = 0; _i < 7; ++_i) { const int _pc = wid * 7 + _i; \
        __builtin_amdgcn_global_load_lds((const unsigned*)(rec0 + (size_t)(n) * REC + _pc * 1024 + lane * 16), (LAS unsigned*)(lds + (buf) * REC_A + _pc * 1024), 16, 0, 0); } } while (0)
    f32x16 S[4], U0, U1, o0, o1;
#pragma unroll
    for (int k = 0; k < 4; ++k)
#pragma unroll
        for (int i = 0; i < 16; ++i) S[k][i] = 0.f;
#pragma unroll
    for (int i = 0; i < 16; ++i) { U0[i] = 0.f; U1[i] = 0.f; o0[i] = 0.f; o1[i] = 0.f; }
    CH_STAGE(0, 0);
    if (comp) { const f32x4* up = (const f32x4*)(rec0 + REC_A) + ((vs * 2 + 0) * 64 + lane) * 4; const f32x4* up1 = up + 64 * 4;
#pragma unroll
        for (int a = 0; a < 4; ++a) { const f32x4 x = up[a], y = up1[a]; U0[4 * a] = x.x; U0[4 * a + 1] = x.y; U0[4 * a + 2] = x.z; U0[4 * a + 3] = x.w; U1[4 * a] = y.x; U1[4 * a + 1] = y.y; U1[4 * a + 2] = y.z; U1[4 * a + 3] = y.w; } }
    asm volatile("s_waitcnt vmcnt(0) lgkmcnt(0)" ::: "memory"); __builtin_amdgcn_s_barrier(); asm volatile("" ::: "memory");
    for (int n = 0; n < NCH; ++n) {
        const int buf = n & 1;
        if (comp && n > 0) { float* op = Oraw + (size_t)(b * SEQ + (n - 1) * 64) * 512 + h * 128 + vs * 32 + (lane & 31);
#pragma unroll
            for (int reg = 0; reg < 16; ++reg) { const int cr = (reg & 3) + 8 * (reg >> 2) + 4 * (lane >> 5); op[(size_t)cr * 512] = o0[reg]; op[(size_t)(32 + cr) * 512] = o1[reg]; } }
        f32x16 N0 = U0, N1 = U1;
        if (n + 1 < NCH) { CH_STAGE(n + 1, buf ^ 1);
            if (comp) { const f32x4* up = (const f32x4*)(rec0 + (size_t)(n + 1) * REC + REC_A) + ((vs * 2 + 0) * 64 + lane) * 4; const f32x4* up1 = up + 64 * 4;
#pragma unroll
                for (int a = 0; a < 4; ++a) { const f32x4 x = up[a], y = up1[a]; N0[4 * a] = x.x; N0[4 * a + 1] = x.y; N0[4 * a + 2] = x.z; N0[4 * a + 3] = x.w; N1[4 * a] = y.x; N1[4 * a + 1] = y.y; N1[4 * a + 2] = y.z; N1[4 * a + 3] = y.w; } } }
        if (comp) {
            const LAS unsigned char* B = lds + buf * REC_A + lane * 16;
            const float egl = EGL[bh * NCH + n];
            f32x16 v0 = U0, v1 = U1;
#pragma unroll
            for (int i = 0; i < 16; ++i) { o0[i] = 0.f; o1[i] = 0.f; }
#pragma unroll
            for (int kt = 0; kt < 4; ++kt)
#pragma unroll
                for (int s = 0; s < 2; ++s) { const bf16x8 sb = pack_acc(S[kt], s);
                    v0 = MFMA32(*(const LAS bf16x8*)(B + ((0 * 4 + kt) * 2 + s) * 1024), sb, v0);
                    v1 = MFMA32(*(const LAS bf16x8*)(B + ((1 * 4 + kt) * 2 + s) * 1024), sb, v1);
                    o0 = MFMA32(*(const LAS bf16x8*)(B + 16384 + ((0 * 4 + kt) * 2 + s) * 1024), sb, o0);
                    o1 = MFMA32(*(const LAS bf16x8*)(B + 16384 + ((1 * 4 + kt) * 2 + s) * 1024), sb, o1); }
            bf16x8 vb[2][2];
            vb[0][0] = pack_acc(v0, 0); vb[0][1] = pack_acc(v0, 1); vb[1][0] = pack_acc(v1, 0); vb[1][1] = pack_acc(v1, 1);
#pragma unroll
            for (int ct = 0; ct < 2; ++ct)
#pragma unroll
                for (int s = 0; s < 2; ++s) {
                    o0 = MFMA32(*(const LAS bf16x8*)(B + 49152 + ((0 * 2 + ct) * 2 + s) * 1024), vb[ct][s], o0);
                    o1 = MFMA32(*(const LAS bf16x8*)(B + 49152 + ((1 * 2 + ct) * 2 + s) * 1024), vb[ct][s], o1); }
#pragma unroll
            for (int kt = 0; kt < 4; ++kt) {
#pragma unroll
                for (int i = 0; i < 16; ++i) S[kt][i] *= egl;
#pragma unroll
                for (int ct = 0; ct < 2; ++ct)
#pragma unroll
                    for (int s = 0; s < 2; ++s) S[kt] = MFMA32(*(const LAS bf16x8*)(B + 32768 + ((kt * 2 + ct) * 2 + s) * 1024), vb[ct][s], S[kt]); }
        }
        U0 = N0; U1 = N1;
        asm volatile("s_waitcnt vmcnt(0) lgkmcnt(0)" ::: "memory"); __builtin_amdgcn_s_barrier(); asm volatile("" ::: "memory");
    }
    if (comp) { float* op = Oraw + (size_t)(b * SEQ + (NCH - 1) * 64) * 512 + h * 128 + vs * 32 + (lane & 31);
#pragma unroll
        for (int reg = 0; reg < 16; ++reg) { const int cr = (reg & 3) + 8 * (reg >> 2) + 4 * (lane >> 5); op[(size_t)cr * 512] = o0[reg]; op[(size_t)(32 + cr) * 512] = o1[reg]; } }
#undef CH_STAGE
}
#if DN_NAIVE
__device__ __forceinline__ void naive_dn(const bf16* QKV, const float* GB, float* Oraw, int unit, int lane) {
    const int bh = unit >> 1, dv = (unit & 1) * 64 + lane, b = bh >> 2, h = bh & 3;
    float S[128];
#pragma unroll
    for (int i = 0; i < 128; ++i) S[i] = 0.f;
    for (int t = 0; t < SEQ; ++t) { const size_t m = (size_t)b * SEQ + t;
        const float al = __expf(GB[m * 8 + h]), be = GB[m * 8 + 4 + h];
        const bf16* qp = QKV + m * 1536 + h * 128; const bf16* kp = qp + 512; const float v = bf2f(qp[1024 + dv]);
        float r = 0.f;
#pragma unroll
        for (int i = 0; i < 128; ++i) { S[i] *= al; r += bf2f(kp[i]) * S[i]; if ((i & 15) == 15) asm volatile("" : "+v"(r) :: "memory"); }
        const float d = be * (v - r); float o = 0.f;
#pragma unroll
        for (int i = 0; i < 128; ++i) { S[i] += bf2f(kp[i]) * d; o += bf2f(qp[i]) * S[i]; if ((i & 15) == 15) asm volatile("" : "+v"(o) :: "memory"); }
        Oraw[m * 512 + h * 128 + dv] = o; }
}
#endif
__device__ __forceinline__ void opost_rows(const float* Oraw, const bf16* P, const float* gdn, bf16* YC, int gw, int NGW, int lane) {
    float gd[8];
#pragma unroll
    for (int e = 0; e < 8; ++e) gd[e] = gdn[(8 * lane + e) & 127];
    for (int m = gw; m < M; m += NGW) {
        const f32x4* op = (const f32x4*)(Oraw + (size_t)m * 512 + 8 * lane); const f32x4 a = op[0], b = op[1];
        float z[8]; unpack8(*(const v4u*)(P + (size_t)m * NP + 3072 + 8 * lane), z);
        float o[8] = {a.x, a.y, a.z, a.w, b.x, b.y, b.z, b.w}; float ss = 0.f;
#pragma unroll
        for (int e = 0; e < 8; ++e) ss += o[e] * o[e];
        ss += __shfl_xor(ss, 1); ss += __shfl_xor(ss, 2); ss += __shfl_xor(ss, 4); ss += __shfl_xor(ss, 8);
        const float r = 1.0f / sqrtf(ss * (1.0f / 128.0f) + EPS);
#pragma unroll
        for (int e = 0; e < 8; ++e) o[e] = o[e] * r * gd[e] * silu_f(z[e]);
        *(v4u*)(YC + (size_t)m * D + 512 + 8 * lane) = pack8(o);
    }
}

__global__ void __launch_bounds__(NWAVES * 64, 2) fwd(Args args) {
    extern __shared__ __attribute__((aligned(16))) unsigned char lds_raw[];
    LAS unsigned char* lds = (LAS unsigned char*)lds_raw;
    const int tid = threadIdx.x, lane = tid & 63, wave = __builtin_amdgcn_readfirstlane(tid >> 6);
    const int G = gridDim.x; const int bx = blockIdx.x; const int vcu = (G % 8 == 0) ? (bx % 8) * (G / 8) + bx / 8 : bx;
    const int gw = vcu * NWAVES + wave, NGW = G * NWAVES;
    unsigned char* ws = args.ws;
    float* MOD = (float*)(ws + WS_MOD); float* GB = (float*)(ws + WS_GB); float* EGL = (float*)(ws + WS_EGL);
    bf16* WinT = (bf16*)(ws + WS_WIN); bf16* WoT = (bf16*)(ws + WS_WO); bf16* WguT = (bf16*)(ws + WS_WGU); bf16* WdT = (bf16*)(ws + WS_WD);
    bf16* H = (bf16*)(ws + WS_H); unsigned char* CH = ws + WS_CH; bf16* P = (bf16*)(ws + WS_P); bf16* ACT = (bf16*)(ws + WS_P); bf16* YC = (bf16*)(ws + WS_YC);
    bf16* QKV = (bf16*)args.out; float* Oraw = args.out; float* OUT = args.out;
    const int lo = args.ph_lo, hi = args.ph_hi;
#ifndef PH_MASK
#define PH_MASK 0xFFF
#endif
#define IN(k) (((PH_MASK >> (k)) & 1) && lo <= (k) && (k) < hi)
#if MK_N_LAUNCHES == 1
#define SEAM(k) do { if (IN(k) && IN((k) + 1)) cg::this_grid().sync(); } while (0)
#else
#define SEAM(k) do { } while (0)
#endif
    if (IN(0)) {
        LAS float* scr = (LAS float*)(lds + wave * 16384);
        constexpr int I_IN = 16 * 112, I_O = 16 * 32, I_GU = 16 * 176, I_DN = 44 * 32, NITEMS = I_IN + I_O + I_GU + I_DN;
        for (int it = gw; it < NITEMS; it += NGW) { int r = it;
            if (r < I_IN) { p0_transpose_item<0>(args.in[I_WIN], D, PIN, 112, WinT, scr, r, lane); continue; } r -= I_IN;
            if (r < I_O) { p0_transpose_item<0>(args.in[I_WOUT], D, D, 32, WoT, scr, r, lane); continue; } r -= I_O;
            if (r < I_GU) { p0_transpose_item<1>(args.in[I_WGU], D, 2 * FF, 176, WguT, scr, r, lane); continue; } r -= I_GU;
            p0_transpose_item<0>(args.in[I_WDN], FF, D, 32, WdT, scr, r, lane); }
        __syncthreads();
        for (int it = bx; it < 256; it += G) p0_mod_item(args, MOD, (LAS float*)lds, it, tid);
    }
    SEAM(0);
    if (IN(1)) adaln_rows<0>(args.in[I_X], args.in[I_GMIX], MOD + 0, MOD + 1024, 6144, H, nullptr, args.in[I_WIN], args.in[I_ALOG], args.in[I_DTB], GB, gw, NGW, lane);
    SEAM(1);
    if (IN(2)) { pg8::Gemm g{H, WinT, M, NP, D}; pg8::StaticOrder S; S.init(M, NP, G, bx); pg8::EpiBf16 E{P, NP};
        pg8::gemm_phase<pg8::EpiBf16, pg8::StaticOrder, true, true>(lds, g, S, E); }
    SEAM(2);
    if (IN(3)) conv_pass(P, args.in[I_CWM], args.in[I_CWQ], args.in[I_GCO], YC, QKV, gw, NGW, lane);
    SEAM(3);
#if DN_NAIVE
    SEAM(4);
    if (IN(5)) { if (bx < 32 && wave == 0) naive_dn(QKV, GB, (float*)(ws + WS_CH), bx, lane); }
    SEAM(5);
    if (IN(6)) opost_rows((const float*)(ws + WS_CH), P, args.in[I_GDN], YC, gw, NGW, lane);
#else
    if (IN(4)) prep_phase(lds, QKV, GB, EGL, CH, tid);
    SEAM(4);
    if (IN(5)) { if (bx < NBH) chain_phase(lds, CH, EGL, Oraw, bx, tid); }
    SEAM(5);
    if (IN(6)) opost_rows(Oraw, P, args.in[I_GDN], YC, gw, NGW, lane);
#endif
    SEAM(6);
    if (IN(7)) { pg8::Gemm g{YC, WoT, M, D, D}; pg8::StaticOrder S; S.init(M, D, G, bx); pg8::EpiResGate E{args.in[I_X], OUT, MOD + 2048, 6144};
        pg8::gemm_phase<pg8::EpiResGate, pg8::StaticOrder, true, true>(lds, g, S, E); }
    SEAM(7);
    if (IN(8)) adaln_rows<1>(OUT, args.in[I_GFFN], MOD + 3072, MOD + 4096, 6144, H, nullptr, nullptr, nullptr, nullptr, nullptr, gw, NGW, lane);
    SEAM(8);
    if (IN(9)) { pg8::Gemm g{H, WguT, M, 2 * FF, D}; pg8::StaticOrder S; S.init(M, 2 * FF, G, bx); pg8::EpiSwiglu E{ACT, FF};
        pg8::gemm_phase<pg8::EpiSwiglu, pg8::StaticOrder, true, true>(lds, g, S, E); }
    SEAM(9);
    if (IN(10)) { pg8::Gemm g{ACT, WdT, M, D, FF}; pg8::StaticOrder S; S.init(M, D, G, bx); pg8::EpiResGate E{OUT, OUT, MOD + 5120, 6144};
        pg8::gemm_phase<pg8::EpiResGate, pg8::StaticOrder, true, true>(lds, g, S, E); }
    SEAM(10);
    if (IN(11)) adaln_rows<2>(OUT, args.in[I_GFIN], MOD + 4 * 6144, MOD + 4 * 6144 + 1024, 2048, nullptr, OUT, nullptr, nullptr, nullptr, nullptr, gw, NGW, lane);
#undef IN
#undef SEAM
}

extern "C" void kernel_launch(void* const* d_in, const int* in_sizes, int n_in, void* d_out, int out_size, void* d_ws, size_t ws_size, hipStream_t stream) {
    static int grid = 0;
    if (grid == 0) {
        if (n_in != 19 || out_size != M * D || ws_size < WS_END) { fprintf(stderr, "kernel_launch: unexpected shapes (n_in %d, out %d, ws %zu)\n", n_in, out_size, ws_size); grid = -1; return; }
        int dev = 0, cus = 0;
        if (hipGetDevice(&dev) != hipSuccess || hipDeviceGetAttribute(&cus, hipDeviceAttributeMultiprocessorCount, dev) != hipSuccess) { grid = -1; return; }
        if (hipFuncSetAttribute((const void*)fwd, hipFuncAttributeMaxDynamicSharedMemorySize, LDS_BYTES) != hipSuccess) { fprintf(stderr, "kernel_launch: hipFuncSetAttribute failed\n"); grid = -1; return; }
        int per_cu = 0;
        if (hipOccupancyMaxActiveBlocksPerMultiprocessor(&per_cu, (const void*)fwd, NWAVES * 64, LDS_BYTES) != hipSuccess || per_cu < 1) { fprintf(stderr, "kernel_launch: occupancy query says %d blocks per CU\n", per_cu); }
        (void)hipGetLastError();
        grid = cus;
    }
    if (grid < 0) return;
    Args a{};
    for (int i = 0; i < 19; ++i) a.in[i] = (const float*)d_in[i];
    a.out = (float*)d_out; a.ws = (unsigned char*)d_ws;
#if MK_N_LAUNCHES == 1
    a.ph_lo = 0; a.ph_hi = PH_END;
    void* kargs[] = {&a};
    hipError_t e = hipLaunchCooperativeKernel((const void*)fwd, dim3(grid), dim3(NWAVES * 64), kargs, LDS_BYTES, stream);
    if (e != hipSuccess) fprintf(stderr, "kernel_launch: cooperative launch failed: %s (grid %d)\n", hipGetErrorString(e), grid);
#else
    for (int ph = 0; ph < PH_END; ++ph) { a.ph_lo = ph; a.ph_hi = ph + 1; hipLaunchKernelGGL(fwd, dim3(grid), dim3(NWAVES * 64), LDS_BYTES, stream, a); }
#endif
}
```

```cpp
#include <hip/hip_runtime.h>
#include <hip/hip_cooperative_groups.h>
#include <cstdio>
#include <cstdint>
namespace cg = cooperative_groups;
#ifndef MK_N_LAUNCHES
#define MK_N_LAUNCHES 1
#endif
#ifndef DN_NAIVE
#define DN_NAIVE 0
#endif
namespace pg8 {
#define PG8_LAS __attribute__((address_space(3)))
typedef unsigned short bf16_t;
typedef short bf16x8 __attribute__((ext_vector_type(8)));
typedef float f32x4 __attribute__((ext_vector_type(4)));
typedef unsigned u32x4 __attribute__((ext_vector_type(4)));
constexpr int BM = 256, BK = 64, HALF = 128, HTB = HALF * BK * 2  , STAGE_BYTES = 8 * HTB, NXCD = 8, WGM = 8;

__host__ __device__ __forceinline__ int lds_byte(int r, int c) { const int st = (r >> 4) * 2 + (c >> 5), rr = r & 15, cc = c & 31, ob = rr * 64 + cc * 2; return st * 1024 + (ob ^ (((ob >> 9) & 1) << 5)); }
__host__ __device__ __forceinline__ void stage_rc(int b, int& R, int& C) { const int st = b / 1024, sb = b % 1024, swz = sb ^ (((sb >> 9) & 1) << 5); R = (st >> 1) * 16 + swz / 64; C = (st & 1) * 32 + (swz % 64) / 2; }
__host__ __device__ __forceinline__ int perm32(int rho) { const int n = rho >> 4, i = rho & 15; return 8 * (i >> 2) + 4 * n + (i & 3); }

struct Unit { int pm, pn; };
struct Gemm { const bf16_t* A; const bf16_t* Bt; int M, N, K; };

struct StaticOrder {
    int nM, nN, nwg, G, c;
    __host__ __device__ void init(int M, int N, int G_, int c_) { nM = M / BM; nN = N / BM; nwg = nM * nN; G = G_; c = c_; }
    __host__ __device__ bool next(int i, Unit& u) const {
        const long L = (long)i * G + c; if (L >= nwg) return false;
        int wgid = (int)L; { const int q = nwg / NXCD, r = nwg % NXCD, xcd = wgid % NXCD, off = wgid / NXCD; wgid = (xcd < r ? xcd * (q + 1) : r * (q + 1) + (xcd - r) * q) + off; }
        const int nig = WGM * nN, gid = wgid / nig, fm = gid * WGM, gsz = (nM - fm) < WGM ? (nM - fm) : WGM;
        u.pm = fm + ((wgid % nig) % gsz); u.pn = (wgid % nig) / gsz; return true;
    }
    __device__ __forceinline__ void a_ready(const Unit&) const {}
    __device__ __forceinline__ void done(const Unit&) const {}
};

typedef float f32x2 __attribute__((ext_vector_type(2)));
typedef __bf16 bf16x2v __attribute__((ext_vector_type(2)));
__device__ __forceinline__ unsigned cvt_pk_bf16(float lo, float hi) { f32x2 v = {lo, hi}; bf16x2v r = __builtin_convertvector(v, bf16x2v); return __builtin_bit_cast(unsigned, r); }
__device__ __forceinline__ float silu_f(float x) { return x * __builtin_amdgcn_rcpf(1.0f + __builtin_amdgcn_exp2f(-1.4426950408889634f * x)); }

struct EpiBf16 {
    static constexpr bool PERM = true, AFTER_DRAIN = false;
    bf16_t* O; int ldc;
    __device__ __forceinline__ void operator()(const f32x4 (&acc)[2][2][4][2], const Unit& u, int wr, int wc, int fr, int fq) const {
        const int row0 = u.pm * BM + wr * 64 + fr; const int col0 = u.pn * BM + wc * 32 + 8 * fq;
#pragma unroll
        for (int ai = 0; ai < 2; ++ai)
#pragma unroll
            for (int m = 0; m < 4; ++m) { bf16_t* rowp = O + (size_t)(row0 + ai * HALF + m * 16) * ldc + col0;
#pragma unroll
                for (int bj = 0; bj < 2; ++bj) { const f32x4 v0 = acc[ai][bj][m][0], v1 = acc[ai][bj][m][1];
                    u32x4 w; w.x = cvt_pk_bf16(v0[0], v0[1]); w.y = cvt_pk_bf16(v0[2], v0[3]); w.z = cvt_pk_bf16(v1[0], v1[1]); w.w = cvt_pk_bf16(v1[2], v1[3]);
                    *(u32x4*)(rowp + bj * HALF) = w; } }
    }
};
struct EpiSwiglu {
    static constexpr bool PERM = true, AFTER_DRAIN = false;
    bf16_t* O; int ldc;
    __device__ __forceinline__ void operator()(const f32x4 (&acc)[2][2][4][2], const Unit& u, int wr, int wc, int fr, int fq) const {
        const int row0 = u.pm * BM + wr * 64 + fr; const int col0 = u.pn * HALF + wc * 32 + 8 * fq;
#pragma unroll
        for (int ai = 0; ai < 2; ++ai)
#pragma unroll
            for (int m = 0; m < 4; ++m) { bf16_t* rowp = O + (size_t)(row0 + ai * HALF + m * 16) * ldc + col0;
                const f32x4 g0 = acc[ai][0][m][0], g1 = acc[ai][0][m][1], u0 = acc[ai][1][m][0], u1 = acc[ai][1][m][1];
                u32x4 w; w.x = cvt_pk_bf16(silu_f(g0[0]) * u0[0], silu_f(g0[1]) * u0[1]); w.y = cvt_pk_bf16(silu_f(g0[2]) * u0[2], silu_f(g0[3]) * u0[3]);
                w.z = cvt_pk_bf16(silu_f(g1[0]) * u1[0], silu_f(g1[1]) * u1[1]); w.w = cvt_pk_bf16(silu_f(g1[2]) * u1[2], silu_f(g1[3]) * u1[3]);
                *(u32x4*)rowp = w; }
    }
};
struct EpiResGate {
    static constexpr bool PERM = false, AFTER_DRAIN = false;
    const float* base; float* out; const float* gate;
    int gstride;
    __device__ __forceinline__ void operator()(const f32x4 (&acc)[2][2][4][2], const Unit& u, int wr, int wc, int fr, int fq) const {
        const int b = u.pm >> 5;
        const int col0 = u.pn * BM + wc * 32 + 4 * fq; const float* gp = gate + (size_t)b * gstride + col0;
        f32x4 gv[2][2];
#pragma unroll
        for (int bj = 0; bj < 2; ++bj)
#pragma unroll
            for (int n = 0; n < 2; ++n) gv[bj][n] = *(const f32x4*)(gp + bj * HALF + n * 16);
#pragma unroll
        for (int ai = 0; ai < 2; ++ai)
#pragma unroll
            for (int m = 0; m < 4; ++m) { const size_t off = (size_t)(u.pm * BM + ai * HALF + wr * 64 + m * 16 + fr) * 1024 + col0;
#pragma unroll
                for (int bj = 0; bj < 2; ++bj)
#pragma unroll
                    for (int n = 0; n < 2; ++n) { const f32x4 bs = *(const f32x4*)(base + off + bj * HALF + n * 16);
                        *(f32x4*)(out + off + bj * HALF + n * 16) = bs + gv[bj][n] * acc[ai][bj][m][n]; } }
    }
};

template <class Epi, class Sched, bool ALIGN_EPI = false, bool SP2 = false>
__device__ __forceinline__ void gemm_phase(PG8_LAS unsigned char* lds, const Gemm g, const Sched& S, const Epi& E) {
    const int tid = threadIdx.x, wid = __builtin_amdgcn_readfirstlane(tid >> 6), lane = tid & 63, wr = wid >> 2, wc = wid & 3, fr = lane & 15, fq = lane >> 4;
    const int K = g.K, nt = K / BK;
    unsigned voffA[2], voffB[2];
#pragma unroll
    for (int i = 0; i < 2; ++i) { int R, C; stage_rc(tid * 16 + i * 8192, R, C); const int Rb = Epi::PERM ? ((R & ~31) + perm32(R & 31)) : R;
        voffA[i] = (unsigned)(R * K + C) * 2u; voffB[i] = (unsigned)(Rb * K + C) * 2u; }
    const size_t kstep = (size_t)(BK * 2);
    const size_t hstep = (size_t)HALF * K * 2;
    const size_t tstep = 2 * hstep;
    const unsigned ldsw = (unsigned)wid * 1024u;
    const int aoff = lds_byte(wr * 64 + fr, fq * 8), boff = lds_byte(wc * 32 + fr, fq * 8);
#define PG8_SA(b, h) (((b) * 2 + (h)) * HTB)
#define PG8_SB(b, h) ((4 + (b) * 2 + (h)) * HTB)
#define PG8_STAGE(bufoff, gbase, voff) do { _Pragma("unroll") for (int _i = 0; _i < 2; ++_i) \
        __builtin_amdgcn_global_load_lds((const unsigned*)((const char*)(gbase) + (voff)[_i]), (PG8_LAS unsigned*)(lds + (bufoff) + ldsw + _i * 8192), 16, 0, 0); } while (0)
#define PG8_LDA(dst, b, h) do { _Pragma("unroll") for (int m = 0; m < 4; ++m) _Pragma("unroll") for (int k = 0; k < 2; ++k) dst[m][k] = *(const PG8_LAS bf16x8*)(lds + PG8_SA(b, h) + aoff + m * 2048 + k * 1024); } while (0)
#define PG8_LDB(dst, b, h) do { _Pragma("unroll") for (int n = 0; n < 2; ++n) _Pragma("unroll") for (int k = 0; k < 2; ++k) dst[n][k] = *(const PG8_LAS bf16x8*)(lds + PG8_SB(b, h) + boff + n * 2048 + k * 1024); } while (0)
#define PG8_MMA(ai, bj, At, Bt) do { __builtin_amdgcn_s_setprio(1); _Pragma("unroll") for (int m = 0; m < 4; ++m) _Pragma("unroll") for (int n = 0; n < 2; ++n) _Pragma("unroll") for (int k = 0; k < 2; ++k) \
        acc[ai][bj][m][n] = __builtin_amdgcn_mfma_f32_16x16x32_bf16(Bt[n][k], At[m][k], acc[ai][bj][m][n], 0, 0, 0); __builtin_amdgcn_s_setprio(0); } while (0)
#define PG8_WAIT_V(n) asm volatile("s_waitcnt vmcnt(" #n ")" ::: "memory")
#define PG8_WAIT_L(n) asm volatile("s_waitcnt lgkmcnt(" #n ")" ::: "memory")
#define PG8_BAR __builtin_amdgcn_s_barrier()
#define PG8_SCHED __builtin_amdgcn_sched_barrier(0)
    Unit cur, nxt; int ui = 0;
    if (!S.next(0, cur)) return;
    f32x4 acc[2][2][4][2];
#pragma unroll
    for (int a = 0; a < 2; ++a)
#pragma unroll
        for (int b = 0; b < 2; ++b)
#pragma unroll
            for (int m = 0; m < 4; ++m)
#pragma unroll
                for (int n = 0; n < 2; ++n) acc[a][b][m][n] = (f32x4){0.f, 0.f, 0.f, 0.f};
    bf16x8 At[4][2], B0[2][2], B1[2][2];
    const char* cA = (const char*)g.A + (size_t)cur.pm * tstep; const char* cB = (const char*)g.Bt + (size_t)cur.pn * tstep;
    S.a_ready(cur);
    if constexpr (SP2) {
        PG8_STAGE(PG8_SB(0, 0), cB, voffB); PG8_STAGE(PG8_SB(0, 1), cB + hstep, voffB); PG8_STAGE(PG8_SA(0, 0), cA, voffA); PG8_STAGE(PG8_SA(0, 1), cA + hstep, voffA);
        if (wr == 1) PG8_BAR;
        PG8_WAIT_V(2); PG8_BAR;
        PG8_STAGE(PG8_SB(1, 0), cB + kstep, voffB); PG8_STAGE(PG8_SA(1, 0), cA + kstep, voffA); PG8_STAGE(PG8_SB(1, 1), cB + hstep + kstep, voffB);
        PG8_WAIT_V(6); PG8_BAR;
    } else {
        PG8_STAGE(PG8_SB(0, 0), cB, voffB); PG8_STAGE(PG8_SA(0, 0), cA, voffA); PG8_STAGE(PG8_SB(0, 1), cB + hstep, voffB); PG8_STAGE(PG8_SA(0, 1), cA + hstep, voffA);
        if (wr == 1) PG8_BAR;
        PG8_WAIT_V(4); PG8_BAR;
        PG8_STAGE(PG8_SB(1, 0), cB + kstep, voffB); PG8_STAGE(PG8_SA(1, 0), cA + kstep, voffA); PG8_STAGE(PG8_SB(1, 1), cB + hstep + kstep, voffB);
        PG8_WAIT_V(6); PG8_BAR;
    }
    for (;;) {
        const bool has_next = S.next(ui + 1, nxt);
        const char* nA = has_next ? (const char*)g.A + (size_t)nxt.pm * tstep : cA; const char* nB = has_next ? (const char*)g.Bt + (size_t)nxt.pn * tstep : cB;
        for (int t = 0; t < nt; t += 2) {
            const bool last = (t == nt - 2);
            const char* a1 = cA + (size_t)(t + 1) * kstep;
            const char* a2 = last ? nA : cA + (size_t)(t + 2) * kstep; const char* b2 = last ? nB : cB + (size_t)(t + 2) * kstep;
            const char* a3 = a2 + kstep; const char* b3 = b2 + kstep;
            if (last && has_next) S.a_ready(nxt);
            if constexpr (SP2) {
            PG8_LDB(B0, 0, 0); PG8_LDB(B1, 0, 1); PG8_SCHED; PG8_LDA(At, 0, 0); PG8_STAGE(PG8_SA(1, 1), a1 + hstep, voffA);
            PG8_WAIT_V(8); PG8_WAIT_L(0); PG8_BAR; PG8_MMA(0, 0, At, B0); PG8_MMA(0, 1, At, B1); PG8_BAR; PG8_SCHED;
            PG8_LDA(At, 0, 1); PG8_STAGE(PG8_SB(0, 0), b2, voffB); PG8_STAGE(PG8_SB(0, 1), b2 + hstep, voffB); PG8_STAGE(PG8_SA(0, 0), a2, voffA);
            PG8_WAIT_V(8); PG8_WAIT_L(0); PG8_BAR; PG8_MMA(1, 0, At, B0); PG8_MMA(1, 1, At, B1); PG8_BAR; PG8_SCHED;
            PG8_LDB(B0, 1, 0); PG8_LDB(B1, 1, 1); PG8_SCHED; PG8_LDA(At, 1, 0); PG8_STAGE(PG8_SA(0, 1), a2 + hstep, voffA);
            PG8_WAIT_V(8); PG8_WAIT_L(0); PG8_BAR; PG8_MMA(0, 0, At, B0); PG8_MMA(0, 1, At, B1); PG8_BAR; PG8_SCHED;
            PG8_LDA(At, 1, 1); PG8_STAGE(PG8_SB(1, 0), b3, voffB); PG8_STAGE(PG8_SB(1, 1), b3 + hstep, voffB); PG8_STAGE(PG8_SA(1, 0), a3, voffA);
            PG8_WAIT_V(8); PG8_WAIT_L(0); PG8_BAR; PG8_MMA(1, 0, At, B0); PG8_MMA(1, 1, At, B1); PG8_BAR; PG8_SCHED;
            } else {
            PG8_LDB(B0, 0, 0); PG8_SCHED; PG8_LDA(At, 0, 0); PG8_STAGE(PG8_SA(1, 1), a1 + hstep, voffA);
            PG8_WAIT_L(8); PG8_BAR; PG8_WAIT_L(0); PG8_MMA(0, 0, At, B0); PG8_BAR; PG8_SCHED;
            PG8_LDB(B1, 0, 1); PG8_STAGE(PG8_SB(0, 0), b2, voffB);
            PG8_BAR; PG8_WAIT_L(0); PG8_MMA(0, 1, At, B1); PG8_BAR;
            PG8_LDA(At, 0, 1); PG8_STAGE(PG8_SA(0, 0), a2, voffA);
            PG8_BAR; PG8_WAIT_L(0); PG8_MMA(1, 0, At, B0); PG8_BAR; PG8_SCHED;
            PG8_STAGE(PG8_SB(0, 1), b2 + hstep, voffB);
            PG8_WAIT_V(6); PG8_BAR; PG8_MMA(1, 1, At, B1); PG8_BAR;
            PG8_LDB(B0, 1, 0); PG8_SCHED; PG8_LDA(At, 1, 0); PG8_STAGE(PG8_SA(0, 1), a2 + hstep, voffA);
            PG8_WAIT_L(8); PG8_BAR; PG8_WAIT_L(0); PG8_MMA(0, 0, At, B0); PG8_BAR; PG8_SCHED;
            PG8_LDB(B1, 1, 1); PG8_STAGE(PG8_SB(1, 0), b3, voffB);
            PG8_BAR; PG8_WAIT_L(0); PG8_MMA(0, 1, At, B1); PG8_BAR;
            PG8_LDA(At, 1, 1); PG8_STAGE(PG8_SA(1, 0), a3, voffA);
            PG8_BAR; PG8_WAIT_L(0); PG8_MMA(1, 0, At, B0); PG8_BAR; PG8_SCHED;
            PG8_STAGE(PG8_SB(1, 1), b3 + hstep, voffB);
            PG8_WAIT_V(6); PG8_BAR; PG8_MMA(1, 1, At, B1); PG8_BAR;
            }
        }
        if constexpr (ALIGN_EPI) { if (wr == 0) PG8_BAR; }
        if constexpr (!Epi::AFTER_DRAIN) { E(acc, cur, wr, wc, fr, fq); S.done(cur); }
        if (!has_next) break;
#pragma unroll
        for (int a = 0; a < 2; ++a)
#pragma unroll
            for (int b = 0; b < 2; ++b)
#pragma unroll
                for (int m = 0; m < 4; ++m)
#pragma unroll
                    for (int n = 0; n < 2; ++n) acc[a][b][m][n] = (f32x4){0.f, 0.f, 0.f, 0.f};
        cur = nxt; cA = nA; cB = nB; ++ui;
        if constexpr (ALIGN_EPI) { if (wr == 1) PG8_BAR; }
    }
    PG8_WAIT_V(0);
    if constexpr (!ALIGN_EPI) { if (wr == 0) PG8_BAR; }
    PG8_BAR;
    if constexpr (Epi::AFTER_DRAIN) { E.fused(acc, cur, wr, wc, fr, fq, lds, wid, lane); S.done(cur); }
#undef PG8_SA
#undef PG8_SB
#undef PG8_STAGE
#undef PG8_LDA
#undef PG8_LDB
#undef PG8_MMA
#undef PG8_WAIT_V
#undef PG8_WAIT_L
#undef PG8_BAR
#undef PG8_SCHED
}
}

constexpr int NWAVES = 8;
constexpr int BATCH = 4, SEQ = 8192, D = 1024, M = BATCH * SEQ;
constexpr int PIN = 3592, NP = 3584;
constexpr int FF = 2816, NCH = 128, NBH = 16;
constexpr int PH_END = 12;
constexpr float EPS = 1e-6f;
constexpr size_t MiB = 1u << 20;
constexpr size_t WS_MOD = 1 * MiB;
constexpr size_t WS_GB = 2 * MiB;
constexpr size_t WS_EGL = 3 * MiB;
constexpr size_t WS_WIN = 4 * MiB, WS_WO = 11 * MiB, WS_WGU = 13 * MiB, WS_WD = 24 * MiB;
constexpr size_t WS_H = 32 * MiB;
constexpr size_t WS_CH = 32 * MiB;
constexpr size_t WS_P = 208 * MiB;
constexpr size_t WS_YC = 432 * MiB;
constexpr size_t WS_END = 496 * MiB;
constexpr int REC = 90112;
constexpr int REC_A = 57344;
constexpr int LDS_BYTES = 147456;

#define LAS __attribute__((address_space(3)))
typedef unsigned short bf16;
typedef unsigned v4u __attribute__((ext_vector_type(4)));
typedef unsigned v2u __attribute__((ext_vector_type(2)));
typedef float f32x4 __attribute__((ext_vector_type(4)));
typedef float f32x16 __attribute__((ext_vector_type(16)));
typedef short bf16x8 __attribute__((ext_vector_type(8)));
#define LDS_WAIT() asm volatile("s_waitcnt lgkmcnt(0)" ::: "memory")
using pg8::cvt_pk_bf16; using pg8::silu_f;
__device__ __forceinline__ float bf2f(unsigned short u) { return __uint_as_float((unsigned)u << 16); }
__device__ __forceinline__ float bflo(unsigned w) { return __uint_as_float(w << 16); }
__device__ __forceinline__ float bfhi(unsigned w) { return __uint_as_float(w & 0xffff0000u); }
__device__ __forceinline__ float wave_sum(float v) {
#pragma unroll
    for (int o = 1; o < 64; o <<= 1) v += __shfl_xor(v, o);
    return v;
}
__device__ __forceinline__ void unpack8(v4u w, float (&f)[8]) { f[0] = bflo(w.x); f[1] = bfhi(w.x); f[2] = bflo(w.y); f[3] = bfhi(w.y); f[4] = bflo(w.z); f[5] = bfhi(w.z); f[6] = bflo(w.w); f[7] = bfhi(w.w); }
__device__ __forceinline__ v4u pack8(const float (&f)[8]) { v4u w; w.x = cvt_pk_bf16(f[0], f[1]); w.y = cvt_pk_bf16(f[2], f[3]); w.z = cvt_pk_bf16(f[4], f[5]); w.w = cvt_pk_bf16(f[6], f[7]); return w; }

struct Args { const float* in[19]; float* out; unsigned char* ws; int ph_lo, ph_hi; };
enum { I_X = 0, I_C, I_WADA, I_BADA, I_WADAF, I_BADAF, I_GMIX, I_GFFN, I_GFIN, I_WIN, I_CWM, I_CWQ, I_ALOG, I_DTB, I_GCO, I_GDN, I_WOUT, I_WGU, I_WDN };

template <int MODE>
__device__ __forceinline__ void p0_transpose_item(const float* W, int K, int ld, int nblk, bf16* WT, LAS float* scr, int item, int lane) {
    const int kb = item / nblk, nb = item % nblk, k0 = 64 * kb, n0 = 32 * nb;
    f32x4 ld4[8];
#pragma unroll
    for (int i = 0; i < 8; ++i) ld4[i] = *(const f32x4*)(W + (size_t)(k0 + 8 * i + (lane >> 3)) * ld + n0 + 4 * (lane & 7));
#pragma unroll
    for (int i = 0; i < 8; ++i) { LAS float* d = scr + (8 * i + (lane >> 3)) * 33 + 4 * (lane & 7); d[0] = ld4[i].x; d[1] = ld4[i].y; d[2] = ld4[i].z; d[3] = ld4[i].w; }
    LDS_WAIT(); asm volatile("" ::: "memory");
    int r0 = n0;
    if (MODE == 1) { r0 = n0 < FF ? 256 * (n0 / 128) + (n0 % 128) : 256 * ((n0 - FF) / 128) + 128 + ((n0 - FF) % 128); }
    const int c = lane & 7;
#pragma unroll
    for (int j = 0; j < 4; ++j) { const int n = (lane >> 3) + 8 * j; const LAS float* s = scr + (8 * c) * 33 + n;
        v4u o; o.x = cvt_pk_bf16(s[0 * 33], s[1 * 33]); o.y = cvt_pk_bf16(s[2 * 33], s[3 * 33]); o.z = cvt_pk_bf16(s[4 * 33], s[5 * 33]); o.w = cvt_pk_bf16(s[6 * 33], s[7 * 33]);
        *(v4u*)(WT + (size_t)(r0 + n) * K + k0 + 8 * c) = o; }
    LDS_WAIT(); asm volatile("" ::: "memory");
}
__device__ __forceinline__ void p0_mod_item(const Args& a, float* MOD, const LAS float* SC, LAS float* red, int item, int tid) {
    const int c4 = tid & 7, ks = tid >> 3, col0 = item * 32;
    const bool fin = col0 >= 6144; const float* W = fin ? a.in[I_WADAF] : a.in[I_WADA]; const int ld = fin ? 2048 : 6144, cb = (fin ? col0 - 6144 : col0);
    f32x4 w[16];
#pragma unroll
    for (int kk = 0; kk < 16; ++kk) w[kk] = *(const f32x4*)(W + (size_t)(16 * ks + kk) * ld + cb + 4 * c4);
    f32x4 acc[4];
#pragma unroll
    for (int b = 0; b < 4; ++b) acc[b] = (f32x4){0.f, 0.f, 0.f, 0.f};
#pragma unroll
    for (int kk = 0; kk < 16; ++kk) { const f32x4 s = *(const LAS f32x4*)(SC + (16 * ks + kk) * 4); acc[0] += s.x * w[kk]; acc[1] += s.y * w[kk]; acc[2] += s.z * w[kk]; acc[3] += s.w * w[kk]; }
#pragma unroll
    for (int b = 0; b < 4; ++b) *(LAS f32x4*)(red + (ks * 4 + b) * 32 + 4 * c4) = acc[b];
    __syncthreads();
    if (tid < 128) { const int b = tid >> 5, cl = tid & 31; float s = 0.f;
#pragma unroll 16
        for (int k = 0; k < 64; ++k) s += red[(k * 4 + b) * 32 + cl];
        const int c = cb + cl;
        s += fin ? a.in[I_BADAF][c] : a.in[I_BADA][c];
        if (fin) MOD[4 * 6144 + b * 2048 + c] = s; else MOD[b * 6144 + c] = s; }
    __syncthreads();
}

template <int MODE>
__device__ __forceinline__ void adaln_one(const f32x4 (&xin)[4], const f32x4 (&gs)[4], const f32x4 (&sh)[4], int m, bf16* Hout, float* Fout, const LAS float* TT, const float* a_log, const float* dt_bias, float* GB, int lane) {
    f32x4 v[4]; float ss = 0.f;
#pragma unroll
    for (int j = 0; j < 4; ++j) { v[j] = xin[j]; ss += (v[j].x * v[j].x + v[j].y * v[j].y) + (v[j].z * v[j].z + v[j].w * v[j].w); }
    const float rinv = 1.0f / sqrtf(wave_sum(ss) * (1.0f / D) + EPS);
#pragma unroll
    for (int j = 0; j < 4; ++j) v[j] = (v[j] * rinv) * gs[j] + sh[j];
    if (MODE == 2) { f32x4* o = (f32x4*)(Fout + (size_t)m * D) + lane;
#pragma unroll
        for (int j = 0; j < 4; ++j) o[64 * j] = v[j];
    } else { v2u* o = (v2u*)(Hout + (size_t)m * D) + lane;
#pragma unroll
        for (int j = 0; j < 4; ++j) { v2u w; w.x = cvt_pk_bf16(v[j].x, v[j].y); w.y = cvt_pk_bf16(v[j].z, v[j].w); o[64 * j] = w; } }
    if (MODE == 0) {
        float d[8];
#pragma unroll
        for (int e = 0; e < 8; ++e) { float s = 0.f;
#pragma unroll
            for (int j = 0; j < 4; ++j) { const f32x4 t = *(const LAS f32x4*)(TT + e * 1024 + 4 * (lane + 64 * j)); s += (v[j].x * t.x + v[j].y * t.y) + (v[j].z * t.z + v[j].w * t.w); }
            asm volatile("" : "+v"(s) :: "memory"); d[e] = s; }
        float k4[4], k2[2], k1;
        { const bool hi = (lane & 32) != 0;
#pragma unroll
          for (int i = 0; i < 4; ++i) { const float snd = hi ? d[i] : d[4 + i]; const float kp = hi ? d[4 + i] : d[i]; k4[i] = kp + __shfl_xor(snd, 32); } }
        { const bool hi = (lane & 16) != 0;
#pragma unroll
          for (int i = 0; i < 2; ++i) { const float snd = hi ? k4[i] : k4[2 + i]; const float kp = hi ? k4[2 + i] : k4[i]; k2[i] = kp + __shfl_xor(snd, 16); } }
        { const bool hi = (lane & 8) != 0; const float snd = hi ? k2[0] : k2[1]; const float kp = hi ? k2[1] : k2[0]; k1 = kp + __shfl_xor(snd, 8); }
        k1 += __shfl_xor(k1, 4); k1 += __shfl_xor(k1, 2); k1 += __shfl_xor(k1, 1);
        if ((lane & 7) == 0) { const int e = lane >> 3; float r;
            if (e < 4) { const float xx = k1 + dt_bias[e]; const float sp = fmaxf(xx, 0.f) + log1pf(__expf(-fabsf(xx))); r = -__expf(a_log[e]) * sp; }
            else r = 1.0f / (1.0f + __expf(-k1));
            GB[(size_t)m * 8 + e] = r; }
    }
}
template <int MODE>
__device__ __forceinline__ void adaln_rows(const float* X, const float* gain, const float* shiftp, const float* scalep, int mstride, bf16* Hout, float* Fout,
                                           const LAS float* TT, const float* a_log, const float* dt_bias, float* GB, int gw, int NGW, int lane) {
    for (int blk = gw; blk < M / 16; blk += NGW) {
        const int m0 = blk * 16, b = m0 >> 13;
        f32x4 gs[4], sh[4];
        { const f32x4* g4 = (const f32x4*)gain + lane; const f32x4* sh4 = (const f32x4*)(shiftp + (size_t)b * mstride) + lane; const f32x4* sc4 = (const f32x4*)(scalep + (size_t)b * mstride) + lane;
#pragma unroll
          for (int j = 0; j < 4; ++j) { gs[j] = g4[64 * j] * (1.0f + sc4[64 * j]); sh[j] = sh4[64 * j]; } }
        f32x4 c0[4], c1[4];
        { const f32x4* xr = (const f32x4*)(X + (size_t)m0 * D) + lane;
#pragma unroll
          for (int j = 0; j < 4; ++j) { c0[j] = xr[64 * j]; c1[j] = xr[256 + 64 * j]; } }
#pragma unroll 1
        for (int i = 0; i < 16; i += 2) {
            f32x4 n0[4], n1[4];
            { const int mn = (i + 2 < 16) ? m0 + i + 2 : m0; const f32x4* xr = (const f32x4*)(X + (size_t)mn * D) + lane;
#pragma unroll
              for (int j = 0; j < 4; ++j) { n0[j] = xr[64 * j]; n1[j] = xr[256 + 64 * j]; } }
            adaln_one<MODE>(c0, gs, sh, m0 + i, Hout, Fout, TT, a_log, dt_bias, GB, lane);
            adaln_one<MODE>(c1, gs, sh, m0 + i + 1, Hout, Fout, TT, a_log, dt_bias, GB, lane);
#pragma unroll
            for (int j = 0; j < 4; ++j) { c0[j] = n0[j]; c1[j] = n1[j]; }
        }
    }
}

__device__ __forceinline__ void conv_qkv(const bf16* P, const float* cwq, bf16* QKV, int X, int t0, bool first, int lane) {
    const int colp = 1536 + 512 * X + 8 * lane, colo = 512 * X + 8 * lane;
    v4u raw[19];
#pragma unroll
    for (int t = 0; t < 19; ++t) { raw[t] = (v4u){0u, 0u, 0u, 0u}; if (t >= 3 || !first) raw[t] = *(const v4u*)(P + (size_t)(t0 - 3 + t) * NP + colp); }
    float w0[8], w1[8], w2[8], w3[8], h3[8], h2[8], h1[8];
#pragma unroll
    for (int e = 0; e < 8; ++e) { w0[e] = cwq[0 * 1536 + colo + e]; w1[e] = cwq[1 * 1536 + colo + e]; w2[e] = cwq[2 * 1536 + colo + e]; w3[e] = cwq[3 * 1536 + colo + e]; }
    unpack8(raw[0], h3); unpack8(raw[1], h2); unpack8(raw[2], h1);
#pragma unroll
    for (int t = 0; t < 16; ++t) { const int m = t0 + t; float x[8], y[8]; unpack8(raw[3 + t], x); float ss = 0.f;
#pragma unroll
        for (int e = 0; e < 8; ++e) { const float c = w0[e] * h3[e] + w1[e] * h2[e] + w2[e] * h1[e] + w3[e] * x[e]; y[e] = silu_f(c); ss += y[e] * y[e]; h3[e] = h2[e]; h2[e] = h1[e]; h1[e] = x[e]; }
        if (X < 2) { ss += __shfl_xor(ss, 1); ss += __shfl_xor(ss, 2); ss += __shfl_xor(ss, 4); ss += __shfl_xor(ss, 8);
            float r = 1.0f / sqrtf(ss + EPS); if (X == 0) r *= 0.08838834764831845f;
#pragma unroll
            for (int e = 0; e < 8; ++e) y[e] *= r; }
        *(v4u*)(QKV + (size_t)m * 1536 + colo) = pack8(y); }
}
__device__ __forceinline__ void conv_pass(const bf16* P, const float* cwm, const float* cwq, const float* gco, bf16* YC, bf16* QKV, int gw, int NGW, int lane) {
    for (int run = gw; run < M / 16; run += NGW) {
        const int t0 = run * 16; const bool first = (t0 & (SEQ - 1)) == 0;
        { float w0[8], w1[8], w2[8], gc[8], u2[8], u1[8]; const int c0 = 8 * lane;
#pragma unroll
          for (int e = 0; e < 8; ++e) { w0[e] = cwm[c0 + e]; w1[e] = cwm[512 + c0 + e]; w2[e] = cwm[1024 + c0 + e]; gc[e] = gco[c0 + e]; u2[e] = 0.f; u1[e] = 0.f; }
          if (!first) { float a[8], b[8]; unpack8(*(const v4u*)(P + (size_t)(t0 - 2) * NP + 512 + c0), a); unpack8(*(const v4u*)(P + (size_t)(t0 - 2) * NP + 1024 + c0), b);
#pragma unroll
              for (int e = 0; e < 8; ++e) u2[e] = a[e] * b[e];
              unpack8(*(const v4u*)(P + (size_t)(t0 - 1) * NP + 512 + c0), a); unpack8(*(const v4u*)(P + (size_t)(t0 - 1) * NP + 1024 + c0), b);
#pragma unroll
              for (int e = 0; e < 8; ++e) u1[e] = a[e] * b[e]; }
#pragma unroll 1
          for (int tb = 0; tb < 16; tb += 8) {
              v4u rb[8], rc[8], rh[8];
#pragma unroll
              for (int t = 0; t < 8; ++t) { const bf16* pr = P + (size_t)(t0 + tb + t) * NP + c0; rb[t] = *(const v4u*)pr; rc[t] = *(const v4u*)(pr + 512); rh[t] = *(const v4u*)(pr + 1024); }
#pragma unroll
              for (int t = 0; t < 8; ++t) { const int m = t0 + tb + t; float gb[8], a[8], b[8], y[8]; unpack8(rb[t], gb); unpack8(rc[t], a); unpack8(rh[t], b); float ss = 0.f;
#pragma unroll
                  for (int e = 0; e < 8; ++e) { const float u0 = a[e] * b[e]; y[e] = gb[e] * (w0[e] * u2[e] + w1[e] * u1[e] + w2[e] * u0); ss += y[e] * y[e]; u2[e] = u1[e]; u1[e] = u0; }
                  ss += __shfl_xor(ss, 1); ss += __shfl_xor(ss, 2); ss += __shfl_xor(ss, 4);
                  const float r = 1.0f / sqrtf(ss * (1.0f / 64.0f) + EPS);
#pragma unroll
                  for (int e = 0; e < 8; ++e) y[e] = y[e] * r * gc[e];
                  *(v4u*)(YC + (size_t)m * D + c0) = pack8(y); } } }
        conv_qkv(P, cwq, QKV, 0, t0, first, lane); conv_qkv(P, cwq, QKV, 1, t0, first, lane); conv_qkv(P, cwq, QKV, 2, t0, first, lane);
    }
}


constexpr int PREP_HALF = 69632, PK_KN = 0, PK_QN = 17408, PK_VV = 34816, PK_LM = 52224, PK_GC = 68608, PK_BT = 68864, PK_EG = 69120, PROW = 272;
template <bool SC>
__device__ __forceinline__ v4u afrag_piece_rows(const LAS unsigned char* tile, const LAS float* sc, int p) {
    const int f = p >> 6, ln = p & 63, mt = f >> 3, kt = (f >> 1) & 3, s = f & 1, r = ln & 31, hh = ln >> 5, row = 32 * mt + r, kb = 32 * kt + 16 * s + 4 * hh;
    const v2u a = *(const LAS v2u*)(tile + row * PROW + kb * 2), b = *(const LAS v2u*)(tile + row * PROW + (kb + 8) * 2);
    float scv = 1.0f; if (SC) scv = sc[row];
    v4u o; o.x = cvt_pk_bf16(bflo(a.x) * scv, bfhi(a.x) * scv); o.y = cvt_pk_bf16(bflo(a.y) * scv, bfhi(a.y) * scv); o.z = cvt_pk_bf16(bflo(b.x) * scv, bfhi(b.x) * scv); o.w = cvt_pk_bf16(bflo(b.y) * scv, bfhi(b.y) * scv);
    return o;
}
__device__ __forceinline__ void prep_phase(LAS unsigned char* lds, const bf16* QKV, const float* GB, float* EGL, unsigned char* CH, int tid) {
    const int half = tid >> 8, t = tid & 255, lane = tid & 63, w = (tid >> 6) & 3, r = lane & 31, hh = lane >> 5;
    LAS unsigned char* L = lds + half * PREP_HALF;
    LAS float* LM = (LAS float*)(L + PK_LM); LAS float* GC = (LAS float*)(L + PK_GC); LAS float* BT = (LAS float*)(L + PK_BT); LAS float* EG = (LAS float*)(L + PK_EG);
    for (int pu = blockIdx.x; pu < NBH * NCH / 2; pu += gridDim.x) {
        const int cid = 2 * pu + half, bh = cid >> 7, n = cid & 127, b = bh >> 2, h = bh & 3, m0 = b * SEQ + n * 64;
        unsigned char* rec = CH + (size_t)cid * REC;
        __syncthreads();
#pragma unroll
        for (int X = 0; X < 3; ++X)
#pragma unroll
            for (int i = 0; i < 4; ++i) { const int p = t + 256 * i, row = p >> 4, c16 = p & 15;
                const v4u v = *(const v4u*)(QKV + (size_t)(m0 + row) * 1536 + 512 * X + 128 * h + 8 * c16);
                *(LAS v4u*)(L + (X == 0 ? PK_QN : (X == 1 ? PK_KN : PK_VV)) + row * PROW + c16 * 16) = v; }
        if (w == 0) { float g = GB[(size_t)(m0 + lane) * 8 + h];
#pragma unroll
            for (int d = 1; d < 64; d <<= 1) { const float o = __shfl_up(g, d); if (lane >= d) g += o; }
            GC[lane] = g; EG[lane] = __expf(g); BT[lane] = GB[(size_t)(m0 + lane) * 8 + 4 + h];
            if (lane == 63) EGL[cid] = __expf(g); }
        __syncthreads();
        { const int mi = w >> 1, nj = w & 1;
          f32x16 kk, qk;
#pragma unroll
          for (int i = 0; i < 16; ++i) { kk[i] = 0.f; qk[i] = 0.f; }
#pragma unroll
          for (int st = 0; st < 8; ++st) {
              const bf16x8 ka = *(const LAS bf16x8*)(L + PK_KN + (32 * mi + r) * PROW + (16 * st + 8 * hh) * 2);
              const bf16x8 kb = *(const LAS bf16x8*)(L + PK_KN + (32 * nj + r) * PROW + (16 * st + 8 * hh) * 2);
              const bf16x8 qb = *(const LAS bf16x8*)(L + PK_QN + (32 * mi + r) * PROW + (16 * st + 8 * hh) * 2);
              kk = __builtin_amdgcn_mfma_f32_32x32x16_bf16(ka, kb, kk, 0, 0, 0);
              qk = __builtin_amdgcn_mfma_f32_32x32x16_bf16(kb, qb, qk, 0, 0, 0);
          }
          const float gj = GC[32 * nj + r], gq = GC[32 * mi + r];
          float av[16];
#pragma unroll
          for (int reg = 0; reg < 16; ++reg) { const int cr = (reg & 3) + 8 * (reg >> 2) + 4 * hh;
              const int i = 32 * mi + cr, j = 32 * nj + r;
              LM[i * 64 + j] = (i > j) ? BT[i] * kk[reg] * __expf(GC[i] - gj) : 0.f;
              const int key = 32 * nj + cr, qr = 32 * mi + r;
              av[reg] = (qr >= key) ? qk[reg] * __expf(gq - GC[key]) : 0.f; }
#pragma unroll
          for (int s = 0; s < 2; ++s) { v4u o; o.x = cvt_pk_bf16(av[8 * s], av[8 * s + 1]); o.y = cvt_pk_bf16(av[8 * s + 2], av[8 * s + 3]); o.z = cvt_pk_bf16(av[8 * s + 4], av[8 * s + 5]); o.w = cvt_pk_bf16(av[8 * s + 6], av[8 * s + 7]);
              *(v4u*)(rec + 49152 + ((mi * 2 + nj) * 2 + s) * 1024 + lane * 16) = o; }
        }
#pragma unroll
        for (int i = 0; i < 4; ++i) { const int p = t + 256 * i; *(v4u*)(rec + 16384 + p * 16) = afrag_piece_rows<true>(L + PK_QN, EG, p); }
        { const float gl = GC[63];
#pragma unroll
          for (int i = 0; i < 4; ++i) { const int p = t + 256 * i, f = p >> 6, ln = p & 63, mt = f >> 2, ct = (f >> 1) & 1, s = f & 1, dk = 32 * mt + (ln & 31), cb = 32 * ct + 16 * s + 4 * (ln >> 5);
              float e[8];
#pragma unroll
              for (int j = 0; j < 8; ++j) { const int c = cb + 8 * (j >> 2) + (j & 3); e[j] = bf2f(*(const LAS unsigned short*)(L + PK_KN + c * PROW + dk * 2)) * __expf(gl - GC[c]); }
              *(v4u*)(rec + 32768 + p * 16) = pack8(e); } }
        __syncthreads();
        { float X[64]; const bool isu = t < 128; const int col = t & 127;
          const LAS unsigned char* src = L + (isu ? PK_VV : PK_KN) + col * 2;
#pragma unroll
          for (int i = 0; i < 64; ++i) {
              const float egi = EG[i]; const float rhs = bf2f(*(const LAS unsigned short*)(src + i * PROW)) * BT[i] * (isu ? 1.0f : egi);
              float a0 = 0.f, a1 = 0.f, a2 = 0.f, a3 = 0.f;
#pragma unroll
              for (int j4 = 0; j4 < (i + 3) / 4; ++j4) { const f32x4 l = *(const LAS f32x4*)(LM + i * 64 + 4 * j4);
                  if (4 * j4 + 0 < i) a0 += l.x * X[4 * j4 + 0]; if (4 * j4 + 1 < i) a1 += l.y * X[4 * j4 + 1]; if (4 * j4 + 2 < i) a2 += l.z * X[4 * j4 + 2]; if (4 * j4 + 3 < i) a3 += l.w * X[4 * j4 + 3]; }
              X[i] = rhs - ((a0 + a1) + (a2 + a3)); asm volatile("" : "+v"(X[i]) :: "memory"); }
          __syncthreads();
          if (isu) { const int vs = col >> 5, dvl = col & 31;
#pragma unroll
              for (int mt = 0; mt < 2; ++mt)
#pragma unroll
                  for (int h2 = 0; h2 < 2; ++h2) { f32x4* dst = (f32x4*)(rec + REC_A + (size_t)(((vs * 2 + mt) * 64 + dvl + 32 * h2) * 16) * 4);
#pragma unroll
                      for (int a = 0; a < 4; ++a) { const int i0 = 32 * mt + 4 * h2 + 8 * a; dst[a] = (f32x4){X[i0], X[i0 + 1], X[i0 + 2], X[i0 + 3]}; } }
          } else {
#pragma unroll
              for (int i = 0; i < 64; ++i) *(LAS unsigned short*)(L + PK_VV + i * PROW + col * 2) = (unsigned short)(cvt_pk_bf16(-X[i], 0.f) & 0xffffu);
          }
        }
        __syncthreads();
#pragma unroll
        for (int i = 0; i < 4; ++i) { const int p = t + 256 * i; *(v4u*)(rec + p * 16) = afrag_piece_rows<false>(L + PK_VV, EG, p); }
    }
}

__device__ __forceinline__ bf16x8 pack_acc(const f32x16& x, int s) {
    v4u p; p.x = cvt_pk_bf16(x[8 * s], x[8 * s + 1]); p.y = cvt_pk_bf16(x[8 * s + 2], x[8 * s + 3]); p.z = cvt_pk_bf16(x[8 * s + 4], x[8 * s + 5]); p.w = cvt_pk_bf16(x[8 * s + 6], x[8 * s + 7]);
    return __builtin_bit_cast(bf16x8, p);
}
#define MFMA32(a, b, c) __builtin_amdgcn_mfma_f32_32x32x16_bf16((a), (b), (c), 0, 0, 0)
__device__ __forceinline__ void chain_phase(LAS unsigned char* lds, const unsigned char* CH, const float* EGL, float* Oraw, int bh, int tid) {
    const int wid = __builtin_amdgcn_readfirstlane(tid >> 6), lane = tid & 63, b = bh >> 2, h = bh & 3, vs = wid & 3;
    const unsigned char* rec0 = CH + (size_t)bh * NCH * REC;
    const bool comp = wid < 4;
#define CH_STAGE(n, buf) do { _Pragma("unroll") for (int _i = 0; _i < 7; ++_i) { const int _pc = wid * 7 + _i; \
        __builtin_amdgcn_global_load_lds((const unsigned*)(rec0 + (size_t)(n) * REC + _pc * 1024 + lane * 16), (LAS unsigned*)(lds + (buf) * REC_A + _pc * 1024), 16, 0, 0); } } while (0)
    f32x16 S[4], U0, U1, o0, o1;
#pragma unroll
    for (int k = 0; k < 4; ++k)
#pragma unroll
        for (int i = 0; i < 16; ++i) S[k][i] = 0.f;
#pragma unroll
    for (int i = 0; i < 16; ++i) { U0[i] = 0.f; U1[i] = 0.f; o0[i] = 0.f; o1[i] = 0.f; }
    CH_STAGE(0, 0);
    if (comp) { const f32x4* up = (const f32x4*)(rec0 + REC_A) + ((vs * 2 + 0) * 64 + lane) * 4; const f32x4* up1 = up + 64 * 4;
#pragma unroll
        for (int a = 0; a < 4; ++a) { const f32x4 x = up[a], y = up1[a]; U0[4 * a] = x.x; U0[4 * a + 1] = x.y; U0[4 * a + 2] = x.z; U0[4 * a + 3] = x.w; U1[4 * a] = y.x; U1[4 * a + 1] = y.y; U1[4 * a + 2] = y.z; U1[4 * a + 3] = y.w; } }
    asm volatile("s_waitcnt vmcnt(0) lgkmcnt(0)" ::: "memory"); __builtin_amdgcn_s_barrier(); asm volatile("" ::: "memory");
    for (int n = 0; n < NCH; ++n) {
        const int buf = n & 1;
        if (comp && n > 0) { float* op = Oraw + (size_t)(b * SEQ + (n - 1) * 64) * 512 + h * 128 + vs * 32 + (lane & 31);
#pragma unroll
            for (int reg = 0; reg < 16; ++reg) { const int cr = (reg & 3) + 8 * (reg >> 2) + 4 * (lane >> 5); op[(size_t)cr * 512] = o0[reg]; op[(size_t)(32 + cr) * 512] = o1[reg]; } }
        f32x16 N0 = U0, N1 = U1;
        if (n + 1 < NCH) { CH_STAGE(n + 1, buf ^ 1);
            if (comp) { const f32x4* up = (const f32x4*)(rec0 + (size_t)(n + 1) * REC + REC_A) + ((vs * 2 + 0) * 64 + lane) * 4; const f32x4* up1 = up + 64 * 4;
#pragma unroll
                for (int a = 0; a < 4; ++a) { const f32x4 x = up[a], y = up1[a]; N0[4 * a] = x.x; N0[4 * a + 1] = x.y; N0[4 * a + 2] = x.z; N0[4 * a + 3] = x.w; N1[4 * a] = y.x; N1[4 * a + 1] = y.y; N1[4 * a + 2] = y.z; N1[4 * a + 3] = y.w; } } }
        if (comp) {
            const LAS unsigned char* B = lds + buf * REC_A + lane * 16;
            const float egl = EGL[bh * NCH + n];
            f32x16 v0 = U0, v1 = U1;
#pragma unroll
            for (int i = 0; i < 16; ++i) { o0[i] = 0.f; o1[i] = 0.f; }
#pragma unroll
            for (int kt = 0; kt < 4; ++kt)
#pragma unroll
                for (int s = 0; s < 2; ++s) { const bf16x8 sb = pack_acc(S[kt], s);
                    v0 = MFMA32(*(const LAS bf16x8*)(B + ((0 * 4 + kt) * 2 + s) * 1024), sb, v0);
                    v1 = MFMA32(*(const LAS bf16x8*)(B + ((1 * 4 + kt) * 2 + s) * 1024), sb, v1);
                    o0 = MFMA32(*(const LAS bf16x8*)(B + 16384 + ((0 * 4 + kt) * 2 + s) * 1024), sb, o0);
                    o1 = MFMA32(*(const LAS bf16x8*)(B + 16384 + ((1 * 4 + kt) * 2 + s) * 1024), sb, o1); }
            bf16x8 vb[2][2];
            vb[0][0] = pack_acc(v0, 0); vb[0][1] = pack_acc(v0, 1); vb[1][0] = pack_acc(v1, 0); vb[1][1] = pack_acc(v1, 1);
#pragma unroll
            for (int ct = 0; ct < 2; ++ct)
#pragma unroll
                for (int s = 0; s < 2; ++s) {
                    o0 = MFMA32(*(const LAS bf16x8*)(B + 49152 + ((0 * 2 + ct) * 2 + s) * 1024), vb[ct][s], o0);
                    o1 = MFMA32(*(const LAS bf16x8*)(B + 49152 + ((1 * 2 + ct) * 2 + s) * 1024), vb[ct][s], o1); }
#pragma unroll
            for (int kt = 0; kt < 4; ++kt) {
#pragma unroll
                for (int i = 0; i < 16; ++i) S[kt][i] *= egl;
#pragma unroll
                for (int ct = 0; ct < 2; ++ct)
#pragma unroll
                    for (int s = 0; s < 2; ++s) S[kt] = MFMA32(*(const LAS bf16x8*)(B + 32768 + ((kt * 2 + ct) * 2 + s) * 1024), vb[ct][s], S[kt]); }
        }
        U0 = N0; U1 = N1;
        asm volatile("s_waitcnt vmcnt(0) lgkmcnt(0)" ::: "memory"); __builtin_amdgcn_s_barrier(); asm volatile("" ::: "memory");
    }
    if (comp) { float* op = Oraw + (size_t)(b * SEQ + (NCH - 1) * 64) * 512 + h * 128 + vs * 32 + (lane & 31);
#pragma unroll
        for (int reg = 0; reg < 16; ++reg) { const int cr = (reg & 3) + 8 * (reg >> 2) + 4 * (lane >> 5); op[(size_t)cr * 512] = o0[reg]; op[(size_t)(32 + cr) * 512] = o1[reg]; } }
#undef CH_STAGE
}
#if DN_NAIVE
__device__ __forceinline__ void naive_dn(const bf16* QKV, const float* GB, float* Oraw, int unit, int lane) {
    const int bh = unit >> 1, dv = (unit & 1) * 64 + lane, b = bh >> 2, h = bh & 3;
    float S[128];
#pragma unroll
    for (int i = 0; i < 128; ++i) S[i] = 0.f;
    for (int t = 0; t < SEQ; ++t) { const size_t m = (size_t)b * SEQ + t;
        const float al = __expf(GB[m * 8 + h]), be = GB[m * 8 + 4 + h];
        const bf16* qp = QKV + m * 1536 + h * 128; const bf16* kp = qp + 512; const float v = bf2f(qp[1024 + dv]);
        float r = 0.f;
#pragma unroll
        for (int i = 0; i < 128; ++i) { S[i] *= al; r += bf2f(kp[i]) * S[i]; if ((i & 15) == 15) asm volatile("" : "+v"(r) :: "memory"); }
        const float d = be * (v - r); float o = 0.f;
#pragma unroll
        for (int i = 0; i < 128; ++i) { S[i] += bf2f(kp[i]) * d; o += bf2f(qp[i]) * S[i]; if ((i & 15) == 15) asm volatile("" : "+v"(o) :: "memory"); }
        Oraw[m * 512 + h * 128 + dv] = o; }
}
#endif
__device__ __forceinline__ void opost_rows(const float* Oraw, const bf16* P, const float* gdn, bf16* YC, int gw, int NGW, int lane) {
    float gd[8];
#pragma unroll
    for (int e = 0; e < 8; ++e) gd[e] = gdn[(8 * lane + e) & 127];
    for (int blk = gw; blk < M / 16; blk += NGW) { const int m0 = blk * 16;
#pragma unroll 1
        for (int i = 0; i < 16; i += 8) {
            f32x4 oa[8], ob[8]; v4u zz[8];
#pragma unroll
            for (int t = 0; t < 8; ++t) { const int m = m0 + i + t; const f32x4* op = (const f32x4*)(Oraw + (size_t)m * 512 + 8 * lane); oa[t] = op[0]; ob[t] = op[1]; zz[t] = *(const v4u*)(P + (size_t)m * NP + 3072 + 8 * lane); }
#pragma unroll
            for (int t = 0; t < 8; ++t) { const int m = m0 + i + t; float z[8]; unpack8(zz[t], z);
                float o[8] = {oa[t].x, oa[t].y, oa[t].z, oa[t].w, ob[t].x, ob[t].y, ob[t].z, ob[t].w}; float ss = 0.f;
#pragma unroll
                for (int e = 0; e < 8; ++e) ss += o[e] * o[e];
                ss += __shfl_xor(ss, 1); ss += __shfl_xor(ss, 2); ss += __shfl_xor(ss, 4); ss += __shfl_xor(ss, 8);
                const float r = 1.0f / sqrtf(ss * (1.0f / 128.0f) + EPS);
#pragma unroll
                for (int e = 0; e < 8; ++e) o[e] = o[e] * r * gd[e] * silu_f(z[e]);
                *(v4u*)(YC + (size_t)m * D + 512 + 8 * lane) = pack8(o); } } }
}

typedef __attribute__((address_space(1))) unsigned gu32;
#define XB_TMO      128
#define XB_XCNT(j)  (256  + 64 * (j))
#define XB_XSUB(j)  (1280 + 64 * (j))
#define XB_XGEN(j)  (2304 + 64 * (j))
#define XB_TOP      3328
#define XB_TOPGEN   3392
#define XCD_BAR_WORDS 3456
#define XB_SPIN_CAP (1u << 18)

__device__ __forceinline__ unsigned xb_ld(unsigned* p)              { return __hip_atomic_load(p, __ATOMIC_RELAXED, __HIP_MEMORY_SCOPE_AGENT); }
__device__ __forceinline__ unsigned xb_add(unsigned* p, unsigned v) { return __hip_atomic_fetch_add(p, v, __ATOMIC_RELAXED, __HIP_MEMORY_SCOPE_AGENT); }
__device__ __forceinline__ unsigned xb_xcc_id() { return (unsigned)__builtin_amdgcn_s_getreg((3 << 11) | 20) & 0xFu; }
#define XB_SPIN(cond, bar) do { unsigned _sp = 0; while (cond) { __builtin_amdgcn_s_sleep(1); \
    if ((++_sp & 255u) == 0u) { if (xb_ld(&(bar)[XB_TMO])) break; if (_sp > XB_SPIN_CAP) { atomicAdd(&(bar)[XB_TMO], 1u); break; } } } } while (0)

struct XcdBarrier {
    unsigned* bar; unsigned x;
    volatile LAS unsigned* st;
};

__device__ __forceinline__ XcdBarrier xcd_barrier_post(unsigned* bar, volatile LAS unsigned* st) {
    XcdBarrier b; b.bar = bar; b.x = xb_xcc_id(); b.st = st;
    if (threadIdx.x == 0) (void)xb_add(&bar[XB_XCNT(b.x)], 1u);
    return b;
}
__device__ __forceinline__ void xcd_barrier_complete(unsigned* bar, unsigned x, unsigned& nloc, unsigned& nx) {
    const unsigned G = gridDim.x * gridDim.y * gridDim.z;
    unsigned sum, cnt, mine, sp = 0u;
    for (;;) {
        sum = 0u; cnt = 0u; mine = 0u;
#pragma unroll
        for (unsigned j = 0; j < 16; ++j) { const unsigned c = xb_ld(&bar[XB_XCNT(j)]); sum += c; cnt += (c > 0u) ? 1u : 0u; mine = (j == x) ? c : mine; }
        if (sum == G) break;
        __builtin_amdgcn_s_sleep(1);
        if ((++sp & 255u) == 0u) { if (xb_ld(&bar[XB_TMO])) break; if (sp > XB_SPIN_CAP) { atomicAdd(&bar[XB_TMO], 1u); break; } }
    }
    nloc = mine > 0u ? mine : 1u; nx = cnt > 0u ? cnt : 1u;
}

__device__ __forceinline__ void xcd_barrier(const XcdBarrier& b) {
    asm volatile("s_waitcnt vmcnt(0)" ::: "memory");
    __syncthreads();
    if (threadIdx.x == 0) {
        unsigned* bar = b.bar;
        __builtin_amdgcn_s_waitcnt(0);
        unsigned nloc = b.st[0], nx = b.st[1];
        if (nloc == 0u) { xcd_barrier_complete(bar, b.x, nloc, nx); b.st[0] = nloc; b.st[1] = nx; }
        const unsigned old = xb_add(&bar[XB_XSUB(b.x)], 1u);
        const unsigned gen = old / nloc;
        if (old + 1u == (gen + 1u) * nloc) {
            __builtin_amdgcn_fence(__ATOMIC_RELEASE, "agent");
            asm volatile("s_waitcnt vmcnt(0)" ::: "memory");
            const unsigned og = xb_add(&bar[XB_TOP], 1u);
            const unsigned tg = og / nx;
            if (og + 1u == (tg + 1u) * nx) xb_add(&bar[XB_TOPGEN], 1u);
            else XB_SPIN(xb_ld(&bar[XB_TOPGEN]) == tg, bar);
            __builtin_amdgcn_fence(__ATOMIC_ACQUIRE, "agent");
            xb_add(&bar[XB_XGEN(b.x)], 1u);
            asm volatile("s_waitcnt vmcnt(0)" ::: "memory");
        } else {
            XB_SPIN(xb_ld(&bar[XB_XGEN(b.x)]) == gen, bar);
            __builtin_amdgcn_fence(__ATOMIC_ACQUIRE, "agent");
            asm volatile("s_waitcnt vmcnt(0)" ::: "memory");
        }
    }
    __syncthreads();
}

__global__ void __launch_bounds__(NWAVES * 64, 2) fwd(Args args) {
    extern __shared__ __attribute__((aligned(16))) unsigned char lds_raw[];
    LAS unsigned char* lds = (LAS unsigned char*)lds_raw;
    const int tid = threadIdx.x, lane = tid & 63, wave = __builtin_amdgcn_readfirstlane(tid >> 6);
    const int G = gridDim.x; const int bx = blockIdx.x; const int vcu = (G % 8 == 0) ? (bx % 8) * (G / 8) + bx / 8 : bx;
    const int gw = vcu * NWAVES + wave, NGW = G * NWAVES;
    unsigned char* ws = args.ws;
    float* MOD = (float*)(ws + WS_MOD); float* GB = (float*)(ws + WS_GB); float* EGL = (float*)(ws + WS_EGL);
    bf16* WinT = (bf16*)(ws + WS_WIN); bf16* WoT = (bf16*)(ws + WS_WO); bf16* WguT = (bf16*)(ws + WS_WGU); bf16* WdT = (bf16*)(ws + WS_WD);
    bf16* H = (bf16*)(ws + WS_H); unsigned char* CH = ws + WS_CH; bf16* P = (bf16*)(ws + WS_P); bf16* ACT = (bf16*)(ws + WS_P); bf16* YC = (bf16*)(ws + WS_YC);
    bf16* QKV = (bf16*)args.out; float* Oraw = args.out; float* OUT = args.out;
    const int lo = args.ph_lo, hi = args.ph_hi;
    volatile LAS unsigned* MISC = (volatile LAS unsigned*)(lds + LDS_BYTES - 64);
    if (tid < 16) MISC[tid] = 0u;
    __syncthreads();
    XcdBarrier bar = xcd_barrier_post((unsigned*)ws, MISC);
    if (lo < 0) cg::this_grid().sync();
#ifndef PH_MASK
#define PH_MASK 0xFFF
#endif
#define IN(k) (((PH_MASK >> (k)) & 1) && lo <= (k) && (k) < hi)
#if MK_N_LAUNCHES == 1
#define SEAM(k) do { if (IN(k) && IN((k) + 1)) xcd_barrier(bar); } while (0)
#else
#define SEAM(k) do { } while (0)
#endif
#ifndef REP_MASK
#define REP_MASK 0
#endif
#define BEGIN_REP(k) for (int rep_ = 0; rep_ <= ((REP_MASK >> (k)) & 1); ++rep_) { if (rep_) xcd_barrier(bar);
#define END_REP }
    BEGIN_REP(0)
    if (IN(0)) {
        LAS float* scr = (LAS float*)(lds + wave * 16384);
        constexpr int I_IN = 16 * 112, I_O = 16 * 32, I_GU = 16 * 176, I_DN = 44 * 32, NITEMS = I_IN + I_O + I_GU + I_DN;
        for (int it = gw; it < NITEMS; it += NGW) { int r = it;
            if (r < I_IN) { p0_transpose_item<0>(args.in[I_WIN], D, PIN, 112, WinT, scr, r, lane); continue; } r -= I_IN;
            if (r < I_O) { p0_transpose_item<0>(args.in[I_WOUT], D, D, 32, WoT, scr, r, lane); continue; } r -= I_O;
            if (r < I_GU) { p0_transpose_item<1>(args.in[I_WGU], D, 2 * FF, 176, WguT, scr, r, lane); continue; } r -= I_GU;
            p0_transpose_item<0>(args.in[I_WDN], FF, D, 32, WdT, scr, r, lane); }
        __syncthreads();
        { LAS float* SC = (LAS float*)lds; const float* cin = args.in[I_C];
          for (int idx = tid; idx < 4096; idx += NWAVES * 64) { const int b = idx >> 10, k = idx & 1023; const float cv = cin[idx]; SC[k * 4 + b] = cv / (1.0f + __expf(-cv)); }
          __syncthreads();
          for (int it = bx; it < 256; it += G) p0_mod_item(args, MOD, SC, (LAS float*)(lds + 16384), it, tid); }
    }
    END_REP
    SEAM(0);
    BEGIN_REP(1)
    if (IN(1)) { LAS float* TT = (LAS float*)lds; const float* wi = args.in[I_WIN];
        for (int idx = tid; idx < 8192; idx += NWAVES * 64) { const int k = idx >> 3, e = idx & 7; TT[e * 1024 + k] = wi[(size_t)k * PIN + NP + e]; }
        __syncthreads();
        adaln_rows<0>(args.in[I_X], args.in[I_GMIX], MOD + 0, MOD + 1024, 6144, H, nullptr, TT, args.in[I_ALOG], args.in[I_DTB], GB, gw, NGW, lane);
        __syncthreads(); }
    END_REP
    SEAM(1);
    BEGIN_REP(2)
    if (IN(2)) { pg8::Gemm g{H, WinT, M, NP, D}; pg8::StaticOrder S; S.init(M, NP, G, bx); pg8::EpiBf16 E{P, NP};
        pg8::gemm_phase<pg8::EpiBf16, pg8::StaticOrder, true, true>(lds, g, S, E); }
    END_REP
    SEAM(2);
    BEGIN_REP(3)
    if (IN(3)) conv_pass(P, args.in[I_CWM], args.in[I_CWQ], args.in[I_GCO], YC, QKV, gw, NGW, lane);
    END_REP
    SEAM(3);
#if DN_NAIVE
    SEAM(4);
    if (IN(5)) { if (bx < 32 && wave == 0) naive_dn(QKV, GB, (float*)(ws + WS_CH), bx, lane); }
    SEAM(5);
    if (IN(6)) opost_rows((const float*)(ws + WS_CH), P, args.in[I_GDN], YC, gw, NGW, lane);
#else
    BEGIN_REP(4)
    if (IN(4)) prep_phase(lds, QKV, GB, EGL, CH, tid);
    END_REP
    SEAM(4);
    BEGIN_REP(5)
    if (IN(5)) { if (bx < NBH) chain_phase(lds, CH, EGL, Oraw, bx, tid); }
    END_REP
    SEAM(5);
    BEGIN_REP(6)
    if (IN(6)) opost_rows(Oraw, P, args.in[I_GDN], YC, gw, NGW, lane);
    END_REP
#endif
    SEAM(6);
    BEGIN_REP(7)
    if (IN(7)) { pg8::Gemm g{YC, WoT, M, D, D}; pg8::StaticOrder S; S.init(M, D, G, bx); pg8::EpiResGate E{args.in[I_X], OUT, MOD + 2048, 6144};
        pg8::gemm_phase<pg8::EpiResGate, pg8::StaticOrder, true, true>(lds, g, S, E); }
    END_REP
    SEAM(7);
    BEGIN_REP(8)
    if (IN(8)) adaln_rows<1>(OUT, args.in[I_GFFN], MOD + 3072, MOD + 4096, 6144, H, nullptr, nullptr, nullptr, nullptr, nullptr, gw, NGW, lane);
    END_REP
    SEAM(8);
    BEGIN_REP(9)
    if (IN(9)) { pg8::Gemm g{H, WguT, M, 2 * FF, D}; pg8::StaticOrder S; S.init(M, 2 * FF, G, bx); pg8::EpiSwiglu E{ACT, FF};
        pg8::gemm_phase<pg8::EpiSwiglu, pg8::StaticOrder, true, true>(lds, g, S, E); }
    END_REP
    SEAM(9);
    BEGIN_REP(10)
    if (IN(10)) { pg8::Gemm g{ACT, WdT, M, D, FF}; pg8::StaticOrder S; S.init(M, D, G, bx); pg8::EpiResGate E{OUT, OUT, MOD + 5120, 6144};
        pg8::gemm_phase<pg8::EpiResGate, pg8::StaticOrder, true, true>(lds, g, S, E); }
    END_REP
    SEAM(10);
    if (IN(11)) adaln_rows<2>(OUT, args.in[I_GFIN], MOD + 4 * 6144, MOD + 4 * 6144 + 1024, 2048, nullptr, OUT, nullptr, nullptr, nullptr, nullptr, gw, NGW, lane);
#undef IN
#undef SEAM
}

extern "C" void kernel_launch(void* const* d_in, const int* in_sizes, int n_in, void* d_out, int out_size, void* d_ws, size_t ws_size, hipStream_t stream) {
    static int grid = 0;
    if (grid == 0) {
        if (n_in != 19 || out_size != M * D || ws_size < WS_END) { fprintf(stderr, "kernel_launch: unexpected shapes (n_in %d, out %d, ws %zu)\n", n_in, out_size, ws_size); grid = -1; return; }
        int dev = 0, cus = 0;
        if (hipGetDevice(&dev) != hipSuccess || hipDeviceGetAttribute(&cus, hipDeviceAttributeMultiprocessorCount, dev) != hipSuccess) { grid = -1; return; }
        if (hipFuncSetAttribute((const void*)fwd, hipFuncAttributeMaxDynamicSharedMemorySize, LDS_BYTES) != hipSuccess) { fprintf(stderr, "kernel_launch: hipFuncSetAttribute failed\n"); grid = -1; return; }
        int per_cu = 0;
        if (hipOccupancyMaxActiveBlocksPerMultiprocessor(&per_cu, (const void*)fwd, NWAVES * 64, LDS_BYTES) != hipSuccess || per_cu < 1) { fprintf(stderr, "kernel_launch: occupancy query says %d blocks per CU\n", per_cu); }
        (void)hipGetLastError();
        grid = cus;
    }
    if (grid < 0) return;
    Args a{};
    for (int i = 0; i < 19; ++i) a.in[i] = (const float*)d_in[i];
    a.out = (float*)d_out; a.ws = (unsigned char*)d_ws;
#if MK_N_LAUNCHES == 1
    if (hipMemsetAsync(d_ws, 0, 16384, stream) != hipSuccess) { fprintf(stderr, "kernel_launch: memset of the barrier words failed\n"); return; }
    a.ph_lo = 0; a.ph_hi = PH_END;
    void* kargs[] = {&a};
    hipError_t e = hipLaunchCooperativeKernel((const void*)fwd, dim3(grid), dim3(NWAVES * 64), kargs, LDS_BYTES, stream);
    if (e != hipSuccess) fprintf(stderr, "kernel_launch: cooperative launch failed: %s (grid %d)\n", hipGetErrorString(e), grid);
#else
    for (int ph = 0; ph < PH_END; ++ph) { a.ph_lo = ph; a.ph_hi = ph + 1; hipLaunchKernelGGL(fwd, dim3(grid), dim3(NWAVES * 64), LDS_BYTES, stream, a); }
#endif
}
```

```cpp
#include <hip/hip_runtime.h>
#include <hip/hip_cooperative_groups.h>
#include <cstdio>
#include <cstdint>
namespace cg = cooperative_groups;
#ifndef MK_N_LAUNCHES
#define MK_N_LAUNCHES 1
#endif
#ifndef DN_NAIVE
#define DN_NAIVE 0
#endif
namespace pg8 {
#define PG8_LAS __attribute__((address_space(3)))
typedef unsigned short bf16_t;
typedef short bf16x8 __attribute__((ext_vector_type(8)));
typedef float f32x4 __attribute__((ext_vector_type(4)));
typedef unsigned u32x4 __attribute__((ext_vector_type(4)));
constexpr int BM = 256, BK = 64, HALF = 128, HTB = HALF * BK * 2  , STAGE_BYTES = 8 * HTB, NXCD = 8, WGM = 8;

__host__ __device__ __forceinline__ int lds_byte(int r, int c) { const int st = (r >> 4) * 2 + (c >> 5), rr = r & 15, cc = c & 31, ob = rr * 64 + cc * 2; return st * 1024 + (ob ^ (((ob >> 9) & 1) << 5)); }
__host__ __device__ __forceinline__ void stage_rc(int b, int& R, int& C) { const int st = b / 1024, sb = b % 1024, swz = sb ^ (((sb >> 9) & 1) << 5); R = (st >> 1) * 16 + swz / 64; C = (st & 1) * 32 + (swz % 64) / 2; }
__host__ __device__ __forceinline__ int perm32(int rho) { const int n = rho >> 4, i = rho & 15; return 8 * (i >> 2) + 4 * n + (i & 3); }

struct Unit { int pm, pn; };
struct Gemm { const bf16_t* A; const bf16_t* Bt; int M, N, K; };

struct StaticOrder {
    int nM, nN, nwg, G, c;
    __host__ __device__ void init(int M, int N, int G_, int c_) { nM = M / BM; nN = N / BM; nwg = nM * nN; G = G_; c = c_; }
    __host__ __device__ bool next(int i, Unit& u) const {
        const long L = (long)i * G + c; if (L >= nwg) return false;
        int wgid = (int)L; { const int q = nwg / NXCD, r = nwg % NXCD, xcd = wgid % NXCD, off = wgid / NXCD; wgid = (xcd < r ? xcd * (q + 1) : r * (q + 1) + (xcd - r) * q) + off; }
        const int nig = WGM * nN, gid = wgid / nig, fm = gid * WGM, gsz = (nM - fm) < WGM ? (nM - fm) : WGM;
        u.pm = fm + ((wgid % nig) % gsz); u.pn = (wgid % nig) / gsz; return true;
    }
    __device__ __forceinline__ void a_ready(const Unit&) const {}
    __device__ __forceinline__ void done(const Unit&) const {}
};

typedef float f32x2 __attribute__((ext_vector_type(2)));
typedef __bf16 bf16x2v __attribute__((ext_vector_type(2)));
__device__ __forceinline__ unsigned cvt_pk_bf16(float lo, float hi) { f32x2 v = {lo, hi}; bf16x2v r = __builtin_convertvector(v, bf16x2v); return __builtin_bit_cast(unsigned, r); }
__device__ __forceinline__ float silu_f(float x) { return x * __builtin_amdgcn_rcpf(1.0f + __builtin_amdgcn_exp2f(-1.4426950408889634f * x)); }

struct EpiBf16 {
    static constexpr bool PERM = true, AFTER_DRAIN = false;
    bf16_t* O; int ldc;
    __device__ __forceinline__ void operator()(const f32x4 (&acc)[2][2][4][2], const Unit& u, int wr, int wc, int fr, int fq) const {
        const int row0 = u.pm * BM + wr * 64 + fr; const int col0 = u.pn * BM + wc * 32 + 8 * fq;
#pragma unroll
        for (int ai = 0; ai < 2; ++ai)
#pragma unroll
            for (int m = 0; m < 4; ++m) { bf16_t* rowp = O + (size_t)(row0 + ai * HALF + m * 16) * ldc + col0;
#pragma unroll
                for (int bj = 0; bj < 2; ++bj) { const f32x4 v0 = acc[ai][bj][m][0], v1 = acc[ai][bj][m][1];
                    u32x4 w; w.x = cvt_pk_bf16(v0[0], v0[1]); w.y = cvt_pk_bf16(v0[2], v0[3]); w.z = cvt_pk_bf16(v1[0], v1[1]); w.w = cvt_pk_bf16(v1[2], v1[3]);
                    *(u32x4*)(rowp + bj * HALF) = w; } }
    }
};
struct EpiSwiglu {
    static constexpr bool PERM = true, AFTER_DRAIN = false;
    bf16_t* O; int ldc;
    __device__ __forceinline__ void operator()(const f32x4 (&acc)[2][2][4][2], const Unit& u, int wr, int wc, int fr, int fq) const {
        const int row0 = u.pm * BM + wr * 64 + fr; const int col0 = u.pn * HALF + wc * 32 + 8 * fq;
#pragma unroll
        for (int ai = 0; ai < 2; ++ai)
#pragma unroll
            for (int m = 0; m < 4; ++m) { bf16_t* rowp = O + (size_t)(row0 + ai * HALF + m * 16) * ldc + col0;
                const f32x4 g0 = acc[ai][0][m][0], g1 = acc[ai][0][m][1], u0 = acc[ai][1][m][0], u1 = acc[ai][1][m][1];
                u32x4 w; w.x = cvt_pk_bf16(silu_f(g0[0]) * u0[0], silu_f(g0[1]) * u0[1]); w.y = cvt_pk_bf16(silu_f(g0[2]) * u0[2], silu_f(g0[3]) * u0[3]);
                w.z = cvt_pk_bf16(silu_f(g1[0]) * u1[0], silu_f(g1[1]) * u1[1]); w.w = cvt_pk_bf16(silu_f(g1[2]) * u1[2], silu_f(g1[3]) * u1[3]);
                *(u32x4*)rowp = w; }
    }
};
struct EpiResGate {
    static constexpr bool PERM = false, AFTER_DRAIN = false;
    const float* base; float* out; const float* gate;
    int gstride;
    __device__ __forceinline__ void operator()(const f32x4 (&acc)[2][2][4][2], const Unit& u, int wr, int wc, int fr, int fq) const {
        const int b = u.pm >> 5;
        const int col0 = u.pn * BM + wc * 32 + 4 * fq; const float* gp = gate + (size_t)b * gstride + col0;
        f32x4 gv[2][2];
#pragma unroll
        for (int bj = 0; bj < 2; ++bj)
#pragma unroll
            for (int n = 0; n < 2; ++n) gv[bj][n] = *(const f32x4*)(gp + bj * HALF + n * 16);
#pragma unroll
        for (int ai = 0; ai < 2; ++ai)
#pragma unroll
            for (int m = 0; m < 4; ++m) { const size_t off = (size_t)(u.pm * BM + ai * HALF + wr * 64 + m * 16 + fr) * 1024 + col0;
#pragma unroll
                for (int bj = 0; bj < 2; ++bj)
#pragma unroll
                    for (int n = 0; n < 2; ++n) { const f32x4 bs = *(const f32x4*)(base + off + bj * HALF + n * 16);
                        *(f32x4*)(out + off + bj * HALF + n * 16) = bs + gv[bj][n] * acc[ai][bj][m][n]; } }
    }
};

template <class Epi, class Sched, bool ALIGN_EPI = false, bool SP2 = false>
__device__ __forceinline__ void gemm_phase(PG8_LAS unsigned char* lds, const Gemm g, const Sched& S, const Epi& E) {
    const int tid = threadIdx.x, wid = __builtin_amdgcn_readfirstlane(tid >> 6), lane = tid & 63, wr = wid >> 2, wc = wid & 3, fr = lane & 15, fq = lane >> 4;
    const int K = g.K, nt = K / BK;
    unsigned voffA[2], voffB[2];
#pragma unroll
    for (int i = 0; i < 2; ++i) { int R, C; stage_rc(tid * 16 + i * 8192, R, C); const int Rb = Epi::PERM ? ((R & ~31) + perm32(R & 31)) : R;
        voffA[i] = (unsigned)(R * K + C) * 2u; voffB[i] = (unsigned)(Rb * K + C) * 2u; }
    const size_t kstep = (size_t)(BK * 2);
    const size_t hstep = (size_t)HALF * K * 2;
    const size_t tstep = 2 * hstep;
    const unsigned ldsw = (unsigned)wid * 1024u;
    const int aoff = lds_byte(wr * 64 + fr, fq * 8), boff = lds_byte(wc * 32 + fr, fq * 8);
#define PG8_SA(b, h) (((b) * 2 + (h)) * HTB)
#define PG8_SB(b, h) ((4 + (b) * 2 + (h)) * HTB)
#define PG8_STAGE(bufoff, gbase, voff) do { _Pragma("unroll") for (int _i = 0; _i < 2; ++_i) \
        __builtin_amdgcn_global_load_lds((const unsigned*)((const char*)(gbase) + (voff)[_i]), (PG8_LAS unsigned*)(lds + (bufoff) + ldsw + _i * 8192), 16, 0, 0); } while (0)
#define PG8_LDA(dst, b, h) do { _Pragma("unroll") for (int m = 0; m < 4; ++m) _Pragma("unroll") for (int k = 0; k < 2; ++k) dst[m][k] = *(const PG8_LAS bf16x8*)(lds + PG8_SA(b, h) + aoff + m * 2048 + k * 1024); } while (0)
#define PG8_LDB(dst, b, h) do { _Pragma("unroll") for (int n = 0; n < 2; ++n) _Pragma("unroll") for (int k = 0; k < 2; ++k) dst[n][k] = *(const PG8_LAS bf16x8*)(lds + PG8_SB(b, h) + boff + n * 2048 + k * 1024); } while (0)
#define PG8_MMA(ai, bj, At, Bt) do { __builtin_amdgcn_s_setprio(1); _Pragma("unroll") for (int m = 0; m < 4; ++m) _Pragma("unroll") for (int n = 0; n < 2; ++n) _Pragma("unroll") for (int k = 0; k < 2; ++k) \
        acc[ai][bj][m][n] = __builtin_amdgcn_mfma_f32_16x16x32_bf16(Bt[n][k], At[m][k], acc[ai][bj][m][n], 0, 0, 0); __builtin_amdgcn_s_setprio(0); } while (0)
#define PG8_WAIT_V(n) asm volatile("s_waitcnt vmcnt(" #n ")" ::: "memory")
#define PG8_WAIT_L(n) asm volatile("s_waitcnt lgkmcnt(" #n ")" ::: "memory")
#define PG8_BAR __builtin_amdgcn_s_barrier()
#define PG8_SCHED __builtin_amdgcn_sched_barrier(0)
    Unit cur, nxt; int ui = 0;
    if (!S.next(0, cur)) return;
    f32x4 acc[2][2][4][2];
#pragma unroll
    for (int a = 0; a < 2; ++a)
#pragma unroll
        for (int b = 0; b < 2; ++b)
#pragma unroll
            for (int m = 0; m < 4; ++m)
#pragma unroll
                for (int n = 0; n < 2; ++n) acc[a][b][m][n] = (f32x4){0.f, 0.f, 0.f, 0.f};
    bf16x8 At[4][2], B0[2][2], B1[2][2];
    const char* cA = (const char*)g.A + (size_t)cur.pm * tstep; const char* cB = (const char*)g.Bt + (size_t)cur.pn * tstep;
    S.a_ready(cur);
    if constexpr (SP2) {
        PG8_STAGE(PG8_SB(0, 0), cB, voffB); PG8_STAGE(PG8_SB(0, 1), cB + hstep, voffB); PG8_STAGE(PG8_SA(0, 0), cA, voffA); PG8_STAGE(PG8_SA(0, 1), cA + hstep, voffA);
        if (wr == 1) PG8_BAR;
        PG8_WAIT_V(2); PG8_BAR;
        PG8_STAGE(PG8_SB(1, 0), cB + kstep, voffB); PG8_STAGE(PG8_SA(1, 0), cA + kstep, voffA); PG8_STAGE(PG8_SB(1, 1), cB + hstep + kstep, voffB);
        PG8_WAIT_V(6); PG8_BAR;
    } else {
        PG8_STAGE(PG8_SB(0, 0), cB, voffB); PG8_STAGE(PG8_SA(0, 0), cA, voffA); PG8_STAGE(PG8_SB(0, 1), cB + hstep, voffB); PG8_STAGE(PG8_SA(0, 1), cA + hstep, voffA);
        if (wr == 1) PG8_BAR;
        PG8_WAIT_V(4); PG8_BAR;
        PG8_STAGE(PG8_SB(1, 0), cB + kstep, voffB); PG8_STAGE(PG8_SA(1, 0), cA + kstep, voffA); PG8_STAGE(PG8_SB(1, 1), cB + hstep + kstep, voffB);
        PG8_WAIT_V(6); PG8_BAR;
    }
    for (;;) {
        const bool has_next = S.next(ui + 1, nxt);
        const char* nA = has_next ? (const char*)g.A + (size_t)nxt.pm * tstep : cA; const char* nB = has_next ? (const char*)g.Bt + (size_t)nxt.pn * tstep : cB;
        for (int t = 0; t < nt; t += 2) {
            const bool last = (t == nt - 2);
            const char* a1 = cA + (size_t)(t + 1) * kstep;
            const char* a2 = last ? nA : cA + (size_t)(t + 2) * kstep; const char* b2 = last ? nB : cB + (size_t)(t + 2) * kstep;
            const char* a3 = a2 + kstep; const char* b3 = b2 + kstep;
            if (last && has_next) S.a_ready(nxt);
            if constexpr (SP2) {
            PG8_LDB(B0, 0, 0); PG8_LDB(B1, 0, 1); PG8_SCHED; PG8_LDA(At, 0, 0); PG8_STAGE(PG8_SA(1, 1), a1 + hstep, voffA);
            PG8_WAIT_V(8); PG8_WAIT_L(0); PG8_BAR; PG8_MMA(0, 0, At, B0); PG8_MMA(0, 1, At, B1); PG8_BAR; PG8_SCHED;
            PG8_LDA(At, 0, 1); PG8_STAGE(PG8_SB(0, 0), b2, voffB); PG8_STAGE(PG8_SB(0, 1), b2 + hstep, voffB); PG8_STAGE(PG8_SA(0, 0), a2, voffA);
            PG8_WAIT_V(8); PG8_WAIT_L(0); PG8_BAR; PG8_MMA(1, 0, At, B0); PG8_MMA(1, 1, At, B1); PG8_BAR; PG8_SCHED;
            PG8_LDB(B0, 1, 0); PG8_LDB(B1, 1, 1); PG8_SCHED; PG8_LDA(At, 1, 0); PG8_STAGE(PG8_SA(0, 1), a2 + hstep, voffA);
            PG8_WAIT_V(8); PG8_WAIT_L(0); PG8_BAR; PG8_MMA(0, 0, At, B0); PG8_MMA(0, 1, At, B1); PG8_BAR; PG8_SCHED;
            PG8_LDA(At, 1, 1); PG8_STAGE(PG8_SB(1, 0), b3, voffB); PG8_STAGE(PG8_SB(1, 1), b3 + hstep, voffB); PG8_STAGE(PG8_SA(1, 0), a3, voffA);
            PG8_WAIT_V(8); PG8_WAIT_L(0); PG8_BAR; PG8_MMA(1, 0, At, B0); PG8_MMA(1, 1, At, B1); PG8_BAR; PG8_SCHED;
            } else {
            PG8_LDB(B0, 0, 0); PG8_SCHED; PG8_LDA(At, 0, 0); PG8_STAGE(PG8_SA(1, 1), a1 + hstep, voffA);
            PG8_WAIT_L(8); PG8_BAR; PG8_WAIT_L(0); PG8_MMA(0, 0, At, B0); PG8_BAR; PG8_SCHED;
            PG8_LDB(B1, 0, 1); PG8_STAGE(PG8_SB(0, 0), b2, voffB);
            PG8_BAR; PG8_WAIT_L(0); PG8_MMA(0, 1, At, B1); PG8_BAR;
            PG8_LDA(At, 0, 1); PG8_STAGE(PG8_SA(0, 0), a2, voffA);
            PG8_BAR; PG8_WAIT_L(0); PG8_MMA(1, 0, At, B0); PG8_BAR; PG8_SCHED;
            PG8_STAGE(PG8_SB(0, 1), b2 + hstep, voffB);
            PG8_WAIT_V(6); PG8_BAR; PG8_MMA(1, 1, At, B1); PG8_BAR;
            PG8_LDB(B0, 1, 0); PG8_SCHED; PG8_LDA(At, 1, 0); PG8_STAGE(PG8_SA(0, 1), a2 + hstep, voffA);
            PG8_WAIT_L(8); PG8_BAR; PG8_WAIT_L(0); PG8_MMA(0, 0, At, B0); PG8_BAR; PG8_SCHED;
            PG8_LDB(B1, 1, 1); PG8_STAGE(PG8_SB(1, 0), b3, voffB);
            PG8_BAR; PG8_WAIT_L(0); PG8_MMA(0, 1, At, B1); PG8_BAR;
            PG8_LDA(At, 1, 1); PG8_STAGE(PG8_SA(1, 0), a3, voffA);
            PG8_BAR; PG8_WAIT_L(0); PG8_MMA(1, 0, At, B0); PG8_BAR; PG8_SCHED;
            PG8_STAGE(PG8_SB(1, 1), b3 + hstep, voffB);
            PG8_WAIT_V(6); PG8_BAR; PG8_MMA(1, 1, At, B1); PG8_BAR;
            }
        }
        if constexpr (ALIGN_EPI) { if (wr == 0) PG8_BAR; }
        if constexpr (!Epi::AFTER_DRAIN) { E(acc, cur, wr, wc, fr, fq); S.done(cur); }
        if (!has_next) break;
#pragma unroll
        for (int a = 0; a < 2; ++a)
#pragma unroll
            for (int b = 0; b < 2; ++b)
#pragma unroll
                for (int m = 0; m < 4; ++m)
#pragma unroll
                    for (int n = 0; n < 2; ++n) acc[a][b][m][n] = (f32x4){0.f, 0.f, 0.f, 0.f};
        cur = nxt; cA = nA; cB = nB; ++ui;
        if constexpr (ALIGN_EPI) { if (wr == 1) PG8_BAR; }
    }
    PG8_WAIT_V(0);
    if constexpr (!ALIGN_EPI) { if (wr == 0) PG8_BAR; }
    PG8_BAR;
    if constexpr (Epi::AFTER_DRAIN) { E.fused(acc, cur, wr, wc, fr, fq, lds, wid, lane); S.done(cur); }
#undef PG8_SA
#undef PG8_SB
#undef PG8_STAGE
#undef PG8_LDA
#undef PG8_LDB
#undef PG8_MMA
#undef PG8_WAIT_V
#undef PG8_WAIT_L
#undef PG8_BAR
#undef PG8_SCHED
}
}

constexpr int NWAVES = 8;
constexpr int BATCH = 4, SEQ = 8192, D = 1024, M = BATCH * SEQ;
constexpr int PIN = 3592, NP = 3584;
constexpr int FF = 2816, NCH = 128, NBH = 16;
constexpr int PH_END = 12;
constexpr float EPS = 1e-6f;
constexpr size_t MiB = 1u << 20;
constexpr size_t WS_MOD = 1 * MiB;
constexpr size_t WS_GB = 2 * MiB;
constexpr size_t WS_EGL = 3 * MiB;
constexpr size_t WS_WIN = 4 * MiB, WS_WO = 11 * MiB, WS_WGU = 13 * MiB, WS_WD = 24 * MiB;
constexpr size_t WS_H = 32 * MiB;
constexpr size_t WS_CH = 32 * MiB;
constexpr size_t WS_P = 208 * MiB;
constexpr size_t WS_YC = 432 * MiB;
constexpr size_t WS_END = 496 * MiB;
constexpr int REC = 74752;
constexpr int REC_A = 57344;
constexpr int LDS_BYTES = 155648;

#define LAS __attribute__((address_space(3)))
typedef unsigned short bf16;
typedef unsigned v4u __attribute__((ext_vector_type(4)));
typedef unsigned v2u __attribute__((ext_vector_type(2)));
typedef float f32x4 __attribute__((ext_vector_type(4)));
typedef float f32x16 __attribute__((ext_vector_type(16)));
typedef short bf16x8 __attribute__((ext_vector_type(8)));
#define LDS_WAIT() asm volatile("s_waitcnt lgkmcnt(0)" ::: "memory")
using pg8::cvt_pk_bf16; using pg8::silu_f;
__device__ __forceinline__ float bf2f(unsigned short u) { return __uint_as_float((unsigned)u << 16); }
__device__ __forceinline__ float bflo(unsigned w) { return __uint_as_float(w << 16); }
__device__ __forceinline__ float bfhi(unsigned w) { return __uint_as_float(w & 0xffff0000u); }
__device__ __forceinline__ float wave_sum(float v) {
#pragma unroll
    for (int o = 1; o < 64; o <<= 1) v += __shfl_xor(v, o);
    return v;
}
__device__ __forceinline__ void unpack8(v4u w, float (&f)[8]) { f[0] = bflo(w.x); f[1] = bfhi(w.x); f[2] = bflo(w.y); f[3] = bfhi(w.y); f[4] = bflo(w.z); f[5] = bfhi(w.z); f[6] = bflo(w.w); f[7] = bfhi(w.w); }
__device__ __forceinline__ v4u pack8(const float (&f)[8]) { v4u w; w.x = cvt_pk_bf16(f[0], f[1]); w.y = cvt_pk_bf16(f[2], f[3]); w.z = cvt_pk_bf16(f[4], f[5]); w.w = cvt_pk_bf16(f[6], f[7]); return w; }

struct Args { const float* in[19]; float* out; unsigned char* ws; int ph_lo, ph_hi; };
enum { I_X = 0, I_C, I_WADA, I_BADA, I_WADAF, I_BADAF, I_GMIX, I_GFFN, I_GFIN, I_WIN, I_CWM, I_CWQ, I_ALOG, I_DTB, I_GCO, I_GDN, I_WOUT, I_WGU, I_WDN };

template <int MODE>
__device__ __forceinline__ void p0_transpose_item(const float* W, int K, int ld, int nblk, bf16* WT, LAS float* scr, int item, int lane) {
    const int kb = item / nblk, nb = item % nblk, k0 = 64 * kb, n0 = 32 * nb;
    f32x4 ld4[8];
#pragma unroll
    for (int i = 0; i < 8; ++i) ld4[i] = *(const f32x4*)(W + (size_t)(k0 + 8 * i + (lane >> 3)) * ld + n0 + 4 * (lane & 7));
#pragma unroll
    for (int i = 0; i < 8; ++i) { LAS float* d = scr + (8 * i + (lane >> 3)) * 33 + 4 * (lane & 7); d[0] = ld4[i].x; d[1] = ld4[i].y; d[2] = ld4[i].z; d[3] = ld4[i].w; }
    LDS_WAIT(); asm volatile("" ::: "memory");
    int r0 = n0;
    if (MODE == 1) { r0 = n0 < FF ? 256 * (n0 / 128) + (n0 % 128) : 256 * ((n0 - FF) / 128) + 128 + ((n0 - FF) % 128); }
    const int c = lane & 7;
#pragma unroll
    for (int j = 0; j < 4; ++j) { const int n = (lane >> 3) + 8 * j; const LAS float* s = scr + (8 * c) * 33 + n;
        v4u o; o.x = cvt_pk_bf16(s[0 * 33], s[1 * 33]); o.y = cvt_pk_bf16(s[2 * 33], s[3 * 33]); o.z = cvt_pk_bf16(s[4 * 33], s[5 * 33]); o.w = cvt_pk_bf16(s[6 * 33], s[7 * 33]);
        *(v4u*)(WT + (size_t)(r0 + n) * K + k0 + 8 * c) = o; }
    LDS_WAIT(); asm volatile("" ::: "memory");
}
__device__ __forceinline__ void p0_mod_item(const Args& a, float* MOD, const LAS float* SC, LAS float* red, int item, int tid) {
    const int c4 = tid & 7, ks = tid >> 3, col0 = item * 32;
    const bool fin = col0 >= 6144; const float* W = fin ? a.in[I_WADAF] : a.in[I_WADA]; const int ld = fin ? 2048 : 6144, cb = (fin ? col0 - 6144 : col0);
    f32x4 w[16];
#pragma unroll
    for (int kk = 0; kk < 16; ++kk) w[kk] = *(const f32x4*)(W + (size_t)(16 * ks + kk) * ld + cb + 4 * c4);
    f32x4 acc[4];
#pragma unroll
    for (int b = 0; b < 4; ++b) acc[b] = (f32x4){0.f, 0.f, 0.f, 0.f};
#pragma unroll
    for (int kk = 0; kk < 16; ++kk) { const f32x4 s = *(const LAS f32x4*)(SC + (16 * ks + kk) * 4); acc[0] += s.x * w[kk]; acc[1] += s.y * w[kk]; acc[2] += s.z * w[kk]; acc[3] += s.w * w[kk]; }
#pragma unroll
    for (int b = 0; b < 4; ++b) *(LAS f32x4*)(red + (ks * 4 + b) * 32 + 4 * c4) = acc[b];
    __syncthreads();
    if (tid < 128) { const int b = tid >> 5, cl = tid & 31; float s = 0.f;
#pragma unroll 16
        for (int k = 0; k < 64; ++k) s += red[(k * 4 + b) * 32 + cl];
        const int c = cb + cl;
        s += fin ? a.in[I_BADAF][c] : a.in[I_BADA][c];
        if (fin) MOD[4 * 6144 + b * 2048 + c] = s; else MOD[b * 6144 + c] = s; }
    __syncthreads();
}

template <int MODE>
__device__ __forceinline__ void adaln_one(const f32x4 (&xin)[4], const f32x4 (&gs)[4], const f32x4 (&sh)[4], int m, bf16* Hout, float* Fout, const LAS float* TT, const float* a_log, const float* dt_bias, float* GB, int lane) {
    f32x4 v[4]; float ss = 0.f;
#pragma unroll
    for (int j = 0; j < 4; ++j) { v[j] = xin[j]; ss += (v[j].x * v[j].x + v[j].y * v[j].y) + (v[j].z * v[j].z + v[j].w * v[j].w); }
    const float rinv = 1.0f / sqrtf(wave_sum(ss) * (1.0f / D) + EPS);
#pragma unroll
    for (int j = 0; j < 4; ++j) v[j] = (v[j] * rinv) * gs[j] + sh[j];
    if (MODE == 2) { f32x4* o = (f32x4*)(Fout + (size_t)m * D) + lane;
#pragma unroll
        for (int j = 0; j < 4; ++j) o[64 * j] = v[j];
    } else { v2u* o = (v2u*)(Hout + (size_t)m * D) + lane;
#pragma unroll
        for (int j = 0; j < 4; ++j) { v2u w; w.x = cvt_pk_bf16(v[j].x, v[j].y); w.y = cvt_pk_bf16(v[j].z, v[j].w); o[64 * j] = w; } }
    if (MODE == 0) {
        float d[8];
#pragma unroll
        for (int e = 0; e < 8; ++e) { float s = 0.f;
#pragma unroll
            for (int j = 0; j < 4; ++j) { const f32x4 t = *(const LAS f32x4*)(TT + e * 1024 + 4 * (lane + 64 * j)); s += (v[j].x * t.x + v[j].y * t.y) + (v[j].z * t.z + v[j].w * t.w); }
            asm volatile("" : "+v"(s) :: "memory"); d[e] = s; }
        float k4[4], k2[2], k1;
        { const bool hi = (lane & 32) != 0;
#pragma unroll
          for (int i = 0; i < 4; ++i) { const float snd = hi ? d[i] : d[4 + i]; const float kp = hi ? d[4 + i] : d[i]; k4[i] = kp + __shfl_xor(snd, 32); } }
        { const bool hi = (lane & 16) != 0;
#pragma unroll
          for (int i = 0; i < 2; ++i) { const float snd = hi ? k4[i] : k4[2 + i]; const float kp = hi ? k4[2 + i] : k4[i]; k2[i] = kp + __shfl_xor(snd, 16); } }
        { const bool hi = (lane & 8) != 0; const float snd = hi ? k2[0] : k2[1]; const float kp = hi ? k2[1] : k2[0]; k1 = kp + __shfl_xor(snd, 8); }
        k1 += __shfl_xor(k1, 4); k1 += __shfl_xor(k1, 2); k1 += __shfl_xor(k1, 1);
        if ((lane & 7) == 0) { const int e = lane >> 3; float r;
            if (e < 4) { const float xx = k1 + dt_bias[e]; const float sp = fmaxf(xx, 0.f) + log1pf(__expf(-fabsf(xx))); r = -__expf(a_log[e]) * sp; }
            else r = 1.0f / (1.0f + __expf(-k1));
            GB[(size_t)m * 8 + e] = r; }
    }
}
template <int MODE>
__device__ __forceinline__ void adaln_rows(const float* X, const float* gain, const float* shiftp, const float* scalep, int mstride, bf16* Hout, float* Fout,
                                           const LAS float* TT, const float* a_log, const float* dt_bias, float* GB, int gw, int NGW, int lane) {
    for (int blk = gw; blk < M / 16; blk += NGW) {
        const int m0 = blk * 16, b = m0 >> 13;
        f32x4 gs[4], sh[4];
        { const f32x4* g4 = (const f32x4*)gain + lane; const f32x4* sh4 = (const f32x4*)(shiftp + (size_t)b * mstride) + lane; const f32x4* sc4 = (const f32x4*)(scalep + (size_t)b * mstride) + lane;
#pragma unroll
          for (int j = 0; j < 4; ++j) { gs[j] = g4[64 * j] * (1.0f + sc4[64 * j]); sh[j] = sh4[64 * j]; } }
        f32x4 c0[4], c1[4];
        { const f32x4* xr = (const f32x4*)(X + (size_t)m0 * D) + lane;
#pragma unroll
          for (int j = 0; j < 4; ++j) { c0[j] = xr[64 * j]; c1[j] = xr[256 + 64 * j]; } }
#pragma unroll 1
        for (int i = 0; i < 16; i += 2) {
            f32x4 n0[4], n1[4];
            { const int mn = (i + 2 < 16) ? m0 + i + 2 : m0; const f32x4* xr = (const f32x4*)(X + (size_t)mn * D) + lane;
#pragma unroll
              for (int j = 0; j < 4; ++j) { n0[j] = xr[64 * j]; n1[j] = xr[256 + 64 * j]; } }
            adaln_one<MODE>(c0, gs, sh, m0 + i, Hout, Fout, TT, a_log, dt_bias, GB, lane);
            adaln_one<MODE>(c1, gs, sh, m0 + i + 1, Hout, Fout, TT, a_log, dt_bias, GB, lane);
#pragma unroll
            for (int j = 0; j < 4; ++j) { c0[j] = n0[j]; c1[j] = n1[j]; }
        }
    }
}

__device__ __forceinline__ void conv_qkv(const bf16* P, const float* cwq, bf16* QKV, int X, int t0, bool first, int lane) {
    const int colp = 1536 + 512 * X + 8 * lane, colo = 512 * X + 8 * lane;
    v4u raw[19];
#pragma unroll
    for (int t = 0; t < 19; ++t) { raw[t] = (v4u){0u, 0u, 0u, 0u}; if (t >= 3 || !first) raw[t] = *(const v4u*)(P + (size_t)(t0 - 3 + t) * NP + colp); }
    float w0[8], w1[8], w2[8], w3[8], h3[8], h2[8], h1[8];
#pragma unroll
    for (int e = 0; e < 8; ++e) { w0[e] = cwq[0 * 1536 + colo + e]; w1[e] = cwq[1 * 1536 + colo + e]; w2[e] = cwq[2 * 1536 + colo + e]; w3[e] = cwq[3 * 1536 + colo + e]; }
    unpack8(raw[0], h3); unpack8(raw[1], h2); unpack8(raw[2], h1);
#pragma unroll
    for (int t = 0; t < 16; ++t) { const int m = t0 + t; float x[8], y[8]; unpack8(raw[3 + t], x); float ss = 0.f;
#pragma unroll
        for (int e = 0; e < 8; ++e) { const float c = w0[e] * h3[e] + w1[e] * h2[e] + w2[e] * h1[e] + w3[e] * x[e]; y[e] = silu_f(c); ss += y[e] * y[e]; h3[e] = h2[e]; h2[e] = h1[e]; h1[e] = x[e]; }
        if (X < 2) { ss += __shfl_xor(ss, 1); ss += __shfl_xor(ss, 2); ss += __shfl_xor(ss, 4); ss += __shfl_xor(ss, 8);
            float r = 1.0f / sqrtf(ss + EPS); if (X == 0) r *= 0.08838834764831845f;
#pragma unroll
            for (int e = 0; e < 8; ++e) y[e] *= r; }
        *(v4u*)(QKV + (size_t)m * 1536 + colo) = pack8(y); }
}
__device__ __forceinline__ void conv_pass(const bf16* P, const float* cwm, const float* cwq, const float* gco, bf16* YC, bf16* QKV, int gw, int NGW, int lane) {
    for (int run = gw; run < M / 16; run += NGW) {
        const int t0 = run * 16; const bool first = (t0 & (SEQ - 1)) == 0;
        { float w0[8], w1[8], w2[8], gc[8], u2[8], u1[8]; const int c0 = 8 * lane;
#pragma unroll
          for (int e = 0; e < 8; ++e) { w0[e] = cwm[c0 + e]; w1[e] = cwm[512 + c0 + e]; w2[e] = cwm[1024 + c0 + e]; gc[e] = gco[c0 + e]; u2[e] = 0.f; u1[e] = 0.f; }
          if (!first) { float a[8], b[8]; unpack8(*(const v4u*)(P + (size_t)(t0 - 2) * NP + 512 + c0), a); unpack8(*(const v4u*)(P + (size_t)(t0 - 2) * NP + 1024 + c0), b);
#pragma unroll
              for (int e = 0; e < 8; ++e) u2[e] = a[e] * b[e];
              unpack8(*(const v4u*)(P + (size_t)(t0 - 1) * NP + 512 + c0), a); unpack8(*(const v4u*)(P + (size_t)(t0 - 1) * NP + 1024 + c0), b);
#pragma unroll
              for (int e = 0; e < 8; ++e) u1[e] = a[e] * b[e]; }
#pragma unroll 1
          for (int tb = 0; tb < 16; tb += 8) {
              v4u rb[8], rc[8], rh[8];
#pragma unroll
              for (int t = 0; t < 8; ++t) { const bf16* pr = P + (size_t)(t0 + tb + t) * NP + c0; rb[t] = *(const v4u*)pr; rc[t] = *(const v4u*)(pr + 512); rh[t] = *(const v4u*)(pr + 1024); }
#pragma unroll
              for (int t = 0; t < 8; ++t) { const int m = t0 + tb + t; float gb[8], a[8], b[8], y[8]; unpack8(rb[t], gb); unpack8(rc[t], a); unpack8(rh[t], b); float ss = 0.f;
#pragma unroll
                  for (int e = 0; e < 8; ++e) { const float u0 = a[e] * b[e]; y[e] = gb[e] * (w0[e] * u2[e] + w1[e] * u1[e] + w2[e] * u0); ss += y[e] * y[e]; u2[e] = u1[e]; u1[e] = u0; }
                  ss += __shfl_xor(ss, 1); ss += __shfl_xor(ss, 2); ss += __shfl_xor(ss, 4);
                  const float r = 1.0f / sqrtf(ss * (1.0f / 64.0f) + EPS);
#pragma unroll
                  for (int e = 0; e < 8; ++e) y[e] = y[e] * r * gc[e];
                  *(v4u*)(YC + (size_t)m * D + c0) = pack8(y); } } }
        conv_qkv(P, cwq, QKV, 0, t0, first, lane); conv_qkv(P, cwq, QKV, 1, t0, first, lane); conv_qkv(P, cwq, QKV, 2, t0, first, lane);
    }
}


constexpr int PREP_HALF = 69632, PK_KN = 0, PK_QN = 17408, PK_VV = 34816, PK_LM = 52224, PK_GC = 68608, PK_BT = 68864, PK_EG = 69120, PROW = 272;
template <bool SC>
__device__ __forceinline__ v4u afrag_piece_rows(const LAS unsigned char* tile, const LAS float* sc, int p) {
    const int f = p >> 6, ln = p & 63, mt = f >> 3, kt = (f >> 1) & 3, s = f & 1, r = ln & 31, hh = ln >> 5, row = 32 * mt + r, kb = 32 * kt + 16 * s + 4 * hh;
    const v2u a = *(const LAS v2u*)(tile + row * PROW + kb * 2), b = *(const LAS v2u*)(tile + row * PROW + (kb + 8) * 2);
    float scv = 1.0f; if (SC) scv = sc[row];
    v4u o; o.x = cvt_pk_bf16(bflo(a.x) * scv, bfhi(a.x) * scv); o.y = cvt_pk_bf16(bflo(a.y) * scv, bfhi(a.y) * scv); o.z = cvt_pk_bf16(bflo(b.x) * scv, bfhi(b.x) * scv); o.w = cvt_pk_bf16(bflo(b.y) * scv, bfhi(b.y) * scv);
    return o;
}
__device__ __forceinline__ void prep_phase(LAS unsigned char* lds, const bf16* QKV, const float* GB, float* EGL, unsigned char* CH, int tid) {
    const int half = tid >> 8, t = tid & 255, lane = tid & 63, w = (tid >> 6) & 3, r = lane & 31, hh = lane >> 5;
    LAS unsigned char* L = lds + half * PREP_HALF;
    LAS float* LM = (LAS float*)(L + PK_LM); LAS float* GC = (LAS float*)(L + PK_GC); LAS float* BT = (LAS float*)(L + PK_BT); LAS float* EG = (LAS float*)(L + PK_EG);
    for (int pu = blockIdx.x; pu < NBH * NCH / 2; pu += gridDim.x) {
        const int cid = 2 * pu + half, bh = cid >> 7, n = cid & 127, b = bh >> 2, h = bh & 3, m0 = b * SEQ + n * 64;
        unsigned char* rec = CH + (size_t)cid * REC;
        __syncthreads();
#pragma unroll
        for (int X = 0; X < 3; ++X)
#pragma unroll
            for (int i = 0; i < 4; ++i) { const int p = t + 256 * i, row = p >> 4, c16 = p & 15;
                const v4u v = *(const v4u*)(QKV + (size_t)(m0 + row) * 1536 + 512 * X + 128 * h + 8 * c16);
                *(LAS v4u*)(L + (X == 0 ? PK_QN : (X == 1 ? PK_KN : PK_VV)) + row * PROW + c16 * 16) = v; }
        if (w == 0) { float g = GB[(size_t)(m0 + lane) * 8 + h];
#pragma unroll
            for (int d = 1; d < 64; d <<= 1) { const float o = __shfl_up(g, d); if (lane >= d) g += o; }
            GC[lane] = g; EG[lane] = __expf(g); BT[lane] = GB[(size_t)(m0 + lane) * 8 + 4 + h];
            if (lane == 63) *(float*)(rec + 73728) = __expf(g); }
        __syncthreads();
        { const int mi = w >> 1, nj = w & 1;
          f32x16 kk, qk;
#pragma unroll
          for (int i = 0; i < 16; ++i) { kk[i] = 0.f; qk[i] = 0.f; }
#pragma unroll
          for (int st = 0; st < 8; ++st) {
              const bf16x8 ka = *(const LAS bf16x8*)(L + PK_KN + (32 * mi + r) * PROW + (16 * st + 8 * hh) * 2);
              const bf16x8 kb = *(const LAS bf16x8*)(L + PK_KN + (32 * nj + r) * PROW + (16 * st + 8 * hh) * 2);
              const bf16x8 qb = *(const LAS bf16x8*)(L + PK_QN + (32 * mi + r) * PROW + (16 * st + 8 * hh) * 2);
              kk = __builtin_amdgcn_mfma_f32_32x32x16_bf16(ka, kb, kk, 0, 0, 0);
              qk = __builtin_amdgcn_mfma_f32_32x32x16_bf16(kb, qb, qk, 0, 0, 0);
          }
          const float gj = GC[32 * nj + r], gq = GC[32 * mi + r];
          float av[16];
#pragma unroll
          for (int reg = 0; reg < 16; ++reg) { const int cr = (reg & 3) + 8 * (reg >> 2) + 4 * hh;
              const int i = 32 * mi + cr, j = 32 * nj + r;
              LM[i * 64 + j] = (i > j) ? BT[i] * kk[reg] * __expf(GC[i] - gj) : 0.f;
              const int key = 32 * nj + cr, qr = 32 * mi + r;
              av[reg] = (qr >= key) ? qk[reg] * __expf(gq - GC[key]) : 0.f; }
#pragma unroll
          for (int s = 0; s < 2; ++s) { v4u o; o.x = cvt_pk_bf16(av[8 * s], av[8 * s + 1]); o.y = cvt_pk_bf16(av[8 * s + 2], av[8 * s + 3]); o.z = cvt_pk_bf16(av[8 * s + 4], av[8 * s + 5]); o.w = cvt_pk_bf16(av[8 * s + 6], av[8 * s + 7]);
              *(v4u*)(rec + 49152 + ((mi * 2 + nj) * 2 + s) * 1024 + lane * 16) = o; }
        }
#pragma unroll
        for (int i = 0; i < 4; ++i) { const int p = t + 256 * i; *(v4u*)(rec + 16384 + p * 16) = afrag_piece_rows<true>(L + PK_QN, EG, p); }
        { const float gl = GC[63];
#pragma unroll
          for (int i = 0; i < 4; ++i) { const int p = t + 256 * i, f = p >> 6, ln = p & 63, mt = f >> 2, ct = (f >> 1) & 1, s = f & 1, dk = 32 * mt + (ln & 31), cb = 32 * ct + 16 * s + 4 * (ln >> 5);
              float e[8];
#pragma unroll
              for (int j = 0; j < 8; ++j) { const int c = cb + 8 * (j >> 2) + (j & 3); e[j] = bf2f(*(const LAS unsigned short*)(L + PK_KN + c * PROW + dk * 2)) * __expf(gl - GC[c]); }
              *(v4u*)(rec + 32768 + p * 16) = pack8(e); } }
        __syncthreads();
        { float X[64]; const bool isu = t < 128; const int col = t & 127;
          const LAS unsigned char* src = L + (isu ? PK_VV : PK_KN) + col * 2;
#pragma unroll
          for (int i = 0; i < 64; ++i) {
              const float egi = EG[i]; const float rhs = bf2f(*(const LAS unsigned short*)(src + i * PROW)) * BT[i] * (isu ? 1.0f : egi);
              float a0 = 0.f, a1 = 0.f, a2 = 0.f, a3 = 0.f;
#pragma unroll
              for (int j4 = 0; j4 < (i + 3) / 4; ++j4) { const f32x4 l = *(const LAS f32x4*)(LM + i * 64 + 4 * j4);
                  if (4 * j4 + 0 < i) a0 += l.x * X[4 * j4 + 0]; if (4 * j4 + 1 < i) a1 += l.y * X[4 * j4 + 1]; if (4 * j4 + 2 < i) a2 += l.z * X[4 * j4 + 2]; if (4 * j4 + 3 < i) a3 += l.w * X[4 * j4 + 3]; }
              X[i] = rhs - ((a0 + a1) + (a2 + a3)); asm volatile("" : "+v"(X[i]) :: "memory"); }
          __syncthreads();
          if (isu) { const int vs = col >> 5, dvl = col & 31;
#pragma unroll
              for (int mt = 0; mt < 2; ++mt)
#pragma unroll
                  for (int h2 = 0; h2 < 2; ++h2) { v4u* dst = (v4u*)(rec + REC_A + (size_t)(((vs * 2 + mt) * 64 + dvl + 32 * h2) * 32));
#pragma unroll
                      for (int a2 = 0; a2 < 2; ++a2) { const int i0 = 32 * mt + 4 * h2 + 16 * a2; v4u w;
                          w.x = cvt_pk_bf16(X[i0], X[i0 + 1]); w.y = cvt_pk_bf16(X[i0 + 2], X[i0 + 3]); w.z = cvt_pk_bf16(X[i0 + 8], X[i0 + 9]); w.w = cvt_pk_bf16(X[i0 + 10], X[i0 + 11]); dst[a2] = w; } }
          } else {
#pragma unroll
              for (int i = 0; i < 64; ++i) *(LAS unsigned short*)(L + PK_VV + i * PROW + col * 2) = (unsigned short)(cvt_pk_bf16(-X[i], 0.f) & 0xffffu);
          }
        }
        __syncthreads();
#pragma unroll
        for (int i = 0; i < 4; ++i) { const int p = t + 256 * i; *(v4u*)(rec + p * 16) = afrag_piece_rows<false>(L + PK_VV, EG, p); }
    }
}

__device__ __forceinline__ bf16x8 pack_acc(const f32x16& x, int s) {
    v4u p; p.x = cvt_pk_bf16(x[8 * s], x[8 * s + 1]); p.y = cvt_pk_bf16(x[8 * s + 2], x[8 * s + 3]); p.z = cvt_pk_bf16(x[8 * s + 4], x[8 * s + 5]); p.w = cvt_pk_bf16(x[8 * s + 6], x[8 * s + 7]);
    return __builtin_bit_cast(bf16x8, p);
}
#define MFMA32(a, b, c) __builtin_amdgcn_mfma_f32_32x32x16_bf16((a), (b), (c), 0, 0, 0)
__device__ __forceinline__ void chain_phase(LAS unsigned char* lds, const unsigned char* CH, float* Oraw, int bh, int tid) {
    const int wid = __builtin_amdgcn_readfirstlane(tid >> 6), lane = tid & 63, b = bh >> 2, h = bh & 3, vs = wid & 3;
    const unsigned char* rec0 = CH + (size_t)bh * NCH * REC;
    const bool comp = wid < 4, stager = (wid == 4 || wid == 5);
    const int hw = wid & 1;
#define CH_MOVE(n, dstbase, stride) do { _Pragma("unroll") for (int _i = 0; _i < 37; ++_i) { const int _pc = hw * 37 + _i; if (_pc < 73) \
        __builtin_amdgcn_global_load_lds((const unsigned*)(rec0 + (size_t)(n) * REC + _pc * 1024 + lane * 16), (LAS unsigned*)((dstbase) + _pc * (stride)), 16, 0, 0); } } while (0)
    constexpr int WARM_AHEAD = 8;
    LAS unsigned char* dummy = lds + 2 * REC + hw * 1024;
    f32x16 S[4], o0, o1;
#pragma unroll
    for (int k = 0; k < 4; ++k)
#pragma unroll
        for (int i = 0; i < 16; ++i) S[k][i] = 0.f;
#pragma unroll
    for (int i = 0; i < 16; ++i) { o0[i] = 0.f; o1[i] = 0.f; }
    if (!comp && !stager) { for (int q = 1; q <= WARM_AHEAD; ++q) { CH_MOVE(q, dummy, 0); asm volatile("s_waitcnt vmcnt(37)" ::: "memory"); } }
    if (stager) CH_MOVE(0, lds, 1024);
    if (!comp) asm volatile("s_waitcnt vmcnt(0)" ::: "memory");
    __builtin_amdgcn_s_barrier(); asm volatile("" ::: "memory");
    for (int n = 0; n < NCH; ++n) {
        const int buf = n & 1;
        if (!comp) {
            if (stager) { if (n + 1 < NCH) CH_MOVE(n + 1, lds + (buf ^ 1) * REC, 1024); asm volatile("s_waitcnt vmcnt(0)" ::: "memory"); }
            else { if (n + 1 + WARM_AHEAD < NCH) CH_MOVE(n + 1 + WARM_AHEAD, dummy, 0); asm volatile("s_waitcnt vmcnt(37)" ::: "memory"); }
        } else {
            if (n > 0) { float* op = Oraw + (size_t)(b * SEQ + (n - 1) * 64) * 512 + h * 128 + vs * 32 + (lane & 31);
#pragma unroll
                for (int reg = 0; reg < 16; ++reg) { const int cr = (reg & 3) + 8 * (reg >> 2) + 4 * (lane >> 5); op[(size_t)cr * 512] = o0[reg]; op[(size_t)(32 + cr) * 512] = o1[reg]; } }
            const LAS unsigned char* B = lds + buf * REC + lane * 16;
            const float egl = *(const LAS float*)(lds + buf * REC + 73728);
            f32x16 v0, v1;
            { const LAS v4u* ul = (const LAS v4u*)(lds + buf * REC + 57344 + ((vs * 2) * 64 + lane) * 32);
              const v4u a0 = ul[0], a1 = ul[1], b0 = ul[128], b1 = ul[129];
              v0[0] = bflo(a0.x); v0[1] = bfhi(a0.x); v0[2] = bflo(a0.y); v0[3] = bfhi(a0.y); v0[4] = bflo(a0.z); v0[5] = bfhi(a0.z); v0[6] = bflo(a0.w); v0[7] = bfhi(a0.w);
              v0[8] = bflo(a1.x); v0[9] = bfhi(a1.x); v0[10] = bflo(a1.y); v0[11] = bfhi(a1.y); v0[12] = bflo(a1.z); v0[13] = bfhi(a1.z); v0[14] = bflo(a1.w); v0[15] = bfhi(a1.w);
              v1[0] = bflo(b0.x); v1[1] = bfhi(b0.x); v1[2] = bflo(b0.y); v1[3] = bfhi(b0.y); v1[4] = bflo(b0.z); v1[5] = bfhi(b0.z); v1[6] = bflo(b0.w); v1[7] = bfhi(b0.w);
              v1[8] = bflo(b1.x); v1[9] = bfhi(b1.x); v1[10] = bflo(b1.y); v1[11] = bfhi(b1.y); v1[12] = bflo(b1.z); v1[13] = bfhi(b1.z); v1[14] = bflo(b1.w); v1[15] = bfhi(b1.w); }
#pragma unroll
            for (int i = 0; i < 16; ++i) { o0[i] = 0.f; o1[i] = 0.f; }
#pragma unroll
            for (int kt = 0; kt < 4; ++kt)
#pragma unroll
                for (int s = 0; s < 2; ++s) { const bf16x8 sb = pack_acc(S[kt], s);
                    v0 = MFMA32(*(const LAS bf16x8*)(B + ((0 * 4 + kt) * 2 + s) * 1024), sb, v0);
                    v1 = MFMA32(*(const LAS bf16x8*)(B + ((1 * 4 + kt) * 2 + s) * 1024), sb, v1);
                    o0 = MFMA32(*(const LAS bf16x8*)(B + 16384 + ((0 * 4 + kt) * 2 + s) * 1024), sb, o0);
                    o1 = MFMA32(*(const LAS bf16x8*)(B + 16384 + ((1 * 4 + kt) * 2 + s) * 1024), sb, o1); }
            bf16x8 vb[2][2];
            vb[0][0] = pack_acc(v0, 0); vb[0][1] = pack_acc(v0, 1); vb[1][0] = pack_acc(v1, 0); vb[1][1] = pack_acc(v1, 1);
#pragma unroll
            for (int ct = 0; ct < 2; ++ct)
#pragma unroll
                for (int s = 0; s < 2; ++s) {
                    o0 = MFMA32(*(const LAS bf16x8*)(B + 49152 + ((0 * 2 + ct) * 2 + s) * 1024), vb[ct][s], o0);
                    o1 = MFMA32(*(const LAS bf16x8*)(B + 49152 + ((1 * 2 + ct) * 2 + s) * 1024), vb[ct][s], o1); }
#pragma unroll
            for (int kt = 0; kt < 4; ++kt)
#pragma unroll
                for (int i = 0; i < 16; ++i) S[kt][i] *= egl;
#pragma unroll
            for (int ct = 0; ct < 2; ++ct)
#pragma unroll
                for (int s = 0; s < 2; ++s)
#pragma unroll
                    for (int kt = 0; kt < 4; ++kt) S[kt] = MFMA32(*(const LAS bf16x8*)(B + 32768 + ((kt * 2 + ct) * 2 + s) * 1024), vb[ct][s], S[kt]);
            asm volatile("s_waitcnt lgkmcnt(0)" ::: "memory");
        }
        __builtin_amdgcn_s_barrier(); asm volatile("" ::: "memory");
    }
    if (comp) { float* op = Oraw + (size_t)(b * SEQ + (NCH - 1) * 64) * 512 + h * 128 + vs * 32 + (lane & 31);
#pragma unroll
        for (int reg = 0; reg < 16; ++reg) { const int cr = (reg & 3) + 8 * (reg >> 2) + 4 * (lane >> 5); op[(size_t)cr * 512] = o0[reg]; op[(size_t)(32 + cr) * 512] = o1[reg]; } }
    asm volatile("s_waitcnt vmcnt(0)" ::: "memory");
#undef CH_MOVE
}
#if DN_NAIVE
__device__ __forceinline__ void naive_dn(const bf16* QKV, const float* GB, float* Oraw, int unit, int lane) {
    const int bh = unit >> 1, dv = (unit & 1) * 64 + lane, b = bh >> 2, h = bh & 3;
    float S[128];
#pragma unroll
    for (int i = 0; i < 128; ++i) S[i] = 0.f;
    for (int t = 0; t < SEQ; ++t) { const size_t m = (size_t)b * SEQ + t;
        const float al = __expf(GB[m * 8 + h]), be = GB[m * 8 + 4 + h];
        const bf16* qp = QKV + m * 1536 + h * 128; const bf16* kp = qp + 512; const float v = bf2f(qp[1024 + dv]);
        float r = 0.f;
#pragma unroll
        for (int i = 0; i < 128; ++i) { S[i] *= al; r += bf2f(kp[i]) * S[i]; if ((i & 15) == 15) asm volatile("" : "+v"(r) :: "memory"); }
        const float d = be * (v - r); float o = 0.f;
#pragma unroll
        for (int i = 0; i < 128; ++i) { S[i] += bf2f(kp[i]) * d; o += bf2f(qp[i]) * S[i]; if ((i & 15) == 15) asm volatile("" : "+v"(o) :: "memory"); }
        Oraw[m * 512 + h * 128 + dv] = o; }
}
#endif
__device__ __forceinline__ void opost_rows(const float* Oraw, const bf16* P, const float* gdn, bf16* YC, int gw, int NGW, int lane) {
    float gd[8];
#pragma unroll
    for (int e = 0; e < 8; ++e) gd[e] = gdn[(8 * lane + e) & 127];
    for (int blk = gw; blk < M / 16; blk += NGW) { const int m0 = blk * 16;
#pragma unroll 1
        for (int i = 0; i < 16; i += 8) {
            f32x4 oa[8], ob[8]; v4u zz[8];
#pragma unroll
            for (int t = 0; t < 8; ++t) { const int m = m0 + i + t; const f32x4* op = (const f32x4*)(Oraw + (size_t)m * 512 + 8 * lane); oa[t] = op[0]; ob[t] = op[1]; zz[t] = *(const v4u*)(P + (size_t)m * NP + 3072 + 8 * lane); }
#pragma unroll
            for (int t = 0; t < 8; ++t) { const int m = m0 + i + t; float z[8]; unpack8(zz[t], z);
                float o[8] = {oa[t].x, oa[t].y, oa[t].z, oa[t].w, ob[t].x, ob[t].y, ob[t].z, ob[t].w}; float ss = 0.f;
#pragma unroll
                for (int e = 0; e < 8; ++e) ss += o[e] * o[e];
                ss += __shfl_xor(ss, 1); ss += __shfl_xor(ss, 2); ss += __shfl_xor(ss, 4); ss += __shfl_xor(ss, 8);
                const float r = 1.0f / sqrtf(ss * (1.0f / 128.0f) + EPS);
#pragma unroll
                for (int e = 0; e < 8; ++e) o[e] = o[e] * r * gd[e] * silu_f(z[e]);
                *(v4u*)(YC + (size_t)m * D + 512 + 8 * lane) = pack8(o); } } }
}

typedef __attribute__((address_space(1))) unsigned gu32;
#define XB_TMO      128
#define XB_XCNT(j)  (256  + 64 * (j))
#define XB_XSUB(j)  (1280 + 64 * (j))
#define XB_XGEN(j)  (2304 + 64 * (j))
#define XB_TOP      3328
#define XB_TOPGEN   3392
#define XCD_BAR_WORDS 3456
#define XB_SPIN_CAP (1u << 18)

__device__ __forceinline__ unsigned xb_ld(unsigned* p)              { return __hip_atomic_load(p, __ATOMIC_RELAXED, __HIP_MEMORY_SCOPE_AGENT); }
__device__ __forceinline__ unsigned xb_add(unsigned* p, unsigned v) { return __hip_atomic_fetch_add(p, v, __ATOMIC_RELAXED, __HIP_MEMORY_SCOPE_AGENT); }
__device__ __forceinline__ unsigned xb_xcc_id() { return (unsigned)__builtin_amdgcn_s_getreg((3 << 11) | 20) & 0xFu; }
#define XB_SPIN(cond, bar) do { unsigned _sp = 0; while (cond) { __builtin_amdgcn_s_sleep(1); \
    if ((++_sp & 255u) == 0u) { if (xb_ld(&(bar)[XB_TMO])) break; if (_sp > XB_SPIN_CAP) { atomicAdd(&(bar)[XB_TMO], 1u); break; } } } } while (0)

struct XcdBarrier {
    unsigned* bar; unsigned x;
    volatile LAS unsigned* st;
};

__device__ __forceinline__ XcdBarrier xcd_barrier_post(unsigned* bar, volatile LAS unsigned* st) {
    XcdBarrier b; b.bar = bar; b.x = xb_xcc_id(); b.st = st;
    if (threadIdx.x == 0) (void)xb_add(&bar[XB_XCNT(b.x)], 1u);
    return b;
}
__device__ __forceinline__ void xcd_barrier_complete(unsigned* bar, unsigned x, unsigned& nloc, unsigned& nx) {
    const unsigned G = gridDim.x * gridDim.y * gridDim.z;
    unsigned sum, cnt, mine, sp = 0u;
    for (;;) {
        sum = 0u; cnt = 0u; mine = 0u;
#pragma unroll
        for (unsigned j = 0; j < 16; ++j) { const unsigned c = xb_ld(&bar[XB_XCNT(j)]); sum += c; cnt += (c > 0u) ? 1u : 0u; mine = (j == x) ? c : mine; }
        if (sum == G) break;
        __builtin_amdgcn_s_sleep(1);
        if ((++sp & 255u) == 0u) { if (xb_ld(&bar[XB_TMO])) break; if (sp > XB_SPIN_CAP) { atomicAdd(&bar[XB_TMO], 1u); break; } }
    }
    nloc = mine > 0u ? mine : 1u; nx = cnt > 0u ? cnt : 1u;
}

__device__ __forceinline__ void xcd_barrier(const XcdBarrier& b) {
    asm volatile("s_waitcnt vmcnt(0)" ::: "memory");
    __syncthreads();
    if (threadIdx.x == 0) {
        unsigned* bar = b.bar;
        __builtin_amdgcn_s_waitcnt(0);
        unsigned nloc = b.st[0], nx = b.st[1];
        if (nloc == 0u) { xcd_barrier_complete(bar, b.x, nloc, nx); b.st[0] = nloc; b.st[1] = nx; }
        const unsigned old = xb_add(&bar[XB_XSUB(b.x)], 1u);
        const unsigned gen = old / nloc;
        if (old + 1u == (gen + 1u) * nloc) {
            __builtin_amdgcn_fence(__ATOMIC_RELEASE, "agent");
            asm volatile("s_waitcnt vmcnt(0)" ::: "memory");
            const unsigned og = xb_add(&bar[XB_TOP], 1u);
            const unsigned tg = og / nx;
            if (og + 1u == (tg + 1u) * nx) xb_add(&bar[XB_TOPGEN], 1u);
            else XB_SPIN(xb_ld(&bar[XB_TOPGEN]) == tg, bar);
            __builtin_amdgcn_fence(__ATOMIC_ACQUIRE, "agent");
            xb_add(&bar[XB_XGEN(b.x)], 1u);
            asm volatile("s_waitcnt vmcnt(0)" ::: "memory");
        } else {
            XB_SPIN(xb_ld(&bar[XB_XGEN(b.x)]) == gen, bar);
            __builtin_amdgcn_fence(__ATOMIC_ACQUIRE, "agent");
            asm volatile("s_waitcnt vmcnt(0)" ::: "memory");
        }
    }
    __syncthreads();
}

__global__ void __launch_bounds__(NWAVES * 64, 2) fwd(Args args) {
    extern __shared__ __attribute__((aligned(16))) unsigned char lds_raw[];
    LAS unsigned char* lds = (LAS unsigned char*)lds_raw;
    const int tid = threadIdx.x, lane = tid & 63, wave = __builtin_amdgcn_readfirstlane(tid >> 6);
    const int G = gridDim.x; const int bx = blockIdx.x; const int vcu = (G % 8 == 0) ? (bx % 8) * (G / 8) + bx / 8 : bx;
    const int gw = vcu * NWAVES + wave, NGW = G * NWAVES;
    unsigned char* ws = args.ws;
    float* MOD = (float*)(ws + WS_MOD); float* GB = (float*)(ws + WS_GB); float* EGL = (float*)(ws + WS_EGL);
    bf16* WinT = (bf16*)(ws + WS_WIN); bf16* WoT = (bf16*)(ws + WS_WO); bf16* WguT = (bf16*)(ws + WS_WGU); bf16* WdT = (bf16*)(ws + WS_WD);
    bf16* H = (bf16*)(ws + WS_H); unsigned char* CH = ws + WS_CH; bf16* P = (bf16*)(ws + WS_P); bf16* ACT = (bf16*)(ws + WS_P); bf16* YC = (bf16*)(ws + WS_YC);
    bf16* QKV = (bf16*)args.out; float* Oraw = args.out; float* OUT = args.out;
    const int lo = args.ph_lo, hi = args.ph_hi;
    volatile LAS unsigned* MISC = (volatile LAS unsigned*)(lds + LDS_BYTES - 64);
    if (tid < 16) MISC[tid] = 0u;
    __syncthreads();
    XcdBarrier bar = xcd_barrier_post((unsigned*)ws, MISC);
    if (lo < 0) cg::this_grid().sync();
#ifndef PH_MASK
#define PH_MASK 0xFFF
#endif
#define IN(k) (((PH_MASK >> (k)) & 1) && lo <= (k) && (k) < hi)
#if MK_N_LAUNCHES == 1
#define SEAM(k) do { if (IN(k) && IN((k) + 1)) xcd_barrier(bar); } while (0)
#else
#define SEAM(k) do { } while (0)
#endif
#ifndef REP_MASK
#define REP_MASK 0
#endif
#define BEGIN_REP(k) for (int rep_ = 0; rep_ <= ((REP_MASK >> (k)) & 1); ++rep_) { if (rep_) xcd_barrier(bar);
#define END_REP }
    BEGIN_REP(0)
    if (IN(0)) {
        LAS float* scr = (LAS float*)(lds + wave * 16384);
        constexpr int I_IN = 16 * 112, I_O = 16 * 32, I_GU = 16 * 176, I_DN = 44 * 32, NITEMS = I_IN + I_O + I_GU + I_DN;
        for (int it = gw; it < NITEMS; it += NGW) { int r = it;
            if (r < I_IN) { p0_transpose_item<0>(args.in[I_WIN], D, PIN, 112, WinT, scr, r, lane); continue; } r -= I_IN;
            if (r < I_O) { p0_transpose_item<0>(args.in[I_WOUT], D, D, 32, WoT, scr, r, lane); continue; } r -= I_O;
            if (r < I_GU) { p0_transpose_item<1>(args.in[I_WGU], D, 2 * FF, 176, WguT, scr, r, lane); continue; } r -= I_GU;
            p0_transpose_item<0>(args.in[I_WDN], FF, D, 32, WdT, scr, r, lane); }
        __syncthreads();
        { LAS float* SC = (LAS float*)lds; const float* cin = args.in[I_C];
          for (int idx = tid; idx < 4096; idx += NWAVES * 64) { const int b = idx >> 10, k = idx & 1023; const float cv = cin[idx]; SC[k * 4 + b] = cv / (1.0f + __expf(-cv)); }
          __syncthreads();
          for (int it = bx; it < 256; it += G) p0_mod_item(args, MOD, SC, (LAS float*)(lds + 16384), it, tid); }
    }
    END_REP
    SEAM(0);
    BEGIN_REP(1)
    if (IN(1)) { LAS float* TT = (LAS float*)lds; const float* wi = args.in[I_WIN];
        for (int idx = tid; idx < 8192; idx += NWAVES * 64) { const int k = idx >> 3, e = idx & 7; TT[e * 1024 + k] = wi[(size_t)k * PIN + NP + e]; }
        __syncthreads();
        adaln_rows<0>(args.in[I_X], args.in[I_GMIX], MOD + 0, MOD + 1024, 6144, H, nullptr, TT, args.in[I_ALOG], args.in[I_DTB], GB, gw, NGW, lane);
        __syncthreads(); }
    END_REP
    SEAM(1);
    BEGIN_REP(2)
    if (IN(2)) { pg8::Gemm g{H, WinT, M, NP, D}; pg8::StaticOrder S; S.init(M, NP, G, bx); pg8::EpiBf16 E{P, NP};
        pg8::gemm_phase<pg8::EpiBf16, pg8::StaticOrder, true, true>(lds, g, S, E); }
    END_REP
    SEAM(2);
    BEGIN_REP(3)
    if (IN(3)) conv_pass(P, args.in[I_CWM], args.in[I_CWQ], args.in[I_GCO], YC, QKV, gw, NGW, lane);
    END_REP
    SEAM(3);
#if DN_NAIVE
    SEAM(4);
    if (IN(5)) { if (bx < 32 && wave == 0) naive_dn(QKV, GB, (float*)(ws + WS_CH), bx, lane); }
    SEAM(5);
    if (IN(6)) opost_rows((const float*)(ws + WS_CH), P, args.in[I_GDN], YC, gw, NGW, lane);
#else
    BEGIN_REP(4)
    if (IN(4)) prep_phase(lds, QKV, GB, EGL, CH, tid);
    END_REP
    SEAM(4);
    BEGIN_REP(5)
    if (IN(5)) { if (bx < NBH) chain_phase(lds, CH, Oraw, bx, tid); }
    END_REP
    SEAM(5);
    BEGIN_REP(6)
    if (IN(6)) opost_rows(Oraw, P, args.in[I_GDN], YC, gw, NGW, lane);
    END_REP
#endif
    SEAM(6);
    BEGIN_REP(7)
    if (IN(7)) { pg8::Gemm g{YC, WoT, M, D, D}; pg8::StaticOrder S; S.init(M, D, G, bx); pg8::EpiResGate E{args.in[I_X], OUT, MOD + 2048, 6144};
        pg8::gemm_phase<pg8::EpiResGate, pg8::StaticOrder, true, true>(lds, g, S, E); }
    END_REP
    SEAM(7);
    BEGIN_REP(8)
    if (IN(8)) adaln_rows<1>(OUT, args.in[I_GFFN], MOD + 3072, MOD + 4096, 6144, H, nullptr, nullptr, nullptr, nullptr, nullptr, gw, NGW, lane);
    END_REP
    SEAM(8);
    BEGIN_REP(9)
    if (IN(9)) { pg8::Gemm g{H, WguT, M, 2 * FF, D}; pg8::StaticOrder S; S.init(M, 2 * FF, G, bx); pg8::EpiSwiglu E{ACT, FF};
        pg8::gemm_phase<pg8::EpiSwiglu, pg8::StaticOrder, true, true>(lds, g, S, E); }
    END_REP
    SEAM(9);
    BEGIN_REP(10)
    if (IN(10)) { pg8::Gemm g{ACT, WdT, M, D, FF}; pg8::StaticOrder S; S.init(M, D, G, bx); pg8::EpiResGate E{OUT, OUT, MOD + 5120, 6144};
        pg8::gemm_phase<pg8::EpiResGate, pg8::StaticOrder, true, true>(lds, g, S, E); }
    END_REP
    SEAM(10);
    if (IN(11)) adaln_rows<2>(OUT, args.in[I_GFIN], MOD + 4 * 6144, MOD + 4 * 6144 + 1024, 2048, nullptr, OUT, nullptr, nullptr, nullptr, nullptr, gw, NGW, lane);
#undef IN
#undef SEAM
}

extern "C" void kernel_launch(void* const* d_in, const int* in_sizes, int n_in, void* d_out, int out_size, void* d_ws, size_t ws_size, hipStream_t stream) {
    static int grid = 0;
    if (grid == 0) {
        if (n_in != 19 || out_size != M * D || ws_size < WS_END) { fprintf(stderr, "kernel_launch: unexpected shapes (n_in %d, out %d, ws %zu)\n", n_in, out_size, ws_size); grid = -1; return; }
        int dev = 0, cus = 0;
        if (hipGetDevice(&dev) != hipSuccess || hipDeviceGetAttribute(&cus, hipDeviceAttributeMultiprocessorCount, dev) != hipSuccess) { grid = -1; return; }
        if (hipFuncSetAttribute((const void*)fwd, hipFuncAttributeMaxDynamicSharedMemorySize, LDS_BYTES) != hipSuccess) { fprintf(stderr, "kernel_launch: hipFuncSetAttribute failed\n"); grid = -1; return; }
        int per_cu = 0;
        if (hipOccupancyMaxActiveBlocksPerMultiprocessor(&per_cu, (const void*)fwd, NWAVES * 64, LDS_BYTES) != hipSuccess || per_cu < 1) { fprintf(stderr, "kernel_launch: occupancy query says %d blocks per CU\n", per_cu); }
        (void)hipGetLastError();
        grid = cus;
    }
    if (grid < 0) return;
    Args a{};
    for (int i = 0; i < 19; ++i) a.in[i] = (const float*)d_in[i];
    a.out = (float*)d_out; a.ws = (unsigned char*)d_ws;
#if MK_N_LAUNCHES == 1
    if (hipMemsetAsync(d_ws, 0, 16384, stream) != hipSuccess) { fprintf(stderr, "kernel_launch: memset of the barrier words failed\n"); return; }
    a.ph_lo = 0; a.ph_hi = PH_END;
    void* kargs[] = {&a};
    hipError_t e = hipLaunchCooperativeKernel((const void*)fwd, dim3(grid), dim3(NWAVES * 64), kargs, LDS_BYTES, stream);
    if (e != hipSuccess) fprintf(stderr, "kernel_launch: cooperative launch failed: %s (grid %d)\n", hipGetErrorString(e), grid);
#else
    for (int ph = 0; ph < PH_END; ++ph) { a.ph_lo = ph; a.ph_hi = ph + 1; hipLaunchKernelGGL(fwd, dim3(grid), dim3(NWAVES * 64), LDS_BYTES, stream, a); }
#endif
}
```

```cpp
#include <hip/hip_runtime.h>
#include <hip/hip_cooperative_groups.h>
#include <cstdio>
#include <cstdint>
namespace cg = cooperative_groups;
#ifndef MK_N_LAUNCHES
#define MK_N_LAUNCHES 1
#endif
#ifndef DN_NAIVE
#define DN_NAIVE 0
#endif
namespace pg8 {
#define PG8_LAS __attribute__((address_space(3)))
typedef unsigned short bf16_t;
typedef short bf16x8 __attribute__((ext_vector_type(8)));
typedef float f32x4 __attribute__((ext_vector_type(4)));
typedef unsigned u32x4 __attribute__((ext_vector_type(4)));
constexpr int BM = 256, BK = 64, HALF = 128, HTB = HALF * BK * 2  , STAGE_BYTES = 8 * HTB, NXCD = 8, WGM = 8;

__host__ __device__ __forceinline__ int lds_byte(int r, int c) { const int st = (r >> 4) * 2 + (c >> 5), rr = r & 15, cc = c & 31, ob = rr * 64 + cc * 2; return st * 1024 + (ob ^ (((ob >> 9) & 1) << 5)); }
__host__ __device__ __forceinline__ void stage_rc(int b, int& R, int& C) { const int st = b / 1024, sb = b % 1024, swz = sb ^ (((sb >> 9) & 1) << 5); R = (st >> 1) * 16 + swz / 64; C = (st & 1) * 32 + (swz % 64) / 2; }
__host__ __device__ __forceinline__ int perm32(int rho) { const int n = rho >> 4, i = rho & 15; return 8 * (i >> 2) + 4 * n + (i & 3); }

struct Unit { int pm, pn; };
struct Gemm { const bf16_t* A; const bf16_t* Bt; int M, N, K; };

struct StaticOrder {
    int nM, nN, nwg, G, c;
    __host__ __device__ void init(int M, int N, int G_, int c_) { nM = M / BM; nN = N / BM; nwg = nM * nN; G = G_; c = c_; }
    __host__ __device__ bool next(int i, Unit& u) const {
        const long L = (long)i * G + c; if (L >= nwg) return false;
        int wgid = (int)L; { const int q = nwg / NXCD, r = nwg % NXCD, xcd = wgid % NXCD, off = wgid / NXCD; wgid = (xcd < r ? xcd * (q + 1) : r * (q + 1) + (xcd - r) * q) + off; }
        const int nig = WGM * nN, gid = wgid / nig, fm = gid * WGM, gsz = (nM - fm) < WGM ? (nM - fm) : WGM;
        u.pm = fm + ((wgid % nig) % gsz); u.pn = (wgid % nig) / gsz; return true;
    }
    __device__ __forceinline__ void a_ready(const Unit&) const {}
    __device__ __forceinline__ void done(const Unit&) const {}
};

typedef float f32x2 __attribute__((ext_vector_type(2)));
typedef __bf16 bf16x2v __attribute__((ext_vector_type(2)));
__device__ __forceinline__ unsigned cvt_pk_bf16(float lo, float hi) { f32x2 v = {lo, hi}; bf16x2v r = __builtin_convertvector(v, bf16x2v); return __builtin_bit_cast(unsigned, r); }
__device__ __forceinline__ float silu_f(float x) { return x * __builtin_amdgcn_rcpf(1.0f + __builtin_amdgcn_exp2f(-1.4426950408889634f * x)); }

struct EpiBf16 {
    static constexpr bool PERM = true, AFTER_DRAIN = false;
    bf16_t* O; int ldc;
    __device__ __forceinline__ void operator()(const f32x4 (&acc)[2][2][4][2], const Unit& u, int wr, int wc, int fr, int fq) const {
        const int row0 = u.pm * BM + wr * 64 + fr; const int col0 = u.pn * BM + wc * 32 + 8 * fq;
#pragma unroll
        for (int ai = 0; ai < 2; ++ai)
#pragma unroll
            for (int m = 0; m < 4; ++m) { bf16_t* rowp = O + (size_t)(row0 + ai * HALF + m * 16) * ldc + col0;
#pragma unroll
                for (int bj = 0; bj < 2; ++bj) { const f32x4 v0 = acc[ai][bj][m][0], v1 = acc[ai][bj][m][1];
                    u32x4 w; w.x = cvt_pk_bf16(v0[0], v0[1]); w.y = cvt_pk_bf16(v0[2], v0[3]); w.z = cvt_pk_bf16(v1[0], v1[1]); w.w = cvt_pk_bf16(v1[2], v1[3]);
                    *(u32x4*)(rowp + bj * HALF) = w; } }
    }
};
struct EpiSwiglu {
    static constexpr bool PERM = true, AFTER_DRAIN = false;
    bf16_t* O; int ldc;
    __device__ __forceinline__ void operator()(const f32x4 (&acc)[2][2][4][2], const Unit& u, int wr, int wc, int fr, int fq) const {
        const int row0 = u.pm * BM + wr * 64 + fr; const int col0 = u.pn * HALF + wc * 32 + 8 * fq;
#pragma unroll
        for (int ai = 0; ai < 2; ++ai)
#pragma unroll
            for (int m = 0; m < 4; ++m) { bf16_t* rowp = O + (size_t)(row0 + ai * HALF + m * 16) * ldc + col0;
                const f32x4 g0 = acc[ai][0][m][0], g1 = acc[ai][0][m][1], u0 = acc[ai][1][m][0], u1 = acc[ai][1][m][1];
                u32x4 w; w.x = cvt_pk_bf16(silu_f(g0[0]) * u0[0], silu_f(g0[1]) * u0[1]); w.y = cvt_pk_bf16(silu_f(g0[2]) * u0[2], silu_f(g0[3]) * u0[3]);
                w.z = cvt_pk_bf16(silu_f(g1[0]) * u1[0], silu_f(g1[1]) * u1[1]); w.w = cvt_pk_bf16(silu_f(g1[2]) * u1[2], silu_f(g1[3]) * u1[3]);
                *(u32x4*)rowp = w; }
    }
};
struct EpiResGate {
    static constexpr bool PERM = false, AFTER_DRAIN = false;
    const float* base; float* out; const float* gate;
    int gstride;
    __device__ __forceinline__ void operator()(const f32x4 (&acc)[2][2][4][2], const Unit& u, int wr, int wc, int fr, int fq) const {
        const int b = u.pm >> 5;
        const int col0 = u.pn * BM + wc * 32 + 4 * fq; const float* gp = gate + (size_t)b * gstride + col0;
        f32x4 gv[2][2];
#pragma unroll
        for (int bj = 0; bj < 2; ++bj)
#pragma unroll
            for (int n = 0; n < 2; ++n) gv[bj][n] = *(const f32x4*)(gp + bj * HALF + n * 16);
#pragma unroll
        for (int ai = 0; ai < 2; ++ai)
#pragma unroll
            for (int m = 0; m < 4; ++m) { const size_t off = (size_t)(u.pm * BM + ai * HALF + wr * 64 + m * 16 + fr) * 1024 + col0;
#pragma unroll
                for (int bj = 0; bj < 2; ++bj)
#pragma unroll
                    for (int n = 0; n < 2; ++n) { const f32x4 bs = *(const f32x4*)(base + off + bj * HALF + n * 16);
                        *(f32x4*)(out + off + bj * HALF + n * 16) = bs + gv[bj][n] * acc[ai][bj][m][n]; } }
    }
};

template <class Epi, class Sched, bool ALIGN_EPI = false, bool SP2 = false>
__device__ __forceinline__ void gemm_phase(PG8_LAS unsigned char* lds, const Gemm g, const Sched& S, const Epi& E) {
    const int tid = threadIdx.x, wid = __builtin_amdgcn_readfirstlane(tid >> 6), lane = tid & 63, wr = wid >> 2, wc = wid & 3, fr = lane & 15, fq = lane >> 4;
    const int K = g.K, nt = K / BK;
    unsigned voffA[2], voffB[2];
#pragma unroll
    for (int i = 0; i < 2; ++i) { int R, C; stage_rc(tid * 16 + i * 8192, R, C); const int Rb = Epi::PERM ? ((R & ~31) + perm32(R & 31)) : R;
        voffA[i] = (unsigned)(R * K + C) * 2u; voffB[i] = (unsigned)(Rb * K + C) * 2u; }
    const size_t kstep = (size_t)(BK * 2);
    const size_t hstep = (size_t)HALF * K * 2;
    const size_t tstep = 2 * hstep;
    const unsigned ldsw = (unsigned)wid * 1024u;
    const int aoff = lds_byte(wr * 64 + fr, fq * 8), boff = lds_byte(wc * 32 + fr, fq * 8);
#define PG8_SA(b, h) (((b) * 2 + (h)) * HTB)
#define PG8_SB(b, h) ((4 + (b) * 2 + (h)) * HTB)
#define PG8_STAGE(bufoff, gbase, voff) do { _Pragma("unroll") for (int _i = 0; _i < 2; ++_i) \
        __builtin_amdgcn_global_load_lds((const unsigned*)((const char*)(gbase) + (voff)[_i]), (PG8_LAS unsigned*)(lds + (bufoff) + ldsw + _i * 8192), 16, 0, 0); } while (0)
#define PG8_LDA(dst, b, h) do { _Pragma("unroll") for (int m = 0; m < 4; ++m) _Pragma("unroll") for (int k = 0; k < 2; ++k) dst[m][k] = *(const PG8_LAS bf16x8*)(lds + PG8_SA(b, h) + aoff + m * 2048 + k * 1024); } while (0)
#define PG8_LDB(dst, b, h) do { _Pragma("unroll") for (int n = 0; n < 2; ++n) _Pragma("unroll") for (int k = 0; k < 2; ++k) dst[n][k] = *(const PG8_LAS bf16x8*)(lds + PG8_SB(b, h) + boff + n * 2048 + k * 1024); } while (0)
#define PG8_MMA(ai, bj, At, Bt) do { __builtin_amdgcn_s_setprio(1); _Pragma("unroll") for (int m = 0; m < 4; ++m) _Pragma("unroll") for (int n = 0; n < 2; ++n) _Pragma("unroll") for (int k = 0; k < 2; ++k) \
        acc[ai][bj][m][n] = __builtin_amdgcn_mfma_f32_16x16x32_bf16(Bt[n][k], At[m][k], acc[ai][bj][m][n], 0, 0, 0); __builtin_amdgcn_s_setprio(0); } while (0)
#define PG8_WAIT_V(n) asm volatile("s_waitcnt vmcnt(" #n ")" ::: "memory")
#define PG8_WAIT_L(n) asm volatile("s_waitcnt lgkmcnt(" #n ")" ::: "memory")
#define PG8_BAR __builtin_amdgcn_s_barrier()
#define PG8_SCHED __builtin_amdgcn_sched_barrier(0)
    Unit cur, nxt; int ui = 0;
    if (!S.next(0, cur)) return;
    f32x4 acc[2][2][4][2];
#pragma unroll
    for (int a = 0; a < 2; ++a)
#pragma unroll
        for (int b = 0; b < 2; ++b)
#pragma unroll
            for (int m = 0; m < 4; ++m)
#pragma unroll
                for (int n = 0; n < 2; ++n) acc[a][b][m][n] = (f32x4){0.f, 0.f, 0.f, 0.f};
    bf16x8 At[4][2], B0[2][2], B1[2][2];
    const char* cA = (const char*)g.A + (size_t)cur.pm * tstep; const char* cB = (const char*)g.Bt + (size_t)cur.pn * tstep;
    S.a_ready(cur);
    if constexpr (SP2) {
        PG8_STAGE(PG8_SB(0, 0), cB, voffB); PG8_STAGE(PG8_SB(0, 1), cB + hstep, voffB); PG8_STAGE(PG8_SA(0, 0), cA, voffA); PG8_STAGE(PG8_SA(0, 1), cA + hstep, voffA);
        if (wr == 1) PG8_BAR;
        PG8_WAIT_V(2); PG8_BAR;
        PG8_STAGE(PG8_SB(1, 0), cB + kstep, voffB); PG8_STAGE(PG8_SA(1, 0), cA + kstep, voffA); PG8_STAGE(PG8_SB(1, 1), cB + hstep + kstep, voffB);
        PG8_WAIT_V(6); PG8_BAR;
    } else {
        PG8_STAGE(PG8_SB(0, 0), cB, voffB); PG8_STAGE(PG8_SA(0, 0), cA, voffA); PG8_STAGE(PG8_SB(0, 1), cB + hstep, voffB); PG8_STAGE(PG8_SA(0, 1), cA + hstep, voffA);
        if (wr == 1) PG8_BAR;
        PG8_WAIT_V(4); PG8_BAR;
        PG8_STAGE(PG8_SB(1, 0), cB + kstep, voffB); PG8_STAGE(PG8_SA(1, 0), cA + kstep, voffA); PG8_STAGE(PG8_SB(1, 1), cB + hstep + kstep, voffB);
        PG8_WAIT_V(6); PG8_BAR;
    }
    for (;;) {
        const bool has_next = S.next(ui + 1, nxt);
        const char* nA = has_next ? (const char*)g.A + (size_t)nxt.pm * tstep : cA; const char* nB = has_next ? (const char*)g.Bt + (size_t)nxt.pn * tstep : cB;
        for (int t = 0; t < nt; t += 2) {
            const bool last = (t == nt - 2);
            const char* a1 = cA + (size_t)(t + 1) * kstep;
            const char* a2 = last ? nA : cA + (size_t)(t + 2) * kstep; const char* b2 = last ? nB : cB + (size_t)(t + 2) * kstep;
            const char* a3 = a2 + kstep; const char* b3 = b2 + kstep;
            if (last && has_next) S.a_ready(nxt);
            if constexpr (SP2) {
            PG8_LDB(B0, 0, 0); PG8_LDB(B1, 0, 1); PG8_SCHED; PG8_LDA(At, 0, 0); PG8_STAGE(PG8_SA(1, 1), a1 + hstep, voffA);
            PG8_WAIT_V(8); PG8_WAIT_L(0); PG8_BAR; PG8_MMA(0, 0, At, B0); PG8_MMA(0, 1, At, B1); PG8_BAR; PG8_SCHED;
            PG8_LDA(At, 0, 1); PG8_STAGE(PG8_SB(0, 0), b2, voffB); PG8_STAGE(PG8_SB(0, 1), b2 + hstep, voffB); PG8_STAGE(PG8_SA(0, 0), a2, voffA);
            PG8_WAIT_V(8); PG8_WAIT_L(0); PG8_BAR; PG8_MMA(1, 0, At, B0); PG8_MMA(1, 1, At, B1); PG8_BAR; PG8_SCHED;
            PG8_LDB(B0, 1, 0); PG8_LDB(B1, 1, 1); PG8_SCHED; PG8_LDA(At, 1, 0); PG8_STAGE(PG8_SA(0, 1), a2 + hstep, voffA);
            PG8_WAIT_V(8); PG8_WAIT_L(0); PG8_BAR; PG8_MMA(0, 0, At, B0); PG8_MMA(0, 1, At, B1); PG8_BAR; PG8_SCHED;
            PG8_LDA(At, 1, 1); PG8_STAGE(PG8_SB(1, 0), b3, voffB); PG8_STAGE(PG8_SB(1, 1), b3 + hstep, voffB); PG8_STAGE(PG8_SA(1, 0), a3, voffA);
            PG8_WAIT_V(8); PG8_WAIT_L(0); PG8_BAR; PG8_MMA(1, 0, At, B0); PG8_MMA(1, 1, At, B1); PG8_BAR; PG8_SCHED;
            } else {
            PG8_LDB(B0, 0, 0); PG8_SCHED; PG8_LDA(At, 0, 0); PG8_STAGE(PG8_SA(1, 1), a1 + hstep, voffA);
            PG8_WAIT_L(8); PG8_BAR; PG8_WAIT_L(0); PG8_MMA(0, 0, At, B0); PG8_BAR; PG8_SCHED;
            PG8_LDB(B1, 0, 1); PG8_STAGE(PG8_SB(0, 0), b2, voffB);
            PG8_BAR; PG8_WAIT_L(0); PG8_MMA(0, 1, At, B1); PG8_BAR;
            PG8_LDA(At, 0, 1); PG8_STAGE(PG8_SA(0, 0), a2, voffA);
            PG8_BAR; PG8_WAIT_L(0); PG8_MMA(1, 0, At, B0); PG8_BAR; PG8_SCHED;
            PG8_STAGE(PG8_SB(0, 1), b2 + hstep, voffB);
            PG8_WAIT_V(6); PG8_BAR; PG8_MMA(1, 1, At, B1); PG8_BAR;
            PG8_LDB(B0, 1, 0); PG8_SCHED; PG8_LDA(At, 1, 0); PG8_STAGE(PG8_SA(0, 1), a2 + hstep, voffA);
            PG8_WAIT_L(8); PG8_BAR; PG8_WAIT_L(0); PG8_MMA(0, 0, At, B0); PG8_BAR; PG8_SCHED;
            PG8_LDB(B1, 1, 1); PG8_STAGE(PG8_SB(1, 0), b3, voffB);
            PG8_BAR; PG8_WAIT_L(0); PG8_MMA(0, 1, At, B1); PG8_BAR;
            PG8_LDA(At, 1, 1); PG8_STAGE(PG8_SA(1, 0), a3, voffA);
            PG8_BAR; PG8_WAIT_L(0); PG8_MMA(1, 0, At, B0); PG8_BAR; PG8_SCHED;
            PG8_STAGE(PG8_SB(1, 1), b3 + hstep, voffB);
            PG8_WAIT_V(6); PG8_BAR; PG8_MMA(1, 1, At, B1); PG8_BAR;
            }
        }
        if constexpr (ALIGN_EPI) { if (wr == 0) PG8_BAR; }
        if constexpr (!Epi::AFTER_DRAIN) { E(acc, cur, wr, wc, fr, fq); S.done(cur); }
        if (!has_next) break;
#pragma unroll
        for (int a = 0; a < 2; ++a)
#pragma unroll
            for (int b = 0; b < 2; ++b)
#pragma unroll
                for (int m = 0; m < 4; ++m)
#pragma unroll
                    for (int n = 0; n < 2; ++n) acc[a][b][m][n] = (f32x4){0.f, 0.f, 0.f, 0.f};
        cur = nxt; cA = nA; cB = nB; ++ui;
        if constexpr (ALIGN_EPI) { if (wr == 1) PG8_BAR; }
    }
    PG8_WAIT_V(0);
    if constexpr (!ALIGN_EPI) { if (wr == 0) PG8_BAR; }
    PG8_BAR;
    if constexpr (Epi::AFTER_DRAIN) { E.fused(acc, cur, wr, wc, fr, fq, lds, wid, lane); S.done(cur); }
#undef PG8_SA
#undef PG8_SB
#undef PG8_STAGE
#undef PG8_LDA
#undef PG8_LDB
#undef PG8_MMA
#undef PG8_WAIT_V
#undef PG8_WAIT_L
#undef PG8_BAR
#undef PG8_SCHED
}
}

constexpr int NWAVES = 8;
constexpr int BATCH = 4, SEQ = 8192, D = 1024, M = BATCH * SEQ;
constexpr int PIN = 3592, NP = 3584;
constexpr int FF = 2816, NCH = 128, NBH = 16;
constexpr int PH_END = 12;
constexpr float EPS = 1e-6f;
constexpr size_t MiB = 1u << 20;
constexpr size_t WS_MOD = 1 * MiB;
constexpr size_t WS_GB = 2 * MiB;
constexpr size_t WS_EGL = 3 * MiB;
constexpr size_t WS_WIN = 4 * MiB, WS_WO = 11 * MiB, WS_WGU = 13 * MiB, WS_WD = 24 * MiB;
constexpr size_t WS_H = 32 * MiB;
constexpr size_t WS_CH = 32 * MiB;
constexpr size_t WS_P = 208 * MiB;
constexpr size_t WS_YC = 432 * MiB;
constexpr size_t WS_END = 496 * MiB;
constexpr int REC = 74752;
constexpr int REC_A = 57344;
constexpr int LDS_BYTES = 155648;

#define LAS __attribute__((address_space(3)))
typedef unsigned short bf16;
typedef unsigned v4u __attribute__((ext_vector_type(4)));
typedef unsigned v2u __attribute__((ext_vector_type(2)));
typedef float f32x4 __attribute__((ext_vector_type(4)));
typedef float f32x16 __attribute__((ext_vector_type(16)));
typedef short bf16x8 __attribute__((ext_vector_type(8)));
#define LDS_WAIT() asm volatile("s_waitcnt lgkmcnt(0)" ::: "memory")
using pg8::cvt_pk_bf16; using pg8::silu_f;
__device__ __forceinline__ float bf2f(unsigned short u) { return __uint_as_float((unsigned)u << 16); }
__device__ __forceinline__ float bflo(unsigned w) { return __uint_as_float(w << 16); }
__device__ __forceinline__ float bfhi(unsigned w) { return __uint_as_float(w & 0xffff0000u); }
__device__ __forceinline__ float wave_sum(float v) {
#pragma unroll
    for (int o = 1; o < 64; o <<= 1) v += __shfl_xor(v, o);
    return v;
}
__device__ __forceinline__ void unpack8(v4u w, float (&f)[8]) { f[0] = bflo(w.x); f[1] = bfhi(w.x); f[2] = bflo(w.y); f[3] = bfhi(w.y); f[4] = bflo(w.z); f[5] = bfhi(w.z); f[6] = bflo(w.w); f[7] = bfhi(w.w); }
__device__ __forceinline__ v4u pack8(const float (&f)[8]) { v4u w; w.x = cvt_pk_bf16(f[0], f[1]); w.y = cvt_pk_bf16(f[2], f[3]); w.z = cvt_pk_bf16(f[4], f[5]); w.w = cvt_pk_bf16(f[6], f[7]); return w; }

struct Args { const float* in[19]; float* out; unsigned char* ws; int ph_lo, ph_hi; };
enum { I_X = 0, I_C, I_WADA, I_BADA, I_WADAF, I_BADAF, I_GMIX, I_GFFN, I_GFIN, I_WIN, I_CWM, I_CWQ, I_ALOG, I_DTB, I_GCO, I_GDN, I_WOUT, I_WGU, I_WDN };

template <int MODE>
__device__ __forceinline__ void p0_transpose_item(const float* W, int K, int ld, int nblk, bf16* WT, LAS float* scr, int item, int lane) {
    const int kb = item / nblk, nb = item % nblk, k0 = 64 * kb, n0 = 32 * nb;
    f32x4 ld4[8];
#pragma unroll
    for (int i = 0; i < 8; ++i) ld4[i] = *(const f32x4*)(W + (size_t)(k0 + 8 * i + (lane >> 3)) * ld + n0 + 4 * (lane & 7));
#pragma unroll
    for (int i = 0; i < 8; ++i) { LAS float* d = scr + (8 * i + (lane >> 3)) * 33 + 4 * (lane & 7); d[0] = ld4[i].x; d[1] = ld4[i].y; d[2] = ld4[i].z; d[3] = ld4[i].w; }
    LDS_WAIT(); asm volatile("" ::: "memory");
    int r0 = n0;
    if (MODE == 1) { r0 = n0 < FF ? 256 * (n0 / 128) + (n0 % 128) : 256 * ((n0 - FF) / 128) + 128 + ((n0 - FF) % 128); }
    const int c = lane & 7;
#pragma unroll
    for (int j = 0; j < 4; ++j) { const int n = (lane >> 3) + 8 * j; const LAS float* s = scr + (8 * c) * 33 + n;
        v4u o; o.x = cvt_pk_bf16(s[0 * 33], s[1 * 33]); o.y = cvt_pk_bf16(s[2 * 33], s[3 * 33]); o.z = cvt_pk_bf16(s[4 * 33], s[5 * 33]); o.w = cvt_pk_bf16(s[6 * 33], s[7 * 33]);
        *(v4u*)(WT + (size_t)(r0 + n) * K + k0 + 8 * c) = o; }
    LDS_WAIT(); asm volatile("" ::: "memory");
}
__device__ __forceinline__ void p0_mod_item(const Args& a, float* MOD, const LAS float* SC, LAS float* red, int item, int tid) {
    const int c4 = tid & 7, ks = tid >> 3, col0 = item * 32;
    const bool fin = col0 >= 6144; const float* W = fin ? a.in[I_WADAF] : a.in[I_WADA]; const int ld = fin ? 2048 : 6144, cb = (fin ? col0 - 6144 : col0);
    f32x4 w[16];
#pragma unroll
    for (int kk = 0; kk < 16; ++kk) w[kk] = *(const f32x4*)(W + (size_t)(16 * ks + kk) * ld + cb + 4 * c4);
    f32x4 acc[4];
#pragma unroll
    for (int b = 0; b < 4; ++b) acc[b] = (f32x4){0.f, 0.f, 0.f, 0.f};
#pragma unroll
    for (int kk = 0; kk < 16; ++kk) { const f32x4 s = *(const LAS f32x4*)(SC + (16 * ks + kk) * 4); acc[0] += s.x * w[kk]; acc[1] += s.y * w[kk]; acc[2] += s.z * w[kk]; acc[3] += s.w * w[kk]; }
#pragma unroll
    for (int b = 0; b < 4; ++b) *(LAS f32x4*)(red + (ks * 4 + b) * 32 + 4 * c4) = acc[b];
    __syncthreads();
    if (tid < 128) { const int b = tid >> 5, cl = tid & 31; float s = 0.f;
#pragma unroll 16
        for (int k = 0; k < 64; ++k) s += red[(k * 4 + b) * 32 + cl];
        const int c = cb + cl;
        s += fin ? a.in[I_BADAF][c] : a.in[I_BADA][c];
        if (fin) MOD[4 * 6144 + b * 2048 + c] = s; else MOD[b * 6144 + c] = s; }
    __syncthreads();
}

template <int MODE>
__device__ __forceinline__ void adaln_one(const f32x4 (&xin)[4], const f32x4 (&gs)[4], const f32x4 (&sh)[4], int m, bf16* Hout, float* Fout, const LAS float* TT, const float* a_log, const float* dt_bias, float* GB, int lane) {
    f32x4 v[4]; float ss = 0.f;
#pragma unroll
    for (int j = 0; j < 4; ++j) { v[j] = xin[j]; ss += (v[j].x * v[j].x + v[j].y * v[j].y) + (v[j].z * v[j].z + v[j].w * v[j].w); }
    const float rinv = 1.0f / sqrtf(wave_sum(ss) * (1.0f / D) + EPS);
#pragma unroll
    for (int j = 0; j < 4; ++j) v[j] = (v[j] * rinv) * gs[j] + sh[j];
    if (MODE == 2) { f32x4* o = (f32x4*)(Fout + (size_t)m * D) + lane;
#pragma unroll
        for (int j = 0; j < 4; ++j) o[64 * j] = v[j];
    } else { v2u* o = (v2u*)(Hout + (size_t)m * D) + lane;
#pragma unroll
        for (int j = 0; j < 4; ++j) { v2u w; w.x = cvt_pk_bf16(v[j].x, v[j].y); w.y = cvt_pk_bf16(v[j].z, v[j].w); o[64 * j] = w; } }
    if (MODE == 0) {
        float d[8];
#pragma unroll
        for (int e = 0; e < 8; ++e) { float s = 0.f;
#pragma unroll
            for (int j = 0; j < 4; ++j) { const f32x4 t = *(const LAS f32x4*)(TT + e * 1024 + 4 * (lane + 64 * j)); s += (v[j].x * t.x + v[j].y * t.y) + (v[j].z * t.z + v[j].w * t.w); }
            asm volatile("" : "+v"(s) :: "memory"); d[e] = s; }
        float k4[4], k2[2], k1;
        { const bool hi = (lane & 32) != 0;
#pragma unroll
          for (int i = 0; i < 4; ++i) { const float snd = hi ? d[i] : d[4 + i]; const float kp = hi ? d[4 + i] : d[i]; k4[i] = kp + __shfl_xor(snd, 32); } }
        { const bool hi = (lane & 16) != 0;
#pragma unroll
          for (int i = 0; i < 2; ++i) { const float snd = hi ? k4[i] : k4[2 + i]; const float kp = hi ? k4[2 + i] : k4[i]; k2[i] = kp + __shfl_xor(snd, 16); } }
        { const bool hi = (lane & 8) != 0; const float snd = hi ? k2[0] : k2[1]; const float kp = hi ? k2[1] : k2[0]; k1 = kp + __shfl_xor(snd, 8); }
        k1 += __shfl_xor(k1, 4); k1 += __shfl_xor(k1, 2); k1 += __shfl_xor(k1, 1);
        if ((lane & 7) == 0) { const int e = lane >> 3; float r;
            if (e < 4) { const float xx = k1 + dt_bias[e]; const float sp = fmaxf(xx, 0.f) + log1pf(__expf(-fabsf(xx))); r = -__expf(a_log[e]) * sp; }
            else r = 1.0f / (1.0f + __expf(-k1));
            GB[(size_t)m * 8 + e] = r; }
    }
}
template <int MODE>
__device__ __forceinline__ void adaln_rows(const float* X, const float* gain, const float* shiftp, const float* scalep, int mstride, bf16* Hout, float* Fout,
                                           const LAS float* TT, const float* a_log, const float* dt_bias, float* GB, int gw, int NGW, int lane) {
    for (int blk = gw; blk < M / 16; blk += NGW) {
        const int m0 = blk * 16, b = m0 >> 13;
        f32x4 gs[4], sh[4];
        { const f32x4* g4 = (const f32x4*)gain + lane; const f32x4* sh4 = (const f32x4*)(shiftp + (size_t)b * mstride) + lane; const f32x4* sc4 = (const f32x4*)(scalep + (size_t)b * mstride) + lane;
#pragma unroll
          for (int j = 0; j < 4; ++j) { gs[j] = g4[64 * j] * (1.0f + sc4[64 * j]); sh[j] = sh4[64 * j]; } }
        f32x4 c0[4], c1[4];
        { const f32x4* xr = (const f32x4*)(X + (size_t)m0 * D) + lane;
#pragma unroll
          for (int j = 0; j < 4; ++j) { c0[j] = xr[64 * j]; c1[j] = xr[256 + 64 * j]; } }
#pragma unroll 1
        for (int i = 0; i < 16; i += 2) {
            f32x4 n0[4], n1[4];
            { const int mn = (i + 2 < 16) ? m0 + i + 2 : m0; const f32x4* xr = (const f32x4*)(X + (size_t)mn * D) + lane;
#pragma unroll
              for (int j = 0; j < 4; ++j) { n0[j] = xr[64 * j]; n1[j] = xr[256 + 64 * j]; } }
            adaln_one<MODE>(c0, gs, sh, m0 + i, Hout, Fout, TT, a_log, dt_bias, GB, lane);
            adaln_one<MODE>(c1, gs, sh, m0 + i + 1, Hout, Fout, TT, a_log, dt_bias, GB, lane);
#pragma unroll
            for (int j = 0; j < 4; ++j) { c0[j] = n0[j]; c1[j] = n1[j]; }
        }
    }
}

__device__ __forceinline__ void conv_qkv(const bf16* P, const float* cwq, bf16* QKV, int X, int t0, bool first, int lane) {
    const int colp = 1536 + 512 * X + 8 * lane, colo = 512 * X + 8 * lane;
    v4u raw[19];
#pragma unroll
    for (int t = 0; t < 19; ++t) { raw[t] = (v4u){0u, 0u, 0u, 0u}; if (t >= 3 || !first) raw[t] = *(const v4u*)(P + (size_t)(t0 - 3 + t) * NP + colp); }
    float w0[8], w1[8], w2[8], w3[8], h3[8], h2[8], h1[8];
#pragma unroll
    for (int e = 0; e < 8; ++e) { w0[e] = cwq[0 * 1536 + colo + e]; w1[e] = cwq[1 * 1536 + colo + e]; w2[e] = cwq[2 * 1536 + colo + e]; w3[e] = cwq[3 * 1536 + colo + e]; }
    unpack8(raw[0], h3); unpack8(raw[1], h2); unpack8(raw[2], h1);
#pragma unroll
    for (int t = 0; t < 16; ++t) { const int m = t0 + t; float x[8], y[8]; unpack8(raw[3 + t], x); float ss = 0.f;
#pragma unroll
        for (int e = 0; e < 8; ++e) { const float c = w0[e] * h3[e] + w1[e] * h2[e] + w2[e] * h1[e] + w3[e] * x[e]; y[e] = silu_f(c); ss += y[e] * y[e]; h3[e] = h2[e]; h2[e] = h1[e]; h1[e] = x[e]; }
        if (X < 2) { ss += __shfl_xor(ss, 1); ss += __shfl_xor(ss, 2); ss += __shfl_xor(ss, 4); ss += __shfl_xor(ss, 8);
            float r = 1.0f / sqrtf(ss + EPS); if (X == 0) r *= 0.08838834764831845f;
#pragma unroll
            for (int e = 0; e < 8; ++e) y[e] *= r; }
        *(v4u*)(QKV + (size_t)m * 1536 + colo) = pack8(y); }
}
__device__ __forceinline__ void conv_pass(const bf16* P, const float* cwm, const float* cwq, const float* gco, bf16* YC, bf16* QKV, int gw, int NGW, int lane) {
    for (int run = gw; run < M / 16; run += NGW) {
        const int t0 = run * 16; const bool first = (t0 & (SEQ - 1)) == 0;
        { float w0[8], w1[8], w2[8], gc[8], u2[8], u1[8]; const int c0 = 8 * lane;
#pragma unroll
          for (int e = 0; e < 8; ++e) { w0[e] = cwm[c0 + e]; w1[e] = cwm[512 + c0 + e]; w2[e] = cwm[1024 + c0 + e]; gc[e] = gco[c0 + e]; u2[e] = 0.f; u1[e] = 0.f; }
          if (!first) { float a[8], b[8]; unpack8(*(const v4u*)(P + (size_t)(t0 - 2) * NP + 512 + c0), a); unpack8(*(const v4u*)(P + (size_t)(t0 - 2) * NP + 1024 + c0), b);
#pragma unroll
              for (int e = 0; e < 8; ++e) u2[e] = a[e] * b[e];
              unpack8(*(const v4u*)(P + (size_t)(t0 - 1) * NP + 512 + c0), a); unpack8(*(const v4u*)(P + (size_t)(t0 - 1) * NP + 1024 + c0), b);
#pragma unroll
              for (int e = 0; e < 8; ++e) u1[e] = a[e] * b[e]; }
#pragma unroll 1
          for (int tb = 0; tb < 16; tb += 8) {
              v4u rb[8], rc[8], rh[8];
#pragma unroll
              for (int t = 0; t < 8; ++t) { const bf16* pr = P + (size_t)(t0 + tb + t) * NP + c0; rb[t] = *(const v4u*)pr; rc[t] = *(const v4u*)(pr + 512); rh[t] = *(const v4u*)(pr + 1024); }
#pragma unroll
              for (int t = 0; t < 8; ++t) { const int m = t0 + tb + t; float gb[8], a[8], b[8], y[8]; unpack8(rb[t], gb); unpack8(rc[t], a); unpack8(rh[t], b); float ss = 0.f;
#pragma unroll
                  for (int e = 0; e < 8; ++e) { const float u0 = a[e] * b[e]; y[e] = gb[e] * (w0[e] * u2[e] + w1[e] * u1[e] + w2[e] * u0); ss += y[e] * y[e]; u2[e] = u1[e]; u1[e] = u0; }
                  ss += __shfl_xor(ss, 1); ss += __shfl_xor(ss, 2); ss += __shfl_xor(ss, 4);
                  const float r = 1.0f / sqrtf(ss * (1.0f / 64.0f) + EPS);
#pragma unroll
                  for (int e = 0; e < 8; ++e) y[e] = y[e] * r * gc[e];
                  *(v4u*)(YC + (size_t)m * D + c0) = pack8(y); } } }
        conv_qkv(P, cwq, QKV, 0, t0, first, lane); conv_qkv(P, cwq, QKV, 1, t0, first, lane); conv_qkv(P, cwq, QKV, 2, t0, first, lane);
    }
}


constexpr int PREP_HALF = 69632, PK_KN = 0, PK_QN = 17408, PK_VV = 34816, PK_LM = 52224, PK_GC = 68608, PK_BT = 68864, PK_EG = 69120, PROW = 272;
template <bool SC>
__device__ __forceinline__ v4u afrag_piece_rows(const LAS unsigned char* tile, const LAS float* sc, int p) {
    const int f = p >> 6, ln = p & 63, mt = f >> 3, kt = (f >> 1) & 3, s = f & 1, r = ln & 31, hh = ln >> 5, row = 32 * mt + r, kb = 32 * kt + 16 * s + 4 * hh;
    const v2u a = *(const LAS v2u*)(tile + row * PROW + kb * 2), b = *(const LAS v2u*)(tile + row * PROW + (kb + 8) * 2);
    float scv = 1.0f; if (SC) scv = sc[row];
    v4u o; o.x = cvt_pk_bf16(bflo(a.x) * scv, bfhi(a.x) * scv); o.y = cvt_pk_bf16(bflo(a.y) * scv, bfhi(a.y) * scv); o.z = cvt_pk_bf16(bflo(b.x) * scv, bfhi(b.x) * scv); o.w = cvt_pk_bf16(bflo(b.y) * scv, bfhi(b.y) * scv);
    return o;
}
__device__ __forceinline__ void prep_phase(LAS unsigned char* lds, const bf16* QKV, const float* GB, float* EGL, unsigned char* CH, unsigned* FLG, int ublk, int nblk, int tid) {
    const int half = tid >> 8, t = tid & 255, lane = tid & 63, w = (tid >> 6) & 3, r = lane & 31, hh = lane >> 5;
    LAS unsigned char* L = lds + half * PREP_HALF;
    LAS float* LM = (LAS float*)(L + PK_LM); LAS float* GC = (LAS float*)(L + PK_GC); LAS float* BT = (LAS float*)(L + PK_BT); LAS float* EG = (LAS float*)(L + PK_EG);
    for (int pu = ublk; pu < NBH * NCH / 2; pu += nblk) {
        const int n = pu >> 3, bh = 2 * (pu & 7) + half, cid = bh * NCH + n, b = bh >> 2, h = bh & 3, m0 = b * SEQ + n * 64;
        unsigned char* rec = CH + (size_t)cid * REC;
        __syncthreads();
#pragma unroll
        for (int X = 0; X < 3; ++X)
#pragma unroll
            for (int i = 0; i < 4; ++i) { const int p = t + 256 * i, row = p >> 4, c16 = p & 15;
                const v4u v = *(const v4u*)(QKV + (size_t)(m0 + row) * 1536 + 512 * X + 128 * h + 8 * c16);
                *(LAS v4u*)(L + (X == 0 ? PK_QN : (X == 1 ? PK_KN : PK_VV)) + row * PROW + c16 * 16) = v; }
        if (w == 0) { float g = GB[(size_t)(m0 + lane) * 8 + h];
#pragma unroll
            for (int d = 1; d < 64; d <<= 1) { const float o = __shfl_up(g, d); if (lane >= d) g += o; }
            GC[lane] = g; EG[lane] = __expf(g); BT[lane] = GB[(size_t)(m0 + lane) * 8 + 4 + h];
            if (lane == 63) *(float*)(rec + 73728) = __expf(g); }
        __syncthreads();
        { const int mi = w >> 1, nj = w & 1;
          f32x16 kk, qk;
#pragma unroll
          for (int i = 0; i < 16; ++i) { kk[i] = 0.f; qk[i] = 0.f; }
#pragma unroll
          for (int st = 0; st < 8; ++st) {
              const bf16x8 ka = *(const LAS bf16x8*)(L + PK_KN + (32 * mi + r) * PROW + (16 * st + 8 * hh) * 2);
              const bf16x8 kb = *(const LAS bf16x8*)(L + PK_KN + (32 * nj + r) * PROW + (16 * st + 8 * hh) * 2);
              const bf16x8 qb = *(const LAS bf16x8*)(L + PK_QN + (32 * mi + r) * PROW + (16 * st + 8 * hh) * 2);
              kk = __builtin_amdgcn_mfma_f32_32x32x16_bf16(ka, kb, kk, 0, 0, 0);
              qk = __builtin_amdgcn_mfma_f32_32x32x16_bf16(kb, qb, qk, 0, 0, 0);
          }
          const float gj = GC[32 * nj + r], gq = GC[32 * mi + r];
          float av[16];
#pragma unroll
          for (int reg = 0; reg < 16; ++reg) { const int cr = (reg & 3) + 8 * (reg >> 2) + 4 * hh;
              const int i = 32 * mi + cr, j = 32 * nj + r;
              LM[i * 64 + j] = (i > j) ? BT[i] * kk[reg] * __expf(GC[i] - gj) : 0.f;
              const int key = 32 * nj + cr, qr = 32 * mi + r;
              av[reg] = (qr >= key) ? qk[reg] * __expf(gq - GC[key]) : 0.f; }
#pragma unroll
          for (int s = 0; s < 2; ++s) { v4u o; o.x = cvt_pk_bf16(av[8 * s], av[8 * s + 1]); o.y = cvt_pk_bf16(av[8 * s + 2], av[8 * s + 3]); o.z = cvt_pk_bf16(av[8 * s + 4], av[8 * s + 5]); o.w = cvt_pk_bf16(av[8 * s + 6], av[8 * s + 7]);
              *(v4u*)(rec + 49152 + ((mi * 2 + nj) * 2 + s) * 1024 + lane * 16) = o; }
        }
#pragma unroll
        for (int i = 0; i < 4; ++i) { const int p = t + 256 * i; *(v4u*)(rec + 16384 + p * 16) = afrag_piece_rows<true>(L + PK_QN, EG, p); }
        { const float gl = GC[63];
#pragma unroll
          for (int i = 0; i < 4; ++i) { const int p = t + 256 * i, f = p >> 6, ln = p & 63, mt = f >> 2, ct = (f >> 1) & 1, s = f & 1, dk = 32 * mt + (ln & 31), cb = 32 * ct + 16 * s + 4 * (ln >> 5);
              float e[8];
#pragma unroll
              for (int j = 0; j < 8; ++j) { const int c = cb + 8 * (j >> 2) + (j & 3); e[j] = bf2f(*(const LAS unsigned short*)(L + PK_KN + c * PROW + dk * 2)) * __expf(gl - GC[c]); }
              *(v4u*)(rec + 32768 + p * 16) = pack8(e); } }
        __syncthreads();
        { float X[64]; const bool isu = t < 128; const int col = t & 127;
          const LAS unsigned char* src = L + (isu ? PK_VV : PK_KN) + col * 2;
#pragma unroll
          for (int i = 0; i < 64; ++i) {
              const float egi = EG[i]; const float rhs = bf2f(*(const LAS unsigned short*)(src + i * PROW)) * BT[i] * (isu ? 1.0f : egi);
              float a0 = 0.f, a1 = 0.f, a2 = 0.f, a3 = 0.f;
#pragma unroll
              for (int j4 = 0; j4 < (i + 3) / 4; ++j4) { const f32x4 l = *(const LAS f32x4*)(LM + i * 64 + 4 * j4);
                  if (4 * j4 + 0 < i) a0 += l.x * X[4 * j4 + 0]; if (4 * j4 + 1 < i) a1 += l.y * X[4 * j4 + 1]; if (4 * j4 + 2 < i) a2 += l.z * X[4 * j4 + 2]; if (4 * j4 + 3 < i) a3 += l.w * X[4 * j4 + 3]; }
              X[i] = rhs - ((a0 + a1) + (a2 + a3)); asm volatile("" : "+v"(X[i]) :: "memory"); }
          __syncthreads();
          if (isu) { const int vs = col >> 5, dvl = col & 31;
#pragma unroll
              for (int mt = 0; mt < 2; ++mt)
#pragma unroll
                  for (int h2 = 0; h2 < 2; ++h2) { v4u* dst = (v4u*)(rec + REC_A + (size_t)(((vs * 2 + mt) * 64 + dvl + 32 * h2) * 32));
#pragma unroll
                      for (int a2 = 0; a2 < 2; ++a2) { const int i0 = 32 * mt + 4 * h2 + 16 * a2; v4u w;
                          w.x = cvt_pk_bf16(X[i0], X[i0 + 1]); w.y = cvt_pk_bf16(X[i0 + 2], X[i0 + 3]); w.z = cvt_pk_bf16(X[i0 + 8], X[i0 + 9]); w.w = cvt_pk_bf16(X[i0 + 10], X[i0 + 11]); dst[a2] = w; } }
          } else {
#pragma unroll
              for (int i = 0; i < 64; ++i) *(LAS unsigned short*)(L + PK_VV + i * PROW + col * 2) = (unsigned short)(cvt_pk_bf16(-X[i], 0.f) & 0xffffu);
          }
        }
        __syncthreads();
#pragma unroll
        for (int i = 0; i < 4; ++i) { const int p = t + 256 * i; *(v4u*)(rec + p * 16) = afrag_piece_rows<false>(L + PK_VV, EG, p); }
        asm volatile("s_waitcnt vmcnt(0)" ::: "memory"); __syncthreads();
        if (tid == 0) { __builtin_amdgcn_fence(__ATOMIC_RELEASE, "agent"); asm volatile("s_waitcnt vmcnt(0)" ::: "memory");
            __hip_atomic_store(FLG + (2 * (pu & 7)) * NCH + n, 1u, __ATOMIC_RELAXED, __HIP_MEMORY_SCOPE_AGENT); __hip_atomic_store(FLG + (2 * (pu & 7) + 1) * NCH + n, 1u, __ATOMIC_RELAXED, __HIP_MEMORY_SCOPE_AGENT); }
    }
}

__device__ __forceinline__ bf16x8 pack_acc(const f32x16& x, int s) {
    v4u p; p.x = cvt_pk_bf16(x[8 * s], x[8 * s + 1]); p.y = cvt_pk_bf16(x[8 * s + 2], x[8 * s + 3]); p.z = cvt_pk_bf16(x[8 * s + 4], x[8 * s + 5]); p.w = cvt_pk_bf16(x[8 * s + 6], x[8 * s + 7]);
    return __builtin_bit_cast(bf16x8, p);
}
#define MFMA32(a, b, c) __builtin_amdgcn_mfma_f32_32x32x16_bf16((a), (b), (c), 0, 0, 0)
#define PIN_SCHED() __builtin_amdgcn_sched_barrier(0)
__device__ __forceinline__ int chain_ready(const unsigned* fl, int have, int lane) {
    for (;;) {
        const int idx = have + 1 + lane;
        const unsigned f = (idx < NCH) ? __hip_atomic_load(fl + idx, __ATOMIC_RELAXED, __HIP_MEMORY_SCOPE_AGENT) : 0u;
        const unsigned long long m = __ballot(f != 0u);
        const int pre = (m == ~0ull) ? 64 : __builtin_ctzll(~m);
        if (pre > 0) { __builtin_amdgcn_fence(__ATOMIC_ACQUIRE, "agent"); asm volatile("s_waitcnt vmcnt(0)" ::: "memory"); return have + pre; }
        __builtin_amdgcn_s_sleep(16);
    }
}
__device__ __forceinline__ void chain_phase(LAS unsigned char* lds, const unsigned char* CH, const unsigned* FLG, bf16* Oraw, int bh, int tid) {
    const int wid = __builtin_amdgcn_readfirstlane(tid >> 6), lane = tid & 63, b = bh >> 2, h = bh & 3, vs = wid & 3;
    const unsigned char* rec0 = CH + (size_t)bh * NCH * REC;
    const bool comp = wid < 4, stager = (wid >= 4 && wid <= 6);
    const int hw = wid - 4;
#define CH_MOVE(n, dstbase) do { _Pragma("unroll") for (int _i = 0; _i < 25; ++_i) { const int _pc = hw * 25 + _i; if (_pc < 73) \
        __builtin_amdgcn_global_load_lds((const unsigned*)(rec0 + (size_t)(n) * REC + _pc * 1024 + lane * 16), (LAS unsigned*)((dstbase) + _pc * 1024), 16, 0, 0); } } while (0)
#define CH_WARM(n) do { _Pragma("unroll") for (int _i = 0; _i < 10; ++_i) { const int _o = (_i * 64 + lane) * 128; \
        __builtin_amdgcn_global_load_lds((const unsigned*)(rec0 + (size_t)(n) * REC + (_o < REC ? _o : 0)), (LAS unsigned*)(dummy), 4, 0, 0); } } while (0)
    constexpr int WARM_AHEAD = 8;
    LAS unsigned char* dummy = lds + 2 * REC;
    f32x16 S[4], o0, o1;
#pragma unroll
    for (int k = 0; k < 4; ++k)
#pragma unroll
        for (int i = 0; i < 16; ++i) S[k][i] = 0.f;
#pragma unroll
    for (int i = 0; i < 16; ++i) { o0[i] = 0.f; o1[i] = 0.f; }
    const unsigned* fl = FLG + bh * NCH; int have = -1;
    if (stager) { while (have < 0) have = chain_ready(fl, have, lane); CH_MOVE(0, lds); }
    if (!comp) asm volatile("s_waitcnt vmcnt(0)" ::: "memory");
    __builtin_amdgcn_s_barrier(); asm volatile("" ::: "memory");
    for (int n = 0; n < NCH; ++n) {
        const int buf = n & 1;
        if (!comp) {
            if (stager) { if (n + 1 < NCH) { while (have < n + 1) have = chain_ready(fl, have, lane); CH_MOVE(n + 1, lds + (buf ^ 1) * REC); } asm volatile("s_waitcnt vmcnt(0)" ::: "memory"); }
            else { const int wn = n + 1 + WARM_AHEAD; if (wn < NCH) { if (have < wn) { const int idx = have + 1 + lane; const unsigned f = (idx < NCH) ? __hip_atomic_load(fl + idx, __ATOMIC_RELAXED, __HIP_MEMORY_SCOPE_AGENT) : 0u;
                        const unsigned long long m = __ballot(f != 0u); const int pre = (m == ~0ull) ? 64 : __builtin_ctzll(~m); if (pre > 0) { __builtin_amdgcn_fence(__ATOMIC_ACQUIRE, "agent"); have += pre; } }
                    if (have >= wn) CH_WARM(wn); }
                   asm volatile("s_waitcnt vmcnt(20)" ::: "memory"); }
        } else {
            const LAS unsigned char* B = lds + buf * REC + lane * 16;
            const float egl = *(const LAS float*)(lds + buf * REC + 73728);
            f32x16 v0, v1;
            { const LAS v4u* ul = (const LAS v4u*)(lds + buf * REC + 57344 + ((vs * 2) * 64 + lane) * 32);
              const v4u a0 = ul[0], a1 = ul[1], b0 = ul[128], b1 = ul[129];
              v0[0] = bflo(a0.x); v0[1] = bfhi(a0.x); v0[2] = bflo(a0.y); v0[3] = bfhi(a0.y); v0[4] = bflo(a0.z); v0[5] = bfhi(a0.z); v0[6] = bflo(a0.w); v0[7] = bfhi(a0.w);
              v0[8] = bflo(a1.x); v0[9] = bfhi(a1.x); v0[10] = bflo(a1.y); v0[11] = bfhi(a1.y); v0[12] = bflo(a1.z); v0[13] = bfhi(a1.z); v0[14] = bflo(a1.w); v0[15] = bfhi(a1.w);
              v1[0] = bflo(b0.x); v1[1] = bfhi(b0.x); v1[2] = bflo(b0.y); v1[3] = bfhi(b0.y); v1[4] = bflo(b0.z); v1[5] = bfhi(b0.z); v1[6] = bflo(b0.w); v1[7] = bfhi(b0.w);
              v1[8] = bflo(b1.x); v1[9] = bfhi(b1.x); v1[10] = bflo(b1.y); v1[11] = bfhi(b1.y); v1[12] = bflo(b1.z); v1[13] = bfhi(b1.z); v1[14] = bflo(b1.w); v1[15] = bfhi(b1.w); }
#pragma unroll
            for (int i = 0; i < 16; ++i) { o0[i] = 0.f; o1[i] = 0.f; }
#define LDF(dst, off) dst = *(const LAS bf16x8*)(B + (off))
#define LD_WQ(F, kt, s) do { LDF(F[0], ((0 * 4 + (kt)) * 2 + (s)) * 1024); LDF(F[1], ((1 * 4 + (kt)) * 2 + (s)) * 1024); LDF(F[2], 16384 + ((0 * 4 + (kt)) * 2 + (s)) * 1024); LDF(F[3], 16384 + ((1 * 4 + (kt)) * 2 + (s)) * 1024); } while (0)
#define MM_WQ(F, kt, s) do { const bf16x8 sb = pack_acc(S[kt], s); v0 = MFMA32(F[0], sb, v0); v1 = MFMA32(F[1], sb, v1); o0 = MFMA32(F[2], sb, o0); o1 = MFMA32(F[3], sb, o1); asm volatile("" : "+v"(o0), "+v"(o1)); } while (0)
#define LD_AT(F, ct) do { LDF(F[0], 49152 + ((0 * 2 + (ct)) * 2 + 0) * 1024); LDF(F[1], 49152 + ((1 * 2 + (ct)) * 2 + 0) * 1024); LDF(F[2], 49152 + ((0 * 2 + (ct)) * 2 + 1) * 1024); LDF(F[3], 49152 + ((1 * 2 + (ct)) * 2 + 1) * 1024); } while (0)
#define MM_AT(F, ct) do { o0 = MFMA32(F[0], vb[ct][0], o0); o1 = MFMA32(F[1], vb[ct][0], o1); o0 = MFMA32(F[2], vb[ct][1], o0); o1 = MFMA32(F[3], vb[ct][1], o1); } while (0)
#define LD_KD(F, ct, s) do { _Pragma("unroll") for (int q = 0; q < 4; ++q) LDF(F[q], 32768 + ((q * 2 + (ct)) * 2 + (s)) * 1024); } while (0)
#define MM_KD(F, ct, s) do { _Pragma("unroll") for (int q = 0; q < 4; ++q) S[q] = MFMA32(F[q], vb[ct][s], S[q]); } while (0)
            bf16x8 FA[4], FB[4];
            LD_WQ(FA, 0, 0); PIN_SCHED();
            LD_WQ(FB, 0, 1); PIN_SCHED(); MM_WQ(FA, 0, 0); PIN_SCHED();
            LD_WQ(FA, 1, 0); PIN_SCHED(); MM_WQ(FB, 0, 1); PIN_SCHED();
            LD_WQ(FB, 1, 1); PIN_SCHED(); MM_WQ(FA, 1, 0); PIN_SCHED();
            LD_WQ(FA, 2, 0); PIN_SCHED(); MM_WQ(FB, 1, 1); PIN_SCHED();
            LD_WQ(FB, 2, 1); PIN_SCHED(); MM_WQ(FA, 2, 0); PIN_SCHED();
            LD_WQ(FA, 3, 0); PIN_SCHED(); MM_WQ(FB, 2, 1); PIN_SCHED();
            LD_WQ(FB, 3, 1); PIN_SCHED(); MM_WQ(FA, 3, 0); PIN_SCHED();
            LD_AT(FA, 0); PIN_SCHED(); MM_WQ(FB, 3, 1); PIN_SCHED();
            bf16x8 vb[2][2];
            vb[0][0] = pack_acc(v0, 0); vb[0][1] = pack_acc(v0, 1); vb[1][0] = pack_acc(v1, 0); vb[1][1] = pack_acc(v1, 1);
            LD_AT(FB, 1); PIN_SCHED(); MM_AT(FA, 0); PIN_SCHED();
#pragma unroll
            for (int kt = 0; kt < 4; ++kt)
#pragma unroll
                for (int i = 0; i < 16; ++i) S[kt][i] *= egl;
            LD_KD(FA, 0, 0); PIN_SCHED(); MM_AT(FB, 1); PIN_SCHED();
            { bf16* op = Oraw + (size_t)(b * SEQ + n * 64 + 4 * (lane >> 5)) * 512 + h * 128 + vs * 32 + (lane & 31); asm volatile("" : "+v"(op));
#pragma unroll
              for (int reg = 0; reg < 16; ++reg) { const int cr = (reg & 3) + 8 * (reg >> 2); const unsigned pk = cvt_pk_bf16(o0[reg], o1[reg]); op[cr * 512] = (bf16)(pk & 0xffffu); op[(32 + cr) * 512] = (bf16)(pk >> 16); } }
            PIN_SCHED();
            LD_KD(FB, 0, 1); PIN_SCHED(); MM_KD(FA, 0, 0); PIN_SCHED();
            LD_KD(FA, 1, 0); PIN_SCHED(); MM_KD(FB, 0, 1); PIN_SCHED();
            LD_KD(FB, 1, 1); PIN_SCHED(); MM_KD(FA, 1, 0); PIN_SCHED();
            MM_KD(FB, 1, 1);
#undef MM_AT
#undef MM_KD
#undef LDF
#undef LD_WQ
#undef MM_WQ
#undef LD_AT
#undef LD_KD
            asm volatile("s_waitcnt lgkmcnt(0)" ::: "memory");
        }
        __builtin_amdgcn_s_barrier(); asm volatile("" ::: "memory");
    }
    asm volatile("s_waitcnt vmcnt(0)" ::: "memory");
#undef CH_MOVE
#undef CH_WARM
}
#if DN_NAIVE
__device__ __forceinline__ void naive_dn(const bf16* QKV, const float* GB, float* Oraw, int unit, int lane) {
    const int bh = unit >> 1, dv = (unit & 1) * 64 + lane, b = bh >> 2, h = bh & 3;
    float S[128];
#pragma unroll
    for (int i = 0; i < 128; ++i) S[i] = 0.f;
    for (int t = 0; t < SEQ; ++t) { const size_t m = (size_t)b * SEQ + t;
        const float al = __expf(GB[m * 8 + h]), be = GB[m * 8 + 4 + h];
        const bf16* qp = QKV + m * 1536 + h * 128; const bf16* kp = qp + 512; const float v = bf2f(qp[1024 + dv]);
        float r = 0.f;
#pragma unroll
        for (int i = 0; i < 128; ++i) { S[i] *= al; r += bf2f(kp[i]) * S[i]; if ((i & 15) == 15) asm volatile("" : "+v"(r) :: "memory"); }
        const float d = be * (v - r); float o = 0.f;
#pragma unroll
        for (int i = 0; i < 128; ++i) { S[i] += bf2f(kp[i]) * d; o += bf2f(qp[i]) * S[i]; if ((i & 15) == 15) asm volatile("" : "+v"(o) :: "memory"); }
        Oraw[m * 512 + h * 128 + dv] = o; }
}
#endif
template <bool OB16>
__device__ __forceinline__ void opost_rows(const void* Oraw_, const bf16* P, const float* gdn, bf16* YC, int gw, int NGW, int lane) {
    const float* Oraw = (const float*)Oraw_; const bf16* Ob = (const bf16*)Oraw_;
    float gd[8];
#pragma unroll
    for (int e = 0; e < 8; ++e) gd[e] = gdn[(8 * lane + e) & 127];
    for (int blk = gw; blk < M / 16; blk += NGW) { const int m0 = blk * 16;
#pragma unroll 1
        for (int i = 0; i < 16; i += 8) {
            f32x4 oa[8], ob[8]; v4u zz[8];
#pragma unroll
            for (int t = 0; t < 8; ++t) { const int m = m0 + i + t;
                if (OB16) { float f[8]; unpack8(*(const v4u*)(Ob + (size_t)m * 512 + 8 * lane), f); oa[t] = (f32x4){f[0], f[1], f[2], f[3]}; ob[t] = (f32x4){f[4], f[5], f[6], f[7]}; }
                else { const f32x4* op = (const f32x4*)(Oraw + (size_t)m * 512 + 8 * lane); oa[t] = op[0]; ob[t] = op[1]; }
                zz[t] = *(const v4u*)(P + (size_t)m * NP + 3072 + 8 * lane); }
#pragma unroll
            for (int t = 0; t < 8; ++t) { const int m = m0 + i + t; float z[8]; unpack8(zz[t], z);
                float o[8] = {oa[t].x, oa[t].y, oa[t].z, oa[t].w, ob[t].x, ob[t].y, ob[t].z, ob[t].w}; float ss = 0.f;
#pragma unroll
                for (int e = 0; e < 8; ++e) ss += o[e] * o[e];
                ss += __shfl_xor(ss, 1); ss += __shfl_xor(ss, 2); ss += __shfl_xor(ss, 4); ss += __shfl_xor(ss, 8);
                const float r = 1.0f / sqrtf(ss * (1.0f / 128.0f) + EPS);
#pragma unroll
                for (int e = 0; e < 8; ++e) o[e] = o[e] * r * gd[e] * silu_f(z[e]);
                *(v4u*)(YC + (size_t)m * D + 512 + 8 * lane) = pack8(o); } } }
}

typedef __attribute__((address_space(1))) unsigned gu32;
#define XB_TMO      128
#define XB_XCNT(j)  (256  + 64 * (j))
#define XB_XSUB(j)  (1280 + 64 * (j))
#define XB_XGEN(j)  (2304 + 64 * (j))
#define XB_TOP      3328
#define XB_TOPGEN   3392
#define XCD_BAR_WORDS 3456
#define XB_SPIN_CAP (1u << 18)

__device__ __forceinline__ unsigned xb_ld(unsigned* p)              { return __hip_atomic_load(p, __ATOMIC_RELAXED, __HIP_MEMORY_SCOPE_AGENT); }
__device__ __forceinline__ unsigned xb_add(unsigned* p, unsigned v) { return __hip_atomic_fetch_add(p, v, __ATOMIC_RELAXED, __HIP_MEMORY_SCOPE_AGENT); }
__device__ __forceinline__ unsigned xb_xcc_id() { return (unsigned)__builtin_amdgcn_s_getreg((3 << 11) | 20) & 0xFu; }
#define XB_SPIN(cond, bar) do { unsigned _sp = 0; while (cond) { __builtin_amdgcn_s_sleep(1); \
    if ((++_sp & 255u) == 0u) { if (xb_ld(&(bar)[XB_TMO])) break; if (_sp > XB_SPIN_CAP) { atomicAdd(&(bar)[XB_TMO], 1u); break; } } } } while (0)

struct XcdBarrier {
    unsigned* bar; unsigned x;
    volatile LAS unsigned* st;
};

__device__ __forceinline__ XcdBarrier xcd_barrier_post(unsigned* bar, volatile LAS unsigned* st) {
    XcdBarrier b; b.bar = bar; b.x = xb_xcc_id(); b.st = st;
    if (threadIdx.x == 0) (void)xb_add(&bar[XB_XCNT(b.x)], 1u);
    return b;
}
__device__ __forceinline__ void xcd_barrier_complete(unsigned* bar, unsigned x, unsigned& nloc, unsigned& nx) {
    const unsigned G = gridDim.x * gridDim.y * gridDim.z;
    unsigned sum, cnt, mine, sp = 0u;
    for (;;) {
        sum = 0u; cnt = 0u; mine = 0u;
#pragma unroll
        for (unsigned j = 0; j < 16; ++j) { const unsigned c = xb_ld(&bar[XB_XCNT(j)]); sum += c; cnt += (c > 0u) ? 1u : 0u; mine = (j == x) ? c : mine; }
        if (sum == G) break;
        __builtin_amdgcn_s_sleep(1);
        if ((++sp & 255u) == 0u) { if (xb_ld(&bar[XB_TMO])) break; if (sp > XB_SPIN_CAP) { atomicAdd(&bar[XB_TMO], 1u); break; } }
    }
    nloc = mine > 0u ? mine : 1u; nx = cnt > 0u ? cnt : 1u;
}

__device__ __forceinline__ void xcd_barrier(const XcdBarrier& b) {
    asm volatile("s_waitcnt vmcnt(0)" ::: "memory");
    __syncthreads();
    if (threadIdx.x == 0) {
        unsigned* bar = b.bar;
        __builtin_amdgcn_s_waitcnt(0);
        unsigned nloc = b.st[0], nx = b.st[1];
        if (nloc == 0u) { xcd_barrier_complete(bar, b.x, nloc, nx); b.st[0] = nloc; b.st[1] = nx; }
        const unsigned old = xb_add(&bar[XB_XSUB(b.x)], 1u);
        const unsigned gen = old / nloc;
        if (old + 1u == (gen + 1u) * nloc) {
            __builtin_amdgcn_fence(__ATOMIC_RELEASE, "agent");
            asm volatile("s_waitcnt vmcnt(0)" ::: "memory");
            const unsigned og = xb_add(&bar[XB_TOP], 1u);
            const unsigned tg = og / nx;
            if (og + 1u == (tg + 1u) * nx) xb_add(&bar[XB_TOPGEN], 1u);
            else XB_SPIN(xb_ld(&bar[XB_TOPGEN]) == tg, bar);
            __builtin_amdgcn_fence(__ATOMIC_ACQUIRE, "agent");
            xb_add(&bar[XB_XGEN(b.x)], 1u);
            asm volatile("s_waitcnt vmcnt(0)" ::: "memory");
        } else {
            XB_SPIN(xb_ld(&bar[XB_XGEN(b.x)]) == gen, bar);
            __builtin_amdgcn_fence(__ATOMIC_ACQUIRE, "agent");
            asm volatile("s_waitcnt vmcnt(0)" ::: "memory");
        }
    }
    __syncthreads();
}

__global__ void __launch_bounds__(NWAVES * 64, 2) fwd(Args args) {
    extern __shared__ __attribute__((aligned(16))) unsigned char lds_raw[];
    LAS unsigned char* lds = (LAS unsigned char*)lds_raw;
    int tid = threadIdx.x, lane = tid & 63, wave = __builtin_amdgcn_readfirstlane(tid >> 6);
    const int G = gridDim.x; const int bx = blockIdx.x; const int vcu = (G % 8 == 0) ? (bx % 8) * (G / 8) + bx / 8 : bx;
    int gw = vcu * NWAVES + wave; const int NGW = G * NWAVES;
#define LAUNDER() do { int tv_ = threadIdx.x; asm volatile("" : "+v"(tv_)); tid = tv_; lane = tid & 63; wave = __builtin_amdgcn_readfirstlane(tid >> 6); gw = vcu * NWAVES + wave; } while (0)
    unsigned char* ws = args.ws;
    float* MOD = (float*)(ws + WS_MOD); float* GB = (float*)(ws + WS_GB); float* EGL = (float*)(ws + WS_EGL);
    bf16* WinT = (bf16*)(ws + WS_WIN); bf16* WoT = (bf16*)(ws + WS_WO); bf16* WguT = (bf16*)(ws + WS_WGU); bf16* WdT = (bf16*)(ws + WS_WD);
    bf16* H = (bf16*)(ws + WS_H); unsigned char* CH = ws + WS_CH; bf16* P = (bf16*)(ws + WS_P); bf16* ACT = (bf16*)(ws + WS_P); bf16* YC = (bf16*)(ws + WS_YC);
    bf16* QKV = (bf16*)args.out; bf16* Oraw = (bf16*)((unsigned char*)args.out + 96 * MiB); float* OUT = args.out;
    const int lo = args.ph_lo, hi = args.ph_hi;
    volatile LAS unsigned* MISC = (volatile LAS unsigned*)(lds + LDS_BYTES - 64);
    if (tid < 16) MISC[tid] = 0u;
    __syncthreads();
    XcdBarrier bar = xcd_barrier_post((unsigned*)ws, MISC);
    if (lo < 0) cg::this_grid().sync();
#ifndef PH_MASK
#define PH_MASK 0xFFF
#endif
#define IN(k) (((PH_MASK >> (k)) & 1) && lo <= (k) && (k) < hi)
#if MK_N_LAUNCHES == 1
#define SEAM(k) do { if (IN(k) && IN((k) + 1)) xcd_barrier(bar); } while (0)
#else
#define SEAM(k) do { } while (0)
#endif
#ifndef REP_MASK
#define REP_MASK 0
#endif
#define BEGIN_REP(k) for (int rep_ = 0; rep_ <= ((REP_MASK >> (k)) & 1); ++rep_) { if (rep_) xcd_barrier(bar); LAUNDER();
#define END_REP }
    BEGIN_REP(0)
    if (IN(0)) {
        LAS float* scr = (LAS float*)(lds + wave * 16384);
        constexpr int I_IN = 16 * 112, I_O = 16 * 32, I_GU = 16 * 176, I_DN = 44 * 32, NITEMS = I_IN + I_O + I_GU + I_DN;
        for (int it = gw; it < NITEMS; it += NGW) { int r = it;
            if (r < I_IN) { p0_transpose_item<0>(args.in[I_WIN], D, PIN, 112, WinT, scr, r, lane); continue; } r -= I_IN;
            if (r < I_O) { p0_transpose_item<0>(args.in[I_WOUT], D, D, 32, WoT, scr, r, lane); continue; } r -= I_O;
            if (r < I_GU) { p0_transpose_item<1>(args.in[I_WGU], D, 2 * FF, 176, WguT, scr, r, lane); continue; } r -= I_GU;
            p0_transpose_item<0>(args.in[I_WDN], FF, D, 32, WdT, scr, r, lane); }
        __syncthreads();
        { LAS float* SC = (LAS float*)lds; const float* cin = args.in[I_C];
          for (int idx = tid; idx < 4096; idx += NWAVES * 64) { const int b = idx >> 10, k = idx & 1023; const float cv = cin[idx]; SC[k * 4 + b] = cv / (1.0f + __expf(-cv)); }
          __syncthreads();
          for (int it = bx; it < 256; it += G) p0_mod_item(args, MOD, SC, (LAS float*)(lds + 16384), it, tid); }
    }
    END_REP
    SEAM(0);
    BEGIN_REP(1)
    if (IN(1)) { LAS float* TT = (LAS float*)lds; const float* wi = args.in[I_WIN];
        for (int idx = tid; idx < 8192; idx += NWAVES * 64) { const int k = idx >> 3, e = idx & 7; TT[e * 1024 + k] = wi[(size_t)k * PIN + NP + e]; }
        __syncthreads();
        adaln_rows<0>(args.in[I_X], args.in[I_GMIX], MOD + 0, MOD + 1024, 6144, H, nullptr, TT, args.in[I_ALOG], args.in[I_DTB], GB, gw, NGW, lane);
        __syncthreads(); }
    END_REP
    SEAM(1);
    BEGIN_REP(2)
    if (IN(2)) { pg8::Gemm g{H, WinT, M, NP, D}; pg8::StaticOrder S; S.init(M, NP, G, bx); pg8::EpiBf16 E{P, NP};
        pg8::gemm_phase<pg8::EpiBf16, pg8::StaticOrder, true, true>(lds, g, S, E); }
    END_REP
    SEAM(2);
    BEGIN_REP(3)
    if (IN(3)) conv_pass(P, args.in[I_CWM], args.in[I_CWQ], args.in[I_GCO], YC, QKV, gw, NGW, lane);
    END_REP
    SEAM(3);
#if DN_NAIVE
    SEAM(4);
    if (IN(5)) { if (bx < 32 && wave == 0) naive_dn(QKV, GB, (float*)(ws + WS_CH), bx, lane); }
    SEAM(5);
    if (IN(6)) opost_rows<false>((const float*)(ws + WS_CH), P, args.in[I_GDN], YC, gw, NGW, lane);
#else
    BEGIN_REP(4)
    if (IN(4)) { unsigned* FLG = (unsigned*)(ws + 16384);
        if (G > 2 * NBH) { if (bx < NBH) chain_phase(lds, CH, FLG, Oraw, bx, tid); else prep_phase(lds, QKV, GB, EGL, CH, FLG, bx - NBH, G - NBH, tid); }
        else { prep_phase(lds, QKV, GB, EGL, CH, FLG, bx, G, tid); } }
    END_REP
    SEAM(4);
    BEGIN_REP(5)
    if (IN(5)) { if (G <= 2 * NBH && bx < NBH) chain_phase(lds, CH, (const unsigned*)(ws + 16384), Oraw, bx, tid); }
    END_REP
    SEAM(5);
    BEGIN_REP(6)
    if (IN(6)) opost_rows<true>(Oraw, P, args.in[I_GDN], YC, gw, NGW, lane);
    END_REP
#endif
    SEAM(6);
    BEGIN_REP(7)
    if (IN(7)) { pg8::Gemm g{YC, WoT, M, D, D}; pg8::StaticOrder S; S.init(M, D, G, bx); pg8::EpiResGate E{args.in[I_X], OUT, MOD + 2048, 6144};
        pg8::gemm_phase<pg8::EpiResGate, pg8::StaticOrder, true, true>(lds, g, S, E); }
    END_REP
    SEAM(7);
    BEGIN_REP(8)
    if (IN(8)) adaln_rows<1>(OUT, args.in[I_GFFN], MOD + 3072, MOD + 4096, 6144, H, nullptr, nullptr, nullptr, nullptr, nullptr, gw, NGW, lane);
    END_REP
    SEAM(8);
    BEGIN_REP(9)
    if (IN(9)) { pg8::Gemm g{H, WguT, M, 2 * FF, D}; pg8::StaticOrder S; S.init(M, 2 * FF, G, bx); pg8::EpiSwiglu E{ACT, FF};
        pg8::gemm_phase<pg8::EpiSwiglu, pg8::StaticOrder, true, true>(lds, g, S, E); }
    END_REP
    SEAM(9);
    BEGIN_REP(10)
    if (IN(10)) { pg8::Gemm g{ACT, WdT, M, D, FF}; pg8::StaticOrder S; S.init(M, D, G, bx); pg8::EpiResGate E{OUT, OUT, MOD + 5120, 6144};
        pg8::gemm_phase<pg8::EpiResGate, pg8::StaticOrder, true, true>(lds, g, S, E); }
    END_REP
    SEAM(10);
    LAUNDER();
    if (IN(11)) adaln_rows<2>(OUT, args.in[I_GFIN], MOD + 4 * 6144, MOD + 4 * 6144 + 1024, 2048, nullptr, OUT, nullptr, nullptr, nullptr, nullptr, gw, NGW, lane);
#undef IN
#undef SEAM
}

extern "C" void kernel_launch(void* const* d_in, const int* in_sizes, int n_in, void* d_out, int out_size, void* d_ws, size_t ws_size, hipStream_t stream) {
    static int grid = 0;
    if (grid == 0) {
        if (n_in != 19 || out_size != M * D || ws_size < WS_END) { fprintf(stderr, "kernel_launch: unexpected shapes (n_in %d, out %d, ws %zu)\n", n_in, out_size, ws_size); grid = -1; return; }
        int dev = 0, cus = 0;
        if (hipGetDevice(&dev) != hipSuccess || hipDeviceGetAttribute(&cus, hipDeviceAttributeMultiprocessorCount, dev) != hipSuccess) { grid = -1; return; }
        if (hipFuncSetAttribute((const void*)fwd, hipFuncAttributeMaxDynamicSharedMemorySize, LDS_BYTES) != hipSuccess) { fprintf(stderr, "kernel_launch: hipFuncSetAttribute failed\n"); grid = -1; return; }
        int per_cu = 0;
        if (hipOccupancyMaxActiveBlocksPerMultiprocessor(&per_cu, (const void*)fwd, NWAVES * 64, LDS_BYTES) != hipSuccess || per_cu < 1) { fprintf(stderr, "kernel_launch: occupancy query says %d blocks per CU\n", per_cu); }
        (void)hipGetLastError();
        grid = cus;
    }
    if (grid < 0) return;
    Args a{};
    for (int i = 0; i < 19; ++i) a.in[i] = (const float*)d_in[i];
    a.out = (float*)d_out; a.ws = (unsigned char*)d_ws;
#if MK_N_LAUNCHES == 1
    if (hipMemsetAsync(d_ws, 0, 32768, stream) != hipSuccess) { fprintf(stderr, "kernel_launch: memset of the barrier words failed\n"); return; }
    a.ph_lo = 0; a.ph_hi = PH_END;
    void* kargs[] = {&a};
    hipError_t e = hipLaunchCooperativeKernel((const void*)fwd, dim3(grid), dim3(NWAVES * 64), kargs, LDS_BYTES, stream);
    if (e != hipSuccess) fprintf(stderr, "kernel_launch: cooperative launch failed: %s (grid %d)\n", hipGetErrorString(e), grid);
#else
    for (int ph = 0; ph < PH_END; ++ph) { a.ph_lo = ph; a.ph_hi = ph + 1; hipLaunchKernelGGL(fwd, dim3(grid), dim3(NWAVES * 64), LDS_BYTES, stream, a); }
#endif
}
```

```cpp
#include <hip/hip_runtime.h>
#include <hip/hip_cooperative_groups.h>
#include <cstdio>
#include <cstdint>
namespace cg = cooperative_groups;
#ifndef MK_N_LAUNCHES
#define MK_N_LAUNCHES 1
#endif
#ifndef DN_NAIVE
#define DN_NAIVE 0
#endif
namespace pg8 {
#define PG8_LAS __attribute__((address_space(3)))
typedef unsigned short bf16_t;
typedef short bf16x8 __attribute__((ext_vector_type(8)));
typedef float f32x4 __attribute__((ext_vector_type(4)));
typedef unsigned u32x4 __attribute__((ext_vector_type(4)));
constexpr int BM = 256, BK = 64, HALF = 128, HTB = HALF * BK * 2  , STAGE_BYTES = 8 * HTB, NXCD = 8, WGM = 8;

__host__ __device__ __forceinline__ int lds_byte(int r, int c) { const int st = (r >> 4) * 2 + (c >> 5), rr = r & 15, cc = c & 31, ob = rr * 64 + cc * 2; return st * 1024 + (ob ^ (((ob >> 9) & 1) << 5)); }
__host__ __device__ __forceinline__ void stage_rc(int b, int& R, int& C) { const int st = b / 1024, sb = b % 1024, swz = sb ^ (((sb >> 9) & 1) << 5); R = (st >> 1) * 16 + swz / 64; C = (st & 1) * 32 + (swz % 64) / 2; }
__host__ __device__ __forceinline__ int perm32(int rho) { const int n = rho >> 4, i = rho & 15; return 8 * (i >> 2) + 4 * n + (i & 3); }

struct Unit { int pm, pn; };
struct Gemm { const bf16_t* A; const bf16_t* Bt; int M, N, K; };

struct StaticOrder {
    int nM, nN, nwg, G, c;
    __host__ __device__ void init(int M, int N, int G_, int c_) { nM = M / BM; nN = N / BM; nwg = nM * nN; G = G_; c = c_; }
    __host__ __device__ bool next(int i, Unit& u) const {
        const long L = (long)i * G + c; if (L >= nwg) return false;
        int wgid = (int)L; { const int q = nwg / NXCD, r = nwg % NXCD, xcd = wgid % NXCD, off = wgid / NXCD; wgid = (xcd < r ? xcd * (q + 1) : r * (q + 1) + (xcd - r) * q) + off; }
        const int nig = WGM * nN, gid = wgid / nig, fm = gid * WGM, gsz = (nM - fm) < WGM ? (nM - fm) : WGM;
        u.pm = fm + ((wgid % nig) % gsz); u.pn = (wgid % nig) / gsz; return true;
    }
    __device__ __forceinline__ void a_ready(const Unit&) const {}
    __device__ __forceinline__ void done(const Unit&) const {}
};

typedef float f32x2 __attribute__((ext_vector_type(2)));
typedef __bf16 bf16x2v __attribute__((ext_vector_type(2)));
__device__ __forceinline__ unsigned cvt_pk_bf16(float lo, float hi) { f32x2 v = {lo, hi}; bf16x2v r = __builtin_convertvector(v, bf16x2v); return __builtin_bit_cast(unsigned, r); }
__device__ __forceinline__ float silu_f(float x) { return x * __builtin_amdgcn_rcpf(1.0f + __builtin_amdgcn_exp2f(-1.4426950408889634f * x)); }

struct EpiBf16 {
    static constexpr bool PERM = true, AFTER_DRAIN = false;
    bf16_t* O; int ldc;
    __device__ __forceinline__ void operator()(const f32x4 (&acc)[2][2][4][2], const Unit& u, int wr, int wc, int fr, int fq) const {
        const int row0 = u.pm * BM + wr * 64 + fr; const int col0 = u.pn * BM + wc * 32 + 8 * fq;
#pragma unroll
        for (int ai = 0; ai < 2; ++ai)
#pragma unroll
            for (int m = 0; m < 4; ++m) { bf16_t* rowp = O + (size_t)(row0 + ai * HALF + m * 16) * ldc + col0;
#pragma unroll
                for (int bj = 0; bj < 2; ++bj) { const f32x4 v0 = acc[ai][bj][m][0], v1 = acc[ai][bj][m][1];
                    u32x4 w; w.x = cvt_pk_bf16(v0[0], v0[1]); w.y = cvt_pk_bf16(v0[2], v0[3]); w.z = cvt_pk_bf16(v1[0], v1[1]); w.w = cvt_pk_bf16(v1[2], v1[3]);
                    *(u32x4*)(rowp + bj * HALF) = w; } }
    }
};
struct EpiSwiglu {
    static constexpr bool PERM = true, AFTER_DRAIN = false;
    bf16_t* O; int ldc;
    __device__ __forceinline__ void operator()(const f32x4 (&acc)[2][2][4][2], const Unit& u, int wr, int wc, int fr, int fq) const {
        const int row0 = u.pm * BM + wr * 64 + fr; const int col0 = u.pn * HALF + wc * 32 + 8 * fq;
#pragma unroll
        for (int ai = 0; ai < 2; ++ai)
#pragma unroll
            for (int m = 0; m < 4; ++m) { bf16_t* rowp = O + (size_t)(row0 + ai * HALF + m * 16) * ldc + col0;
                const f32x4 g0 = acc[ai][0][m][0], g1 = acc[ai][0][m][1], u0 = acc[ai][1][m][0], u1 = acc[ai][1][m][1];
                u32x4 w; w.x = cvt_pk_bf16(silu_f(g0[0]) * u0[0], silu_f(g0[1]) * u0[1]); w.y = cvt_pk_bf16(silu_f(g0[2]) * u0[2], silu_f(g0[3]) * u0[3]);
                w.z = cvt_pk_bf16(silu_f(g1[0]) * u1[0], silu_f(g1[1]) * u1[1]); w.w = cvt_pk_bf16(silu_f(g1[2]) * u1[2], silu_f(g1[3]) * u1[3]);
                *(u32x4*)rowp = w; }
    }
};
struct EpiResGate {
    static constexpr bool PERM = false, AFTER_DRAIN = false;
    const float* base; float* out; const float* gate;
    int gstride;
    __device__ __forceinline__ void operator()(const f32x4 (&acc)[2][2][4][2], const Unit& u, int wr, int wc, int fr, int fq) const {
        const int b = u.pm >> 5;
        const int col0 = u.pn * BM + wc * 32 + 4 * fq; const float* gp = gate + (size_t)b * gstride + col0;
        f32x4 gv[2][2];
#pragma unroll
        for (int bj = 0; bj < 2; ++bj)
#pragma unroll
            for (int n = 0; n < 2; ++n) gv[bj][n] = *(const f32x4*)(gp + bj * HALF + n * 16);
#pragma unroll
        for (int ai = 0; ai < 2; ++ai)
#pragma unroll
            for (int m = 0; m < 4; ++m) { const size_t off = (size_t)(u.pm * BM + ai * HALF + wr * 64 + m * 16 + fr) * 1024 + col0;
#pragma unroll
                for (int bj = 0; bj < 2; ++bj)
#pragma unroll
                    for (int n = 0; n < 2; ++n) { const f32x4 bs = *(const f32x4*)(base + off + bj * HALF + n * 16);
                        *(f32x4*)(out + off + bj * HALF + n * 16) = bs + gv[bj][n] * acc[ai][bj][m][n]; } }
    }
};

template <class Epi, class Sched, bool ALIGN_EPI = false, bool SP2 = false>
__device__ __forceinline__ void gemm_phase(PG8_LAS unsigned char* lds, const Gemm g, const Sched& S, const Epi& E) {
    const int tid = threadIdx.x, wid = __builtin_amdgcn_readfirstlane(tid >> 6), lane = tid & 63, wr = wid >> 2, wc = wid & 3, fr = lane & 15, fq = lane >> 4;
    const int K = g.K, nt = K / BK;
    unsigned voffA[2], voffB[2];
#pragma unroll
    for (int i = 0; i < 2; ++i) { int R, C; stage_rc(tid * 16 + i * 8192, R, C); const int Rb = Epi::PERM ? ((R & ~31) + perm32(R & 31)) : R;
        voffA[i] = (unsigned)(R * K + C) * 2u; voffB[i] = (unsigned)(Rb * K + C) * 2u; }
    const size_t kstep = (size_t)(BK * 2);
    const size_t hstep = (size_t)HALF * K * 2;
    const size_t tstep = 2 * hstep;
    const unsigned ldsw = (unsigned)wid * 1024u;
    const int aoff = lds_byte(wr * 64 + fr, fq * 8), boff = lds_byte(wc * 32 + fr, fq * 8);
#define PG8_SA(b, h) (((b) * 2 + (h)) * HTB)
#define PG8_SB(b, h) ((4 + (b) * 2 + (h)) * HTB)
#define PG8_STAGE(bufoff, gbase, voff) do { _Pragma("unroll") for (int _i = 0; _i < 2; ++_i) \
        __builtin_amdgcn_global_load_lds((const unsigned*)((const char*)(gbase) + (voff)[_i]), (PG8_LAS unsigned*)(lds + (bufoff) + ldsw + _i * 8192), 16, 0, 0); } while (0)
#define PG8_LDA(dst, b, h) do { _Pragma("unroll") for (int m = 0; m < 4; ++m) _Pragma("unroll") for (int k = 0; k < 2; ++k) dst[m][k] = *(const PG8_LAS bf16x8*)(lds + PG8_SA(b, h) + aoff + m * 2048 + k * 1024); } while (0)
#define PG8_LDB(dst, b, h) do { _Pragma("unroll") for (int n = 0; n < 2; ++n) _Pragma("unroll") for (int k = 0; k < 2; ++k) dst[n][k] = *(const PG8_LAS bf16x8*)(lds + PG8_SB(b, h) + boff + n * 2048 + k * 1024); } while (0)
#define PG8_MMA(ai, bj, At, Bt) do { __builtin_amdgcn_s_setprio(1); _Pragma("unroll") for (int m = 0; m < 4; ++m) _Pragma("unroll") for (int n = 0; n < 2; ++n) _Pragma("unroll") for (int k = 0; k < 2; ++k) \
        acc[ai][bj][m][n] = __builtin_amdgcn_mfma_f32_16x16x32_bf16(Bt[n][k], At[m][k], acc[ai][bj][m][n], 0, 0, 0); __builtin_amdgcn_s_setprio(0); } while (0)
#define PG8_WAIT_V(n) asm volatile("s_waitcnt vmcnt(" #n ")" ::: "memory")
#define PG8_WAIT_L(n) asm volatile("s_waitcnt lgkmcnt(" #n ")" ::: "memory")
#define PG8_BAR __builtin_amdgcn_s_barrier()
#define PG8_SCHED __builtin_amdgcn_sched_barrier(0)
    Unit cur, nxt; int ui = 0;
    if (!S.next(0, cur)) return;
    f32x4 acc[2][2][4][2];
#pragma unroll
    for (int a = 0; a < 2; ++a)
#pragma unroll
        for (int b = 0; b < 2; ++b)
#pragma unroll
            for (int m = 0; m < 4; ++m)
#pragma unroll
                for (int n = 0; n < 2; ++n) acc[a][b][m][n] = (f32x4){0.f, 0.f, 0.f, 0.f};
    bf16x8 At[4][2], B0[2][2], B1[2][2];
    const char* cA = (const char*)g.A + (size_t)cur.pm * tstep; const char* cB = (const char*)g.Bt + (size_t)cur.pn * tstep;
    S.a_ready(cur);
    if constexpr (SP2) {
        PG8_STAGE(PG8_SB(0, 0), cB, voffB); PG8_STAGE(PG8_SB(0, 1), cB + hstep, voffB); PG8_STAGE(PG8_SA(0, 0), cA, voffA); PG8_STAGE(PG8_SA(0, 1), cA + hstep, voffA);
        if (wr == 1) PG8_BAR;
        PG8_WAIT_V(2); PG8_BAR;
        PG8_STAGE(PG8_SB(1, 0), cB + kstep, voffB); PG8_STAGE(PG8_SA(1, 0), cA + kstep, voffA); PG8_STAGE(PG8_SB(1, 1), cB + hstep + kstep, voffB);
        PG8_WAIT_V(6); PG8_BAR;
    } else {
        PG8_STAGE(PG8_SB(0, 0), cB, voffB); PG8_STAGE(PG8_SA(0, 0), cA, voffA); PG8_STAGE(PG8_SB(0, 1), cB + hstep, voffB); PG8_STAGE(PG8_SA(0, 1), cA + hstep, voffA);
        if (wr == 1) PG8_BAR;
        PG8_WAIT_V(4); PG8_BAR;
        PG8_STAGE(PG8_SB(1, 0), cB + kstep, voffB); PG8_STAGE(PG8_SA(1, 0), cA + kstep, voffA); PG8_STAGE(PG8_SB(1, 1), cB + hstep + kstep, voffB);
        PG8_WAIT_V(6); PG8_BAR;
    }
    for (;;) {
        const bool has_next = S.next(ui + 1, nxt);
        const char* nA = has_next ? (const char*)g.A + (size_t)nxt.pm * tstep : cA; const char* nB = has_next ? (const char*)g.Bt + (size_t)nxt.pn * tstep : cB;
        for (int t = 0; t < nt; t += 2) {
            const bool last = (t == nt - 2);
            const char* a1 = cA + (size_t)(t + 1) * kstep;
            const char* a2 = last ? nA : cA + (size_t)(t + 2) * kstep; const char* b2 = last ? nB : cB + (size_t)(t + 2) * kstep;
            const char* a3 = a2 + kstep; const char* b3 = b2 + kstep;
            if (last && has_next) S.a_ready(nxt);
            if constexpr (SP2) {
            PG8_LDB(B0, 0, 0); PG8_LDB(B1, 0, 1); PG8_SCHED; PG8_LDA(At, 0, 0); PG8_STAGE(PG8_SA(1, 1), a1 + hstep, voffA);
            PG8_WAIT_V(8); PG8_WAIT_L(0); PG8_BAR; PG8_MMA(0, 0, At, B0); PG8_MMA(0, 1, At, B1); PG8_BAR; PG8_SCHED;
            PG8_LDA(At, 0, 1); PG8_STAGE(PG8_SB(0, 0), b2, voffB); PG8_STAGE(PG8_SB(0, 1), b2 + hstep, voffB); PG8_STAGE(PG8_SA(0, 0), a2, voffA);
            PG8_WAIT_V(8); PG8_WAIT_L(0); PG8_BAR; PG8_MMA(1, 0, At, B0); PG8_MMA(1, 1, At, B1); PG8_BAR; PG8_SCHED;
            PG8_LDB(B0, 1, 0); PG8_LDB(B1, 1, 1); PG8_SCHED; PG8_LDA(At, 1, 0); PG8_STAGE(PG8_SA(0, 1), a2 + hstep, voffA);
            PG8_WAIT_V(8); PG8_WAIT_L(0); PG8_BAR; PG8_MMA(0, 0, At, B0); PG8_MMA(0, 1, At, B1); PG8_BAR; PG8_SCHED;
            PG8_LDA(At, 1, 1); PG8_STAGE(PG8_SB(1, 0), b3, voffB); PG8_STAGE(PG8_SB(1, 1), b3 + hstep, voffB); PG8_STAGE(PG8_SA(1, 0), a3, voffA);
            PG8_WAIT_V(8); PG8_WAIT_L(0); PG8_BAR; PG8_MMA(1, 0, At, B0); PG8_MMA(1, 1, At, B1); PG8_BAR; PG8_SCHED;
            } else {
            PG8_LDB(B0, 0, 0); PG8_SCHED; PG8_LDA(At, 0, 0); PG8_STAGE(PG8_SA(1, 1), a1 + hstep, voffA);
            PG8_WAIT_L(8); PG8_BAR; PG8_WAIT_L(0); PG8_MMA(0, 0, At, B0); PG8_BAR; PG8_SCHED;
            PG8_LDB(B1, 0, 1); PG8_STAGE(PG8_SB(0, 0), b2, voffB);
            PG8_BAR; PG8_WAIT_L(0); PG8_MMA(0, 1, At, B1); PG8_BAR;
            PG8_LDA(At, 0, 1); PG8_STAGE(PG8_SA(0, 0), a2, voffA);
            PG8_BAR; PG8_WAIT_L(0); PG8_MMA(1, 0, At, B0); PG8_BAR; PG8_SCHED;
            PG8_STAGE(PG8_SB(0, 1), b2 + hstep, voffB);
            PG8_WAIT_V(6); PG8_BAR; PG8_MMA(1, 1, At, B1); PG8_BAR;
            PG8_LDB(B0, 1, 0); PG8_SCHED; PG8_LDA(At, 1, 0); PG8_STAGE(PG8_SA(0, 1), a2 + hstep, voffA);
            PG8_WAIT_L(8); PG8_BAR; PG8_WAIT_L(0); PG8_MMA(0, 0, At, B0); PG8_BAR; PG8_SCHED;
            PG8_LDB(B1, 1, 1); PG8_STAGE(PG8_SB(1, 0), b3, voffB);
            PG8_BAR; PG8_WAIT_L(0); PG8_MMA(0, 1, At, B1); PG8_BAR;
            PG8_LDA(At, 1, 1); PG8_STAGE(PG8_SA(1, 0), a3, voffA);
            PG8_BAR; PG8_WAIT_L(0); PG8_MMA(1, 0, At, B0); PG8_BAR; PG8_SCHED;
            PG8_STAGE(PG8_SB(1, 1), b3 + hstep, voffB);
            PG8_WAIT_V(6); PG8_BAR; PG8_MMA(1, 1, At, B1); PG8_BAR;
            }
        }
        if constexpr (ALIGN_EPI) { if (wr == 0) PG8_BAR; }
        if constexpr (!Epi::AFTER_DRAIN) { E(acc, cur, wr, wc, fr, fq); S.done(cur); }
        if (!has_next) break;
#pragma unroll
        for (int a = 0; a < 2; ++a)
#pragma unroll
            for (int b = 0; b < 2; ++b)
#pragma unroll
                for (int m = 0; m < 4; ++m)
#pragma unroll
                    for (int n = 0; n < 2; ++n) acc[a][b][m][n] = (f32x4){0.f, 0.f, 0.f, 0.f};
        cur = nxt; cA = nA; cB = nB; ++ui;
        if constexpr (ALIGN_EPI) { if (wr == 1) PG8_BAR; }
    }
    PG8_WAIT_V(0);
    if constexpr (!ALIGN_EPI) { if (wr == 0) PG8_BAR; }
    PG8_BAR;
    if constexpr (Epi::AFTER_DRAIN) { E.fused(acc, cur, wr, wc, fr, fq, lds, wid, lane); S.done(cur); }
#undef PG8_SA
#undef PG8_SB
#undef PG8_STAGE
#undef PG8_LDA
#undef PG8_LDB
#undef PG8_MMA
#undef PG8_WAIT_V
#undef PG8_WAIT_L
#undef PG8_BAR
#undef PG8_SCHED
}
}

constexpr int NWAVES = 8;
constexpr int BATCH = 4, SEQ = 8192, D = 1024, M = BATCH * SEQ;
constexpr int PIN = 3592, NP = 3584;
constexpr int FF = 2816, NCH = 128, NBH = 16;
constexpr int PH_END = 12;
constexpr float EPS = 1e-6f;
constexpr size_t MiB = 1u << 20;
constexpr size_t WS_MOD = 1 * MiB;
constexpr size_t WS_GB = 2 * MiB;
constexpr size_t WS_EGL = 3 * MiB;
constexpr size_t WS_WIN = 4 * MiB, WS_WO = 11 * MiB, WS_WGU = 13 * MiB, WS_WD = 24 * MiB;
constexpr size_t WS_H = 32 * MiB;
constexpr size_t WS_CH = 32 * MiB;
constexpr size_t WS_P = 208 * MiB;
constexpr size_t WS_YC = 432 * MiB;
constexpr size_t WS_END = 496 * MiB;
constexpr int REC = 74752;
constexpr int REC_A = 57344;
constexpr int LDS_BYTES = 155648;

#define LAS __attribute__((address_space(3)))
typedef unsigned short bf16;
typedef unsigned v4u __attribute__((ext_vector_type(4)));
typedef unsigned v2u __attribute__((ext_vector_type(2)));
typedef float f32x4 __attribute__((ext_vector_type(4)));
typedef float f32x16 __attribute__((ext_vector_type(16)));
typedef short bf16x8 __attribute__((ext_vector_type(8)));
#define LDS_WAIT() asm volatile("s_waitcnt lgkmcnt(0)" ::: "memory")
using pg8::cvt_pk_bf16; using pg8::silu_f;
__device__ __forceinline__ float bf2f(unsigned short u) { return __uint_as_float((unsigned)u << 16); }
__device__ __forceinline__ float bflo(unsigned w) { return __uint_as_float(w << 16); }
__device__ __forceinline__ float bfhi(unsigned w) { return __uint_as_float(w & 0xffff0000u); }
__device__ __forceinline__ float wave_sum(float v) {
#pragma unroll
    for (int o = 1; o < 64; o <<= 1) v += __shfl_xor(v, o);
    return v;
}
__device__ __forceinline__ void unpack8(v4u w, float (&f)[8]) { f[0] = bflo(w.x); f[1] = bfhi(w.x); f[2] = bflo(w.y); f[3] = bfhi(w.y); f[4] = bflo(w.z); f[5] = bfhi(w.z); f[6] = bflo(w.w); f[7] = bfhi(w.w); }
__device__ __forceinline__ v4u pack8(const float (&f)[8]) { v4u w; w.x = cvt_pk_bf16(f[0], f[1]); w.y = cvt_pk_bf16(f[2], f[3]); w.z = cvt_pk_bf16(f[4], f[5]); w.w = cvt_pk_bf16(f[6], f[7]); return w; }

struct Args { const float* in[19]; float* out; unsigned char* ws; int ph_lo, ph_hi; };
enum { I_X = 0, I_C, I_WADA, I_BADA, I_WADAF, I_BADAF, I_GMIX, I_GFFN, I_GFIN, I_WIN, I_CWM, I_CWQ, I_ALOG, I_DTB, I_GCO, I_GDN, I_WOUT, I_WGU, I_WDN };

template <int MODE>
__device__ __forceinline__ void p0_transpose_item(const float* W, int K, int ld, int nblk, bf16* WT, LAS float* scr, int item, int lane) {
    const int kb = item / nblk, nb = item % nblk, k0 = 64 * kb, n0 = 32 * nb;
    f32x4 ld4[8];
#pragma unroll
    for (int i = 0; i < 8; ++i) ld4[i] = *(const f32x4*)(W + (size_t)(k0 + 8 * i + (lane >> 3)) * ld + n0 + 4 * (lane & 7));
#pragma unroll
    for (int i = 0; i < 8; ++i) { LAS float* d = scr + (8 * i + (lane >> 3)) * 33 + 4 * (lane & 7); d[0] = ld4[i].x; d[1] = ld4[i].y; d[2] = ld4[i].z; d[3] = ld4[i].w; }
    LDS_WAIT(); asm volatile("" ::: "memory");
    int r0 = n0;
    if (MODE == 1) { r0 = n0 < FF ? 256 * (n0 / 128) + (n0 % 128) : 256 * ((n0 - FF) / 128) + 128 + ((n0 - FF) % 128); }
    const int c = lane & 7;
#pragma unroll
    for (int j = 0; j < 4; ++j) { const int n = (lane >> 3) + 8 * j; const LAS float* s = scr + (8 * c) * 33 + n;
        v4u o; o.x = cvt_pk_bf16(s[0 * 33], s[1 * 33]); o.y = cvt_pk_bf16(s[2 * 33], s[3 * 33]); o.z = cvt_pk_bf16(s[4 * 33], s[5 * 33]); o.w = cvt_pk_bf16(s[6 * 33], s[7 * 33]);
        *(v4u*)(WT + (size_t)(r0 + n) * K + k0 + 8 * c) = o; }
    LDS_WAIT(); asm volatile("" ::: "memory");
}
__device__ __forceinline__ void p0_mod_item(const Args& a, float* MOD, const LAS float* SC, LAS float* red, int item, int tid) {
    const int c4 = tid & 7, ks = tid >> 3, col0 = item * 32;
    const bool fin = col0 >= 6144; const float* W = fin ? a.in[I_WADAF] : a.in[I_WADA]; const int ld = fin ? 2048 : 6144, cb = (fin ? col0 - 6144 : col0);
    f32x4 w[16];
#pragma unroll
    for (int kk = 0; kk < 16; ++kk) w[kk] = *(const f32x4*)(W + (size_t)(16 * ks + kk) * ld + cb + 4 * c4);
    f32x4 acc[4];
#pragma unroll
    for (int b = 0; b < 4; ++b) acc[b] = (f32x4){0.f, 0.f, 0.f, 0.f};
#pragma unroll
    for (int kk = 0; kk < 16; ++kk) { const f32x4 s = *(const LAS f32x4*)(SC + (16 * ks + kk) * 4); acc[0] += s.x * w[kk]; acc[1] += s.y * w[kk]; acc[2] += s.z * w[kk]; acc[3] += s.w * w[kk]; }
#pragma unroll
    for (int b = 0; b < 4; ++b) *(LAS f32x4*)(red + (ks * 4 + b) * 32 + 4 * c4) = acc[b];
    __syncthreads();
    if (tid < 128) { const int b = tid >> 5, cl = tid & 31; float s = 0.f;
#pragma unroll 16
        for (int k = 0; k < 64; ++k) s += red[(k * 4 + b) * 32 + cl];
        const int c = cb + cl;
        s += fin ? a.in[I_BADAF][c] : a.in[I_BADA][c];
        if (fin) MOD[4 * 6144 + b * 2048 + c] = s; else MOD[b * 6144 + c] = s; }
    __syncthreads();
}

template <int MODE>
__device__ __forceinline__ void adaln_one(const f32x4 (&xin)[4], const f32x4 (&gs)[4], const f32x4 (&sh)[4], int m, bf16* Hout, float* Fout, const LAS float* TT, const float* a_log, const float* dt_bias, float* GB, int lane) {
    f32x4 v[4]; float ss = 0.f;
#pragma unroll
    for (int j = 0; j < 4; ++j) { v[j] = xin[j]; ss += (v[j].x * v[j].x + v[j].y * v[j].y) + (v[j].z * v[j].z + v[j].w * v[j].w); }
    const float rinv = 1.0f / sqrtf(wave_sum(ss) * (1.0f / D) + EPS);
#pragma unroll
    for (int j = 0; j < 4; ++j) v[j] = (v[j] * rinv) * gs[j] + sh[j];
    if (MODE == 2) { f32x4* o = (f32x4*)(Fout + (size_t)m * D) + lane;
#pragma unroll
        for (int j = 0; j < 4; ++j) o[64 * j] = v[j];
    } else { v2u* o = (v2u*)(Hout + (size_t)m * D) + lane;
#pragma unroll
        for (int j = 0; j < 4; ++j) { v2u w; w.x = cvt_pk_bf16(v[j].x, v[j].y); w.y = cvt_pk_bf16(v[j].z, v[j].w); o[64 * j] = w; } }
    if (MODE == 0) {
        float d[8];
#pragma unroll
        for (int e = 0; e < 8; ++e) { float s = 0.f;
#pragma unroll
            for (int j = 0; j < 4; ++j) { const f32x4 t = *(const LAS f32x4*)(TT + e * 1024 + 4 * (lane + 64 * j)); s += (v[j].x * t.x + v[j].y * t.y) + (v[j].z * t.z + v[j].w * t.w); }
            asm volatile("" : "+v"(s) :: "memory"); d[e] = s; }
        float k4[4], k2[2], k1;
        { const bool hi = (lane & 32) != 0;
#pragma unroll
          for (int i = 0; i < 4; ++i) { const float snd = hi ? d[i] : d[4 + i]; const float kp = hi ? d[4 + i] : d[i]; k4[i] = kp + __shfl_xor(snd, 32); } }
        { const bool hi = (lane & 16) != 0;
#pragma unroll
          for (int i = 0; i < 2; ++i) { const float snd = hi ? k4[i] : k4[2 + i]; const float kp = hi ? k4[2 + i] : k4[i]; k2[i] = kp + __shfl_xor(snd, 16); } }
        { const bool hi = (lane & 8) != 0; const float snd = hi ? k2[0] : k2[1]; const float kp = hi ? k2[1] : k2[0]; k1 = kp + __shfl_xor(snd, 8); }
        k1 += __shfl_xor(k1, 4); k1 += __shfl_xor(k1, 2); k1 += __shfl_xor(k1, 1);
        if ((lane & 7) == 0) { const int e = lane >> 3; float r;
            if (e < 4) { const float xx = k1 + dt_bias[e]; const float sp = fmaxf(xx, 0.f) + log1pf(__expf(-fabsf(xx))); r = -__expf(a_log[e]) * sp; }
            else r = 1.0f / (1.0f + __expf(-k1));
            GB[(size_t)m * 8 + e] = r; }
    }
}
template <int MODE>
__device__ __forceinline__ void adaln_rows(const float* X, const float* gain, const float* shiftp, const float* scalep, int mstride, bf16* Hout, float* Fout,
                                           const LAS float* TT, const float* a_log, const float* dt_bias, float* GB, int gw, int NGW, int lane) {
    for (int blk = gw; blk < M / 16; blk += NGW) {
        const int m0 = blk * 16, b = m0 >> 13;
        f32x4 gs[4], sh[4];
        { const f32x4* g4 = (const f32x4*)gain + lane; const f32x4* sh4 = (const f32x4*)(shiftp + (size_t)b * mstride) + lane; const f32x4* sc4 = (const f32x4*)(scalep + (size_t)b * mstride) + lane;
#pragma unroll
          for (int j = 0; j < 4; ++j) { gs[j] = g4[64 * j] * (1.0f + sc4[64 * j]); sh[j] = sh4[64 * j]; } }
        f32x4 c0[4], c1[4];
        { const f32x4* xr = (const f32x4*)(X + (size_t)m0 * D) + lane;
#pragma unroll
          for (int j = 0; j < 4; ++j) { c0[j] = xr[64 * j]; c1[j] = xr[256 + 64 * j]; } }
#pragma unroll 1
        for (int i = 0; i < 16; i += 2) {
            f32x4 n0[4], n1[4];
            { const int mn = (i + 2 < 16) ? m0 + i + 2 : m0; const f32x4* xr = (const f32x4*)(X + (size_t)mn * D) + lane;
#pragma unroll
              for (int j = 0; j < 4; ++j) { n0[j] = xr[64 * j]; n1[j] = xr[256 + 64 * j]; } }
            adaln_one<MODE>(c0, gs, sh, m0 + i, Hout, Fout, TT, a_log, dt_bias, GB, lane);
            adaln_one<MODE>(c1, gs, sh, m0 + i + 1, Hout, Fout, TT, a_log, dt_bias, GB, lane);
#pragma unroll
            for (int j = 0; j < 4; ++j) { c0[j] = n0[j]; c1[j] = n1[j]; }
        }
    }
}

__device__ __forceinline__ void conv_qkv(const bf16* P, const float* cwq, bf16* QKV, int X, int t0, bool first, int lane) {
    const int colp = 1536 + 512 * X + 8 * lane, colo = 512 * X + 8 * lane;
    v4u raw[19];
#pragma unroll
    for (int t = 0; t < 19; ++t) { raw[t] = (v4u){0u, 0u, 0u, 0u}; if (t >= 3 || !first) raw[t] = *(const v4u*)(P + (size_t)(t0 - 3 + t) * NP + colp); }
    float w0[8], w1[8], w2[8], w3[8], h3[8], h2[8], h1[8];
#pragma unroll
    for (int e = 0; e < 8; ++e) { w0[e] = cwq[0 * 1536 + colo + e]; w1[e] = cwq[1 * 1536 + colo + e]; w2[e] = cwq[2 * 1536 + colo + e]; w3[e] = cwq[3 * 1536 + colo + e]; }
    unpack8(raw[0], h3); unpack8(raw[1], h2); unpack8(raw[2], h1);
#pragma unroll
    for (int t = 0; t < 16; ++t) { const int m = t0 + t; float x[8], y[8]; unpack8(raw[3 + t], x); float ss = 0.f;
#pragma unroll
        for (int e = 0; e < 8; ++e) { const float c = w0[e] * h3[e] + w1[e] * h2[e] + w2[e] * h1[e] + w3[e] * x[e]; y[e] = silu_f(c); ss += y[e] * y[e]; h3[e] = h2[e]; h2[e] = h1[e]; h1[e] = x[e]; }
        if (X < 2) { ss += __shfl_xor(ss, 1); ss += __shfl_xor(ss, 2); ss += __shfl_xor(ss, 4); ss += __shfl_xor(ss, 8);
            float r = 1.0f / sqrtf(ss + EPS); if (X == 0) r *= 0.08838834764831845f;
#pragma unroll
            for (int e = 0; e < 8; ++e) y[e] *= r; }
        *(v4u*)(QKV + (size_t)m * 1536 + colo) = pack8(y); }
}
__device__ __forceinline__ void conv_pass(const bf16* P, const float* cwm, const float* cwq, const float* gco, bf16* YC, bf16* QKV, int gw, int NGW, int lane) {
    for (int run = gw; run < M / 16; run += NGW) {
        const int t0 = run * 16; const bool first = (t0 & (SEQ - 1)) == 0;
        { float w0[8], w1[8], w2[8], gc[8], u2[8], u1[8]; const int c0 = 8 * lane;
#pragma unroll
          for (int e = 0; e < 8; ++e) { w0[e] = cwm[c0 + e]; w1[e] = cwm[512 + c0 + e]; w2[e] = cwm[1024 + c0 + e]; gc[e] = gco[c0 + e]; u2[e] = 0.f; u1[e] = 0.f; }
          if (!first) { float a[8], b[8]; unpack8(*(const v4u*)(P + (size_t)(t0 - 2) * NP + 512 + c0), a); unpack8(*(const v4u*)(P + (size_t)(t0 - 2) * NP + 1024 + c0), b);
#pragma unroll
              for (int e = 0; e < 8; ++e) u2[e] = a[e] * b[e];
              unpack8(*(const v4u*)(P + (size_t)(t0 - 1) * NP + 512 + c0), a); unpack8(*(const v4u*)(P + (size_t)(t0 - 1) * NP + 1024 + c0), b);
#pragma unroll
              for (int e = 0; e < 8; ++e) u1[e] = a[e] * b[e]; }
#pragma unroll 1
          for (int tb = 0; tb < 16; tb += 8) {
              v4u rb[8], rc[8], rh[8];
#pragma unroll
              for (int t = 0; t < 8; ++t) { const bf16* pr = P + (size_t)(t0 + tb + t) * NP + c0; rb[t] = *(const v4u*)pr; rc[t] = *(const v4u*)(pr + 512); rh[t] = *(const v4u*)(pr + 1024); }
#pragma unroll
              for (int t = 0; t < 8; ++t) { const int m = t0 + tb + t; float gb[8], a[8], b[8], y[8]; unpack8(rb[t], gb); unpack8(rc[t], a); unpack8(rh[t], b); float ss = 0.f;
#pragma unroll
                  for (int e = 0; e < 8; ++e) { const float u0 = a[e] * b[e]; y[e] = gb[e] * (w0[e] * u2[e] + w1[e] * u1[e] + w2[e] * u0); ss += y[e] * y[e]; u2[e] = u1[e]; u1[e] = u0; }
                  ss += __shfl_xor(ss, 1); ss += __shfl_xor(ss, 2); ss += __shfl_xor(ss, 4);
                  const float r = 1.0f / sqrtf(ss * (1.0f / 64.0f) + EPS);
#pragma unroll
                  for (int e = 0; e < 8; ++e) y[e] = y[e] * r * gc[e];
                  *(v4u*)(YC + (size_t)m * D + c0) = pack8(y); } } }
        conv_qkv(P, cwq, QKV, 0, t0, first, lane); conv_qkv(P, cwq, QKV, 1, t0, first, lane); conv_qkv(P, cwq, QKV, 2, t0, first, lane);
    }
}


constexpr int PREP_HALF = 69632, PK_KN = 0, PK_QN = 17408, PK_VV = 34816, PK_LM = 52224, PK_GC = 68608, PK_BT = 68864, PK_EG = 69120, PROW = 272;
template <bool SC>
__device__ __forceinline__ v4u afrag_piece_rows(const LAS unsigned char* tile, const LAS float* sc, int p) {
    const int f = p >> 6, ln = p & 63, mt = f >> 3, kt = (f >> 1) & 3, s = f & 1, r = ln & 31, hh = ln >> 5, row = 32 * mt + r, kb = 32 * kt + 16 * s + 4 * hh;
    const v2u a = *(const LAS v2u*)(tile + row * PROW + kb * 2), b = *(const LAS v2u*)(tile + row * PROW + (kb + 8) * 2);
    float scv = 1.0f; if (SC) scv = sc[row];
    v4u o; o.x = cvt_pk_bf16(bflo(a.x) * scv, bfhi(a.x) * scv); o.y = cvt_pk_bf16(bflo(a.y) * scv, bfhi(a.y) * scv); o.z = cvt_pk_bf16(bflo(b.x) * scv, bfhi(b.x) * scv); o.w = cvt_pk_bf16(bflo(b.y) * scv, bfhi(b.y) * scv);
    return o;
}
__device__ __forceinline__ void prep_phase(LAS unsigned char* lds, const bf16* QKV, const float* GB, float* EGL, unsigned char* CH, unsigned* FLG, int ublk, int nblk, int tid) {
    const int half = tid >> 8, t = tid & 255, lane = tid & 63, w = (tid >> 6) & 3, r = lane & 31, hh = lane >> 5;
    LAS unsigned char* L = lds + half * PREP_HALF;
    LAS float* LM = (LAS float*)(L + PK_LM); LAS float* GC = (LAS float*)(L + PK_GC); LAS float* BT = (LAS float*)(L + PK_BT); LAS float* EG = (LAS float*)(L + PK_EG);
    for (int pu = ublk; pu < NBH * NCH / 2; pu += nblk) {
        const int n = pu >> 3, bh = 2 * (pu & 7) + half, cid = bh * NCH + n, b = bh >> 2, h = bh & 3, m0 = b * SEQ + n * 64;
        unsigned char* rec = CH + (size_t)cid * REC;
        __syncthreads();
#pragma unroll
        for (int X = 0; X < 3; ++X)
#pragma unroll
            for (int i = 0; i < 4; ++i) { const int p = t + 256 * i, row = p >> 4, c16 = p & 15;
                const v4u v = *(const v4u*)(QKV + (size_t)(m0 + row) * 1536 + 512 * X + 128 * h + 8 * c16);
                *(LAS v4u*)(L + (X == 0 ? PK_QN : (X == 1 ? PK_KN : PK_VV)) + row * PROW + c16 * 16) = v; }
        if (w == 0) { float g = GB[(size_t)(m0 + lane) * 8 + h];
#pragma unroll
            for (int d = 1; d < 64; d <<= 1) { const float o = __shfl_up(g, d); if (lane >= d) g += o; }
            GC[lane] = g; EG[lane] = __expf(g); BT[lane] = GB[(size_t)(m0 + lane) * 8 + 4 + h];
            if (lane == 63) *(float*)(rec + 73728) = __expf(g); }
        __syncthreads();
        { const int mi = w >> 1, nj = w & 1;
          f32x16 kk, qk;
#pragma unroll
          for (int i = 0; i < 16; ++i) { kk[i] = 0.f; qk[i] = 0.f; }
#pragma unroll
          for (int st = 0; st < 8; ++st) {
              const bf16x8 ka = *(const LAS bf16x8*)(L + PK_KN + (32 * mi + r) * PROW + (16 * st + 8 * hh) * 2);
              const bf16x8 kb = *(const LAS bf16x8*)(L + PK_KN + (32 * nj + r) * PROW + (16 * st + 8 * hh) * 2);
              const bf16x8 qb = *(const LAS bf16x8*)(L + PK_QN + (32 * mi + r) * PROW + (16 * st + 8 * hh) * 2);
              kk = __builtin_amdgcn_mfma_f32_32x32x16_bf16(ka, kb, kk, 0, 0, 0);
              qk = __builtin_amdgcn_mfma_f32_32x32x16_bf16(kb, qb, qk, 0, 0, 0);
          }
          const float gj = GC[32 * nj + r], gq = GC[32 * mi + r];
          float av[16];
#pragma unroll
          for (int reg = 0; reg < 16; ++reg) { const int cr = (reg & 3) + 8 * (reg >> 2) + 4 * hh;
              const int i = 32 * mi + cr, j = 32 * nj + r;
              LM[i * 64 + j] = (i > j) ? BT[i] * kk[reg] * __expf(GC[i] - gj) : 0.f;
              const int key = 32 * nj + cr, qr = 32 * mi + r;
              av[reg] = (qr >= key) ? qk[reg] * __expf(gq - GC[key]) : 0.f; }
#pragma unroll
          for (int s = 0; s < 2; ++s) { v4u o; o.x = cvt_pk_bf16(av[8 * s], av[8 * s + 1]); o.y = cvt_pk_bf16(av[8 * s + 2], av[8 * s + 3]); o.z = cvt_pk_bf16(av[8 * s + 4], av[8 * s + 5]); o.w = cvt_pk_bf16(av[8 * s + 6], av[8 * s + 7]);
              *(v4u*)(rec + 49152 + ((mi * 2 + nj) * 2 + s) * 1024 + lane * 16) = o; }
        }
#pragma unroll
        for (int i = 0; i < 4; ++i) { const int p = t + 256 * i; *(v4u*)(rec + 16384 + p * 16) = afrag_piece_rows<true>(L + PK_QN, EG, p); }
        { const float gl = GC[63];
#pragma unroll
          for (int i = 0; i < 4; ++i) { const int p = t + 256 * i, f = p >> 6, ln = p & 63, mt = f >> 2, ct = (f >> 1) & 1, s = f & 1, dk = 32 * mt + (ln & 31), cb = 32 * ct + 16 * s + 4 * (ln >> 5);
              float e[8];
#pragma unroll
              for (int j = 0; j < 8; ++j) { const int c = cb + 8 * (j >> 2) + (j & 3); e[j] = bf2f(*(const LAS unsigned short*)(L + PK_KN + c * PROW + dk * 2)) * __expf(gl - GC[c]); }
              *(v4u*)(rec + 32768 + p * 16) = pack8(e); } }
        __syncthreads();
        { float X[64]; const bool isu = t < 128; const int col = t & 127;
          const LAS unsigned char* src = L + (isu ? PK_VV : PK_KN) + col * 2;
#pragma unroll
          for (int i = 0; i < 64; ++i) {
              const float egi = EG[i]; const float rhs = bf2f(*(const LAS unsigned short*)(src + i * PROW)) * BT[i] * (isu ? 1.0f : egi);
              float a0 = 0.f, a1 = 0.f, a2 = 0.f, a3 = 0.f;
#pragma unroll
              for (int j4 = 0; j4 < (i + 3) / 4; ++j4) { const f32x4 l = *(const LAS f32x4*)(LM + i * 64 + 4 * j4);
                  if (4 * j4 + 0 < i) a0 += l.x * X[4 * j4 + 0]; if (4 * j4 + 1 < i) a1 += l.y * X[4 * j4 + 1]; if (4 * j4 + 2 < i) a2 += l.z * X[4 * j4 + 2]; if (4 * j4 + 3 < i) a3 += l.w * X[4 * j4 + 3]; }
              X[i] = rhs - ((a0 + a1) + (a2 + a3)); asm volatile("" : "+v"(X[i]) :: "memory"); }
          __syncthreads();
          if (isu) { const int vs = col >> 5, dvl = col & 31;
#pragma unroll
              for (int mt = 0; mt < 2; ++mt)
#pragma unroll
                  for (int h2 = 0; h2 < 2; ++h2) { v4u* dst = (v4u*)(rec + REC_A + (size_t)(((vs * 2 + mt) * 64 + dvl + 32 * h2) * 32));
#pragma unroll
                      for (int a2 = 0; a2 < 2; ++a2) { const int i0 = 32 * mt + 4 * h2 + 16 * a2; v4u w;
                          w.x = cvt_pk_bf16(X[i0], X[i0 + 1]); w.y = cvt_pk_bf16(X[i0 + 2], X[i0 + 3]); w.z = cvt_pk_bf16(X[i0 + 8], X[i0 + 9]); w.w = cvt_pk_bf16(X[i0 + 10], X[i0 + 11]); dst[a2] = w; } }
          } else {
#pragma unroll
              for (int i = 0; i < 64; ++i) *(LAS unsigned short*)(L + PK_VV + i * PROW + col * 2) = (unsigned short)(cvt_pk_bf16(-X[i], 0.f) & 0xffffu);
          }
        }
        __syncthreads();
#pragma unroll
        for (int i = 0; i < 4; ++i) { const int p = t + 256 * i; *(v4u*)(rec + p * 16) = afrag_piece_rows<false>(L + PK_VV, EG, p); }
        asm volatile("s_waitcnt vmcnt(0)" ::: "memory"); __syncthreads();
        if (tid == 0) { __builtin_amdgcn_fence(__ATOMIC_RELEASE, "agent"); asm volatile("s_waitcnt vmcnt(0)" ::: "memory");
            __hip_atomic_store(FLG + (2 * (pu & 7)) * NCH + n, 1u, __ATOMIC_RELAXED, __HIP_MEMORY_SCOPE_AGENT); __hip_atomic_store(FLG + (2 * (pu & 7) + 1) * NCH + n, 1u, __ATOMIC_RELAXED, __HIP_MEMORY_SCOPE_AGENT); }
    }
}

__device__ __forceinline__ bf16x8 pack_acc(const f32x16& x, int s) {
    v4u p; p.x = cvt_pk_bf16(x[8 * s], x[8 * s + 1]); p.y = cvt_pk_bf16(x[8 * s + 2], x[8 * s + 3]); p.z = cvt_pk_bf16(x[8 * s + 4], x[8 * s + 5]); p.w = cvt_pk_bf16(x[8 * s + 6], x[8 * s + 7]);
    return __builtin_bit_cast(bf16x8, p);
}
#define MFMA32(a, b, c) __builtin_amdgcn_mfma_f32_32x32x16_bf16((a), (b), (c), 0, 0, 0)
#define PIN_SCHED() __builtin_amdgcn_sched_barrier(0)
__device__ __forceinline__ int chain_ready(const unsigned* fl, int have, int lane) {
    for (;;) {
        const int idx = have + 1 + lane;
        const unsigned f = (idx < NCH) ? __hip_atomic_load(fl + idx, __ATOMIC_RELAXED, __HIP_MEMORY_SCOPE_AGENT) : 0u;
        const unsigned long long m = __ballot(f != 0u);
        const int pre = (m == ~0ull) ? 64 : __builtin_ctzll(~m);
        if (pre > 0) { __builtin_amdgcn_fence(__ATOMIC_ACQUIRE, "agent"); asm volatile("s_waitcnt vmcnt(0)" ::: "memory"); return have + pre; }
        __builtin_amdgcn_s_sleep(16);
    }
}
__device__ __forceinline__ void chain_phase(LAS unsigned char* lds, const unsigned char* CH, const unsigned* FLG, bf16* Oraw, int bh, int tid) {
    const int wid = __builtin_amdgcn_readfirstlane(tid >> 6), lane = tid & 63, b = bh >> 2, h = bh & 3, vs = wid & 3;
    const unsigned char* rec0 = CH + (size_t)bh * NCH * REC;
    const bool comp = wid < 4, stager = (wid >= 4);
    const int hw = wid - 4;
#define CH_MOVE(n, dstbase) do { _Pragma("unroll") for (int _i = 0; _i < 19; ++_i) { const int _pc = hw * 19 + _i; if (_pc < 73) \
        __builtin_amdgcn_global_load_lds((const unsigned*)(rec0 + (size_t)(n) * REC + _pc * 1024 + lane * 16), (LAS unsigned*)((dstbase) + _pc * 1024), 16, 0, 0); } } while (0)
#define CH_WARM(n) do { _Pragma("unroll") for (int _i = 0; _i < 10; ++_i) { const int _o = (_i * 64 + lane) * 128; \
        __builtin_amdgcn_global_load_lds((const unsigned*)(rec0 + (size_t)(n) * REC + (_o < REC ? _o : 0)), (LAS unsigned*)(dummy), 4, 0, 0); } } while (0)
    constexpr int WARM_AHEAD = 8;
    LAS unsigned char* dummy = lds + 2 * REC;
    f32x16 S[4], o0, o1;
#pragma unroll
    for (int k = 0; k < 4; ++k)
#pragma unroll
        for (int i = 0; i < 16; ++i) S[k][i] = 0.f;
#pragma unroll
    for (int i = 0; i < 16; ++i) { o0[i] = 0.f; o1[i] = 0.f; }
    const unsigned* fl = FLG + bh * NCH; int have = -1;
    if (stager) { while (have < 0) have = chain_ready(fl, have, lane); CH_MOVE(0, lds); }
    if (!comp) asm volatile("s_waitcnt vmcnt(0)" ::: "memory");
    __builtin_amdgcn_s_barrier(); asm volatile("" ::: "memory");
    for (int n = 0; n < NCH; ++n) {
        const int buf = n & 1;
        if (!comp) {
            if (stager) { if (n + 1 < NCH) { while (have < n + 1) have = chain_ready(fl, have, lane); CH_MOVE(n + 1, lds + (buf ^ 1) * REC); } asm volatile("s_waitcnt vmcnt(0)" ::: "memory"); }
            else { const int wn = n + 1 + WARM_AHEAD; if (wn < NCH) { if (have < wn) { const int idx = have + 1 + lane; const unsigned f = (idx < NCH) ? __hip_atomic_load(fl + idx, __ATOMIC_RELAXED, __HIP_MEMORY_SCOPE_AGENT) : 0u;
                        const unsigned long long m = __ballot(f != 0u); const int pre = (m == ~0ull) ? 64 : __builtin_ctzll(~m); if (pre > 0) { __builtin_amdgcn_fence(__ATOMIC_ACQUIRE, "agent"); have += pre; } }
                    if (have >= wn) CH_WARM(wn); }
                   asm volatile("s_waitcnt vmcnt(20)" ::: "memory"); }
        } else {
            const LAS unsigned char* B = lds + buf * REC + lane * 16;
            const float egl = *(const LAS float*)(lds + buf * REC + 73728);
            f32x16 v0, v1;
            { const LAS v4u* ul = (const LAS v4u*)(lds + buf * REC + 57344 + ((vs * 2) * 64 + lane) * 32);
              const v4u a0 = ul[0], a1 = ul[1], b0 = ul[128], b1 = ul[129];
              v0[0] = bflo(a0.x); v0[1] = bfhi(a0.x); v0[2] = bflo(a0.y); v0[3] = bfhi(a0.y); v0[4] = bflo(a0.z); v0[5] = bfhi(a0.z); v0[6] = bflo(a0.w); v0[7] = bfhi(a0.w);
              v0[8] = bflo(a1.x); v0[9] = bfhi(a1.x); v0[10] = bflo(a1.y); v0[11] = bfhi(a1.y); v0[12] = bflo(a1.z); v0[13] = bfhi(a1.z); v0[14] = bflo(a1.w); v0[15] = bfhi(a1.w);
              v1[0] = bflo(b0.x); v1[1] = bfhi(b0.x); v1[2] = bflo(b0.y); v1[3] = bfhi(b0.y); v1[4] = bflo(b0.z); v1[5] = bfhi(b0.z); v1[6] = bflo(b0.w); v1[7] = bfhi(b0.w);
              v1[8] = bflo(b1.x); v1[9] = bfhi(b1.x); v1[10] = bflo(b1.y); v1[11] = bfhi(b1.y); v1[12] = bflo(b1.z); v1[13] = bfhi(b1.z); v1[14] = bflo(b1.w); v1[15] = bfhi(b1.w); }
#pragma unroll
            for (int i = 0; i < 16; ++i) { o0[i] = 0.f; o1[i] = 0.f; }
#define LDF(dst, off) dst = *(const LAS bf16x8*)(B + (off))
#define LD_WQ(F, kt, s) do { LDF(F[0], ((0 * 4 + (kt)) * 2 + (s)) * 1024); LDF(F[1], ((1 * 4 + (kt)) * 2 + (s)) * 1024); LDF(F[2], 16384 + ((0 * 4 + (kt)) * 2 + (s)) * 1024); LDF(F[3], 16384 + ((1 * 4 + (kt)) * 2 + (s)) * 1024); } while (0)
#define MM_WQ(F, kt, s) do { const bf16x8 sb = pack_acc(S[kt], s); v0 = MFMA32(F[0], sb, v0); v1 = MFMA32(F[1], sb, v1); o0 = MFMA32(F[2], sb, o0); o1 = MFMA32(F[3], sb, o1); asm volatile("" : "+v"(o0), "+v"(o1)); } while (0)
#define LD_AT(F, ct) do { LDF(F[0], 49152 + ((0 * 2 + (ct)) * 2 + 0) * 1024); LDF(F[1], 49152 + ((1 * 2 + (ct)) * 2 + 0) * 1024); LDF(F[2], 49152 + ((0 * 2 + (ct)) * 2 + 1) * 1024); LDF(F[3], 49152 + ((1 * 2 + (ct)) * 2 + 1) * 1024); } while (0)
#define MM_AT(F, ct) do { o0 = MFMA32(F[0], vb[ct][0], o0); o1 = MFMA32(F[1], vb[ct][0], o1); o0 = MFMA32(F[2], vb[ct][1], o0); o1 = MFMA32(F[3], vb[ct][1], o1); } while (0)
#define LD_KD(F, ct, s) do { _Pragma("unroll") for (int q = 0; q < 4; ++q) LDF(F[q], 32768 + ((q * 2 + (ct)) * 2 + (s)) * 1024); } while (0)
#define MM_KD(F, ct, s) do { _Pragma("unroll") for (int q = 0; q < 4; ++q) S[q] = MFMA32(F[q], vb[ct][s], S[q]); } while (0)
            bf16x8 FA[4], FB[4];
            LD_WQ(FA, 0, 0); PIN_SCHED();
            LD_WQ(FB, 0, 1); PIN_SCHED(); MM_WQ(FA, 0, 0); PIN_SCHED();
            LD_WQ(FA, 1, 0); PIN_SCHED(); MM_WQ(FB, 0, 1); PIN_SCHED();
            LD_WQ(FB, 1, 1); PIN_SCHED(); MM_WQ(FA, 1, 0); PIN_SCHED();
            LD_WQ(FA, 2, 0); PIN_SCHED(); MM_WQ(FB, 1, 1); PIN_SCHED();
            LD_WQ(FB, 2, 1); PIN_SCHED(); MM_WQ(FA, 2, 0); PIN_SCHED();
            LD_WQ(FA, 3, 0); PIN_SCHED(); MM_WQ(FB, 2, 1); PIN_SCHED();
            LD_WQ(FB, 3, 1); PIN_SCHED(); MM_WQ(FA, 3, 0); PIN_SCHED();
            LD_AT(FA, 0); PIN_SCHED(); MM_WQ(FB, 3, 1); PIN_SCHED();
            bf16x8 vb[2][2];
            vb[0][0] = pack_acc(v0, 0); vb[0][1] = pack_acc(v0, 1); vb[1][0] = pack_acc(v1, 0); vb[1][1] = pack_acc(v1, 1);
            LD_AT(FB, 1); PIN_SCHED(); MM_AT(FA, 0); PIN_SCHED();
#pragma unroll
            for (int kt = 0; kt < 4; ++kt)
#pragma unroll
                for (int i = 0; i < 16; ++i) S[kt][i] *= egl;
            LD_KD(FA, 0, 0); PIN_SCHED(); MM_AT(FB, 1); PIN_SCHED();
            { bf16* op = Oraw + (size_t)(b * SEQ + n * 64 + 4 * (lane >> 5)) * 512 + h * 128 + vs * 32 + (lane & 31); asm volatile("" : "+v"(op));
#pragma unroll
              for (int reg = 0; reg < 16; ++reg) { const int cr = (reg & 3) + 8 * (reg >> 2); const unsigned pk = cvt_pk_bf16(o0[reg], o1[reg]); op[cr * 512] = (bf16)(pk & 0xffffu); op[(32 + cr) * 512] = (bf16)(pk >> 16); } }
            PIN_SCHED();
            LD_KD(FB, 0, 1); PIN_SCHED(); MM_KD(FA, 0, 0); PIN_SCHED();
            LD_KD(FA, 1, 0); PIN_SCHED(); MM_KD(FB, 0, 1); PIN_SCHED();
            LD_KD(FB, 1, 1); PIN_SCHED(); MM_KD(FA, 1, 0); PIN_SCHED();
            MM_KD(FB, 1, 1);
#undef MM_AT
#undef MM_KD
#undef LDF
#undef LD_WQ
#undef MM_WQ
#undef LD_AT
#undef LD_KD
            asm volatile("s_waitcnt lgkmcnt(0)" ::: "memory");
        }
        __builtin_amdgcn_s_barrier(); asm volatile("" ::: "memory");
    }
    asm volatile("s_waitcnt vmcnt(0)" ::: "memory");
#undef CH_MOVE
#undef CH_WARM
}
#if DN_NAIVE
__device__ __forceinline__ void naive_dn(const bf16* QKV, const float* GB, float* Oraw, int unit, int lane) {
    const int bh = unit >> 1, dv = (unit & 1) * 64 + lane, b = bh >> 2, h = bh & 3;
    float S[128];
#pragma unroll
    for (int i = 0; i < 128; ++i) S[i] = 0.f;
    for (int t = 0; t < SEQ; ++t) { const size_t m = (size_t)b * SEQ + t;
        const float al = __expf(GB[m * 8 + h]), be = GB[m * 8 + 4 + h];
        const bf16* qp = QKV + m * 1536 + h * 128; const bf16* kp = qp + 512; const float v = bf2f(qp[1024 + dv]);
        float r = 0.f;
#pragma unroll
        for (int i = 0; i < 128; ++i) { S[i] *= al; r += bf2f(kp[i]) * S[i]; if ((i & 15) == 15) asm volatile("" : "+v"(r) :: "memory"); }
        const float d = be * (v - r); float o = 0.f;
#pragma unroll
        for (int i = 0; i < 128; ++i) { S[i] += bf2f(kp[i]) * d; o += bf2f(qp[i]) * S[i]; if ((i & 15) == 15) asm volatile("" : "+v"(o) :: "memory"); }
        Oraw[m * 512 + h * 128 + dv] = o; }
}
#endif
template <bool OB16>
__device__ __forceinline__ void opost_rows(const void* Oraw_, const bf16* P, const float* gdn, bf16* YC, int gw, int NGW, int lane) {
    const float* Oraw = (const float*)Oraw_; const bf16* Ob = (const bf16*)Oraw_;
    float gd[8];
#pragma unroll
    for (int e = 0; e < 8; ++e) gd[e] = gdn[(8 * lane + e) & 127];
    for (int blk = gw; blk < M / 16; blk += NGW) { const int m0 = blk * 16;
#pragma unroll 1
        for (int i = 0; i < 16; i += 8) {
            f32x4 oa[8], ob[8]; v4u zz[8];
#pragma unroll
            for (int t = 0; t < 8; ++t) { const int m = m0 + i + t;
                if (OB16) { float f[8]; unpack8(*(const v4u*)(Ob + (size_t)m * 512 + 8 * lane), f); oa[t] = (f32x4){f[0], f[1], f[2], f[3]}; ob[t] = (f32x4){f[4], f[5], f[6], f[7]}; }
                else { const f32x4* op = (const f32x4*)(Oraw + (size_t)m * 512 + 8 * lane); oa[t] = op[0]; ob[t] = op[1]; }
                zz[t] = *(const v4u*)(P + (size_t)m * NP + 3072 + 8 * lane); }
#pragma unroll
            for (int t = 0; t < 8; ++t) { const int m = m0 + i + t; float z[8]; unpack8(zz[t], z);
                float o[8] = {oa[t].x, oa[t].y, oa[t].z, oa[t].w, ob[t].x, ob[t].y, ob[t].z, ob[t].w}; float ss = 0.f;
#pragma unroll
                for (int e = 0; e < 8; ++e) ss += o[e] * o[e];
                ss += __shfl_xor(ss, 1); ss += __shfl_xor(ss, 2); ss += __shfl_xor(ss, 4); ss += __shfl_xor(ss, 8);
                const float r = 1.0f / sqrtf(ss * (1.0f / 128.0f) + EPS);
#pragma unroll
                for (int e = 0; e < 8; ++e) o[e] = o[e] * r * gd[e] * silu_f(z[e]);
                *(v4u*)(YC + (size_t)m * D + 512 + 8 * lane) = pack8(o); } } }
}

typedef __attribute__((address_space(1))) unsigned gu32;
#define XB_TMO      128
#define XB_XCNT(j)  (256  + 64 * (j))
#define XB_XSUB(j)  (1280 + 64 * (j))
#define XB_XGEN(j)  (2304 + 64 * (j))
#define XB_TOP      3328
#define XB_TOPGEN   3392
#define XCD_BAR_WORDS 3456
#define XB_SPIN_CAP (1u << 18)

__device__ __forceinline__ unsigned xb_ld(unsigned* p)              { return __hip_atomic_load(p, __ATOMIC_RELAXED, __HIP_MEMORY_SCOPE_AGENT); }
__device__ __forceinline__ unsigned xb_add(unsigned* p, unsigned v) { return __hip_atomic_fetch_add(p, v, __ATOMIC_RELAXED, __HIP_MEMORY_SCOPE_AGENT); }
__device__ __forceinline__ unsigned xb_xcc_id() { return (unsigned)__builtin_amdgcn_s_getreg((3 << 11) | 20) & 0xFu; }
#define XB_SPIN(cond, bar) do { unsigned _sp = 0; while (cond) { __builtin_amdgcn_s_sleep(1); \
    if ((++_sp & 255u) == 0u) { if (xb_ld(&(bar)[XB_TMO])) break; if (_sp > XB_SPIN_CAP) { atomicAdd(&(bar)[XB_TMO], 1u); break; } } } } while (0)

struct XcdBarrier {
    unsigned* bar; unsigned x;
    volatile LAS unsigned* st;
};

__device__ __forceinline__ XcdBarrier xcd_barrier_post(unsigned* bar, volatile LAS unsigned* st) {
    XcdBarrier b; b.bar = bar; b.x = xb_xcc_id(); b.st = st;
    if (threadIdx.x == 0) (void)xb_add(&bar[XB_XCNT(b.x)], 1u);
    return b;
}
__device__ __forceinline__ void xcd_barrier_complete(unsigned* bar, unsigned x, unsigned& nloc, unsigned& nx) {
    const unsigned G = gridDim.x * gridDim.y * gridDim.z;
    unsigned sum, cnt, mine, sp = 0u;
    for (;;) {
        sum = 0u; cnt = 0u; mine = 0u;
#pragma unroll
        for (unsigned j = 0; j < 16; ++j) { const unsigned c = xb_ld(&bar[XB_XCNT(j)]); sum += c; cnt += (c > 0u) ? 1u : 0u; mine = (j == x) ? c : mine; }
        if (sum == G) break;
        __builtin_amdgcn_s_sleep(1);
        if ((++sp & 255u) == 0u) { if (xb_ld(&bar[XB_TMO])) break; if (sp > XB_SPIN_CAP) { atomicAdd(&bar[XB_TMO], 1u); break; } }
    }
    nloc = mine > 0u ? mine : 1u; nx = cnt > 0u ? cnt : 1u;
}

__device__ __forceinline__ void xcd_barrier(const XcdBarrier& b) {
    asm volatile("s_waitcnt vmcnt(0)" ::: "memory");
    __syncthreads();
    if (threadIdx.x == 0) {
        unsigned* bar = b.bar;
        __builtin_amdgcn_s_waitcnt(0);
        unsigned nloc = b.st[0], nx = b.st[1];
        if (nloc == 0u) { xcd_barrier_complete(bar, b.x, nloc, nx); b.st[0] = nloc; b.st[1] = nx; }
        const unsigned old = xb_add(&bar[XB_XSUB(b.x)], 1u);
        const unsigned gen = old / nloc;
        if (old + 1u == (gen + 1u) * nloc) {
            __builtin_amdgcn_fence(__ATOMIC_RELEASE, "agent");
            asm volatile("s_waitcnt vmcnt(0)" ::: "memory");
            const unsigned og = xb_add(&bar[XB_TOP], 1u);
            const unsigned tg = og / nx;
            if (og + 1u == (tg + 1u) * nx) xb_add(&bar[XB_TOPGEN], 1u);
            else XB_SPIN(xb_ld(&bar[XB_TOPGEN]) == tg, bar);
            __builtin_amdgcn_fence(__ATOMIC_ACQUIRE, "agent");
            xb_add(&bar[XB_XGEN(b.x)], 1u);
            asm volatile("s_waitcnt vmcnt(0)" ::: "memory");
        } else {
            XB_SPIN(xb_ld(&bar[XB_XGEN(b.x)]) == gen, bar);
            __builtin_amdgcn_fence(__ATOMIC_ACQUIRE, "agent");
            asm volatile("s_waitcnt vmcnt(0)" ::: "memory");
        }
    }
    __syncthreads();
}

__global__ void __launch_bounds__(NWAVES * 64, 2) fwd(Args args) {
    extern __shared__ __attribute__((aligned(16))) unsigned char lds_raw[];
    LAS unsigned char* lds = (LAS unsigned char*)lds_raw;
    int tid = threadIdx.x, lane = tid & 63, wave = __builtin_amdgcn_readfirstlane(tid >> 6);
    const int G = gridDim.x; const int bx = blockIdx.x; const int vcu = (G % 8 == 0) ? (bx % 8) * (G / 8) + bx / 8 : bx;
    int gw = vcu * NWAVES + wave; const int NGW = G * NWAVES;
#define LAUNDER() do { int tv_ = threadIdx.x; asm volatile("" : "+v"(tv_)); tid = tv_; lane = tid & 63; wave = __builtin_amdgcn_readfirstlane(tid >> 6); gw = vcu * NWAVES + wave; } while (0)
    unsigned char* ws = args.ws;
    float* MOD = (float*)(ws + WS_MOD); float* GB = (float*)(ws + WS_GB); float* EGL = (float*)(ws + WS_EGL);
    bf16* WinT = (bf16*)(ws + WS_WIN); bf16* WoT = (bf16*)(ws + WS_WO); bf16* WguT = (bf16*)(ws + WS_WGU); bf16* WdT = (bf16*)(ws + WS_WD);
    bf16* H = (bf16*)(ws + WS_H); unsigned char* CH = ws + WS_CH; bf16* P = (bf16*)(ws + WS_P); bf16* ACT = (bf16*)(ws + WS_P); bf16* YC = (bf16*)(ws + WS_YC);
    bf16* QKV = (bf16*)args.out; bf16* Oraw = (bf16*)((unsigned char*)args.out + 96 * MiB); float* OUT = args.out;
    const int lo = args.ph_lo, hi = args.ph_hi;
    volatile LAS unsigned* MISC = (volatile LAS unsigned*)(lds + LDS_BYTES - 64);
    if (tid < 16) MISC[tid] = 0u;
    __syncthreads();
    XcdBarrier bar = xcd_barrier_post((unsigned*)ws, MISC);
    if (lo < 0) cg::this_grid().sync();
#ifndef PH_MASK
#define PH_MASK 0xFFF
#endif
#define IN(k) (((PH_MASK >> (k)) & 1) && lo <= (k) && (k) < hi)
#if MK_N_LAUNCHES == 1
#define SEAM(k) do { if (IN(k) && IN((k) + 1) && (k) != 5) xcd_barrier(bar); } while (0)
#else
#define SEAM(k) do { } while (0)
#endif
#ifndef REP_MASK
#define REP_MASK 0
#endif
#define BEGIN_REP(k) for (int rep_ = 0; rep_ <= ((REP_MASK >> (k)) & 1); ++rep_) { if (rep_) xcd_barrier(bar); LAUNDER();
#define END_REP }
    BEGIN_REP(0)
    if (IN(0)) {
        LAS float* scr = (LAS float*)(lds + wave * 16384);
        constexpr int I_IN = 16 * 112, I_O = 16 * 32, I_GU = 16 * 176, I_DN = 44 * 32, NITEMS = I_IN + I_O + I_GU + I_DN;
        for (int it = gw; it < NITEMS; it += NGW) { int r = it;
            if (r < I_IN) { p0_transpose_item<0>(args.in[I_WIN], D, PIN, 112, WinT, scr, r, lane); continue; } r -= I_IN;
            if (r < I_O) { p0_transpose_item<0>(args.in[I_WOUT], D, D, 32, WoT, scr, r, lane); continue; } r -= I_O;
            if (r < I_GU) { p0_transpose_item<1>(args.in[I_WGU], D, 2 * FF, 176, WguT, scr, r, lane); continue; } r -= I_GU;
            p0_transpose_item<0>(args.in[I_WDN], FF, D, 32, WdT, scr, r, lane); }
        __syncthreads();
        { LAS float* SC = (LAS float*)lds; const float* cin = args.in[I_C];
          for (int idx = tid; idx < 4096; idx += NWAVES * 64) { const int b = idx >> 10, k = idx & 1023; const float cv = cin[idx]; SC[k * 4 + b] = cv / (1.0f + __expf(-cv)); }
          __syncthreads();
          for (int it = bx; it < 256; it += G) p0_mod_item(args, MOD, SC, (LAS float*)(lds + 16384), it, tid); }
    }
    END_REP
    SEAM(0);
    BEGIN_REP(1)
    if (IN(1)) { LAS float* TT = (LAS float*)lds; const float* wi = args.in[I_WIN];
        for (int idx = tid; idx < 8192; idx += NWAVES * 64) { const int k = idx >> 3, e = idx & 7; TT[e * 1024 + k] = wi[(size_t)k * PIN + NP + e]; }
        __syncthreads();
        adaln_rows<0>(args.in[I_X], args.in[I_GMIX], MOD + 0, MOD + 1024, 6144, H, nullptr, TT, args.in[I_ALOG], args.in[I_DTB], GB, gw, NGW, lane);
        __syncthreads(); }
    END_REP
    SEAM(1);
    BEGIN_REP(2)
    if (IN(2)) { pg8::Gemm g{H, WinT, M, NP, D}; pg8::StaticOrder S; S.init(M, NP, G, bx); pg8::EpiBf16 E{P, NP};
        pg8::gemm_phase<pg8::EpiBf16, pg8::StaticOrder, true, true>(lds, g, S, E); }
    END_REP
    SEAM(2);
    BEGIN_REP(3)
    if (IN(3)) conv_pass(P, args.in[I_CWM], args.in[I_CWQ], args.in[I_GCO], YC, QKV, gw, NGW, lane);
    END_REP
    SEAM(3);
#if DN_NAIVE
    SEAM(4);
    if (IN(5)) { if (bx < 32 && wave == 0) naive_dn(QKV, GB, (float*)(ws + WS_CH), bx, lane); }
    SEAM(5);
    if (IN(6)) opost_rows<false>((const float*)(ws + WS_CH), P, args.in[I_GDN], YC, gw, NGW, lane);
#else
    BEGIN_REP(4)
    if (IN(4)) { unsigned* FLG = (unsigned*)(ws + 16384);
        if (bx < NBH) chain_phase(lds, CH, FLG, Oraw, bx, tid); else prep_phase(lds, QKV, GB, EGL, CH, FLG, bx - NBH, G - NBH, tid); }
    END_REP
    SEAM(4);
    BEGIN_REP(6)
    if (IN(6)) opost_rows<true>(Oraw, P, args.in[I_GDN], YC, gw, NGW, lane);
    END_REP
#endif
    SEAM(6);
    BEGIN_REP(7)
    if (IN(7)) { pg8::Gemm g{YC, WoT, M, D, D}; pg8::StaticOrder S; S.init(M, D, G, bx); pg8::EpiResGate E{args.in[I_X], OUT, MOD + 2048, 6144};
        pg8::gemm_phase<pg8::EpiResGate, pg8::StaticOrder, true, true>(lds, g, S, E); }
    END_REP
    SEAM(7);
    BEGIN_REP(8)
    if (IN(8)) adaln_rows<1>(OUT, args.in[I_GFFN], MOD + 3072, MOD + 4096, 6144, H, nullptr, nullptr, nullptr, nullptr, nullptr, gw, NGW, lane);
    END_REP
    SEAM(8);
    BEGIN_REP(9)
    if (IN(9)) { pg8::Gemm g{H, WguT, M, 2 * FF, D}; pg8::StaticOrder S; S.init(M, 2 * FF, G, bx); pg8::EpiSwiglu E{ACT, FF};
        pg8::gemm_phase<pg8::EpiSwiglu, pg8::StaticOrder, true, true>(lds, g, S, E); }
    END_REP
    SEAM(9);
    BEGIN_REP(10)
    if (IN(10)) { pg8::Gemm g{ACT, WdT, M, D, FF}; pg8::StaticOrder S; S.init(M, D, G, bx); pg8::EpiResGate E{OUT, OUT, MOD + 5120, 6144};
        pg8::gemm_phase<pg8::EpiResGate, pg8::StaticOrder, true, true>(lds, g, S, E); }
    END_REP
    SEAM(10);
    LAUNDER();
    if (IN(11)) adaln_rows<2>(OUT, args.in[I_GFIN], MOD + 4 * 6144, MOD + 4 * 6144 + 1024, 2048, nullptr, OUT, nullptr, nullptr, nullptr, nullptr, gw, NGW, lane);
#undef IN
#undef SEAM
}

extern "C" void kernel_launch(void* const* d_in, const int* in_sizes, int n_in, void* d_out, int out_size, void* d_ws, size_t ws_size, hipStream_t stream) {
    static int grid = 0;
    if (grid == 0) {
        if (n_in != 19 || out_size != M * D || ws_size < WS_END) { fprintf(stderr, "kernel_launch: unexpected shapes (n_in %d, out %d, ws %zu)\n", n_in, out_size, ws_size); grid = -1; return; }
        int dev = 0, cus = 0;
        if (hipGetDevice(&dev) != hipSuccess || hipDeviceGetAttribute(&cus, hipDeviceAttributeMultiprocessorCount, dev) != hipSuccess) { grid = -1; return; }
        if (hipFuncSetAttribute((const void*)fwd, hipFuncAttributeMaxDynamicSharedMemorySize, LDS_BYTES) != hipSuccess) { fprintf(stderr, "kernel_launch: hipFuncSetAttribute failed\n"); grid = -1; return; }
        int per_cu = 0;
        if (hipOccupancyMaxActiveBlocksPerMultiprocessor(&per_cu, (const void*)fwd, NWAVES * 64, LDS_BYTES) != hipSuccess || per_cu < 1) { fprintf(stderr, "kernel_launch: occupancy query says %d blocks per CU\n", per_cu); }
        (void)hipGetLastError();
        grid = cus;
    }
    if (grid < 0) return;
    Args a{};
    for (int i = 0; i < 19; ++i) a.in[i] = (const float*)d_in[i];
    a.out = (float*)d_out; a.ws = (unsigned char*)d_ws;
#if MK_N_LAUNCHES == 1
    if (hipMemsetAsync(d_ws, 0, 32768, stream) != hipSuccess) { fprintf(stderr, "kernel_launch: memset of the barrier words failed\n"); return; }
    a.ph_lo = 0; a.ph_hi = PH_END;
    void* kargs[] = {&a};
    hipError_t e = hipLaunchCooperativeKernel((const void*)fwd, dim3(grid), dim3(NWAVES * 64), kargs, LDS_BYTES, stream);
    if (e != hipSuccess) fprintf(stderr, "kernel_launch: cooperative launch failed: %s (grid %d)\n", hipGetErrorString(e), grid);
#else
    for (int ph = 0; ph < PH_END; ++ph) { a.ph_lo = ph; a.ph_hi = ph + 1; hipLaunchKernelGGL(fwd, dim3(grid), dim3(NWAVES * 64), LDS_BYTES, stream, a); }
#endif
}
```

```cpp
#include <hip/hip_runtime.h>
#include <hip/hip_cooperative_groups.h>
#include <cstdio>
#include <cstdint>
namespace cg = cooperative_groups;
#ifndef MK_N_LAUNCHES
#define MK_N_LAUNCHES 1
#endif
#ifndef DN_NAIVE
#define DN_NAIVE 0
#endif
namespace pg8 {
#define PG8_LAS __attribute__((address_space(3)))
typedef unsigned short bf16_t;
typedef short bf16x8 __attribute__((ext_vector_type(8)));
typedef float f32x4 __attribute__((ext_vector_type(4)));
typedef unsigned u32x4 __attribute__((ext_vector_type(4)));
constexpr int BM = 256, BK = 64, HALF = 128, HTB = HALF * BK * 2  , STAGE_BYTES = 8 * HTB, NXCD = 8, WGM = 8;

__host__ __device__ __forceinline__ int lds_byte(int r, int c) { const int st = (r >> 4) * 2 + (c >> 5), rr = r & 15, cc = c & 31, ob = rr * 64 + cc * 2; return st * 1024 + (ob ^ (((ob >> 9) & 1) << 5)); }
__host__ __device__ __forceinline__ void stage_rc(int b, int& R, int& C) { const int st = b / 1024, sb = b % 1024, swz = sb ^ (((sb >> 9) & 1) << 5); R = (st >> 1) * 16 + swz / 64; C = (st & 1) * 32 + (swz % 64) / 2; }
__host__ __device__ __forceinline__ int perm32(int rho) { const int n = rho >> 4, i = rho & 15; return 8 * (i >> 2) + 4 * n + (i & 3); }

struct Unit { int pm, pn; };
struct Gemm { const bf16_t* A; const bf16_t* Bt; int M, N, K; };

struct StaticOrder {
    int nM, nN, nwg, G, c;
    __host__ __device__ void init(int M, int N, int G_, int c_) { nM = M / BM; nN = N / BM; nwg = nM * nN; G = G_; c = c_; }
    __host__ __device__ bool next(int i, Unit& u) const {
        const long L = (long)i * G + c; if (L >= nwg) return false;
        int wgid = (int)L; { const int q = nwg / NXCD, r = nwg % NXCD, xcd = wgid % NXCD, off = wgid / NXCD; wgid = (xcd < r ? xcd * (q + 1) : r * (q + 1) + (xcd - r) * q) + off; }
        const int nig = WGM * nN, gid = wgid / nig, fm = gid * WGM, gsz = (nM - fm) < WGM ? (nM - fm) : WGM;
        u.pm = fm + ((wgid % nig) % gsz); u.pn = (wgid % nig) / gsz; return true;
    }
    __device__ __forceinline__ void a_ready(const Unit&) const {}
    __device__ __forceinline__ void done(const Unit&) const {}
};

typedef float f32x2 __attribute__((ext_vector_type(2)));
typedef __bf16 bf16x2v __attribute__((ext_vector_type(2)));
__device__ __forceinline__ unsigned cvt_pk_bf16(float lo, float hi) { f32x2 v = {lo, hi}; bf16x2v r = __builtin_convertvector(v, bf16x2v); return __builtin_bit_cast(unsigned, r); }
__device__ __forceinline__ float silu_f(float x) { return x * __builtin_amdgcn_rcpf(1.0f + __builtin_amdgcn_exp2f(-1.4426950408889634f * x)); }

struct EpiBf16 {
    static constexpr bool PERM = true, AFTER_DRAIN = false;
    bf16_t* O; int ldc;
    __device__ __forceinline__ void operator()(const f32x4 (&acc)[2][2][4][2], const Unit& u, int wr, int wc, int fr, int fq) const {
        const int row0 = u.pm * BM + wr * 64 + fr; const int col0 = u.pn * BM + wc * 32 + 8 * fq;
#pragma unroll
        for (int ai = 0; ai < 2; ++ai)
#pragma unroll
            for (int m = 0; m < 4; ++m) { bf16_t* rowp = O + (size_t)(row0 + ai * HALF + m * 16) * ldc + col0;
#pragma unroll
                for (int bj = 0; bj < 2; ++bj) { const f32x4 v0 = acc[ai][bj][m][0], v1 = acc[ai][bj][m][1];
                    u32x4 w; w.x = cvt_pk_bf16(v0[0], v0[1]); w.y = cvt_pk_bf16(v0[2], v0[3]); w.z = cvt_pk_bf16(v1[0], v1[1]); w.w = cvt_pk_bf16(v1[2], v1[3]);
                    *(u32x4*)(rowp + bj * HALF) = w; } }
    }
};
struct EpiSwiglu {
    static constexpr bool PERM = true, AFTER_DRAIN = false;
    bf16_t* O; int ldc;
    __device__ __forceinline__ void operator()(const f32x4 (&acc)[2][2][4][2], const Unit& u, int wr, int wc, int fr, int fq) const {
        const int row0 = u.pm * BM + wr * 64 + fr; const int col0 = u.pn * HALF + wc * 32 + 8 * fq;
#pragma unroll
        for (int ai = 0; ai < 2; ++ai)
#pragma unroll
            for (int m = 0; m < 4; ++m) { bf16_t* rowp = O + (size_t)(row0 + ai * HALF + m * 16) * ldc + col0;
                const f32x4 g0 = acc[ai][0][m][0], g1 = acc[ai][0][m][1], u0 = acc[ai][1][m][0], u1 = acc[ai][1][m][1];
                u32x4 w; w.x = cvt_pk_bf16(silu_f(g0[0]) * u0[0], silu_f(g0[1]) * u0[1]); w.y = cvt_pk_bf16(silu_f(g0[2]) * u0[2], silu_f(g0[3]) * u0[3]);
                w.z = cvt_pk_bf16(silu_f(g1[0]) * u1[0], silu_f(g1[1]) * u1[1]); w.w = cvt_pk_bf16(silu_f(g1[2]) * u1[2], silu_f(g1[3]) * u1[3]);
                *(u32x4*)rowp = w; }
    }
};
struct EpiResGate {
    static constexpr bool PERM = false, AFTER_DRAIN = false;
    const float* base; float* out; const float* gate;
    int gstride;
    __device__ __forceinline__ void operator()(const f32x4 (&acc)[2][2][4][2], const Unit& u, int wr, int wc, int fr, int fq) const {
        const int b = u.pm >> 5;
        const int col0 = u.pn * BM + wc * 32 + 4 * fq; const float* gp = gate + (size_t)b * gstride + col0;
        f32x4 gv[2][2];
#pragma unroll
        for (int bj = 0; bj < 2; ++bj)
#pragma unroll
            for (int n = 0; n < 2; ++n) gv[bj][n] = *(const f32x4*)(gp + bj * HALF + n * 16);
#pragma unroll
        for (int ai = 0; ai < 2; ++ai)
#pragma unroll
            for (int m = 0; m < 4; ++m) { const size_t off = (size_t)(u.pm * BM + ai * HALF + wr * 64 + m * 16 + fr) * 1024 + col0;
#pragma unroll
                for (int bj = 0; bj < 2; ++bj)
#pragma unroll
                    for (int n = 0; n < 2; ++n) { const f32x4 bs = *(const f32x4*)(base + off + bj * HALF + n * 16);
                        *(f32x4*)(out + off + bj * HALF + n * 16) = bs + gv[bj][n] * acc[ai][bj][m][n]; } }
    }
};

template <class Epi, class Sched, bool ALIGN_EPI = false, bool SP2 = false>
__device__ __forceinline__ void gemm_phase(PG8_LAS unsigned char* lds, const Gemm g, const Sched& S, const Epi& E) {
    const int tid = threadIdx.x, wid = __builtin_amdgcn_readfirstlane(tid >> 6), lane = tid & 63, wr = wid >> 2, wc = wid & 3, fr = lane & 15, fq = lane >> 4;
    const int K = g.K, nt = K / BK;
    unsigned voffA[2], voffB[2];
#pragma unroll
    for (int i = 0; i < 2; ++i) { int R, C; stage_rc(tid * 16 + i * 8192, R, C); const int Rb = Epi::PERM ? ((R & ~31) + perm32(R & 31)) : R;
        voffA[i] = (unsigned)(R * K + C) * 2u; voffB[i] = (unsigned)(Rb * K + C) * 2u; }
    const size_t kstep = (size_t)(BK * 2);
    const size_t hstep = (size_t)HALF * K * 2;
    const size_t tstep = 2 * hstep;
    const unsigned ldsw = (unsigned)wid * 1024u;
    const int aoff = lds_byte(wr * 64 + fr, fq * 8), boff = lds_byte(wc * 32 + fr, fq * 8);
#define PG8_SA(b, h) (((b) * 2 + (h)) * HTB)
#define PG8_SB(b, h) ((4 + (b) * 2 + (h)) * HTB)
#define PG8_STAGE(bufoff, gbase, voff) do { _Pragma("unroll") for (int _i = 0; _i < 2; ++_i) \
        __builtin_amdgcn_global_load_lds((const unsigned*)((const char*)(gbase) + (voff)[_i]), (PG8_LAS unsigned*)(lds + (bufoff) + ldsw + _i * 8192), 16, 0, 0); } while (0)
#define PG8_LDA(dst, b, h) do { _Pragma("unroll") for (int m = 0; m < 4; ++m) _Pragma("unroll") for (int k = 0; k < 2; ++k) dst[m][k] = *(const PG8_LAS bf16x8*)(lds + PG8_SA(b, h) + aoff + m * 2048 + k * 1024); } while (0)
#define PG8_LDB(dst, b, h) do { _Pragma("unroll") for (int n = 0; n < 2; ++n) _Pragma("unroll") for (int k = 0; k < 2; ++k) dst[n][k] = *(const PG8_LAS bf16x8*)(lds + PG8_SB(b, h) + boff + n * 2048 + k * 1024); } while (0)
#define PG8_MMA(ai, bj, At, Bt) do { __builtin_amdgcn_s_setprio(1); _Pragma("unroll") for (int m = 0; m < 4; ++m) _Pragma("unroll") for (int n = 0; n < 2; ++n) _Pragma("unroll") for (int k = 0; k < 2; ++k) \
        acc[ai][bj][m][n] = __builtin_amdgcn_mfma_f32_16x16x32_bf16(Bt[n][k], At[m][k], acc[ai][bj][m][n], 0, 0, 0); __builtin_amdgcn_s_setprio(0); } while (0)
#define PG8_WAIT_V(n) asm volatile("s_waitcnt vmcnt(" #n ")" ::: "memory")
#define PG8_WAIT_L(n) asm volatile("s_waitcnt lgkmcnt(" #n ")" ::: "memory")
#define PG8_BAR __builtin_amdgcn_s_barrier()
#define PG8_SCHED __builtin_amdgcn_sched_barrier(0)
    Unit cur, nxt; int ui = 0;
    if (!S.next(0, cur)) return;
    f32x4 acc[2][2][4][2];
#pragma unroll
    for (int a = 0; a < 2; ++a)
#pragma unroll
        for (int b = 0; b < 2; ++b)
#pragma unroll
            for (int m = 0; m < 4; ++m)
#pragma unroll
                for (int n = 0; n < 2; ++n) acc[a][b][m][n] = (f32x4){0.f, 0.f, 0.f, 0.f};
    bf16x8 At[4][2], B0[2][2], B1[2][2];
    const char* cA = (const char*)g.A + (size_t)cur.pm * tstep; const char* cB = (const char*)g.Bt + (size_t)cur.pn * tstep;
    S.a_ready(cur);
    if constexpr (SP2) {
        PG8_STAGE(PG8_SB(0, 0), cB, voffB); PG8_STAGE(PG8_SB(0, 1), cB + hstep, voffB); PG8_STAGE(PG8_SA(0, 0), cA, voffA); PG8_STAGE(PG8_SA(0, 1), cA + hstep, voffA);
        if (wr == 1) PG8_BAR;
        PG8_WAIT_V(2); PG8_BAR;
        PG8_STAGE(PG8_SB(1, 0), cB + kstep, voffB); PG8_STAGE(PG8_SA(1, 0), cA + kstep, voffA); PG8_STAGE(PG8_SB(1, 1), cB + hstep + kstep, voffB);
        PG8_WAIT_V(6); PG8_BAR;
    } else {
        PG8_STAGE(PG8_SB(0, 0), cB, voffB); PG8_STAGE(PG8_SA(0, 0), cA, voffA); PG8_STAGE(PG8_SB(0, 1), cB + hstep, voffB); PG8_STAGE(PG8_SA(0, 1), cA + hstep, voffA);
        if (wr == 1) PG8_BAR;
        PG8_WAIT_V(4); PG8_BAR;
        PG8_STAGE(PG8_SB(1, 0), cB + kstep, voffB); PG8_STAGE(PG8_SA(1, 0), cA + kstep, voffA); PG8_STAGE(PG8_SB(1, 1), cB + hstep + kstep, voffB);
        PG8_WAIT_V(6); PG8_BAR;
    }
    for (;;) {
        const bool has_next = S.next(ui + 1, nxt);
        const char* nA = has_next ? (const char*)g.A + (size_t)nxt.pm * tstep : cA; const char* nB = has_next ? (const char*)g.Bt + (size_t)nxt.pn * tstep : cB;
        for (int t = 0; t < nt; t += 2) {
            const bool last = (t == nt - 2);
            const char* a1 = cA + (size_t)(t + 1) * kstep;
            const char* a2 = last ? nA : cA + (size_t)(t + 2) * kstep; const char* b2 = last ? nB : cB + (size_t)(t + 2) * kstep;
            const char* a3 = a2 + kstep; const char* b3 = b2 + kstep;
            if (last && has_next) S.a_ready(nxt);
            if constexpr (SP2) {
            PG8_LDB(B0, 0, 0); PG8_LDB(B1, 0, 1); PG8_SCHED; PG8_LDA(At, 0, 0); PG8_STAGE(PG8_SA(1, 1), a1 + hstep, voffA);
            PG8_WAIT_V(8); PG8_WAIT_L(0); PG8_BAR; PG8_MMA(0, 0, At, B0); PG8_MMA(0, 1, At, B1); PG8_BAR; PG8_SCHED;
            PG8_LDA(At, 0, 1); PG8_STAGE(PG8_SB(0, 0), b2, voffB); PG8_STAGE(PG8_SB(0, 1), b2 + hstep, voffB); PG8_STAGE(PG8_SA(0, 0), a2, voffA);
            PG8_WAIT_V(8); PG8_WAIT_L(0); PG8_BAR; PG8_MMA(1, 0, At, B0); PG8_MMA(1, 1, At, B1); PG8_BAR; PG8_SCHED;
            PG8_LDB(B0, 1, 0); PG8_LDB(B1, 1, 1); PG8_SCHED; PG8_LDA(At, 1, 0); PG8_STAGE(PG8_SA(0, 1), a2 + hstep, voffA);
            PG8_WAIT_V(8); PG8_WAIT_L(0); PG8_BAR; PG8_MMA(0, 0, At, B0); PG8_MMA(0, 1, At, B1); PG8_BAR; PG8_SCHED;
            PG8_LDA(At, 1, 1); PG8_STAGE(PG8_SB(1, 0), b3, voffB); PG8_STAGE(PG8_SB(1, 1), b3 + hstep, voffB); PG8_STAGE(PG8_SA(1, 0), a3, voffA);
            PG8_WAIT_V(8); PG8_WAIT_L(0); PG8_BAR; PG8_MMA(1, 0, At, B0); PG8_MMA(1, 1, At, B1); PG8_BAR; PG8_SCHED;
            } else {
            PG8_LDB(B0, 0, 0); PG8_SCHED; PG8_LDA(At, 0, 0); PG8_STAGE(PG8_SA(1, 1), a1 + hstep, voffA);
            PG8_WAIT_L(8); PG8_BAR; PG8_WAIT_L(0); PG8_MMA(0, 0, At, B0); PG8_BAR; PG8_SCHED;
            PG8_LDB(B1, 0, 1); PG8_STAGE(PG8_SB(0, 0), b2, voffB);
            PG8_BAR; PG8_WAIT_L(0); PG8_MMA(0, 1, At, B1); PG8_BAR;
            PG8_LDA(At, 0, 1); PG8_STAGE(PG8_SA(0, 0), a2, voffA);
            PG8_BAR; PG8_WAIT_L(0); PG8_MMA(1, 0, At, B0); PG8_BAR; PG8_SCHED;
            PG8_STAGE(PG8_SB(0, 1), b2 + hstep, voffB);
            PG8_WAIT_V(6); PG8_BAR; PG8_MMA(1, 1, At, B1); PG8_BAR;
            PG8_LDB(B0, 1, 0); PG8_SCHED; PG8_LDA(At, 1, 0); PG8_STAGE(PG8_SA(0, 1), a2 + hstep, voffA);
            PG8_WAIT_L(8); PG8_BAR; PG8_WAIT_L(0); PG8_MMA(0, 0, At, B0); PG8_BAR; PG8_SCHED;
            PG8_LDB(B1, 1, 1); PG8_STAGE(PG8_SB(1, 0), b3, voffB);
            PG8_BAR; PG8_WAIT_L(0); PG8_MMA(0, 1, At, B1); PG8_BAR;
            PG8_LDA(At, 1, 1); PG8_STAGE(PG8_SA(1, 0), a3, voffA);
            PG8_BAR; PG8_WAIT_L(0); PG8_MMA(1, 0, At, B0); PG8_BAR; PG8_SCHED;
            PG8_STAGE(PG8_SB(1, 1), b3 + hstep, voffB);
            PG8_WAIT_V(6); PG8_BAR; PG8_MMA(1, 1, At, B1); PG8_BAR;
            }
        }
        if constexpr (ALIGN_EPI) { if (wr == 0) PG8_BAR; }
        if constexpr (!Epi::AFTER_DRAIN) { E(acc, cur, wr, wc, fr, fq); S.done(cur); }
        if (!has_next) break;
#pragma unroll
        for (int a = 0; a < 2; ++a)
#pragma unroll
            for (int b = 0; b < 2; ++b)
#pragma unroll
                for (int m = 0; m < 4; ++m)
#pragma unroll
                    for (int n = 0; n < 2; ++n) acc[a][b][m][n] = (f32x4){0.f, 0.f, 0.f, 0.f};
        cur = nxt; cA = nA; cB = nB; ++ui;
        if constexpr (ALIGN_EPI) { if (wr == 1) PG8_BAR; }
    }
    PG8_WAIT_V(0);
    if constexpr (!ALIGN_EPI) { if (wr == 0) PG8_BAR; }
    PG8_BAR;
    if constexpr (Epi::AFTER_DRAIN) { E.fused(acc, cur, wr, wc, fr, fq, lds, wid, lane); S.done(cur); }
#undef PG8_SA
#undef PG8_SB
#undef PG8_STAGE
#undef PG8_LDA
#undef PG8_LDB
#undef PG8_MMA
#undef PG8_WAIT_V
#undef PG8_WAIT_L
#undef PG8_BAR
#undef PG8_SCHED
}
}

constexpr int NWAVES = 8;
constexpr int BATCH = 4, SEQ = 8192, D = 1024, M = BATCH * SEQ;
constexpr int PIN = 3592, NP = 3584;
constexpr int FF = 2816, NCH = 128, NBH = 16;
constexpr int PH_END = 12;
constexpr float EPS = 1e-6f;
constexpr size_t MiB = 1u << 20;
constexpr size_t WS_MOD = 1 * MiB;
constexpr size_t WS_GB = 2 * MiB;
constexpr size_t WS_EGL = 3 * MiB;
constexpr size_t WS_WIN = 4 * MiB, WS_WO = 11 * MiB, WS_WGU = 13 * MiB, WS_WD = 24 * MiB;
constexpr size_t WS_H = 32 * MiB;
constexpr size_t WS_CH = 32 * MiB;
constexpr size_t WS_P = 208 * MiB;
constexpr size_t WS_YC = 432 * MiB;
constexpr size_t WS_END = 496 * MiB;
constexpr int REC = 74752;
constexpr int REC_A = 57344;
constexpr int LDS_BYTES = 155648;

#define LAS __attribute__((address_space(3)))
typedef unsigned short bf16;
typedef unsigned v4u __attribute__((ext_vector_type(4)));
typedef unsigned v2u __attribute__((ext_vector_type(2)));
typedef float f32x4 __attribute__((ext_vector_type(4)));
typedef float f32x16 __attribute__((ext_vector_type(16)));
typedef short bf16x8 __attribute__((ext_vector_type(8)));
#define LDS_WAIT() asm volatile("s_waitcnt lgkmcnt(0)" ::: "memory")
using pg8::cvt_pk_bf16; using pg8::silu_f;
__device__ __forceinline__ float bf2f(unsigned short u) { return __uint_as_float((unsigned)u << 16); }
__device__ __forceinline__ float bflo(unsigned w) { return __uint_as_float(w << 16); }
__device__ __forceinline__ float bfhi(unsigned w) { return __uint_as_float(w & 0xffff0000u); }
__device__ __forceinline__ float wave_sum(float v) {
#pragma unroll
    for (int o = 1; o < 64; o <<= 1) v += __shfl_xor(v, o);
    return v;
}
__device__ __forceinline__ void unpack8(v4u w, float (&f)[8]) { f[0] = bflo(w.x); f[1] = bfhi(w.x); f[2] = bflo(w.y); f[3] = bfhi(w.y); f[4] = bflo(w.z); f[5] = bfhi(w.z); f[6] = bflo(w.w); f[7] = bfhi(w.w); }
__device__ __forceinline__ v4u pack8(const float (&f)[8]) { v4u w; w.x = cvt_pk_bf16(f[0], f[1]); w.y = cvt_pk_bf16(f[2], f[3]); w.z = cvt_pk_bf16(f[4], f[5]); w.w = cvt_pk_bf16(f[6], f[7]); return w; }

struct Args { const float* in[19]; float* out; unsigned char* ws; int ph_lo, ph_hi; };
enum { I_X = 0, I_C, I_WADA, I_BADA, I_WADAF, I_BADAF, I_GMIX, I_GFFN, I_GFIN, I_WIN, I_CWM, I_CWQ, I_ALOG, I_DTB, I_GCO, I_GDN, I_WOUT, I_WGU, I_WDN };

template <int MODE>
__device__ __forceinline__ void p0_transpose_item(const float* W, int K, int ld, int nblk, bf16* WT, LAS float* scr, int item, int lane) {
    const int kb = item / nblk, nb = item % nblk, k0 = 64 * kb, n0 = 32 * nb;
    f32x4 ld4[8];
#pragma unroll
    for (int i = 0; i < 8; ++i) ld4[i] = *(const f32x4*)(W + (size_t)(k0 + 8 * i + (lane >> 3)) * ld + n0 + 4 * (lane & 7));
#pragma unroll
    for (int i = 0; i < 8; ++i) { LAS float* d = scr + (8 * i + (lane >> 3)) * 33 + 4 * (lane & 7); d[0] = ld4[i].x; d[1] = ld4[i].y; d[2] = ld4[i].z; d[3] = ld4[i].w; }
    LDS_WAIT(); asm volatile("" ::: "memory");
    int r0 = n0;
    if (MODE == 1) { r0 = n0 < FF ? 256 * (n0 / 128) + (n0 % 128) : 256 * ((n0 - FF) / 128) + 128 + ((n0 - FF) % 128); }
    const int c = lane & 7;
#pragma unroll
    for (int j = 0; j < 4; ++j) { const int n = (lane >> 3) + 8 * j; const LAS float* s = scr + (8 * c) * 33 + n;
        v4u o; o.x = cvt_pk_bf16(s[0 * 33], s[1 * 33]); o.y = cvt_pk_bf16(s[2 * 33], s[3 * 33]); o.z = cvt_pk_bf16(s[4 * 33], s[5 * 33]); o.w = cvt_pk_bf16(s[6 * 33], s[7 * 33]);
        *(v4u*)(WT + (size_t)(r0 + n) * K + k0 + 8 * c) = o; }
    LDS_WAIT(); asm volatile("" ::: "memory");
}
__device__ __forceinline__ void p0_mod_item(const Args& a, float* MOD, const LAS float* SC, LAS float* red, int item, int tid) {
    const int c4 = tid & 7, ks = tid >> 3, col0 = item * 32;
    const bool fin = col0 >= 6144; const float* W = fin ? a.in[I_WADAF] : a.in[I_WADA]; const int ld = fin ? 2048 : 6144, cb = (fin ? col0 - 6144 : col0);
    f32x4 w[16];
#pragma unroll
    for (int kk = 0; kk < 16; ++kk) w[kk] = *(const f32x4*)(W + (size_t)(16 * ks + kk) * ld + cb + 4 * c4);
    f32x4 acc[4];
#pragma unroll
    for (int b = 0; b < 4; ++b) acc[b] = (f32x4){0.f, 0.f, 0.f, 0.f};
#pragma unroll
    for (int kk = 0; kk < 16; ++kk) { const f32x4 s = *(const LAS f32x4*)(SC + (16 * ks + kk) * 4); acc[0] += s.x * w[kk]; acc[1] += s.y * w[kk]; acc[2] += s.z * w[kk]; acc[3] += s.w * w[kk]; }
#pragma unroll
    for (int b = 0; b < 4; ++b) *(LAS f32x4*)(red + (ks * 4 + b) * 32 + 4 * c4) = acc[b];
    __syncthreads();
    if (tid < 128) { const int b = tid >> 5, cl = tid & 31; float s = 0.f;
#pragma unroll 16
        for (int k = 0; k < 64; ++k) s += red[(k * 4 + b) * 32 + cl];
        const int c = cb + cl;
        s += fin ? a.in[I_BADAF][c] : a.in[I_BADA][c];
        if (fin) MOD[4 * 6144 + b * 2048 + c] = s; else MOD[b * 6144 + c] = s; }
    __syncthreads();
}

template <int MODE>
__device__ __forceinline__ void adaln_one(const f32x4 (&xin)[4], const f32x4 (&gs)[4], const f32x4 (&sh)[4], int m, bf16* Hout, float* Fout, const LAS float* TT, const float* a_log, const float* dt_bias, float* GB, int lane) {
    f32x4 v[4]; float ss = 0.f;
#pragma unroll
    for (int j = 0; j < 4; ++j) { v[j] = xin[j]; ss += (v[j].x * v[j].x + v[j].y * v[j].y) + (v[j].z * v[j].z + v[j].w * v[j].w); }
    const float rinv = 1.0f / sqrtf(wave_sum(ss) * (1.0f / D) + EPS);
#pragma unroll
    for (int j = 0; j < 4; ++j) v[j] = (v[j] * rinv) * gs[j] + sh[j];
    if (MODE == 2) { f32x4* o = (f32x4*)(Fout + (size_t)m * D) + lane;
#pragma unroll
        for (int j = 0; j < 4; ++j) o[64 * j] = v[j];
    } else { v2u* o = (v2u*)(Hout + (size_t)m * D) + lane;
#pragma unroll
        for (int j = 0; j < 4; ++j) { v2u w; w.x = cvt_pk_bf16(v[j].x, v[j].y); w.y = cvt_pk_bf16(v[j].z, v[j].w); o[64 * j] = w; } }
    if (MODE == 0) {
        float d[8];
#pragma unroll
        for (int e = 0; e < 8; ++e) { float s = 0.f;
#pragma unroll
            for (int j = 0; j < 4; ++j) { const f32x4 t = *(const LAS f32x4*)(TT + e * 1024 + 4 * (lane + 64 * j)); s += (v[j].x * t.x + v[j].y * t.y) + (v[j].z * t.z + v[j].w * t.w); }
            asm volatile("" : "+v"(s) :: "memory"); d[e] = s; }
        float k4[4], k2[2], k1;
        { const bool hi = (lane & 32) != 0;
#pragma unroll
          for (int i = 0; i < 4; ++i) { const float snd = hi ? d[i] : d[4 + i]; const float kp = hi ? d[4 + i] : d[i]; k4[i] = kp + __shfl_xor(snd, 32); } }
        { const bool hi = (lane & 16) != 0;
#pragma unroll
          for (int i = 0; i < 2; ++i) { const float snd = hi ? k4[i] : k4[2 + i]; const float kp = hi ? k4[2 + i] : k4[i]; k2[i] = kp + __shfl_xor(snd, 16); } }
        { const bool hi = (lane & 8) != 0; const float snd = hi ? k2[0] : k2[1]; const float kp = hi ? k2[1] : k2[0]; k1 = kp + __shfl_xor(snd, 8); }
        k1 += __shfl_xor(k1, 4); k1 += __shfl_xor(k1, 2); k1 += __shfl_xor(k1, 1);
        if ((lane & 7) == 0) { const int e = lane >> 3; float r;
            if (e < 4) { const float xx = k1 + dt_bias[e]; const float sp = fmaxf(xx, 0.f) + log1pf(__expf(-fabsf(xx))); r = -__expf(a_log[e]) * sp; }
            else r = 1.0f / (1.0f + __expf(-k1));
            GB[(size_t)m * 8 + e] = r; }
    }
}
template <int MODE>
__device__ __forceinline__ void adaln_rows(const float* X, const float* gain, const float* shiftp, const float* scalep, int mstride, bf16* Hout, float* Fout,
                                           const LAS float* TT, const float* a_log, const float* dt_bias, float* GB, int gw, int NGW, int lane) {
    for (int blk = gw; blk < M / 16; blk += NGW) {
        const int m0 = blk * 16, b = m0 >> 13;
        f32x4 gs[4], sh[4];
        { const f32x4* g4 = (const f32x4*)gain + lane; const f32x4* sh4 = (const f32x4*)(shiftp + (size_t)b * mstride) + lane; const f32x4* sc4 = (const f32x4*)(scalep + (size_t)b * mstride) + lane;
#pragma unroll
          for (int j = 0; j < 4; ++j) { gs[j] = g4[64 * j] * (1.0f + sc4[64 * j]); sh[j] = sh4[64 * j]; } }
        f32x4 c0[4], c1[4];
        { const f32x4* xr = (const f32x4*)(X + (size_t)m0 * D) + lane;
#pragma unroll
          for (int j = 0; j < 4; ++j) { c0[j] = xr[64 * j]; c1[j] = xr[256 + 64 * j]; } }
#pragma unroll 1
        for (int i = 0; i < 16; i += 2) {
            f32x4 n0[4], n1[4];
            { const int mn = (i + 2 < 16) ? m0 + i + 2 : m0; const f32x4* xr = (const f32x4*)(X + (size_t)mn * D) + lane;
#pragma unroll
              for (int j = 0; j < 4; ++j) { n0[j] = xr[64 * j]; n1[j] = xr[256 + 64 * j]; } }
            adaln_one<MODE>(c0, gs, sh, m0 + i, Hout, Fout, TT, a_log, dt_bias, GB, lane);
            adaln_one<MODE>(c1, gs, sh, m0 + i + 1, Hout, Fout, TT, a_log, dt_bias, GB, lane);
#pragma unroll
            for (int j = 0; j < 4; ++j) { c0[j] = n0[j]; c1[j] = n1[j]; }
        }
    }
}

__device__ __forceinline__ void conv_qkv(const bf16* P, const float* cwq, bf16* QKV, int X, int t0, bool first, int lane) {
    const int colp = 1536 + 512 * X + 8 * lane, colo = 512 * X + 8 * lane;
    v4u raw[19];
#pragma unroll
    for (int t = 0; t < 19; ++t) { raw[t] = (v4u){0u, 0u, 0u, 0u}; if (t >= 3 || !first) raw[t] = *(const v4u*)(P + (size_t)(t0 - 3 + t) * NP + colp); }
    float w0[8], w1[8], w2[8], w3[8], h3[8], h2[8], h1[8];
#pragma unroll
    for (int e = 0; e < 8; ++e) { w0[e] = cwq[0 * 1536 + colo + e]; w1[e] = cwq[1 * 1536 + colo + e]; w2[e] = cwq[2 * 1536 + colo + e]; w3[e] = cwq[3 * 1536 + colo + e]; }
    unpack8(raw[0], h3); unpack8(raw[1], h2); unpack8(raw[2], h1);
#pragma unroll
    for (int t = 0; t < 16; ++t) { const int m = t0 + t; float x[8], y[8]; unpack8(raw[3 + t], x); float ss = 0.f;
#pragma unroll
        for (int e = 0; e < 8; ++e) { const float c = w0[e] * h3[e] + w1[e] * h2[e] + w2[e] * h1[e] + w3[e] * x[e]; y[e] = silu_f(c); ss += y[e] * y[e]; h3[e] = h2[e]; h2[e] = h1[e]; h1[e] = x[e]; }
        if (X < 2) { ss += __shfl_xor(ss, 1); ss += __shfl_xor(ss, 2); ss += __shfl_xor(ss, 4); ss += __shfl_xor(ss, 8);
            float r = 1.0f / sqrtf(ss + EPS); if (X == 0) r *= 0.08838834764831845f;
#pragma unroll
            for (int e = 0; e < 8; ++e) y[e] *= r; }
        *(v4u*)(QKV + (size_t)m * 1536 + colo) = pack8(y); }
}
__device__ __forceinline__ void conv_pass(const bf16* P, const float* cwm, const float* cwq, const float* gco, bf16* YC, bf16* QKV, int gw, int NGW, int lane) {
    for (int run = gw; run < M / 16; run += NGW) {
        const int t0 = run * 16; const bool first = (t0 & (SEQ - 1)) == 0;
        { float w0[8], w1[8], w2[8], gc[8], u2[8], u1[8]; const int c0 = 8 * lane;
#pragma unroll
          for (int e = 0; e < 8; ++e) { w0[e] = cwm[c0 + e]; w1[e] = cwm[512 + c0 + e]; w2[e] = cwm[1024 + c0 + e]; gc[e] = gco[c0 + e]; u2[e] = 0.f; u1[e] = 0.f; }
          if (!first) { float a[8], b[8]; unpack8(*(const v4u*)(P + (size_t)(t0 - 2) * NP + 512 + c0), a); unpack8(*(const v4u*)(P + (size_t)(t0 - 2) * NP + 1024 + c0), b);
#pragma unroll
              for (int e = 0; e < 8; ++e) u2[e] = a[e] * b[e];
              unpack8(*(const v4u*)(P + (size_t)(t0 - 1) * NP + 512 + c0), a); unpack8(*(const v4u*)(P + (size_t)(t0 - 1) * NP + 1024 + c0), b);
#pragma unroll
              for (int e = 0; e < 8; ++e) u1[e] = a[e] * b[e]; }
#pragma unroll 1
          for (int tb = 0; tb < 16; tb += 8) {
              v4u rb[8], rc[8], rh[8];
#pragma unroll
              for (int t = 0; t < 8; ++t) { const bf16* pr = P + (size_t)(t0 + tb + t) * NP + c0; rb[t] = *(const v4u*)pr; rc[t] = *(const v4u*)(pr + 512); rh[t] = *(const v4u*)(pr + 1024); }
#pragma unroll
              for (int t = 0; t < 8; ++t) { const int m = t0 + tb + t; float gb[8], a[8], b[8], y[8]; unpack8(rb[t], gb); unpack8(rc[t], a); unpack8(rh[t], b); float ss = 0.f;
#pragma unroll
                  for (int e = 0; e < 8; ++e) { const float u0 = a[e] * b[e]; y[e] = gb[e] * (w0[e] * u2[e] + w1[e] * u1[e] + w2[e] * u0); ss += y[e] * y[e]; u2[e] = u1[e]; u1[e] = u0; }
                  ss += __shfl_xor(ss, 1); ss += __shfl_xor(ss, 2); ss += __shfl_xor(ss, 4);
                  const float r = 1.0f / sqrtf(ss * (1.0f / 64.0f) + EPS);
#pragma unroll
                  for (int e = 0; e < 8; ++e) y[e] = y[e] * r * gc[e];
                  *(v4u*)(YC + (size_t)m * D + c0) = pack8(y); } } }
        conv_qkv(P, cwq, QKV, 0, t0, first, lane); conv_qkv(P, cwq, QKV, 1, t0, first, lane); conv_qkv(P, cwq, QKV, 2, t0, first, lane);
    }
}


constexpr int PREP_HALF = 69632, PK_KN = 0, PK_QN = 17408, PK_VV = 34816, PK_LM = 52224, PK_GC = 68608, PK_BT = 68864, PK_EG = 69120, PROW = 272;
template <bool SC>
__device__ __forceinline__ v4u afrag_piece_rows(const LAS unsigned char* tile, const LAS float* sc, int p) {
    const int f = p >> 6, ln = p & 63, mt = f >> 3, kt = (f >> 1) & 3, s = f & 1, r = ln & 31, hh = ln >> 5, row = 32 * mt + r, kb = 32 * kt + 16 * s + 4 * hh;
    const v2u a = *(const LAS v2u*)(tile + row * PROW + kb * 2), b = *(const LAS v2u*)(tile + row * PROW + (kb + 8) * 2);
    float scv = 1.0f; if (SC) scv = sc[row];
    v4u o; o.x = cvt_pk_bf16(bflo(a.x) * scv, bfhi(a.x) * scv); o.y = cvt_pk_bf16(bflo(a.y) * scv, bfhi(a.y) * scv); o.z = cvt_pk_bf16(bflo(b.x) * scv, bfhi(b.x) * scv); o.w = cvt_pk_bf16(bflo(b.y) * scv, bfhi(b.y) * scv);
    return o;
}
#define LBAR() do { asm volatile("s_waitcnt lgkmcnt(0)" ::: "memory"); __builtin_amdgcn_s_barrier(); asm volatile("" ::: "memory"); } while (0)
__device__ __forceinline__ void prep_phase(LAS unsigned char* lds, const bf16* QKV, const float* GB, float* EGL, unsigned char* CH, unsigned* FLG, int ublk, int nblk, int tid) {
    const int half = tid >> 8, t = tid & 255, lane = tid & 63, w = (tid >> 6) & 3, r = lane & 31, hh = lane >> 5;
    LAS unsigned char* L = lds + half * PREP_HALF;
    LAS float* LM = (LAS float*)(L + PK_LM); LAS float* GC = (LAS float*)(L + PK_GC); LAS float* BT = (LAS float*)(L + PK_BT); LAS float* EG = (LAS float*)(L + PK_EG);
    for (int pu = ublk; pu < NBH * NCH / 2; pu += nblk) {
        const int n = pu >> 3, bh = 2 * (pu & 7) + half, cid = bh * NCH + n, b = bh >> 2, h = bh & 3, m0 = b * SEQ + n * 64;
        unsigned char* rec = CH + (size_t)cid * REC;
        LBAR();
#pragma unroll
        for (int X = 0; X < 3; ++X)
#pragma unroll
            for (int i = 0; i < 4; ++i) { const int p = t + 256 * i, row = p >> 4, c16 = p & 15;
                const v4u v = *(const v4u*)(QKV + (size_t)(m0 + row) * 1536 + 512 * X + 128 * h + 8 * c16);
                *(LAS v4u*)(L + (X == 0 ? PK_QN : (X == 1 ? PK_KN : PK_VV)) + row * PROW + c16 * 16) = v; }
        if (w == 0) { float g = GB[(size_t)(m0 + lane) * 8 + h];
#pragma unroll
            for (int d = 1; d < 64; d <<= 1) { const float o = __shfl_up(g, d); if (lane >= d) g += o; }
            GC[lane] = g; EG[lane] = __expf(g); BT[lane] = GB[(size_t)(m0 + lane) * 8 + 4 + h];
            if (lane == 63) *(float*)(rec + 73728) = __expf(g); }
        LBAR();
        { const int mi = w >> 1, nj = w & 1;
          f32x16 kk, qk;
#pragma unroll
          for (int i = 0; i < 16; ++i) { kk[i] = 0.f; qk[i] = 0.f; }
#pragma unroll
          for (int st = 0; st < 8; ++st) {
              const bf16x8 ka = *(const LAS bf16x8*)(L + PK_KN + (32 * mi + r) * PROW + (16 * st + 8 * hh) * 2);
              const bf16x8 kb = *(const LAS bf16x8*)(L + PK_KN + (32 * nj + r) * PROW + (16 * st + 8 * hh) * 2);
              const bf16x8 qb = *(const LAS bf16x8*)(L + PK_QN + (32 * mi + r) * PROW + (16 * st + 8 * hh) * 2);
              kk = __builtin_amdgcn_mfma_f32_32x32x16_bf16(ka, kb, kk, 0, 0, 0);
              qk = __builtin_amdgcn_mfma_f32_32x32x16_bf16(kb, qb, qk, 0, 0, 0);
          }
          const float gj = GC[32 * nj + r], gq = GC[32 * mi + r];
          float av[16];
#pragma unroll
          for (int reg = 0; reg < 16; ++reg) { const int cr = (reg & 3) + 8 * (reg >> 2) + 4 * hh;
              const int i = 32 * mi + cr, j = 32 * nj + r;
              LM[i * 64 + j] = (i > j) ? BT[i] * kk[reg] * __expf(GC[i] - gj) : 0.f;
              const int key = 32 * nj + cr, qr = 32 * mi + r;
              av[reg] = (qr >= key) ? qk[reg] * __expf(gq - GC[key]) : 0.f; }
#pragma unroll
          for (int s = 0; s < 2; ++s) { v4u o; o.x = cvt_pk_bf16(av[8 * s], av[8 * s + 1]); o.y = cvt_pk_bf16(av[8 * s + 2], av[8 * s + 3]); o.z = cvt_pk_bf16(av[8 * s + 4], av[8 * s + 5]); o.w = cvt_pk_bf16(av[8 * s + 6], av[8 * s + 7]);
              *(v4u*)(rec + 49152 + ((mi * 2 + nj) * 2 + s) * 1024 + lane * 16) = o; }
        }
#pragma unroll
        for (int i = 0; i < 4; ++i) { const int p = t + 256 * i; *(v4u*)(rec + 16384 + p * 16) = afrag_piece_rows<true>(L + PK_QN, EG, p); }
        { const float gl = GC[63];
#pragma unroll
          for (int i = 0; i < 4; ++i) { const int p = t + 256 * i, f = p >> 6, ln = p & 63, mt = f >> 2, ct = (f >> 1) & 1, s = f & 1, dk = 32 * mt + (ln & 31), cb = 32 * ct + 16 * s + 4 * (ln >> 5);
              float e[8];
#pragma unroll
              for (int j = 0; j < 8; ++j) { const int c = cb + 8 * (j >> 2) + (j & 3); e[j] = bf2f(*(const LAS unsigned short*)(L + PK_KN + c * PROW + dk * 2)) * __expf(gl - GC[c]); }
              *(v4u*)(rec + 32768 + p * 16) = pack8(e); } }
        LBAR();
        { float X[64]; const bool isu = t < 128; const int col = t & 127;
          const LAS unsigned char* src = L + (isu ? PK_VV : PK_KN) + col * 2;
#pragma unroll
          for (int i = 0; i < 64; ++i) {
              const float egi = EG[i]; const float rhs = bf2f(*(const LAS unsigned short*)(src + i * PROW)) * BT[i] * (isu ? 1.0f : egi);
              float a0 = 0.f, a1 = 0.f, a2 = 0.f, a3 = 0.f;
#pragma unroll
              for (int j4 = 0; j4 < (i + 3) / 4; ++j4) { const f32x4 l = *(const LAS f32x4*)(LM + i * 64 + 4 * j4);
                  if (4 * j4 + 0 < i) a0 += l.x * X[4 * j4 + 0]; if (4 * j4 + 1 < i) a1 += l.y * X[4 * j4 + 1]; if (4 * j4 + 2 < i) a2 += l.z * X[4 * j4 + 2]; if (4 * j4 + 3 < i) a3 += l.w * X[4 * j4 + 3]; }
              X[i] = rhs - ((a0 + a1) + (a2 + a3)); asm volatile("" : "+v"(X[i]) :: "memory"); }
          LBAR();
          if (isu) { const int vs = col >> 5, dvl = col & 31;
#pragma unroll
              for (int mt = 0; mt < 2; ++mt)
#pragma unroll
                  for (int h2 = 0; h2 < 2; ++h2) { v4u* dst = (v4u*)(rec + REC_A + (size_t)(((vs * 2 + mt) * 64 + dvl + 32 * h2) * 32));
#pragma unroll
                      for (int a2 = 0; a2 < 2; ++a2) { const int i0 = 32 * mt + 4 * h2 + 16 * a2; v4u w;
                          w.x = cvt_pk_bf16(X[i0], X[i0 + 1]); w.y = cvt_pk_bf16(X[i0 + 2], X[i0 + 3]); w.z = cvt_pk_bf16(X[i0 + 8], X[i0 + 9]); w.w = cvt_pk_bf16(X[i0 + 10], X[i0 + 11]); dst[a2] = w; } }
          } else {
#pragma unroll
              for (int i = 0; i < 64; ++i) *(LAS unsigned short*)(L + PK_VV + i * PROW + col * 2) = (unsigned short)(cvt_pk_bf16(-X[i], 0.f) & 0xffffu);
          }
        }
        LBAR();
#pragma unroll
        for (int i = 0; i < 4; ++i) { const int p = t + 256 * i; *(v4u*)(rec + p * 16) = afrag_piece_rows<false>(L + PK_VV, EG, p); }
        asm volatile("s_waitcnt vmcnt(0)" ::: "memory"); __syncthreads();
        if (tid == 0) { __builtin_amdgcn_fence(__ATOMIC_RELEASE, "agent"); asm volatile("s_waitcnt vmcnt(0)" ::: "memory");
            __hip_atomic_store(FLG + (2 * (pu & 7)) * NCH + n, 1u, __ATOMIC_RELAXED, __HIP_MEMORY_SCOPE_AGENT); __hip_atomic_store(FLG + (2 * (pu & 7) + 1) * NCH + n, 1u, __ATOMIC_RELAXED, __HIP_MEMORY_SCOPE_AGENT); }
    }
}

__device__ __forceinline__ bf16x8 pack_acc(const f32x16& x, int s) {
    v4u p; p.x = cvt_pk_bf16(x[8 * s], x[8 * s + 1]); p.y = cvt_pk_bf16(x[8 * s + 2], x[8 * s + 3]); p.z = cvt_pk_bf16(x[8 * s + 4], x[8 * s + 5]); p.w = cvt_pk_bf16(x[8 * s + 6], x[8 * s + 7]);
    return __builtin_bit_cast(bf16x8, p);
}
#define MFMA32(a, b, c) __builtin_amdgcn_mfma_f32_32x32x16_bf16((a), (b), (c), 0, 0, 0)
#define PIN_SCHED() __builtin_amdgcn_sched_barrier(0)
__device__ __forceinline__ int chain_ready(const unsigned* fl, int have, int lane) {
    for (;;) {
        const int idx = have + 1 + lane;
        const unsigned f = (idx < NCH) ? __hip_atomic_load(fl + idx, __ATOMIC_RELAXED, __HIP_MEMORY_SCOPE_AGENT) : 0u;
        const unsigned long long m = __ballot(f != 0u);
        const int pre = (m == ~0ull) ? 64 : __builtin_ctzll(~m);
        if (pre > 0) { __builtin_amdgcn_fence(__ATOMIC_ACQUIRE, "agent"); asm volatile("s_waitcnt vmcnt(0)" ::: "memory"); return have + pre; }
        __builtin_amdgcn_s_sleep(16);
    }
}
__device__ __forceinline__ void chain_phase(LAS unsigned char* lds, const unsigned char* CH, const unsigned* FLG, bf16* Oraw, int bh, int tid) {
    const int wid = __builtin_amdgcn_readfirstlane(tid >> 6), lane = tid & 63, b = bh >> 2, h = bh & 3, vs = wid & 3;
    const unsigned char* rec0 = CH + (size_t)bh * NCH * REC;
    const bool comp = wid < 4, stager = (wid >= 4);
    const int hw = wid - 4;
#define CH_MOVE(n, dstbase) do { _Pragma("unroll") for (int _i = 0; _i < 19; ++_i) { const int _pc = hw * 19 + _i; if (_pc < 73) \
        __builtin_amdgcn_global_load_lds((const unsigned*)(rec0 + (size_t)(n) * REC + _pc * 1024 + lane * 16), (LAS unsigned*)((dstbase) + _pc * 1024), 16, 0, 0); } } while (0)
#define CH_WARM(n) do { _Pragma("unroll") for (int _i = 0; _i < 10; ++_i) { const int _o = (_i * 64 + lane) * 128; \
        __builtin_amdgcn_global_load_lds((const unsigned*)(rec0 + (size_t)(n) * REC + (_o < REC ? _o : 0)), (LAS unsigned*)(dummy), 4, 0, 0); } } while (0)
    constexpr int WARM_AHEAD = 8;
    LAS unsigned char* dummy = lds + 2 * REC;
    f32x16 S[4], o0, o1;
#pragma unroll
    for (int k = 0; k < 4; ++k)
#pragma unroll
        for (int i = 0; i < 16; ++i) S[k][i] = 0.f;
#pragma unroll
    for (int i = 0; i < 16; ++i) { o0[i] = 0.f; o1[i] = 0.f; }
    const unsigned* fl = FLG + bh * NCH; int have = -1;
    if (stager) { while (have < 0) have = chain_ready(fl, have, lane); CH_MOVE(0, lds); }
    if (!comp) asm volatile("s_waitcnt vmcnt(0)" ::: "memory");
    __builtin_amdgcn_s_barrier(); asm volatile("" ::: "memory");
    for (int n = 0; n < NCH; ++n) {
        const int buf = n & 1;
        if (!comp) {
            if (stager) { if (n + 1 < NCH) { while (have < n + 1) have = chain_ready(fl, have, lane); CH_MOVE(n + 1, lds + (buf ^ 1) * REC); } asm volatile("s_waitcnt vmcnt(0)" ::: "memory"); }
            else { const int wn = n + 1 + WARM_AHEAD; if (wn < NCH) { if (have < wn) { const int idx = have + 1 + lane; const unsigned f = (idx < NCH) ? __hip_atomic_load(fl + idx, __ATOMIC_RELAXED, __HIP_MEMORY_SCOPE_AGENT) : 0u;
                        const unsigned long long m = __ballot(f != 0u); const int pre = (m == ~0ull) ? 64 : __builtin_ctzll(~m); if (pre > 0) { __builtin_amdgcn_fence(__ATOMIC_ACQUIRE, "agent"); have += pre; } }
                    if (have >= wn) CH_WARM(wn); }
                   asm volatile("s_waitcnt vmcnt(20)" ::: "memory"); }
        } else {
            const LAS unsigned char* B = lds + buf * REC + lane * 16;
            const float egl = *(const LAS float*)(lds + buf * REC + 73728);
            f32x16 v0, v1;
            { const LAS v4u* ul = (const LAS v4u*)(lds + buf * REC + 57344 + ((vs * 2) * 64 + lane) * 32);
              const v4u a0 = ul[0], a1 = ul[1], b0 = ul[128], b1 = ul[129];
              v0[0] = bflo(a0.x); v0[1] = bfhi(a0.x); v0[2] = bflo(a0.y); v0[3] = bfhi(a0.y); v0[4] = bflo(a0.z); v0[5] = bfhi(a0.z); v0[6] = bflo(a0.w); v0[7] = bfhi(a0.w);
              v0[8] = bflo(a1.x); v0[9] = bfhi(a1.x); v0[10] = bflo(a1.y); v0[11] = bfhi(a1.y); v0[12] = bflo(a1.z); v0[13] = bfhi(a1.z); v0[14] = bflo(a1.w); v0[15] = bfhi(a1.w);
              v1[0] = bflo(b0.x); v1[1] = bfhi(b0.x); v1[2] = bflo(b0.y); v1[3] = bfhi(b0.y); v1[4] = bflo(b0.z); v1[5] = bfhi(b0.z); v1[6] = bflo(b0.w); v1[7] = bfhi(b0.w);
              v1[8] = bflo(b1.x); v1[9] = bfhi(b1.x); v1[10] = bflo(b1.y); v1[11] = bfhi(b1.y); v1[12] = bflo(b1.z); v1[13] = bfhi(b1.z); v1[14] = bflo(b1.w); v1[15] = bfhi(b1.w); }
#pragma unroll
            for (int i = 0; i < 16; ++i) { o0[i] = 0.f; o1[i] = 0.f; }
#define LDF(dst, off) dst = *(const LAS bf16x8*)(B + (off))
#define LD_WQ(F, kt, s) do { LDF(F[0], ((0 * 4 + (kt)) * 2 + (s)) * 1024); LDF(F[1], ((1 * 4 + (kt)) * 2 + (s)) * 1024); LDF(F[2], 16384 + ((0 * 4 + (kt)) * 2 + (s)) * 1024); LDF(F[3], 16384 + ((1 * 4 + (kt)) * 2 + (s)) * 1024); } while (0)
#define MM_WQ(F, kt, s) do { const bf16x8 sb = pack_acc(S[kt], s); v0 = MFMA32(F[0], sb, v0); v1 = MFMA32(F[1], sb, v1); o0 = MFMA32(F[2], sb, o0); o1 = MFMA32(F[3], sb, o1); asm volatile("" : "+v"(o0), "+v"(o1)); } while (0)
#define LD_AT(F, ct) do { LDF(F[0], 49152 + ((0 * 2 + (ct)) * 2 + 0) * 1024); LDF(F[1], 49152 + ((1 * 2 + (ct)) * 2 + 0) * 1024); LDF(F[2], 49152 + ((0 * 2 + (ct)) * 2 + 1) * 1024); LDF(F[3], 49152 + ((1 * 2 + (ct)) * 2 + 1) * 1024); } while (0)
#define MM_AT(F, ct) do { o0 = MFMA32(F[0], vb[ct][0], o0); o1 = MFMA32(F[1], vb[ct][0], o1); o0 = MFMA32(F[2], vb[ct][1], o0); o1 = MFMA32(F[3], vb[ct][1], o1); } while (0)
#define LD_KD(F, ct, s) do { _Pragma("unroll") for (int q = 0; q < 4; ++q) LDF(F[q], 32768 + ((q * 2 + (ct)) * 2 + (s)) * 1024); } while (0)
#define MM_KD(F, ct, s) do { _Pragma("unroll") for (int q = 0; q < 4; ++q) S[q] = MFMA32(F[q], vb[ct][s], S[q]); } while (0)
            bf16x8 FA[4], FB[4];
            LD_WQ(FA, 0, 0); PIN_SCHED();
            LD_WQ(FB, 0, 1); PIN_SCHED(); MM_WQ(FA, 0, 0); PIN_SCHED();
            LD_WQ(FA, 1, 0); PIN_SCHED(); MM_WQ(FB, 0, 1); PIN_SCHED();
            LD_WQ(FB, 1, 1); PIN_SCHED(); MM_WQ(FA, 1, 0); PIN_SCHED();
            LD_WQ(FA, 2, 0); PIN_SCHED(); MM_WQ(FB, 1, 1); PIN_SCHED();
            LD_WQ(FB, 2, 1); PIN_SCHED(); MM_WQ(FA, 2, 0); PIN_SCHED();
            LD_WQ(FA, 3, 0); PIN_SCHED(); MM_WQ(FB, 2, 1); PIN_SCHED();
            LD_WQ(FB, 3, 1); PIN_SCHED(); MM_WQ(FA, 3, 0); PIN_SCHED();
            LD_AT(FA, 0); PIN_SCHED(); MM_WQ(FB, 3, 1); PIN_SCHED();
            bf16x8 vb[2][2];
            vb[0][0] = pack_acc(v0, 0); vb[0][1] = pack_acc(v0, 1); vb[1][0] = pack_acc(v1, 0); vb[1][1] = pack_acc(v1, 1);
            LD_AT(FB, 1); PIN_SCHED(); MM_AT(FA, 0); PIN_SCHED();
#pragma unroll
            for (int kt = 0; kt < 4; ++kt)
#pragma unroll
                for (int i = 0; i < 16; ++i) S[kt][i] *= egl;
            LD_KD(FA, 0, 0); PIN_SCHED(); MM_AT(FB, 1); PIN_SCHED();
            { bf16* op = Oraw + (size_t)(b * SEQ + n * 64 + 4 * (lane >> 5)) * 512 + h * 128 + vs * 32 + (lane & 31); asm volatile("" : "+v"(op));
#pragma unroll
              for (int reg = 0; reg < 16; ++reg) { const int cr = (reg & 3) + 8 * (reg >> 2); const unsigned pk = cvt_pk_bf16(o0[reg], o1[reg]); op[cr * 512] = (bf16)(pk & 0xffffu); op[(32 + cr) * 512] = (bf16)(pk >> 16); } }
            PIN_SCHED();
            LD_KD(FB, 0, 1); PIN_SCHED(); MM_KD(FA, 0, 0); PIN_SCHED();
            LD_KD(FA, 1, 0); PIN_SCHED(); MM_KD(FB, 0, 1); PIN_SCHED();
            LD_KD(FB, 1, 1); PIN_SCHED(); MM_KD(FA, 1, 0); PIN_SCHED();
            MM_KD(FB, 1, 1);
#undef MM_AT
#undef MM_KD
#undef LDF
#undef LD_WQ
#undef MM_WQ
#undef LD_AT
#undef LD_KD
            asm volatile("s_waitcnt lgkmcnt(0)" ::: "memory");
        }
        __builtin_amdgcn_s_barrier(); asm volatile("" ::: "memory");
    }
    asm volatile("s_waitcnt vmcnt(0)" ::: "memory");
#undef CH_MOVE
#undef CH_WARM
}
#if DN_NAIVE
__device__ __forceinline__ void naive_dn(const bf16* QKV, const float* GB, float* Oraw, int unit, int lane) {
    const int bh = unit >> 1, dv = (unit & 1) * 64 + lane, b = bh >> 2, h = bh & 3;
    float S[128];
#pragma unroll
    for (int i = 0; i < 128; ++i) S[i] = 0.f;
    for (int t = 0; t < SEQ; ++t) { const size_t m = (size_t)b * SEQ + t;
        const float al = __expf(GB[m * 8 + h]), be = GB[m * 8 + 4 + h];
        const bf16* qp = QKV + m * 1536 + h * 128; const bf16* kp = qp + 512; const float v = bf2f(qp[1024 + dv]);
        float r = 0.f;
#pragma unroll
        for (int i = 0; i < 128; ++i) { S[i] *= al; r += bf2f(kp[i]) * S[i]; if ((i & 15) == 15) asm volatile("" : "+v"(r) :: "memory"); }
        const float d = be * (v - r); float o = 0.f;
#pragma unroll
        for (int i = 0; i < 128; ++i) { S[i] += bf2f(kp[i]) * d; o += bf2f(qp[i]) * S[i]; if ((i & 15) == 15) asm volatile("" : "+v"(o) :: "memory"); }
        Oraw[m * 512 + h * 128 + dv] = o; }
}
#endif
template <bool OB16>
__device__ __forceinline__ void opost_rows(const void* Oraw_, const bf16* P, const float* gdn, bf16* YC, int gw, int NGW, int lane) {
    const float* Oraw = (const float*)Oraw_; const bf16* Ob = (const bf16*)Oraw_;
    float gd[8];
#pragma unroll
    for (int e = 0; e < 8; ++e) gd[e] = gdn[(8 * lane + e) & 127];
    for (int blk = gw; blk < M / 16; blk += NGW) { const int m0 = blk * 16;
#pragma unroll 1
        for (int i = 0; i < 16; i += 8) {
            f32x4 oa[8], ob[8]; v4u zz[8];
#pragma unroll
            for (int t = 0; t < 8; ++t) { const int m = m0 + i + t;
                if (OB16) { float f[8]; unpack8(*(const v4u*)(Ob + (size_t)m * 512 + 8 * lane), f); oa[t] = (f32x4){f[0], f[1], f[2], f[3]}; ob[t] = (f32x4){f[4], f[5], f[6], f[7]}; }
                else { const f32x4* op = (const f32x4*)(Oraw + (size_t)m * 512 + 8 * lane); oa[t] = op[0]; ob[t] = op[1]; }
                zz[t] = *(const v4u*)(P + (size_t)m * NP + 3072 + 8 * lane); }
#pragma unroll
            for (int t = 0; t < 8; ++t) { const int m = m0 + i + t; float z[8]; unpack8(zz[t], z);
                float o[8] = {oa[t].x, oa[t].y, oa[t].z, oa[t].w, ob[t].x, ob[t].y, ob[t].z, ob[t].w}; float ss = 0.f;
#pragma unroll
                for (int e = 0; e < 8; ++e) ss += o[e] * o[e];
                ss += __shfl_xor(ss, 1); ss += __shfl_xor(ss, 2); ss += __shfl_xor(ss, 4); ss += __shfl_xor(ss, 8);
                const float r = 1.0f / sqrtf(ss * (1.0f / 128.0f) + EPS);
#pragma unroll
                for (int e = 0; e < 8; ++e) o[e] = o[e] * r * gd[e] * silu_f(z[e]);
                *(v4u*)(YC + (size_t)m * D + 512 + 8 * lane) = pack8(o); } } }
}

typedef __attribute__((address_space(1))) unsigned gu32;
#define XB_TMO      128
#define XB_XCNT(j)  (256  + 64 * (j))
#define XB_XSUB(j)  (1280 + 64 * (j))
#define XB_XGEN(j)  (2304 + 64 * (j))
#define XB_TOP      3328
#define XB_TOPGEN   3392
#define XCD_BAR_WORDS 3456
#define XB_SPIN_CAP (1u << 18)

__device__ __forceinline__ unsigned xb_ld(unsigned* p)              { return __hip_atomic_load(p, __ATOMIC_RELAXED, __HIP_MEMORY_SCOPE_AGENT); }
__device__ __forceinline__ unsigned xb_add(unsigned* p, unsigned v) { return __hip_atomic_fetch_add(p, v, __ATOMIC_RELAXED, __HIP_MEMORY_SCOPE_AGENT); }
__device__ __forceinline__ unsigned xb_xcc_id() { return (unsigned)__builtin_amdgcn_s_getreg((3 << 11) | 20) & 0xFu; }
#define XB_SPIN(cond, bar) do { unsigned _sp = 0; while (cond) { __builtin_amdgcn_s_sleep(1); \
    if ((++_sp & 255u) == 0u) { if (xb_ld(&(bar)[XB_TMO])) break; if (_sp > XB_SPIN_CAP) { atomicAdd(&(bar)[XB_TMO], 1u); break; } } } } while (0)

struct XcdBarrier {
    unsigned* bar; unsigned x;
    volatile LAS unsigned* st;
};

__device__ __forceinline__ XcdBarrier xcd_barrier_post(unsigned* bar, volatile LAS unsigned* st) {
    XcdBarrier b; b.bar = bar; b.x = xb_xcc_id(); b.st = st;
    if (threadIdx.x == 0) (void)xb_add(&bar[XB_XCNT(b.x)], 1u);
    return b;
}
__device__ __forceinline__ void xcd_barrier_complete(unsigned* bar, unsigned x, unsigned& nloc, unsigned& nx) {
    const unsigned G = gridDim.x * gridDim.y * gridDim.z;
    unsigned sum, cnt, mine, sp = 0u;
    for (;;) {
        sum = 0u; cnt = 0u; mine = 0u;
#pragma unroll
        for (unsigned j = 0; j < 16; ++j) { const unsigned c = xb_ld(&bar[XB_XCNT(j)]); sum += c; cnt += (c > 0u) ? 1u : 0u; mine = (j == x) ? c : mine; }
        if (sum == G) break;
        __builtin_amdgcn_s_sleep(1);
        if ((++sp & 255u) == 0u) { if (xb_ld(&bar[XB_TMO])) break; if (sp > XB_SPIN_CAP) { atomicAdd(&bar[XB_TMO], 1u); break; } }
    }
    nloc = mine > 0u ? mine : 1u; nx = cnt > 0u ? cnt : 1u;
}

__device__ __forceinline__ void xcd_barrier(const XcdBarrier& b) {
    asm volatile("s_waitcnt vmcnt(0)" ::: "memory");
    __syncthreads();
    if (threadIdx.x == 0) {
        unsigned* bar = b.bar;
        __builtin_amdgcn_s_waitcnt(0);
        unsigned nloc = b.st[0], nx = b.st[1];
        if (nloc == 0u) { xcd_barrier_complete(bar, b.x, nloc, nx); b.st[0] = nloc; b.st[1] = nx; }
        const unsigned old = xb_add(&bar[XB_XSUB(b.x)], 1u);
        const unsigned gen = old / nloc;
        if (old + 1u == (gen + 1u) * nloc) {
            __builtin_amdgcn_fence(__ATOMIC_RELEASE, "agent");
            asm volatile("s_waitcnt vmcnt(0)" ::: "memory");
            const unsigned og = xb_add(&bar[XB_TOP], 1u);
            const unsigned tg = og / nx;
            if (og + 1u == (tg + 1u) * nx) xb_add(&bar[XB_TOPGEN], 1u);
            else XB_SPIN(xb_ld(&bar[XB_TOPGEN]) == tg, bar);
            __builtin_amdgcn_fence(__ATOMIC_ACQUIRE, "agent");
            xb_add(&bar[XB_XGEN(b.x)], 1u);
            asm volatile("s_waitcnt vmcnt(0)" ::: "memory");
        } else {
            XB_SPIN(xb_ld(&bar[XB_XGEN(b.x)]) == gen, bar);
            __builtin_amdgcn_fence(__ATOMIC_ACQUIRE, "agent");
            asm volatile("s_waitcnt vmcnt(0)" ::: "memory");
        }
    }
    __syncthreads();
}

__global__ void __launch_bounds__(NWAVES * 64, 2) fwd(Args args) {
    extern __shared__ __attribute__((aligned(16))) unsigned char lds_raw[];
    LAS unsigned char* lds = (LAS unsigned char*)lds_raw;
    int tid = threadIdx.x, lane = tid & 63, wave = __builtin_amdgcn_readfirstlane(tid >> 6);
    const int G = gridDim.x; const int bx = blockIdx.x; const int vcu = (G % 8 == 0) ? (bx % 8) * (G / 8) + bx / 8 : bx;
    int gw = vcu * NWAVES + wave; const int NGW = G * NWAVES;
#define LAUNDER() do { int tv_ = threadIdx.x; asm volatile("" : "+v"(tv_)); tid = tv_; lane = tid & 63; wave = __builtin_amdgcn_readfirstlane(tid >> 6); gw = vcu * NWAVES + wave; } while (0)
    unsigned char* ws = args.ws;
    float* MOD = (float*)(ws + WS_MOD); float* GB = (float*)(ws + WS_GB); float* EGL = (float*)(ws + WS_EGL);
    bf16* WinT = (bf16*)(ws + WS_WIN); bf16* WoT = (bf16*)(ws + WS_WO); bf16* WguT = (bf16*)(ws + WS_WGU); bf16* WdT = (bf16*)(ws + WS_WD);
    bf16* H = (bf16*)(ws + WS_H); unsigned char* CH = ws + WS_CH; bf16* P = (bf16*)(ws + WS_P); bf16* ACT = (bf16*)(ws + WS_P); bf16* YC = (bf16*)(ws + WS_YC);
    bf16* QKV = (bf16*)args.out; bf16* Oraw = (bf16*)((unsigned char*)args.out + 96 * MiB); float* OUT = args.out;
    const int lo = args.ph_lo, hi = args.ph_hi;
    volatile LAS unsigned* MISC = (volatile LAS unsigned*)(lds + LDS_BYTES - 64);
    if (tid < 16) MISC[tid] = 0u;
    __syncthreads();
    XcdBarrier bar = xcd_barrier_post((unsigned*)ws, MISC);
    if (lo < 0) cg::this_grid().sync();
#ifndef PH_MASK
#define PH_MASK 0xFFF
#endif
#define IN(k) (((PH_MASK >> (k)) & 1) && lo <= (k) && (k) < hi)
#if MK_N_LAUNCHES == 1
#define SEAM(k) do { if (IN(k) && IN((k) + 1) && (k) != 5) xcd_barrier(bar); } while (0)
#else
#define SEAM(k) do { } while (0)
#endif
#ifndef REP_MASK
#define REP_MASK 0
#endif
#define BEGIN_REP(k) for (int rep_ = 0; rep_ <= ((REP_MASK >> (k)) & 1); ++rep_) { if (rep_) xcd_barrier(bar); LAUNDER();
#define END_REP }
    BEGIN_REP(0)
    if (IN(0)) {
        LAS float* scr = (LAS float*)(lds + wave * 16384);
        constexpr int I_IN = 16 * 112, I_O = 16 * 32, I_GU = 16 * 176, I_DN = 44 * 32, NITEMS = I_IN + I_O + I_GU + I_DN;
        for (int it = gw; it < NITEMS; it += NGW) { int r = it;
            if (r < I_IN) { p0_transpose_item<0>(args.in[I_WIN], D, PIN, 112, WinT, scr, r, lane); continue; } r -= I_IN;
            if (r < I_O) { p0_transpose_item<0>(args.in[I_WOUT], D, D, 32, WoT, scr, r, lane); continue; } r -= I_O;
            if (r < I_GU) { p0_transpose_item<1>(args.in[I_WGU], D, 2 * FF, 176, WguT, scr, r, lane); continue; } r -= I_GU;
            p0_transpose_item<0>(args.in[I_WDN], FF, D, 32, WdT, scr, r, lane); }
        __syncthreads();
        { LAS float* SC = (LAS float*)lds; const float* cin = args.in[I_C];
          for (int idx = tid; idx < 4096; idx += NWAVES * 64) { const int b = idx >> 10, k = idx & 1023; const float cv = cin[idx]; SC[k * 4 + b] = cv / (1.0f + __expf(-cv)); }
          __syncthreads();
          for (int it = bx; it < 256; it += G) p0_mod_item(args, MOD, SC, (LAS float*)(lds + 16384), it, tid); }
    }
    END_REP
    SEAM(0);
    BEGIN_REP(1)
    if (IN(1)) { LAS float* TT = (LAS float*)lds; const float* wi = args.in[I_WIN];
        for (int idx = tid; idx < 8192; idx += NWAVES * 64) { const int k = idx >> 3, e = idx & 7; TT[e * 1024 + k] = wi[(size_t)k * PIN + NP + e]; }
        __syncthreads();
        adaln_rows<0>(args.in[I_X], args.in[I_GMIX], MOD + 0, MOD + 1024, 6144, H, nullptr, TT, args.in[I_ALOG], args.in[I_DTB], GB, gw, NGW, lane);
        __syncthreads(); }
    END_REP
    SEAM(1);
    BEGIN_REP(2)
    if (IN(2)) { pg8::Gemm g{H, WinT, M, NP, D}; pg8::StaticOrder S; S.init(M, NP, G, bx); pg8::EpiBf16 E{P, NP};
        pg8::gemm_phase<pg8::EpiBf16, pg8::StaticOrder, true, true>(lds, g, S, E); }
    END_REP
    SEAM(2);
    BEGIN_REP(3)
    if (IN(3)) conv_pass(P, args.in[I_CWM], args.in[I_CWQ], args.in[I_GCO], YC, QKV, gw, NGW, lane);
    END_REP
    SEAM(3);
#if DN_NAIVE
    SEAM(4);
    if (IN(5)) { if (bx < 32 && wave == 0) naive_dn(QKV, GB, (float*)(ws + WS_CH), bx, lane); }
    SEAM(5);
    if (IN(6)) opost_rows<false>((const float*)(ws + WS_CH), P, args.in[I_GDN], YC, gw, NGW, lane);
#else
    BEGIN_REP(4)
    if (IN(4)) { unsigned* FLG = (unsigned*)(ws + 16384);
        if (bx < NBH) chain_phase(lds, CH, FLG, Oraw, bx, tid); else prep_phase(lds, QKV, GB, EGL, CH, FLG, bx - NBH, G - NBH, tid); }
    END_REP
    SEAM(4);
    BEGIN_REP(6)
    if (IN(6)) opost_rows<true>(Oraw, P, args.in[I_GDN], YC, gw, NGW, lane);
    END_REP
#endif
    SEAM(6);
    BEGIN_REP(7)
    if (IN(7)) { pg8::Gemm g{YC, WoT, M, D, D}; pg8::StaticOrder S; S.init(M, D, G, bx); pg8::EpiResGate E{args.in[I_X], OUT, MOD + 2048, 6144};
        pg8::gemm_phase<pg8::EpiResGate, pg8::StaticOrder, true, true>(lds, g, S, E); }
    END_REP
    SEAM(7);
    BEGIN_REP(8)
    if (IN(8)) adaln_rows<1>(OUT, args.in[I_GFFN], MOD + 3072, MOD + 4096, 6144, H, nullptr, nullptr, nullptr, nullptr, nullptr, gw, NGW, lane);
    END_REP
    SEAM(8);
    BEGIN_REP(9)
    if (IN(9)) { pg8::Gemm g{H, WguT, M, 2 * FF, D}; pg8::StaticOrder S; S.init(M, 2 * FF, G, bx); pg8::EpiSwiglu E{ACT, FF};
        pg8::gemm_phase<pg8::EpiSwiglu, pg8::StaticOrder, true, true>(lds, g, S, E); }
    END_REP
    SEAM(9);
    BEGIN_REP(10)
    if (IN(10)) { pg8::Gemm g{ACT, WdT, M, D, FF}; pg8::StaticOrder S; S.init(M, D, G, bx); pg8::EpiResGate E{OUT, OUT, MOD + 5120, 6144};
        pg8::gemm_phase<pg8::EpiResGate, pg8::StaticOrder, true, true>(lds, g, S, E); }
    END_REP
    SEAM(10);
    LAUNDER();
    if (IN(11)) adaln_rows<2>(OUT, args.in[I_GFIN], MOD + 4 * 6144, MOD + 4 * 6144 + 1024, 2048, nullptr, OUT, nullptr, nullptr, nullptr, nullptr, gw, NGW, lane);
#undef IN
#undef SEAM
}

extern "C" void kernel_launch(void* const* d_in, const int* in_sizes, int n_in, void* d_out, int out_size, void* d_ws, size_t ws_size, hipStream_t stream) {
    static int grid = 0;
    if (grid == 0) {
        if (n_in != 19 || out_size != M * D || ws_size < WS_END) { fprintf(stderr, "kernel_launch: unexpected shapes (n_in %d, out %d, ws %zu)\n", n_in, out_size, ws_size); grid = -1; return; }
        int dev = 0, cus = 0;
        if (hipGetDevice(&dev) != hipSuccess || hipDeviceGetAttribute(&cus, hipDeviceAttributeMultiprocessorCount, dev) != hipSuccess) { grid = -1; return; }
        if (hipFuncSetAttribute((const void*)fwd, hipFuncAttributeMaxDynamicSharedMemorySize, LDS_BYTES) != hipSuccess) { fprintf(stderr, "kernel_launch: hipFuncSetAttribute failed\n"); grid = -1; return; }
        int per_cu = 0;
        if (hipOccupancyMaxActiveBlocksPerMultiprocessor(&per_cu, (const void*)fwd, NWAVES * 64, LDS_BYTES) != hipSuccess || per_cu < 1) { fprintf(stderr, "kernel_launch: occupancy query says %d blocks per CU\n", per_cu); }
        (void)hipGetLastError();
        grid = cus;
    }
    if (grid < 0) return;
    Args a{};
    for (int i = 0; i < 19; ++i) a.in[i] = (const float*)d_in[i];
    a.out = (float*)d_out; a.ws = (unsigned char*)d_ws;
#if MK_N_LAUNCHES == 1
    if (hipMemsetAsync(d_ws, 0, 32768, stream) != hipSuccess) { fprintf(stderr, "kernel_launch: memset of the barrier words failed\n"); return; }
    a.ph_lo = 0; a.ph_hi = PH_END;
    void* kargs[] = {&a};
    hipError_t e = hipLaunchCooperativeKernel((const void*)fwd, dim3(grid), dim3(NWAVES * 64), kargs, LDS_BYTES, stream);
    if (e != hipSuccess) fprintf(stderr, "kernel_launch: cooperative launch failed: %s (grid %d)\n", hipGetErrorString(e), grid);
#else
    for (int ph = 0; ph < PH_END; ++ph) { a.ph_lo = ph; a.ph_hi = ph + 1; hipLaunchKernelGGL(fwd, dim3(grid), dim3(NWAVES * 64), LDS_BYTES, stream, a); }
#endif
}
```

```cpp
#include <hip/hip_runtime.h>
#include <hip/hip_cooperative_groups.h>
#include <cstdio>
#include <cstdint>
namespace cg = cooperative_groups;
#ifndef MK_N_LAUNCHES
#define MK_N_LAUNCHES 1
#endif
#ifndef DN_NAIVE
#define DN_NAIVE 0
#endif
namespace pg8 {
#define PG8_LAS __attribute__((address_space(3)))
typedef unsigned short bf16_t;
typedef short bf16x8 __attribute__((ext_vector_type(8)));
typedef float f32x4 __attribute__((ext_vector_type(4)));
typedef unsigned u32x4 __attribute__((ext_vector_type(4)));
constexpr int BM = 256, BK = 64, HALF = 128, HTB = HALF * BK * 2  , STAGE_BYTES = 8 * HTB, NXCD = 8, WGM = 8;

__host__ __device__ __forceinline__ int lds_byte(int r, int c) { const int st = (r >> 4) * 2 + (c >> 5), rr = r & 15, cc = c & 31, ob = rr * 64 + cc * 2; return st * 1024 + (ob ^ (((ob >> 9) & 1) << 5)); }
__host__ __device__ __forceinline__ void stage_rc(int b, int& R, int& C) { const int st = b / 1024, sb = b % 1024, swz = sb ^ (((sb >> 9) & 1) << 5); R = (st >> 1) * 16 + swz / 64; C = (st & 1) * 32 + (swz % 64) / 2; }
__host__ __device__ __forceinline__ int perm32(int rho) { const int n = rho >> 4, i = rho & 15; return 8 * (i >> 2) + 4 * n + (i & 3); }

struct Unit { int pm, pn; };
struct Gemm { const bf16_t* A; const bf16_t* Bt; int M, N, K; };

struct StaticOrder {
    int nM, nN, nwg, G, c;
    __host__ __device__ void init(int M, int N, int G_, int c_) { nM = M / BM; nN = N / BM; nwg = nM * nN; G = G_; c = c_; }
    __host__ __device__ bool next(int i, Unit& u) const {
        const long L = (long)i * G + c; if (L >= nwg) return false;
        int wgid = (int)L; { const int q = nwg / NXCD, r = nwg % NXCD, xcd = wgid % NXCD, off = wgid / NXCD; wgid = (xcd < r ? xcd * (q + 1) : r * (q + 1) + (xcd - r) * q) + off; }
        const int nig = WGM * nN, gid = wgid / nig, fm = gid * WGM, gsz = (nM - fm) < WGM ? (nM - fm) : WGM;
        u.pm = fm + ((wgid % nig) % gsz); u.pn = (wgid % nig) / gsz; return true;
    }
    __device__ __forceinline__ void a_ready(const Unit&) const {}
    __device__ __forceinline__ void done(const Unit&) const {}
};

typedef float f32x2 __attribute__((ext_vector_type(2)));
typedef __bf16 bf16x2v __attribute__((ext_vector_type(2)));
__device__ __forceinline__ unsigned cvt_pk_bf16(float lo, float hi) { f32x2 v = {lo, hi}; bf16x2v r = __builtin_convertvector(v, bf16x2v); return __builtin_bit_cast(unsigned, r); }
__device__ __forceinline__ float silu_f(float x) { return x * __builtin_amdgcn_rcpf(1.0f + __builtin_amdgcn_exp2f(-1.4426950408889634f * x)); }

struct EpiBf16 {
    static constexpr bool PERM = true, AFTER_DRAIN = false;
    bf16_t* O; int ldc;
    __device__ __forceinline__ void operator()(const f32x4 (&acc)[2][2][4][2], const Unit& u, int wr, int wc, int fr, int fq) const {
        const int row0 = u.pm * BM + wr * 64 + fr; const int col0 = u.pn * BM + wc * 32 + 8 * fq;
#pragma unroll
        for (int ai = 0; ai < 2; ++ai)
#pragma unroll
            for (int m = 0; m < 4; ++m) { bf16_t* rowp = O + (size_t)(row0 + ai * HALF + m * 16) * ldc + col0;
#pragma unroll
                for (int bj = 0; bj < 2; ++bj) { const f32x4 v0 = acc[ai][bj][m][0], v1 = acc[ai][bj][m][1];
                    u32x4 w; w.x = cvt_pk_bf16(v0[0], v0[1]); w.y = cvt_pk_bf16(v0[2], v0[3]); w.z = cvt_pk_bf16(v1[0], v1[1]); w.w = cvt_pk_bf16(v1[2], v1[3]);
                    *(u32x4*)(rowp + bj * HALF) = w; } }
    }
};
struct EpiSwiglu {
    static constexpr bool PERM = true, AFTER_DRAIN = false;
    bf16_t* O; int ldc;
    __device__ __forceinline__ void operator()(const f32x4 (&acc)[2][2][4][2], const Unit& u, int wr, int wc, int fr, int fq) const {
        const int row0 = u.pm * BM + wr * 64 + fr; const int col0 = u.pn * HALF + wc * 32 + 8 * fq;
#pragma unroll
        for (int ai = 0; ai < 2; ++ai)
#pragma unroll
            for (int m = 0; m < 4; ++m) { bf16_t* rowp = O + (size_t)(row0 + ai * HALF + m * 16) * ldc + col0;
                const f32x4 g0 = acc[ai][0][m][0], g1 = acc[ai][0][m][1], u0 = acc[ai][1][m][0], u1 = acc[ai][1][m][1];
                u32x4 w; w.x = cvt_pk_bf16(silu_f(g0[0]) * u0[0], silu_f(g0[1]) * u0[1]); w.y = cvt_pk_bf16(silu_f(g0[2]) * u0[2], silu_f(g0[3]) * u0[3]);
                w.z = cvt_pk_bf16(silu_f(g1[0]) * u1[0], silu_f(g1[1]) * u1[1]); w.w = cvt_pk_bf16(silu_f(g1[2]) * u1[2], silu_f(g1[3]) * u1[3]);
                *(u32x4*)rowp = w; }
    }
};
struct EpiResGate {
    static constexpr bool PERM = false, AFTER_DRAIN = false;
    const float* base; float* out; const float* gate;
    int gstride;
    __device__ __forceinline__ void operator()(const f32x4 (&acc)[2][2][4][2], const Unit& u, int wr, int wc, int fr, int fq) const {
        const int b = u.pm >> 5;
        const int col0 = u.pn * BM + wc * 32 + 4 * fq; const float* gp = gate + (size_t)b * gstride + col0;
        f32x4 gv[2][2];
#pragma unroll
        for (int bj = 0; bj < 2; ++bj)
#pragma unroll
            for (int n = 0; n < 2; ++n) gv[bj][n] = *(const f32x4*)(gp + bj * HALF + n * 16);
#pragma unroll
        for (int ai = 0; ai < 2; ++ai)
#pragma unroll
            for (int m = 0; m < 4; ++m) { const size_t off = (size_t)(u.pm * BM + ai * HALF + wr * 64 + m * 16 + fr) * 1024 + col0;
#pragma unroll
                for (int bj = 0; bj < 2; ++bj)
#pragma unroll
                    for (int n = 0; n < 2; ++n) { const f32x4 bs = *(const f32x4*)(base + off + bj * HALF + n * 16);
                        *(f32x4*)(out + off + bj * HALF + n * 16) = bs + gv[bj][n] * acc[ai][bj][m][n]; } }
    }
};

template <class Epi, class Sched, bool ALIGN_EPI = false, bool SP2 = false>
__device__ __forceinline__ void gemm_phase(PG8_LAS unsigned char* lds, const Gemm g, const Sched& S, const Epi& E) {
    const int tid = threadIdx.x, wid = __builtin_amdgcn_readfirstlane(tid >> 6), lane = tid & 63, wr = wid >> 2, wc = wid & 3, fr = lane & 15, fq = lane >> 4;
    const int K = g.K, nt = K / BK;
    unsigned voffA[2], voffB[2];
#pragma unroll
    for (int i = 0; i < 2; ++i) { int R, C; stage_rc(tid * 16 + i * 8192, R, C); const int Rb = Epi::PERM ? ((R & ~31) + perm32(R & 31)) : R;
        voffA[i] = (unsigned)(R * K + C) * 2u; voffB[i] = (unsigned)(Rb * K + C) * 2u; }
    const size_t kstep = (size_t)(BK * 2);
    const size_t hstep = (size_t)HALF * K * 2;
    const size_t tstep = 2 * hstep;
    const unsigned ldsw = (unsigned)wid * 1024u;
    const int aoff = lds_byte(wr * 64 + fr, fq * 8), boff = lds_byte(wc * 32 + fr, fq * 8);
#define PG8_SA(b, h) (((b) * 2 + (h)) * HTB)
#define PG8_SB(b, h) ((4 + (b) * 2 + (h)) * HTB)
#define PG8_STAGE(bufoff, gbase, voff) do { _Pragma("unroll") for (int _i = 0; _i < 2; ++_i) \
        __builtin_amdgcn_global_load_lds((const unsigned*)((const char*)(gbase) + (voff)[_i]), (PG8_LAS unsigned*)(lds + (bufoff) + ldsw + _i * 8192), 16, 0, 0); } while (0)
#define PG8_LDA(dst, b, h) do { _Pragma("unroll") for (int m = 0; m < 4; ++m) _Pragma("unroll") for (int k = 0; k < 2; ++k) dst[m][k] = *(const PG8_LAS bf16x8*)(lds + PG8_SA(b, h) + aoff + m * 2048 + k * 1024); } while (0)
#define PG8_LDB(dst, b, h) do { _Pragma("unroll") for (int n = 0; n < 2; ++n) _Pragma("unroll") for (int k = 0; k < 2; ++k) dst[n][k] = *(const PG8_LAS bf16x8*)(lds + PG8_SB(b, h) + boff + n * 2048 + k * 1024); } while (0)
#define PG8_MMA(ai, bj, At, Bt) do { __builtin_amdgcn_s_setprio(1); _Pragma("unroll") for (int m = 0; m < 4; ++m) _Pragma("unroll") for (int n = 0; n < 2; ++n) _Pragma("unroll") for (int k = 0; k < 2; ++k) \
        acc[ai][bj][m][n] = __builtin_amdgcn_mfma_f32_16x16x32_bf16(Bt[n][k], At[m][k], acc[ai][bj][m][n], 0, 0, 0); __builtin_amdgcn_s_setprio(0); } while (0)
#define PG8_WAIT_V(n) asm volatile("s_waitcnt vmcnt(" #n ")" ::: "memory")
#define PG8_WAIT_L(n) asm volatile("s_waitcnt lgkmcnt(" #n ")" ::: "memory")
#define PG8_BAR __builtin_amdgcn_s_barrier()
#define PG8_SCHED __builtin_amdgcn_sched_barrier(0)
    Unit cur, nxt; int ui = 0;
    if (!S.next(0, cur)) return;
    f32x4 acc[2][2][4][2];
#pragma unroll
    for (int a = 0; a < 2; ++a)
#pragma unroll
        for (int b = 0; b < 2; ++b)
#pragma unroll
            for (int m = 0; m < 4; ++m)
#pragma unroll
                for (int n = 0; n < 2; ++n) acc[a][b][m][n] = (f32x4){0.f, 0.f, 0.f, 0.f};
    bf16x8 At[4][2], B0[2][2], B1[2][2];
    const char* cA = (const char*)g.A + (size_t)cur.pm * tstep; const char* cB = (const char*)g.Bt + (size_t)cur.pn * tstep;
    S.a_ready(cur);
    if constexpr (SP2) {
        PG8_STAGE(PG8_SB(0, 0), cB, voffB); PG8_STAGE(PG8_SB(0, 1), cB + hstep, voffB); PG8_STAGE(PG8_SA(0, 0), cA, voffA); PG8_STAGE(PG8_SA(0, 1), cA + hstep, voffA);
        if (wr == 1) PG8_BAR;
        PG8_WAIT_V(2); PG8_BAR;
        PG8_STAGE(PG8_SB(1, 0), cB + kstep, voffB); PG8_STAGE(PG8_SA(1, 0), cA + kstep, voffA); PG8_STAGE(PG8_SB(1, 1), cB + hstep + kstep, voffB);
        PG8_WAIT_V(6); PG8_BAR;
    } else {
        PG8_STAGE(PG8_SB(0, 0), cB, voffB); PG8_STAGE(PG8_SA(0, 0), cA, voffA); PG8_STAGE(PG8_SB(0, 1), cB + hstep, voffB); PG8_STAGE(PG8_SA(0, 1), cA + hstep, voffA);
        if (wr == 1) PG8_BAR;
        PG8_WAIT_V(4); PG8_BAR;
        PG8_STAGE(PG8_SB(1, 0), cB + kstep, voffB); PG8_STAGE(PG8_SA(1, 0), cA + kstep, voffA); PG8_STAGE(PG8_SB(1, 1), cB + hstep + kstep, voffB);
        PG8_WAIT_V(6); PG8_BAR;
    }
    for (;;) {
        const bool has_next = S.next(ui + 1, nxt);
        const char* nA = has_next ? (const char*)g.A + (size_t)nxt.pm * tstep : cA; const char* nB = has_next ? (const char*)g.Bt + (size_t)nxt.pn * tstep : cB;
        for (int t = 0; t < nt; t += 2) {
            const bool last = (t == nt - 2);
            const char* a1 = cA + (size_t)(t + 1) * kstep;
            const char* a2 = last ? nA : cA + (size_t)(t + 2) * kstep; const char* b2 = last ? nB : cB + (size_t)(t + 2) * kstep;
            const char* a3 = a2 + kstep; const char* b3 = b2 + kstep;
            if (last && has_next) S.a_ready(nxt);
            if constexpr (SP2) {
            PG8_LDB(B0, 0, 0); PG8_LDB(B1, 0, 1); PG8_SCHED; PG8_LDA(At, 0, 0); PG8_STAGE(PG8_SA(1, 1), a1 + hstep, voffA);
            PG8_WAIT_V(8); PG8_WAIT_L(0); PG8_BAR; PG8_MMA(0, 0, At, B0); PG8_MMA(0, 1, At, B1); PG8_BAR; PG8_SCHED;
            PG8_LDA(At, 0, 1); PG8_STAGE(PG8_SB(0, 0), b2, voffB); PG8_STAGE(PG8_SB(0, 1), b2 + hstep, voffB); PG8_STAGE(PG8_SA(0, 0), a2, voffA);
            PG8_WAIT_V(8); PG8_WAIT_L(0); PG8_BAR; PG8_MMA(1, 0, At, B0); PG8_MMA(1, 1, At, B1); PG8_BAR; PG8_SCHED;
            PG8_LDB(B0, 1, 0); PG8_LDB(B1, 1, 1); PG8_SCHED; PG8_LDA(At, 1, 0); PG8_STAGE(PG8_SA(0, 1), a2 + hstep, voffA);
            PG8_WAIT_V(8); PG8_WAIT_L(0); PG8_BAR; PG8_MMA(0, 0, At, B0); PG8_MMA(0, 1, At, B1); PG8_BAR; PG8_SCHED;
            PG8_LDA(At, 1, 1); PG8_STAGE(PG8_SB(1, 0), b3, voffB); PG8_STAGE(PG8_SB(1, 1), b3 + hstep, voffB); PG8_STAGE(PG8_SA(1, 0), a3, voffA);
            PG8_WAIT_V(8); PG8_WAIT_L(0); PG8_BAR; PG8_MMA(1, 0, At, B0); PG8_MMA(1, 1, At, B1); PG8_BAR; PG8_SCHED;
            } else {
            PG8_LDB(B0, 0, 0); PG8_SCHED; PG8_LDA(At, 0, 0); PG8_STAGE(PG8_SA(1, 1), a1 + hstep, voffA);
            PG8_WAIT_L(8); PG8_BAR; PG8_WAIT_L(0); PG8_MMA(0, 0, At, B0); PG8_BAR; PG8_SCHED;
            PG8_LDB(B1, 0, 1); PG8_STAGE(PG8_SB(0, 0), b2, voffB);
            PG8_BAR; PG8_WAIT_L(0); PG8_MMA(0, 1, At, B1); PG8_BAR;
            PG8_LDA(At, 0, 1); PG8_STAGE(PG8_SA(0, 0), a2, voffA);
            PG8_BAR; PG8_WAIT_L(0); PG8_MMA(1, 0, At, B0); PG8_BAR; PG8_SCHED;
            PG8_STAGE(PG8_SB(0, 1), b2 + hstep, voffB);
            PG8_WAIT_V(6); PG8_BAR; PG8_MMA(1, 1, At, B1); PG8_BAR;
            PG8_LDB(B0, 1, 0); PG8_SCHED; PG8_LDA(At, 1, 0); PG8_STAGE(PG8_SA(0, 1), a2 + hstep, voffA);
            PG8_WAIT_L(8); PG8_BAR; PG8_WAIT_L(0); PG8_MMA(0, 0, At, B0); PG8_BAR; PG8_SCHED;
            PG8_LDB(B1, 1, 1); PG8_STAGE(PG8_SB(1, 0), b3, voffB);
            PG8_BAR; PG8_WAIT_L(0); PG8_MMA(0, 1, At, B1); PG8_BAR;
            PG8_LDA(At, 1, 1); PG8_STAGE(PG8_SA(1, 0), a3, voffA);
            PG8_BAR; PG8_WAIT_L(0); PG8_MMA(1, 0, At, B0); PG8_BAR; PG8_SCHED;
            PG8_STAGE(PG8_SB(1, 1), b3 + hstep, voffB);
            PG8_WAIT_V(6); PG8_BAR; PG8_MMA(1, 1, At, B1); PG8_BAR;
            }
        }
        if constexpr (ALIGN_EPI) { if (wr == 0) PG8_BAR; }
        if constexpr (!Epi::AFTER_DRAIN) { E(acc, cur, wr, wc, fr, fq); S.done(cur); }
        if (!has_next) break;
#pragma unroll
        for (int a = 0; a < 2; ++a)
#pragma unroll
            for (int b = 0; b < 2; ++b)
#pragma unroll
                for (int m = 0; m < 4; ++m)
#pragma unroll
                    for (int n = 0; n < 2; ++n) acc[a][b][m][n] = (f32x4){0.f, 0.f, 0.f, 0.f};
        cur = nxt; cA = nA; cB = nB; ++ui;
        if constexpr (ALIGN_EPI) { if (wr == 1) PG8_BAR; }
    }
    PG8_WAIT_V(0);
    if constexpr (!ALIGN_EPI) { if (wr == 0) PG8_BAR; }
    PG8_BAR;
    if constexpr (Epi::AFTER_DRAIN) { E.fused(acc, cur, wr, wc, fr, fq, lds, wid, lane); S.done(cur); }
#undef PG8_SA
#undef PG8_SB
#undef PG8_STAGE
#undef PG8_LDA
#undef PG8_LDB
#undef PG8_MMA
#undef PG8_WAIT_V
#undef PG8_WAIT_L
#undef PG8_BAR
#undef PG8_SCHED
}
}

constexpr int NWAVES = 8;
constexpr int BATCH = 4, SEQ = 8192, D = 1024, M = BATCH * SEQ;
constexpr int PIN = 3592, NP = 3584;
constexpr int FF = 2816, NCH = 128, NBH = 16;
constexpr int PH_END = 12;
constexpr float EPS = 1e-6f;
constexpr size_t MiB = 1u << 20;
constexpr size_t WS_MOD = 1 * MiB;
constexpr size_t WS_GB = 2 * MiB;
constexpr size_t WS_EGL = 3 * MiB;
constexpr size_t WS_WIN = 4 * MiB, WS_WO = 11 * MiB, WS_WGU = 13 * MiB, WS_WD = 24 * MiB;
constexpr size_t WS_H = 32 * MiB;
constexpr size_t WS_CH = 32 * MiB;
constexpr size_t WS_P = 208 * MiB;
constexpr size_t WS_YC = 432 * MiB;
constexpr size_t WS_END = 496 * MiB;
constexpr int REC = 74752;
constexpr int REC_A = 57344;
constexpr int LDS_BYTES = 155648;

#define LAS __attribute__((address_space(3)))
typedef unsigned short bf16;
typedef unsigned v4u __attribute__((ext_vector_type(4)));
typedef unsigned v2u __attribute__((ext_vector_type(2)));
typedef float f32x4 __attribute__((ext_vector_type(4)));
typedef float f32x16 __attribute__((ext_vector_type(16)));
typedef short bf16x8 __attribute__((ext_vector_type(8)));
#define LDS_WAIT() asm volatile("s_waitcnt lgkmcnt(0)" ::: "memory")
using pg8::cvt_pk_bf16; using pg8::silu_f;
__device__ __forceinline__ float bf2f(unsigned short u) { return __uint_as_float((unsigned)u << 16); }
__device__ __forceinline__ float bflo(unsigned w) { return __uint_as_float(w << 16); }
__device__ __forceinline__ float bfhi(unsigned w) { return __uint_as_float(w & 0xffff0000u); }
__device__ __forceinline__ float wave_sum(float v) {
#pragma unroll
    for (int o = 1; o < 64; o <<= 1) v += __shfl_xor(v, o);
    return v;
}
__device__ __forceinline__ void unpack8(v4u w, float (&f)[8]) { f[0] = bflo(w.x); f[1] = bfhi(w.x); f[2] = bflo(w.y); f[3] = bfhi(w.y); f[4] = bflo(w.z); f[5] = bfhi(w.z); f[6] = bflo(w.w); f[7] = bfhi(w.w); }
__device__ __forceinline__ v4u pack8(const float (&f)[8]) { v4u w; w.x = cvt_pk_bf16(f[0], f[1]); w.y = cvt_pk_bf16(f[2], f[3]); w.z = cvt_pk_bf16(f[4], f[5]); w.w = cvt_pk_bf16(f[6], f[7]); return w; }

struct Args { const float* in[19]; float* out; unsigned char* ws; int ph_lo, ph_hi; };
enum { I_X = 0, I_C, I_WADA, I_BADA, I_WADAF, I_BADAF, I_GMIX, I_GFFN, I_GFIN, I_WIN, I_CWM, I_CWQ, I_ALOG, I_DTB, I_GCO, I_GDN, I_WOUT, I_WGU, I_WDN };

template <int MODE>
__device__ __forceinline__ void p0_transpose_item(const float* W, int K, int ld, int nblk, bf16* WT, LAS float* scr, int item, int lane) {
    const int kb = item / nblk, nb = item % nblk, k0 = 64 * kb, n0 = 32 * nb;
    f32x4 ld4[8];
#pragma unroll
    for (int i = 0; i < 8; ++i) ld4[i] = *(const f32x4*)(W + (size_t)(k0 + 8 * i + (lane >> 3)) * ld + n0 + 4 * (lane & 7));
#pragma unroll
    for (int i = 0; i < 8; ++i) { LAS float* d = scr + (8 * i + (lane >> 3)) * 33 + 4 * (lane & 7); d[0] = ld4[i].x; d[1] = ld4[i].y; d[2] = ld4[i].z; d[3] = ld4[i].w; }
    LDS_WAIT(); asm volatile("" ::: "memory");
    int r0 = n0;
    if (MODE == 1) { r0 = n0 < FF ? 256 * (n0 / 128) + (n0 % 128) : 256 * ((n0 - FF) / 128) + 128 + ((n0 - FF) % 128); }
    const int c = lane & 7;
#pragma unroll
    for (int j = 0; j < 4; ++j) { const int n = (lane >> 3) + 8 * j; const LAS float* s = scr + (8 * c) * 33 + n;
        v4u o; o.x = cvt_pk_bf16(s[0 * 33], s[1 * 33]); o.y = cvt_pk_bf16(s[2 * 33], s[3 * 33]); o.z = cvt_pk_bf16(s[4 * 33], s[5 * 33]); o.w = cvt_pk_bf16(s[6 * 33], s[7 * 33]);
        *(v4u*)(WT + (size_t)(r0 + n) * K + k0 + 8 * c) = o; }
    LDS_WAIT(); asm volatile("" ::: "memory");
}
__device__ __forceinline__ void p0_mod_item(const Args& a, float* MOD, const LAS float* SC, LAS float* red, int item, int tid) {
    const int c4 = tid & 7, ks = tid >> 3, col0 = item * 32;
    const bool fin = col0 >= 6144; const float* W = fin ? a.in[I_WADAF] : a.in[I_WADA]; const int ld = fin ? 2048 : 6144, cb = (fin ? col0 - 6144 : col0);
    f32x4 w[16];
#pragma unroll
    for (int kk = 0; kk < 16; ++kk) w[kk] = *(const f32x4*)(W + (size_t)(16 * ks + kk) * ld + cb + 4 * c4);
    f32x4 acc[4];
#pragma unroll
    for (int b = 0; b < 4; ++b) acc[b] = (f32x4){0.f, 0.f, 0.f, 0.f};
#pragma unroll
    for (int kk = 0; kk < 16; ++kk) { const f32x4 s = *(const LAS f32x4*)(SC + (16 * ks + kk) * 4); acc[0] += s.x * w[kk]; acc[1] += s.y * w[kk]; acc[2] += s.z * w[kk]; acc[3] += s.w * w[kk]; }
#pragma unroll
    for (int b = 0; b < 4; ++b) *(LAS f32x4*)(red + (ks * 4 + b) * 32 + 4 * c4) = acc[b];
    __syncthreads();
    if (tid < 128) { const int b = tid >> 5, cl = tid & 31; float s = 0.f;
#pragma unroll 16
        for (int k = 0; k < 64; ++k) s += red[(k * 4 + b) * 32 + cl];
        const int c = cb + cl;
        s += fin ? a.in[I_BADAF][c] : a.in[I_BADA][c];
        if (fin) MOD[4 * 6144 + b * 2048 + c] = s; else MOD[b * 6144 + c] = s; }
    __syncthreads();
}

template <int MODE>
__device__ __forceinline__ void adaln_one(const f32x4 (&xin)[4], const f32x4 (&gs)[4], const f32x4 (&sh)[4], int m, bf16* Hout, float* Fout, const LAS float* TT, const float* a_log, const float* dt_bias, float* GB, int lane) {
    f32x4 v[4]; float ss = 0.f;
#pragma unroll
    for (int j = 0; j < 4; ++j) { v[j] = xin[j]; ss += (v[j].x * v[j].x + v[j].y * v[j].y) + (v[j].z * v[j].z + v[j].w * v[j].w); }
    const float rinv = 1.0f / sqrtf(wave_sum(ss) * (1.0f / D) + EPS);
#pragma unroll
    for (int j = 0; j < 4; ++j) v[j] = (v[j] * rinv) * gs[j] + sh[j];
    if (MODE == 2) { f32x4* o = (f32x4*)(Fout + (size_t)m * D) + lane;
#pragma unroll
        for (int j = 0; j < 4; ++j) o[64 * j] = v[j];
    } else { v2u* o = (v2u*)(Hout + (size_t)m * D) + lane;
#pragma unroll
        for (int j = 0; j < 4; ++j) { v2u w; w.x = cvt_pk_bf16(v[j].x, v[j].y); w.y = cvt_pk_bf16(v[j].z, v[j].w); o[64 * j] = w; } }
    if (MODE == 0) {
        float d[8];
#pragma unroll
        for (int e = 0; e < 8; ++e) { float s = 0.f;
#pragma unroll
            for (int j = 0; j < 4; ++j) { const f32x4 t = *(const LAS f32x4*)(TT + e * 1024 + 4 * (lane + 64 * j)); s += (v[j].x * t.x + v[j].y * t.y) + (v[j].z * t.z + v[j].w * t.w); }
            asm volatile("" : "+v"(s) :: "memory"); d[e] = s; }
        float k4[4], k2[2], k1;
        { const bool hi = (lane & 32) != 0;
#pragma unroll
          for (int i = 0; i < 4; ++i) { const float snd = hi ? d[i] : d[4 + i]; const float kp = hi ? d[4 + i] : d[i]; k4[i] = kp + __shfl_xor(snd, 32); } }
        { const bool hi = (lane & 16) != 0;
#pragma unroll
          for (int i = 0; i < 2; ++i) { const float snd = hi ? k4[i] : k4[2 + i]; const float kp = hi ? k4[2 + i] : k4[i]; k2[i] = kp + __shfl_xor(snd, 16); } }
        { const bool hi = (lane & 8) != 0; const float snd = hi ? k2[0] : k2[1]; const float kp = hi ? k2[1] : k2[0]; k1 = kp + __shfl_xor(snd, 8); }
        k1 += __shfl_xor(k1, 4); k1 += __shfl_xor(k1, 2); k1 += __shfl_xor(k1, 1);
        if ((lane & 7) == 0) { const int e = lane >> 3; float r;
            if (e < 4) { const float xx = k1 + dt_bias[e]; const float sp = fmaxf(xx, 0.f) + log1pf(__expf(-fabsf(xx))); r = -__expf(a_log[e]) * sp; }
            else r = 1.0f / (1.0f + __expf(-k1));
            GB[(size_t)m * 8 + e] = r; }
    }
}
template <int MODE>
__device__ __forceinline__ void adaln_rows(const float* X, const float* gain, const float* shiftp, const float* scalep, int mstride, bf16* Hout, float* Fout,
                                           const LAS float* TT, const float* a_log, const float* dt_bias, float* GB, int gw, int NGW, int lane) {
    for (int blk = gw; blk < M / 16; blk += NGW) {
        const int m0 = blk * 16, b = m0 >> 13;
        f32x4 gs[4], sh[4];
        { const f32x4* g4 = (const f32x4*)gain + lane; const f32x4* sh4 = (const f32x4*)(shiftp + (size_t)b * mstride) + lane; const f32x4* sc4 = (const f32x4*)(scalep + (size_t)b * mstride) + lane;
#pragma unroll
          for (int j = 0; j < 4; ++j) { gs[j] = g4[64 * j] * (1.0f + sc4[64 * j]); sh[j] = sh4[64 * j]; } }
        f32x4 c0[4], c1[4];
        { const f32x4* xr = (const f32x4*)(X + (size_t)m0 * D) + lane;
#pragma unroll
          for (int j = 0; j < 4; ++j) { c0[j] = xr[64 * j]; c1[j] = xr[256 + 64 * j]; } }
#pragma unroll 1
        for (int i = 0; i < 16; i += 2) {
            f32x4 n0[4], n1[4];
            { const int mn = (i + 2 < 16) ? m0 + i + 2 : m0; const f32x4* xr = (const f32x4*)(X + (size_t)mn * D) + lane;
#pragma unroll
              for (int j = 0; j < 4; ++j) { n0[j] = xr[64 * j]; n1[j] = xr[256 + 64 * j]; } }
            adaln_one<MODE>(c0, gs, sh, m0 + i, Hout, Fout, TT, a_log, dt_bias, GB, lane);
            adaln_one<MODE>(c1, gs, sh, m0 + i + 1, Hout, Fout, TT, a_log, dt_bias, GB, lane);
#pragma unroll
            for (int j = 0; j < 4; ++j) { c0[j] = n0[j]; c1[j] = n1[j]; }
        }
    }
}

__device__ __forceinline__ void conv_qkv(const bf16* P, const float* cwq, bf16* QKV, int X, int t0, bool first, int lane) {
    const int colp = 1536 + 512 * X + 8 * lane, colo = 512 * X + 8 * lane;
    v4u raw[19];
#pragma unroll
    for (int t = 0; t < 19; ++t) { raw[t] = (v4u){0u, 0u, 0u, 0u}; if (t >= 3 || !first) raw[t] = *(const v4u*)(P + (size_t)(t0 - 3 + t) * NP + colp); }
    float w0[8], w1[8], w2[8], w3[8], h3[8], h2[8], h1[8];
#pragma unroll
    for (int e = 0; e < 8; ++e) { w0[e] = cwq[0 * 1536 + colo + e]; w1[e] = cwq[1 * 1536 + colo + e]; w2[e] = cwq[2 * 1536 + colo + e]; w3[e] = cwq[3 * 1536 + colo + e]; }
    unpack8(raw[0], h3); unpack8(raw[1], h2); unpack8(raw[2], h1);
#pragma unroll
    for (int t = 0; t < 16; ++t) { const int m = t0 + t; float x[8], y[8]; unpack8(raw[3 + t], x); float ss = 0.f;
#pragma unroll
        for (int e = 0; e < 8; ++e) { const float c = w0[e] * h3[e] + w1[e] * h2[e] + w2[e] * h1[e] + w3[e] * x[e]; y[e] = silu_f(c); ss += y[e] * y[e]; h3[e] = h2[e]; h2[e] = h1[e]; h1[e] = x[e]; }
        if (X < 2) { ss += __shfl_xor(ss, 1); ss += __shfl_xor(ss, 2); ss += __shfl_xor(ss, 4); ss += __shfl_xor(ss, 8);
            float r = 1.0f / sqrtf(ss + EPS); if (X == 0) r *= 0.08838834764831845f;
#pragma unroll
            for (int e = 0; e < 8; ++e) y[e] *= r; }
        *(v4u*)(QKV + (size_t)m * 1536 + colo) = pack8(y); }
}
__device__ __forceinline__ void conv_pass(const bf16* P, const float* cwm, const float* cwq, const float* gco, bf16* YC, bf16* QKV, int gw, int NGW, int lane) {
    for (int run = gw; run < M / 16; run += NGW) {
        const int t0 = run * 16; const bool first = (t0 & (SEQ - 1)) == 0;
        { float w0[8], w1[8], w2[8], gc[8], u2[8], u1[8]; const int c0 = 8 * lane;
#pragma unroll
          for (int e = 0; e < 8; ++e) { w0[e] = cwm[c0 + e]; w1[e] = cwm[512 + c0 + e]; w2[e] = cwm[1024 + c0 + e]; gc[e] = gco[c0 + e]; u2[e] = 0.f; u1[e] = 0.f; }
          if (!first) { float a[8], b[8]; unpack8(*(const v4u*)(P + (size_t)(t0 - 2) * NP + 512 + c0), a); unpack8(*(const v4u*)(P + (size_t)(t0 - 2) * NP + 1024 + c0), b);
#pragma unroll
              for (int e = 0; e < 8; ++e) u2[e] = a[e] * b[e];
              unpack8(*(const v4u*)(P + (size_t)(t0 - 1) * NP + 512 + c0), a); unpack8(*(const v4u*)(P + (size_t)(t0 - 1) * NP + 1024 + c0), b);
#pragma unroll
              for (int e = 0; e < 8; ++e) u1[e] = a[e] * b[e]; }
#pragma unroll 1
          for (int tb = 0; tb < 16; tb += 8) {
              v4u rb[8], rc[8], rh[8];
#pragma unroll
              for (int t = 0; t < 8; ++t) { const bf16* pr = P + (size_t)(t0 + tb + t) * NP + c0; rb[t] = *(const v4u*)pr; rc[t] = *(const v4u*)(pr + 512); rh[t] = *(const v4u*)(pr + 1024); }
#pragma unroll
              for (int t = 0; t < 8; ++t) { const int m = t0 + tb + t; float gb[8], a[8], b[8], y[8]; unpack8(rb[t], gb); unpack8(rc[t], a); unpack8(rh[t], b); float ss = 0.f;
#pragma unroll
                  for (int e = 0; e < 8; ++e) { const float u0 = a[e] * b[e]; y[e] = gb[e] * (w0[e] * u2[e] + w1[e] * u1[e] + w2[e] * u0); ss += y[e] * y[e]; u2[e] = u1[e]; u1[e] = u0; }
                  ss += __shfl_xor(ss, 1); ss += __shfl_xor(ss, 2); ss += __shfl_xor(ss, 4);
                  const float r = 1.0f / sqrtf(ss * (1.0f / 64.0f) + EPS);
#pragma unroll
                  for (int e = 0; e < 8; ++e) y[e] = y[e] * r * gc[e];
                  *(v4u*)(YC + (size_t)m * D + c0) = pack8(y); } } }
        conv_qkv(P, cwq, QKV, 0, t0, first, lane); conv_qkv(P, cwq, QKV, 1, t0, first, lane); conv_qkv(P, cwq, QKV, 2, t0, first, lane);
    }
}


constexpr int PREP_HALF = 69632, PK_KN = 0, PK_QN = 17408, PK_VV = 34816, PK_LM = 52224, PK_GC = 68608, PK_BT = 68864, PK_EG = 69120, PROW = 272;
template <bool SC>
__device__ __forceinline__ v4u afrag_piece_rows(const LAS unsigned char* tile, const LAS float* sc, int p) {
    const int f = p >> 6, ln = p & 63, mt = f >> 3, kt = (f >> 1) & 3, s = f & 1, r = ln & 31, hh = ln >> 5, row = 32 * mt + r, kb = 32 * kt + 16 * s + 4 * hh;
    const v2u a = *(const LAS v2u*)(tile + row * PROW + kb * 2), b = *(const LAS v2u*)(tile + row * PROW + (kb + 8) * 2);
    float scv = 1.0f; if (SC) scv = sc[row];
    v4u o; o.x = cvt_pk_bf16(bflo(a.x) * scv, bfhi(a.x) * scv); o.y = cvt_pk_bf16(bflo(a.y) * scv, bfhi(a.y) * scv); o.z = cvt_pk_bf16(bflo(b.x) * scv, bfhi(b.x) * scv); o.w = cvt_pk_bf16(bflo(b.y) * scv, bfhi(b.y) * scv);
    return o;
}
#define LBAR() do { asm volatile("s_waitcnt lgkmcnt(0)" ::: "memory"); __builtin_amdgcn_s_barrier(); asm volatile("" ::: "memory"); } while (0)
__device__ __forceinline__ void st_wt16(void* p, v4u v) { asm volatile("global_store_dwordx4 %0, %1, off sc1\n\ts_nop 1" :: "v"(p), "v"(v) : "memory"); }
__device__ __forceinline__ void st_wt4(void* p, float v) { asm volatile("global_store_dword %0, %1, off sc1\n\ts_nop 1" :: "v"(p), "v"(v) : "memory"); }
__device__ __forceinline__ void prep_phase(LAS unsigned char* lds, const bf16* QKV, const float* GB, float* EGL, unsigned char* CH, unsigned* FLG, int ublk, int nblk, int tid) {
    const int half = tid >> 8, t = tid & 255, lane = tid & 63, w = (tid >> 6) & 3, r = lane & 31, hh = lane >> 5;
    LAS unsigned char* L = lds + half * PREP_HALF;
    LAS float* LM = (LAS float*)(L + PK_LM); LAS float* GC = (LAS float*)(L + PK_GC); LAS float* BT = (LAS float*)(L + PK_BT); LAS float* EG = (LAS float*)(L + PK_EG);
    for (int pu = ublk; pu < NBH * NCH / 2; pu += nblk) {
        const int n = pu >> 3, bh = 2 * (pu & 7) + half, cid = bh * NCH + n, b = bh >> 2, h = bh & 3, m0 = b * SEQ + n * 64;
        unsigned char* rec = CH + (size_t)cid * REC;
        LBAR();
#pragma unroll
        for (int X = 0; X < 3; ++X)
#pragma unroll
            for (int i = 0; i < 4; ++i) { const int p = t + 256 * i, row = p >> 4, c16 = p & 15;
                const v4u v = *(const v4u*)(QKV + (size_t)(m0 + row) * 1536 + 512 * X + 128 * h + 8 * c16);
                *(LAS v4u*)(L + (X == 0 ? PK_QN : (X == 1 ? PK_KN : PK_VV)) + row * PROW + c16 * 16) = v; }
        if (w == 0) { float g = GB[(size_t)(m0 + lane) * 8 + h];
#pragma unroll
            for (int d = 1; d < 64; d <<= 1) { const float o = __shfl_up(g, d); if (lane >= d) g += o; }
            GC[lane] = g; EG[lane] = __expf(g); BT[lane] = GB[(size_t)(m0 + lane) * 8 + 4 + h];
            if (lane == 63) st_wt4(rec + 73728, __expf(g)); }
        LBAR();
        { const int mi = w >> 1, nj = w & 1;
          f32x16 kk, qk;
#pragma unroll
          for (int i = 0; i < 16; ++i) { kk[i] = 0.f; qk[i] = 0.f; }
#pragma unroll
          for (int st = 0; st < 8; ++st) {
              const bf16x8 ka = *(const LAS bf16x8*)(L + PK_KN + (32 * mi + r) * PROW + (16 * st + 8 * hh) * 2);
              const bf16x8 kb = *(const LAS bf16x8*)(L + PK_KN + (32 * nj + r) * PROW + (16 * st + 8 * hh) * 2);
              const bf16x8 qb = *(const LAS bf16x8*)(L + PK_QN + (32 * mi + r) * PROW + (16 * st + 8 * hh) * 2);
              kk = __builtin_amdgcn_mfma_f32_32x32x16_bf16(ka, kb, kk, 0, 0, 0);
              qk = __builtin_amdgcn_mfma_f32_32x32x16_bf16(kb, qb, qk, 0, 0, 0);
          }
          const float gj = GC[32 * nj + r], gq = GC[32 * mi + r];
          float av[16];
#pragma unroll
          for (int reg = 0; reg < 16; ++reg) { const int cr = (reg & 3) + 8 * (reg >> 2) + 4 * hh;
              const int i = 32 * mi + cr, j = 32 * nj + r;
              LM[i * 64 + j] = (i > j) ? BT[i] * kk[reg] * __expf(GC[i] - gj) : 0.f;
              const int key = 32 * nj + cr, qr = 32 * mi + r;
              av[reg] = (qr >= key) ? qk[reg] * __expf(gq - GC[key]) : 0.f; }
#pragma unroll
          for (int s = 0; s < 2; ++s) { v4u o; o.x = cvt_pk_bf16(av[8 * s], av[8 * s + 1]); o.y = cvt_pk_bf16(av[8 * s + 2], av[8 * s + 3]); o.z = cvt_pk_bf16(av[8 * s + 4], av[8 * s + 5]); o.w = cvt_pk_bf16(av[8 * s + 6], av[8 * s + 7]);
              st_wt16(rec + 49152 + ((mi * 2 + nj) * 2 + s) * 1024 + lane * 16, o); }
        }
#pragma unroll
        for (int i = 0; i < 4; ++i) { const int p = t + 256 * i; st_wt16(rec + 16384 + p * 16, afrag_piece_rows<true>(L + PK_QN, EG, p)); }
        { const float gl = GC[63];
#pragma unroll
          for (int i = 0; i < 4; ++i) { const int p = t + 256 * i, f = p >> 6, ln = p & 63, mt = f >> 2, ct = (f >> 1) & 1, s = f & 1, dk = 32 * mt + (ln & 31), cb = 32 * ct + 16 * s + 4 * (ln >> 5);
              float e[8];
#pragma unroll
              for (int j = 0; j < 8; ++j) { const int c = cb + 8 * (j >> 2) + (j & 3); e[j] = bf2f(*(const LAS unsigned short*)(L + PK_KN + c * PROW + dk * 2)) * __expf(gl - GC[c]); }
              st_wt16(rec + 32768 + p * 16, pack8(e)); } }
        LBAR();
        { float X[64]; const bool isu = t < 128; const int col = t & 127;
          const LAS unsigned char* src = L + (isu ? PK_VV : PK_KN) + col * 2;
#pragma unroll
          for (int i = 0; i < 64; ++i) {
              const float egi = EG[i]; const float rhs = bf2f(*(const LAS unsigned short*)(src + i * PROW)) * BT[i] * (isu ? 1.0f : egi);
              float a0 = 0.f, a1 = 0.f, a2 = 0.f, a3 = 0.f;
#pragma unroll
              for (int j4 = 0; j4 < (i + 3) / 4; ++j4) { const f32x4 l = *(const LAS f32x4*)(LM + i * 64 + 4 * j4);
                  if (4 * j4 + 0 < i) a0 += l.x * X[4 * j4 + 0]; if (4 * j4 + 1 < i) a1 += l.y * X[4 * j4 + 1]; if (4 * j4 + 2 < i) a2 += l.z * X[4 * j4 + 2]; if (4 * j4 + 3 < i) a3 += l.w * X[4 * j4 + 3]; }
              X[i] = rhs - ((a0 + a1) + (a2 + a3)); asm volatile("" : "+v"(X[i]) :: "memory"); }
          LBAR();
          if (isu) { const int vs = col >> 5, dvl = col & 31;
#pragma unroll
              for (int mt = 0; mt < 2; ++mt)
#pragma unroll
                  for (int h2 = 0; h2 < 2; ++h2) { v4u* dst = (v4u*)(rec + REC_A + (size_t)(((vs * 2 + mt) * 64 + dvl + 32 * h2) * 32));
#pragma unroll
                      for (int a2 = 0; a2 < 2; ++a2) { const int i0 = 32 * mt + 4 * h2 + 16 * a2; v4u w;
                          w.x = cvt_pk_bf16(X[i0], X[i0 + 1]); w.y = cvt_pk_bf16(X[i0 + 2], X[i0 + 3]); w.z = cvt_pk_bf16(X[i0 + 8], X[i0 + 9]); w.w = cvt_pk_bf16(X[i0 + 10], X[i0 + 11]); st_wt16(dst + a2, w); } }
          } else {
#pragma unroll
              for (int i = 0; i < 64; ++i) *(LAS unsigned short*)(L + PK_VV + i * PROW + col * 2) = (unsigned short)(cvt_pk_bf16(-X[i], 0.f) & 0xffffu);
          }
        }
        LBAR();
#pragma unroll
        for (int i = 0; i < 4; ++i) { const int p = t + 256 * i; st_wt16(rec + p * 16, afrag_piece_rows<false>(L + PK_VV, EG, p)); }
        asm volatile("s_waitcnt vmcnt(0)" ::: "memory"); __syncthreads();
        if (tid == 0) {
            __hip_atomic_store(FLG + (2 * (pu & 7)) * NCH + n, 1u, __ATOMIC_RELAXED, __HIP_MEMORY_SCOPE_AGENT); __hip_atomic_store(FLG + (2 * (pu & 7) + 1) * NCH + n, 1u, __ATOMIC_RELAXED, __HIP_MEMORY_SCOPE_AGENT); }
    }
}

__device__ __forceinline__ bf16x8 pack_acc(const f32x16& x, int s) {
    v4u p; p.x = cvt_pk_bf16(x[8 * s], x[8 * s + 1]); p.y = cvt_pk_bf16(x[8 * s + 2], x[8 * s + 3]); p.z = cvt_pk_bf16(x[8 * s + 4], x[8 * s + 5]); p.w = cvt_pk_bf16(x[8 * s + 6], x[8 * s + 7]);
    return __builtin_bit_cast(bf16x8, p);
}
#define MFMA32(a, b, c) __builtin_amdgcn_mfma_f32_32x32x16_bf16((a), (b), (c), 0, 0, 0)
#define PIN_SCHED() __builtin_amdgcn_sched_barrier(0)
__device__ __forceinline__ int chain_ready(const unsigned* fl, int have, int lane) {
    for (;;) {
        const int idx = have + 1 + lane;
        const unsigned f = (idx < NCH) ? __hip_atomic_load(fl + idx, __ATOMIC_RELAXED, __HIP_MEMORY_SCOPE_AGENT) : 0u;
        const unsigned long long m = __ballot(f != 0u);
        const int pre = (m == ~0ull) ? 64 : __builtin_ctzll(~m);
        if (pre > 0) { __builtin_amdgcn_fence(__ATOMIC_ACQUIRE, "agent"); asm volatile("s_waitcnt vmcnt(0)" ::: "memory"); return have + pre; }
        __builtin_amdgcn_s_sleep(16);
    }
}
__device__ __forceinline__ void chain_phase(LAS unsigned char* lds, const unsigned char* CH, const unsigned* FLG, bf16* Oraw, int bh, int tid) {
    const int wid = __builtin_amdgcn_readfirstlane(tid >> 6), lane = tid & 63, b = bh >> 2, h = bh & 3, vs = wid & 3;
    const unsigned char* rec0 = CH + (size_t)bh * NCH * REC;
    const bool comp = wid < 4, stager = (wid >= 4);
    const int hw = wid - 4;
#define CH_MOVE(n, dstbase) do { _Pragma("unroll") for (int _i = 0; _i < 19; ++_i) { const int _pc = hw * 19 + _i; if (_pc < 73) \
        __builtin_amdgcn_global_load_lds((const unsigned*)(rec0 + (size_t)(n) * REC + _pc * 1024 + lane * 16), (LAS unsigned*)((dstbase) + _pc * 1024), 16, 0, 0); } } while (0)
#define CH_WARM(n) do { _Pragma("unroll") for (int _i = 0; _i < 10; ++_i) { const int _o = (_i * 64 + lane) * 128; \
        __builtin_amdgcn_global_load_lds((const unsigned*)(rec0 + (size_t)(n) * REC + (_o < REC ? _o : 0)), (LAS unsigned*)(dummy), 4, 0, 0); } } while (0)
    constexpr int WARM_AHEAD = 8;
    LAS unsigned char* dummy = lds + 2 * REC;
    f32x16 S[4], o0, o1;
#pragma unroll
    for (int k = 0; k < 4; ++k)
#pragma unroll
        for (int i = 0; i < 16; ++i) S[k][i] = 0.f;
#pragma unroll
    for (int i = 0; i < 16; ++i) { o0[i] = 0.f; o1[i] = 0.f; }
    const unsigned* fl = FLG + bh * NCH; int have = -1;
    if (stager) { while (have < 0) have = chain_ready(fl, have, lane); CH_MOVE(0, lds); }
    if (!comp) asm volatile("s_waitcnt vmcnt(0)" ::: "memory");
    __builtin_amdgcn_s_barrier(); asm volatile("" ::: "memory");
    for (int n = 0; n < NCH; ++n) {
        const int buf = n & 1;
        if (!comp) {
            if (stager) { if (n + 1 < NCH) { while (have < n + 1) have = chain_ready(fl, have, lane); CH_MOVE(n + 1, lds + (buf ^ 1) * REC); } asm volatile("s_waitcnt vmcnt(0)" ::: "memory"); }
            else { const int wn = n + 1 + WARM_AHEAD; if (wn < NCH) { if (have < wn) { const int idx = have + 1 + lane; const unsigned f = (idx < NCH) ? __hip_atomic_load(fl + idx, __ATOMIC_RELAXED, __HIP_MEMORY_SCOPE_AGENT) : 0u;
                        const unsigned long long m = __ballot(f != 0u); const int pre = (m == ~0ull) ? 64 : __builtin_ctzll(~m); if (pre > 0) { __builtin_amdgcn_fence(__ATOMIC_ACQUIRE, "agent"); have += pre; } }
                    if (have >= wn) CH_WARM(wn); }
                   asm volatile("s_waitcnt vmcnt(20)" ::: "memory"); }
        } else {
            const LAS unsigned char* B = lds + buf * REC + lane * 16;
            const float egl = *(const LAS float*)(lds + buf * REC + 73728);
            f32x16 v0, v1;
            { const LAS v4u* ul = (const LAS v4u*)(lds + buf * REC + 57344 + ((vs * 2) * 64 + lane) * 32);
              const v4u a0 = ul[0], a1 = ul[1], b0 = ul[128], b1 = ul[129];
              v0[0] = bflo(a0.x); v0[1] = bfhi(a0.x); v0[2] = bflo(a0.y); v0[3] = bfhi(a0.y); v0[4] = bflo(a0.z); v0[5] = bfhi(a0.z); v0[6] = bflo(a0.w); v0[7] = bfhi(a0.w);
              v0[8] = bflo(a1.x); v0[9] = bfhi(a1.x); v0[10] = bflo(a1.y); v0[11] = bfhi(a1.y); v0[12] = bflo(a1.z); v0[13] = bfhi(a1.z); v0[14] = bflo(a1.w); v0[15] = bfhi(a1.w);
              v1[0] = bflo(b0.x); v1[1] = bfhi(b0.x); v1[2] = bflo(b0.y); v1[3] = bfhi(b0.y); v1[4] = bflo(b0.z); v1[5] = bfhi(b0.z); v1[6] = bflo(b0.w); v1[7] = bfhi(b0.w);
              v1[8] = bflo(b1.x); v1[9] = bfhi(b1.x); v1[10] = bflo(b1.y); v1[11] = bfhi(b1.y); v1[12] = bflo(b1.z); v1[13] = bfhi(b1.z); v1[14] = bflo(b1.w); v1[15] = bfhi(b1.w); }
#pragma unroll
            for (int i = 0; i < 16; ++i) { o0[i] = 0.f; o1[i] = 0.f; }
#define LDF(dst, off) dst = *(const LAS bf16x8*)(B + (off))
#define LD_WQ(F, kt, s) do { LDF(F[0], ((0 * 4 + (kt)) * 2 + (s)) * 1024); LDF(F[1], ((1 * 4 + (kt)) * 2 + (s)) * 1024); LDF(F[2], 16384 + ((0 * 4 + (kt)) * 2 + (s)) * 1024); LDF(F[3], 16384 + ((1 * 4 + (kt)) * 2 + (s)) * 1024); } while (0)
#define MM_WQ(F, kt, s) do { const bf16x8 sb = pack_acc(S[kt], s); v0 = MFMA32(F[0], sb, v0); v1 = MFMA32(F[1], sb, v1); o0 = MFMA32(F[2], sb, o0); o1 = MFMA32(F[3], sb, o1); asm volatile("" : "+v"(o0), "+v"(o1)); } while (0)
#define LD_AT(F, ct) do { LDF(F[0], 49152 + ((0 * 2 + (ct)) * 2 + 0) * 1024); LDF(F[1], 49152 + ((1 * 2 + (ct)) * 2 + 0) * 1024); LDF(F[2], 49152 + ((0 * 2 + (ct)) * 2 + 1) * 1024); LDF(F[3], 49152 + ((1 * 2 + (ct)) * 2 + 1) * 1024); } while (0)
#define MM_AT(F, ct) do { o0 = MFMA32(F[0], vb[ct][0], o0); o1 = MFMA32(F[1], vb[ct][0], o1); o0 = MFMA32(F[2], vb[ct][1], o0); o1 = MFMA32(F[3], vb[ct][1], o1); } while (0)
#define LD_KD(F, ct, s) do { _Pragma("unroll") for (int q = 0; q < 4; ++q) LDF(F[q], 32768 + ((q * 2 + (ct)) * 2 + (s)) * 1024); } while (0)
#define MM_KD(F, ct, s) do { _Pragma("unroll") for (int q = 0; q < 4; ++q) S[q] = MFMA32(F[q], vb[ct][s], S[q]); } while (0)
            bf16x8 FA[4], FB[4];
            LD_WQ(FA, 0, 0); PIN_SCHED();
            LD_WQ(FB, 0, 1); PIN_SCHED(); MM_WQ(FA, 0, 0); PIN_SCHED();
            LD_WQ(FA, 1, 0); PIN_SCHED(); MM_WQ(FB, 0, 1); PIN_SCHED();
            LD_WQ(FB, 1, 1); PIN_SCHED(); MM_WQ(FA, 1, 0); PIN_SCHED();
            LD_WQ(FA, 2, 0); PIN_SCHED(); MM_WQ(FB, 1, 1); PIN_SCHED();
            LD_WQ(FB, 2, 1); PIN_SCHED(); MM_WQ(FA, 2, 0); PIN_SCHED();
            LD_WQ(FA, 3, 0); PIN_SCHED(); MM_WQ(FB, 2, 1); PIN_SCHED();
            LD_WQ(FB, 3, 1); PIN_SCHED(); MM_WQ(FA, 3, 0); PIN_SCHED();
            LD_AT(FA, 0); PIN_SCHED(); MM_WQ(FB, 3, 1); PIN_SCHED();
            bf16x8 vb[2][2];
            vb[0][0] = pack_acc(v0, 0); vb[0][1] = pack_acc(v0, 1); vb[1][0] = pack_acc(v1, 0); vb[1][1] = pack_acc(v1, 1);
            LD_AT(FB, 1); PIN_SCHED(); MM_AT(FA, 0); PIN_SCHED();
#pragma unroll
            for (int kt = 0; kt < 4; ++kt)
#pragma unroll
                for (int i = 0; i < 16; ++i) S[kt][i] *= egl;
            LD_KD(FA, 0, 0); PIN_SCHED(); MM_AT(FB, 1); PIN_SCHED();
            { bf16* op = Oraw + (size_t)(b * SEQ + n * 64 + 4 * (lane >> 5)) * 512 + h * 128 + vs * 32 + (lane & 31); asm volatile("" : "+v"(op));
#pragma unroll
              for (int reg = 0; reg < 16; ++reg) { const int cr = (reg & 3) + 8 * (reg >> 2); const unsigned pk = cvt_pk_bf16(o0[reg], o1[reg]); op[cr * 512] = (bf16)(pk & 0xffffu); op[(32 + cr) * 512] = (bf16)(pk >> 16); } }
            PIN_SCHED();
            LD_KD(FB, 0, 1); PIN_SCHED(); MM_KD(FA, 0, 0); PIN_SCHED();
            LD_KD(FA, 1, 0); PIN_SCHED(); MM_KD(FB, 0, 1); PIN_SCHED();
            LD_KD(FB, 1, 1); PIN_SCHED(); MM_KD(FA, 1, 0); PIN_SCHED();
            MM_KD(FB, 1, 1);
#undef MM_AT
#undef MM_KD
#undef LDF
#undef LD_WQ
#undef MM_WQ
#undef LD_AT
#undef LD_KD
            asm volatile("s_waitcnt lgkmcnt(0)" ::: "memory");
        }
        __builtin_amdgcn_s_barrier(); asm volatile("" ::: "memory");
    }
    asm volatile("s_waitcnt vmcnt(0)" ::: "memory");
#undef CH_MOVE
#undef CH_WARM
}
#if DN_NAIVE
__device__ __forceinline__ void naive_dn(const bf16* QKV, const float* GB, float* Oraw, int unit, int lane) {
    const int bh = unit >> 1, dv = (unit & 1) * 64 + lane, b = bh >> 2, h = bh & 3;
    float S[128];
#pragma unroll
    for (int i = 0; i < 128; ++i) S[i] = 0.f;
    for (int t = 0; t < SEQ; ++t) { const size_t m = (size_t)b * SEQ + t;
        const float al = __expf(GB[m * 8 + h]), be = GB[m * 8 + 4 + h];
        const bf16* qp = QKV + m * 1536 + h * 128; const bf16* kp = qp + 512; const float v = bf2f(qp[1024 + dv]);
        float r = 0.f;
#pragma unroll
        for (int i = 0; i < 128; ++i) { S[i] *= al; r += bf2f(kp[i]) * S[i]; if ((i & 15) == 15) asm volatile("" : "+v"(r) :: "memory"); }
        const float d = be * (v - r); float o = 0.f;
#pragma unroll
        for (int i = 0; i < 128; ++i) { S[i] += bf2f(kp[i]) * d; o += bf2f(qp[i]) * S[i]; if ((i & 15) == 15) asm volatile("" : "+v"(o) :: "memory"); }
        Oraw[m * 512 + h * 128 + dv] = o; }
}
#endif
template <bool OB16>
__device__ __forceinline__ void opost_rows(const void* Oraw_, const bf16* P, const float* gdn, bf16* YC, int gw, int NGW, int lane) {
    const float* Oraw = (const float*)Oraw_; const bf16* Ob = (const bf16*)Oraw_;
    float gd[8];
#pragma unroll
    for (int e = 0; e < 8; ++e) gd[e] = gdn[(8 * lane + e) & 127];
    for (int blk = gw; blk < M / 16; blk += NGW) { const int m0 = blk * 16;
#pragma unroll 1
        for (int i = 0; i < 16; i += 8) {
            f32x4 oa[8], ob[8]; v4u zz[8];
#pragma unroll
            for (int t = 0; t < 8; ++t) { const int m = m0 + i + t;
                if (OB16) { float f[8]; unpack8(*(const v4u*)(Ob + (size_t)m * 512 + 8 * lane), f); oa[t] = (f32x4){f[0], f[1], f[2], f[3]}; ob[t] = (f32x4){f[4], f[5], f[6], f[7]}; }
                else { const f32x4* op = (const f32x4*)(Oraw + (size_t)m * 512 + 8 * lane); oa[t] = op[0]; ob[t] = op[1]; }
                zz[t] = *(const v4u*)(P + (size_t)m * NP + 3072 + 8 * lane); }
#pragma unroll
            for (int t = 0; t < 8; ++t) { const int m = m0 + i + t; float z[8]; unpack8(zz[t], z);
                float o[8] = {oa[t].x, oa[t].y, oa[t].z, oa[t].w, ob[t].x, ob[t].y, ob[t].z, ob[t].w}; float ss = 0.f;
#pragma unroll
                for (int e = 0; e < 8; ++e) ss += o[e] * o[e];
                ss += __shfl_xor(ss, 1); ss += __shfl_xor(ss, 2); ss += __shfl_xor(ss, 4); ss += __shfl_xor(ss, 8);
                const float r = 1.0f / sqrtf(ss * (1.0f / 128.0f) + EPS);
#pragma unroll
                for (int e = 0; e < 8; ++e) o[e] = o[e] * r * gd[e] * silu_f(z[e]);
                *(v4u*)(YC + (size_t)m * D + 512 + 8 * lane) = pack8(o); } } }
}

typedef __attribute__((address_space(1))) unsigned gu32;
#define XB_TMO      128
#define XB_XCNT(j)  (256  + 64 * (j))
#define XB_XSUB(j)  (1280 + 64 * (j))
#define XB_XGEN(j)  (2304 + 64 * (j))
#define XB_TOP      3328
#define XB_TOPGEN   3392
#define XCD_BAR_WORDS 3456
#define XB_SPIN_CAP (1u << 18)

__device__ __forceinline__ unsigned xb_ld(unsigned* p)              { return __hip_atomic_load(p, __ATOMIC_RELAXED, __HIP_MEMORY_SCOPE_AGENT); }
__device__ __forceinline__ unsigned xb_add(unsigned* p, unsigned v) { return __hip_atomic_fetch_add(p, v, __ATOMIC_RELAXED, __HIP_MEMORY_SCOPE_AGENT); }
__device__ __forceinline__ unsigned xb_xcc_id() { return (unsigned)__builtin_amdgcn_s_getreg((3 << 11) | 20) & 0xFu; }
#define XB_SPIN(cond, bar) do { unsigned _sp = 0; while (cond) { __builtin_amdgcn_s_sleep(1); \
    if ((++_sp & 255u) == 0u) { if (xb_ld(&(bar)[XB_TMO])) break; if (_sp > XB_SPIN_CAP) { atomicAdd(&(bar)[XB_TMO], 1u); break; } } } } while (0)

struct XcdBarrier {
    unsigned* bar; unsigned x;
    volatile LAS unsigned* st;
};

__device__ __forceinline__ XcdBarrier xcd_barrier_post(unsigned* bar, volatile LAS unsigned* st) {
    XcdBarrier b; b.bar = bar; b.x = xb_xcc_id(); b.st = st;
    if (threadIdx.x == 0) (void)xb_add(&bar[XB_XCNT(b.x)], 1u);
    return b;
}
__device__ __forceinline__ void xcd_barrier_complete(unsigned* bar, unsigned x, unsigned& nloc, unsigned& nx) {
    const unsigned G = gridDim.x * gridDim.y * gridDim.z;
    unsigned sum, cnt, mine, sp = 0u;
    for (;;) {
        sum = 0u; cnt = 0u; mine = 0u;
#pragma unroll
        for (unsigned j = 0; j < 16; ++j) { const unsigned c = xb_ld(&bar[XB_XCNT(j)]); sum += c; cnt += (c > 0u) ? 1u : 0u; mine = (j == x) ? c : mine; }
        if (sum == G) break;
        __builtin_amdgcn_s_sleep(1);
        if ((++sp & 255u) == 0u) { if (xb_ld(&bar[XB_TMO])) break; if (sp > XB_SPIN_CAP) { atomicAdd(&bar[XB_TMO], 1u); break; } }
    }
    nloc = mine > 0u ? mine : 1u; nx = cnt > 0u ? cnt : 1u;
}

__device__ __forceinline__ void xcd_barrier(const XcdBarrier& b) {
    asm volatile("s_waitcnt vmcnt(0)" ::: "memory");
    __syncthreads();
    if (threadIdx.x == 0) {
        unsigned* bar = b.bar;
        __builtin_amdgcn_s_waitcnt(0);
        unsigned nloc = b.st[0], nx = b.st[1];
        if (nloc == 0u) { xcd_barrier_complete(bar, b.x, nloc, nx); b.st[0] = nloc; b.st[1] = nx; }
        const unsigned old = xb_add(&bar[XB_XSUB(b.x)], 1u);
        const unsigned gen = old / nloc;
        if (old + 1u == (gen + 1u) * nloc) {
            __builtin_amdgcn_fence(__ATOMIC_RELEASE, "agent");
            asm volatile("s_waitcnt vmcnt(0)" ::: "memory");
            const unsigned og = xb_add(&bar[XB_TOP], 1u);
            const unsigned tg = og / nx;
            if (og + 1u == (tg + 1u) * nx) xb_add(&bar[XB_TOPGEN], 1u);
            else XB_SPIN(xb_ld(&bar[XB_TOPGEN]) == tg, bar);
            __builtin_amdgcn_fence(__ATOMIC_ACQUIRE, "agent");
            xb_add(&bar[XB_XGEN(b.x)], 1u);
            asm volatile("s_waitcnt vmcnt(0)" ::: "memory");
        } else {
            XB_SPIN(xb_ld(&bar[XB_XGEN(b.x)]) == gen, bar);
            __builtin_amdgcn_fence(__ATOMIC_ACQUIRE, "agent");
            asm volatile("s_waitcnt vmcnt(0)" ::: "memory");
        }
    }
    __syncthreads();
}

__global__ void __launch_bounds__(NWAVES * 64, 2) fwd(Args args) {
    extern __shared__ __attribute__((aligned(16))) unsigned char lds_raw[];
    LAS unsigned char* lds = (LAS unsigned char*)lds_raw;
    int tid = threadIdx.x, lane = tid & 63, wave = __builtin_amdgcn_readfirstlane(tid >> 6);
    const int G = gridDim.x; const int bx = blockIdx.x; const int vcu = (G % 8 == 0) ? (bx % 8) * (G / 8) + bx / 8 : bx;
    int gw = vcu * NWAVES + wave; const int NGW = G * NWAVES;
#define LAUNDER() do { int tv_ = threadIdx.x; asm volatile("" : "+v"(tv_)); tid = tv_; lane = tid & 63; wave = __builtin_amdgcn_readfirstlane(tid >> 6); gw = vcu * NWAVES + wave; } while (0)
    unsigned char* ws = args.ws;
    float* MOD = (float*)(ws + WS_MOD); float* GB = (float*)(ws + WS_GB); float* EGL = (float*)(ws + WS_EGL);
    bf16* WinT = (bf16*)(ws + WS_WIN); bf16* WoT = (bf16*)(ws + WS_WO); bf16* WguT = (bf16*)(ws + WS_WGU); bf16* WdT = (bf16*)(ws + WS_WD);
    bf16* H = (bf16*)(ws + WS_H); unsigned char* CH = ws + WS_CH; bf16* P = (bf16*)(ws + WS_P); bf16* ACT = (bf16*)(ws + WS_P); bf16* YC = (bf16*)(ws + WS_YC);
    bf16* QKV = (bf16*)args.out; bf16* Oraw = (bf16*)((unsigned char*)args.out + 96 * MiB); float* OUT = args.out;
    const int lo = args.ph_lo, hi = args.ph_hi;
    volatile LAS unsigned* MISC = (volatile LAS unsigned*)(lds + LDS_BYTES - 64);
    if (tid < 16) MISC[tid] = 0u;
    __syncthreads();
    XcdBarrier bar = xcd_barrier_post((unsigned*)ws, MISC);
    if (lo < 0) cg::this_grid().sync();
#ifndef PH_MASK
#define PH_MASK 0xFFF
#endif
#define IN(k) (((PH_MASK >> (k)) & 1) && lo <= (k) && (k) < hi)
#if MK_N_LAUNCHES == 1
#define SEAM(k) do { if (IN(k) && IN((k) + 1) && (k) != 5) xcd_barrier(bar); } while (0)
#else
#define SEAM(k) do { } while (0)
#endif
#ifndef REP_MASK
#define REP_MASK 0
#endif
#define BEGIN_REP(k) for (int rep_ = 0; rep_ <= ((REP_MASK >> (k)) & 1); ++rep_) { if (rep_) xcd_barrier(bar); LAUNDER();
#define END_REP }
    BEGIN_REP(0)
    if (IN(0)) {
        LAS float* scr = (LAS float*)(lds + wave * 16384);
        constexpr int I_IN = 16 * 112, I_O = 16 * 32, I_GU = 16 * 176, I_DN = 44 * 32, NITEMS = I_IN + I_O + I_GU + I_DN;
        for (int it = gw; it < NITEMS; it += NGW) { int r = it;
            if (r < I_IN) { p0_transpose_item<0>(args.in[I_WIN], D, PIN, 112, WinT, scr, r, lane); continue; } r -= I_IN;
            if (r < I_O) { p0_transpose_item<0>(args.in[I_WOUT], D, D, 32, WoT, scr, r, lane); continue; } r -= I_O;
            if (r < I_GU) { p0_transpose_item<1>(args.in[I_WGU], D, 2 * FF, 176, WguT, scr, r, lane); continue; } r -= I_GU;
            p0_transpose_item<0>(args.in[I_WDN], FF, D, 32, WdT, scr, r, lane); }
        __syncthreads();
        { LAS float* SC = (LAS float*)lds; const float* cin = args.in[I_C];
          for (int idx = tid; idx < 4096; idx += NWAVES * 64) { const int b = idx >> 10, k = idx & 1023; const float cv = cin[idx]; SC[k * 4 + b] = cv / (1.0f + __expf(-cv)); }
          __syncthreads();
          for (int it = bx; it < 256; it += G) p0_mod_item(args, MOD, SC, (LAS float*)(lds + 16384), it, tid); }
    }
    END_REP
    SEAM(0);
    BEGIN_REP(1)
    if (IN(1)) { LAS float* TT = (LAS float*)lds; const float* wi = args.in[I_WIN];
        for (int idx = tid; idx < 8192; idx += NWAVES * 64) { const int k = idx >> 3, e = idx & 7; TT[e * 1024 + k] = wi[(size_t)k * PIN + NP + e]; }
        __syncthreads();
        adaln_rows<0>(args.in[I_X], args.in[I_GMIX], MOD + 0, MOD + 1024, 6144, H, nullptr, TT, args.in[I_ALOG], args.in[I_DTB], GB, gw, NGW, lane);
        __syncthreads(); }
    END_REP
    SEAM(1);
    BEGIN_REP(2)
    if (IN(2)) { pg8::Gemm g{H, WinT, M, NP, D}; pg8::StaticOrder S; S.init(M, NP, G, bx); pg8::EpiBf16 E{P, NP};
        pg8::gemm_phase<pg8::EpiBf16, pg8::StaticOrder, true, true>(lds, g, S, E); }
    END_REP
    SEAM(2);
    BEGIN_REP(3)
    if (IN(3)) conv_pass(P, args.in[I_CWM], args.in[I_CWQ], args.in[I_GCO], YC, QKV, gw, NGW, lane);
    END_REP
    SEAM(3);
#if DN_NAIVE
    SEAM(4);
    if (IN(5)) { if (bx < 32 && wave == 0) naive_dn(QKV, GB, (float*)(ws + WS_CH), bx, lane); }
    SEAM(5);
    if (IN(6)) opost_rows<false>((const float*)(ws + WS_CH), P, args.in[I_GDN], YC, gw, NGW, lane);
#else
    BEGIN_REP(4)
    if (IN(4)) { unsigned* FLG = (unsigned*)(ws + 16384);
        if (bx < NBH) chain_phase(lds, CH, FLG, Oraw, bx, tid); else prep_phase(lds, QKV, GB, EGL, CH, FLG, bx - NBH, G - NBH, tid); }
    END_REP
    SEAM(4);
    BEGIN_REP(6)
    if (IN(6)) opost_rows<true>(Oraw, P, args.in[I_GDN], YC, gw, NGW, lane);
    END_REP
#endif
    SEAM(6);
    BEGIN_REP(7)
    if (IN(7)) { pg8::Gemm g{YC, WoT, M, D, D}; pg8::StaticOrder S; S.init(M, D, G, bx); pg8::EpiResGate E{args.in[I_X], OUT, MOD + 2048, 6144};
        pg8::gemm_phase<pg8::EpiResGate, pg8::StaticOrder, true, true>(lds, g, S, E); }
    END_REP
    SEAM(7);
    BEGIN_REP(8)
    if (IN(8)) adaln_rows<1>(OUT, args.in[I_GFFN], MOD + 3072, MOD + 4096, 6144, H, nullptr, nullptr, nullptr, nullptr, nullptr, gw, NGW, lane);
    END_REP
    SEAM(8);
    BEGIN_REP(9)
    if (IN(9)) { pg8::Gemm g{H, WguT, M, 2 * FF, D}; pg8::StaticOrder S; S.init(M, 2 * FF, G, bx); pg8::EpiSwiglu E{ACT, FF};
        pg8::gemm_phase<pg8::EpiSwiglu, pg8::StaticOrder, true, true>(lds, g, S, E); }
    END_REP
    SEAM(9);
    BEGIN_REP(10)
    if (IN(10)) { pg8::Gemm g{ACT, WdT, M, D, FF}; pg8::StaticOrder S; S.init(M, D, G, bx); pg8::EpiResGate E{OUT, OUT, MOD + 5120, 6144};
        pg8::gemm_phase<pg8::EpiResGate, pg8::StaticOrder, true, true>(lds, g, S, E); }
    END_REP
    SEAM(10);
    LAUNDER();
    if (IN(11)) adaln_rows<2>(OUT, args.in[I_GFIN], MOD + 4 * 6144, MOD + 4 * 6144 + 1024, 2048, nullptr, OUT, nullptr, nullptr, nullptr, nullptr, gw, NGW, lane);
#undef IN
#undef SEAM
}

extern "C" void kernel_launch(void* const* d_in, const int* in_sizes, int n_in, void* d_out, int out_size, void* d_ws, size_t ws_size, hipStream_t stream) {
    static int grid = 0;
    if (grid == 0) {
        if (n_in != 19 || out_size != M * D || ws_size < WS_END) { fprintf(stderr, "kernel_launch: unexpected shapes (n_in %d, out %d, ws %zu)\n", n_in, out_size, ws_size); grid = -1; return; }
        int dev = 0, cus = 0;
        if (hipGetDevice(&dev) != hipSuccess || hipDeviceGetAttribute(&cus, hipDeviceAttributeMultiprocessorCount, dev) != hipSuccess) { grid = -1; return; }
        if (hipFuncSetAttribute((const void*)fwd, hipFuncAttributeMaxDynamicSharedMemorySize, LDS_BYTES) != hipSuccess) { fprintf(stderr, "kernel_launch: hipFuncSetAttribute failed\n"); grid = -1; return; }
        int per_cu = 0;
        if (hipOccupancyMaxActiveBlocksPerMultiprocessor(&per_cu, (const void*)fwd, NWAVES * 64, LDS_BYTES) != hipSuccess || per_cu < 1) { fprintf(stderr, "kernel_launch: occupancy query says %d blocks per CU\n", per_cu); }
        (void)hipGetLastError();
        grid = cus;
    }
    if (grid < 0) return;
    Args a{};
    for (int i = 0; i < 19; ++i) a.in[i] = (const float*)d_in[i];
    a.out = (float*)d_out; a.ws = (unsigned char*)d_ws;
#if MK_N_LAUNCHES == 1
    if (hipMemsetAsync(d_ws, 0, 32768, stream) != hipSuccess) { fprintf(stderr, "kernel_launch: memset of the barrier words failed\n"); return; }
    a.ph_lo = 0; a.ph_hi = PH_END;
    void* kargs[] = {&a};
    hipError_t e = hipLaunchCooperativeKernel((const void*)fwd, dim3(grid), dim3(NWAVES * 64), kargs, LDS_BYTES, stream);
    if (e != hipSuccess) fprintf(stderr, "kernel_launch: cooperative launch failed: %s (grid %d)\n", hipGetErrorString(e), grid);
#else
    for (int ph = 0; ph < PH_END; ++ph) { a.ph_lo = ph; a.ph_hi = ph + 1; hipLaunchKernelGGL(fwd, dim3(grid), dim3(NWAVES * 64), LDS_BYTES, stream, a); }
#endif
}
```

```cpp
#include <hip/hip_runtime.h>
#include <hip/hip_cooperative_groups.h>
#include <cstdio>
#include <cstdint>
namespace cg = cooperative_groups;
#ifndef MK_N_LAUNCHES
#define MK_N_LAUNCHES 1
#endif
#ifndef DN_NAIVE
#define DN_NAIVE 0
#endif
namespace pg8 {
#define PG8_LAS __attribute__((address_space(3)))
typedef unsigned short bf16_t;
typedef short bf16x8 __attribute__((ext_vector_type(8)));
typedef float f32x4 __attribute__((ext_vector_type(4)));
typedef unsigned u32x4 __attribute__((ext_vector_type(4)));
constexpr int BM = 256, BK = 64, HALF = 128, HTB = HALF * BK * 2  , STAGE_BYTES = 8 * HTB, NXCD = 8, WGM = 8;

__host__ __device__ __forceinline__ int lds_byte(int r, int c) { const int st = (r >> 4) * 2 + (c >> 5), rr = r & 15, cc = c & 31, ob = rr * 64 + cc * 2; return st * 1024 + (ob ^ (((ob >> 9) & 1) << 5)); }
__host__ __device__ __forceinline__ void stage_rc(int b, int& R, int& C) { const int st = b / 1024, sb = b % 1024, swz = sb ^ (((sb >> 9) & 1) << 5); R = (st >> 1) * 16 + swz / 64; C = (st & 1) * 32 + (swz % 64) / 2; }
__host__ __device__ __forceinline__ int perm32(int rho) { const int n = rho >> 4, i = rho & 15; return 8 * (i >> 2) + 4 * n + (i & 3); }

struct Unit { int pm, pn; };
struct Gemm { const bf16_t* A; const bf16_t* Bt; int M, N, K; };

struct StaticOrder {
    int nM, nN, nwg, G, c;
    __host__ __device__ void init(int M, int N, int G_, int c_) { nM = M / BM; nN = N / BM; nwg = nM * nN; G = G_; c = c_; }
    __host__ __device__ bool next(int i, Unit& u) const {
        const long L = (long)i * G + c; if (L >= nwg) return false;
        int wgid = (int)L; { const int q = nwg / NXCD, r = nwg % NXCD, xcd = wgid % NXCD, off = wgid / NXCD; wgid = (xcd < r ? xcd * (q + 1) : r * (q + 1) + (xcd - r) * q) + off; }
        const int nig = WGM * nN, gid = wgid / nig, fm = gid * WGM, gsz = (nM - fm) < WGM ? (nM - fm) : WGM;
        u.pm = fm + ((wgid % nig) % gsz); u.pn = (wgid % nig) / gsz; return true;
    }
    __device__ __forceinline__ void a_ready(const Unit&) const {}
    __device__ __forceinline__ void done(const Unit&) const {}
};

typedef float f32x2 __attribute__((ext_vector_type(2)));
typedef __bf16 bf16x2v __attribute__((ext_vector_type(2)));
__device__ __forceinline__ unsigned cvt_pk_bf16(float lo, float hi) { f32x2 v = {lo, hi}; bf16x2v r = __builtin_convertvector(v, bf16x2v); return __builtin_bit_cast(unsigned, r); }
__device__ __forceinline__ float silu_f(float x) { return x * __builtin_amdgcn_rcpf(1.0f + __builtin_amdgcn_exp2f(-1.4426950408889634f * x)); }

struct EpiBf16 {
    static constexpr bool PERM = true, AFTER_DRAIN = false;
    bf16_t* O; int ldc;
    __device__ __forceinline__ void operator()(const f32x4 (&acc)[2][2][4][2], const Unit& u, int wr, int wc, int fr, int fq) const {
        const int row0 = u.pm * BM + wr * 64 + fr; const int col0 = u.pn * BM + wc * 32 + 8 * fq;
#pragma unroll
        for (int ai = 0; ai < 2; ++ai)
#pragma unroll
            for (int m = 0; m < 4; ++m) { bf16_t* rowp = O + (size_t)(row0 + ai * HALF + m * 16) * ldc + col0;
#pragma unroll
                for (int bj = 0; bj < 2; ++bj) { const f32x4 v0 = acc[ai][bj][m][0], v1 = acc[ai][bj][m][1];
                    u32x4 w; w.x = cvt_pk_bf16(v0[0], v0[1]); w.y = cvt_pk_bf16(v0[2], v0[3]); w.z = cvt_pk_bf16(v1[0], v1[1]); w.w = cvt_pk_bf16(v1[2], v1[3]);
                    *(u32x4*)(rowp + bj * HALF) = w; } }
    }
};
struct EpiSwiglu {
    static constexpr bool PERM = true, AFTER_DRAIN = false;
    bf16_t* O; int ldc;
    __device__ __forceinline__ void operator()(const f32x4 (&acc)[2][2][4][2], const Unit& u, int wr, int wc, int fr, int fq) const {
        const int row0 = u.pm * BM + wr * 64 + fr; const int col0 = u.pn * HALF + wc * 32 + 8 * fq;
#pragma unroll
        for (int ai = 0; ai < 2; ++ai)
#pragma unroll
            for (int m = 0; m < 4; ++m) { bf16_t* rowp = O + (size_t)(row0 + ai * HALF + m * 16) * ldc + col0;
                const f32x4 g0 = acc[ai][0][m][0], g1 = acc[ai][0][m][1], u0 = acc[ai][1][m][0], u1 = acc[ai][1][m][1];
                u32x4 w; w.x = cvt_pk_bf16(silu_f(g0[0]) * u0[0], silu_f(g0[1]) * u0[1]); w.y = cvt_pk_bf16(silu_f(g0[2]) * u0[2], silu_f(g0[3]) * u0[3]);
                w.z = cvt_pk_bf16(silu_f(g1[0]) * u1[0], silu_f(g1[1]) * u1[1]); w.w = cvt_pk_bf16(silu_f(g1[2]) * u1[2], silu_f(g1[3]) * u1[3]);
                *(u32x4*)rowp = w; }
    }
};
struct EpiResGate {
    static constexpr bool PERM = false, AFTER_DRAIN = false;
    const float* base; float* out; const float* gate;
    int gstride;
    __device__ __forceinline__ void operator()(const f32x4 (&acc)[2][2][4][2], const Unit& u, int wr, int wc, int fr, int fq) const {
        const int b = u.pm >> 5;
        const int col0 = u.pn * BM + wc * 32 + 4 * fq; const float* gp = gate + (size_t)b * gstride + col0;
        f32x4 gv[2][2];
#pragma unroll
        for (int bj = 0; bj < 2; ++bj)
#pragma unroll
            for (int n = 0; n < 2; ++n) gv[bj][n] = *(const f32x4*)(gp + bj * HALF + n * 16);
#pragma unroll
        for (int ai = 0; ai < 2; ++ai)
#pragma unroll
            for (int m = 0; m < 4; ++m) { const size_t off = (size_t)(u.pm * BM + ai * HALF + wr * 64 + m * 16 + fr) * 1024 + col0;
#pragma unroll
                for (int bj = 0; bj < 2; ++bj)
#pragma unroll
                    for (int n = 0; n < 2; ++n) { const f32x4 bs = *(const f32x4*)(base + off + bj * HALF + n * 16);
                        *(f32x4*)(out + off + bj * HALF + n * 16) = bs + gv[bj][n] * acc[ai][bj][m][n]; } }
    }
};

struct EpiResGateNorm {
    static constexpr bool PERM = false, AFTER_DRAIN = false;
    const float* base; float* out; const float* gate; int gstride;
    const float* gain; const float* shiftp; const float* scalep; int mstride;
    float* SS; unsigned* cnt; PG8_LAS unsigned char* xl;
    __device__ __forceinline__ void operator()(f32x4 (&acc)[2][2][4][2], const Unit& u, int wr, int wc, int fr, int fq) const {
        const int tid = threadIdx.x, lane = tid & 63, wid = __builtin_amdgcn_readfirstlane(tid >> 6);
        const int b = u.pm >> 5;
        const int col0 = u.pn * BM + wc * 32 + 4 * fq; const float* gp = gate + (size_t)b * gstride + col0;
        PG8_LAS float* Pt = (PG8_LAS float*)xl; PG8_LAS float* St = (PG8_LAS float*)(xl + 4096);
        f32x4 gv[2][2];
#pragma unroll
        for (int bj = 0; bj < 2; ++bj)
#pragma unroll
            for (int n = 0; n < 2; ++n) gv[bj][n] = *(const f32x4*)(gp + bj * HALF + n * 16);
#pragma unroll
        for (int ai = 0; ai < 2; ++ai)
#pragma unroll
            for (int m = 0; m < 4; ++m) { const size_t off = (size_t)(u.pm * BM + ai * HALF + wr * 64 + m * 16 + fr) * 1024 + col0; float s = 0.f;
#pragma unroll
                for (int bj = 0; bj < 2; ++bj)
#pragma unroll
                    for (int n = 0; n < 2; ++n) { const f32x4 v = *(const f32x4*)(base + off + bj * HALF + n * 16) + gv[bj][n] * acc[ai][bj][m][n]; acc[ai][bj][m][n] = v; s += (v.x * v.x + v.y * v.y) + (v.z * v.z + v.w * v.w); }
                s += __shfl_xor(s, 16); s += __shfl_xor(s, 32);
                if (fq == 0) Pt[(ai * HALF + wr * 64 + m * 16 + fr) * 4 + wc] = s; }
        asm volatile("s_waitcnt lgkmcnt(0)" ::: "memory"); __builtin_amdgcn_s_barrier(); asm volatile("" ::: "memory");
        if (tid < 256) { const f32x4 p = *(const PG8_LAS f32x4*)(Pt + tid * 4); const float part = (p.x + p.y) + (p.z + p.w);
            float* slot = SS + (size_t)(u.pm * BM + tid) * 4 + u.pn; asm volatile("global_store_dword %0, %1, off sc1\n\ts_nop 1" :: "v"(slot), "v"(part) : "memory"); }
        asm volatile("s_waitcnt vmcnt(0)" ::: "memory"); __builtin_amdgcn_s_barrier(); asm volatile("" ::: "memory");
        if (wid == 0) { unsigned* c = cnt + u.pm * 16;
            if (lane == 0) __hip_atomic_fetch_add(c, 1u, __ATOMIC_RELAXED, __HIP_MEMORY_SCOPE_AGENT);
            unsigned spins = 0;
            while ((unsigned)__builtin_amdgcn_readfirstlane(__hip_atomic_load(c, __ATOMIC_RELAXED, __HIP_MEMORY_SCOPE_AGENT)) < 4u && ++spins < 4000000u) __builtin_amdgcn_s_sleep(2);
            __builtin_amdgcn_fence(__ATOMIC_ACQUIRE, "agent"); asm volatile("s_waitcnt vmcnt(0)" ::: "memory"); }
        __builtin_amdgcn_s_barrier(); asm volatile("" ::: "memory");
        if (tid < 256) { const f32x4 q = *(const f32x4*)(SS + (size_t)(u.pm * BM + tid) * 4); St[tid] = 1.0f / sqrtf(((q.x + q.y) + (q.z + q.w)) * (1.0f / 1024.0f) + 1e-6f); }
        f32x4 gs[2][2], sh[2][2];
#pragma unroll
        for (int bj = 0; bj < 2; ++bj)
#pragma unroll
            for (int n = 0; n < 2; ++n) { const int c = col0 + bj * HALF + n * 16; gs[bj][n] = *(const f32x4*)(gain + c) * (1.0f + *(const f32x4*)(scalep + (size_t)b * mstride + c)); sh[bj][n] = *(const f32x4*)(shiftp + (size_t)b * mstride + c); }
        asm volatile("s_waitcnt lgkmcnt(0)" ::: "memory"); __builtin_amdgcn_s_barrier(); asm volatile("" ::: "memory");
#pragma unroll
        for (int ai = 0; ai < 2; ++ai)
#pragma unroll
            for (int m = 0; m < 4; ++m) { const int r = ai * HALF + wr * 64 + m * 16 + fr; const float rinv = St[r]; const size_t off = (size_t)(u.pm * BM + r) * 1024 + col0;
#pragma unroll
                for (int bj = 0; bj < 2; ++bj)
#pragma unroll
                    for (int n = 0; n < 2; ++n) *(f32x4*)(out + off + bj * HALF + n * 16) = (acc[ai][bj][m][n] * rinv) * gs[bj][n] + sh[bj][n]; }
        asm volatile("s_waitcnt lgkmcnt(0)" ::: "memory"); __builtin_amdgcn_s_barrier(); asm volatile("" ::: "memory");
    }
};

template <class Epi, class Sched, bool ALIGN_EPI = false, bool SP2 = false>
__device__ __forceinline__ void gemm_phase(PG8_LAS unsigned char* lds, const Gemm g, const Sched& S, const Epi& E) {
    const int tid = threadIdx.x, wid = __builtin_amdgcn_readfirstlane(tid >> 6), lane = tid & 63, wr = wid >> 2, wc = wid & 3, fr = lane & 15, fq = lane >> 4;
    const int K = g.K, nt = K / BK;
    unsigned voffA[2], voffB[2];
#pragma unroll
    for (int i = 0; i < 2; ++i) { int R, C; stage_rc(tid * 16 + i * 8192, R, C); const int Rb = Epi::PERM ? ((R & ~31) + perm32(R & 31)) : R;
        voffA[i] = (unsigned)(R * K + C) * 2u; voffB[i] = (unsigned)(Rb * K + C) * 2u; }
    const size_t kstep = (size_t)(BK * 2);
    const size_t hstep = (size_t)HALF * K * 2;
    const size_t tstep = 2 * hstep;
    const unsigned ldsw = (unsigned)wid * 1024u;
    const int aoff = lds_byte(wr * 64 + fr, fq * 8), boff = lds_byte(wc * 32 + fr, fq * 8);
#define PG8_SA(b, h) (((b) * 2 + (h)) * HTB)
#define PG8_SB(b, h) ((4 + (b) * 2 + (h)) * HTB)
#define PG8_STAGE(bufoff, gbase, voff) do { _Pragma("unroll") for (int _i = 0; _i < 2; ++_i) \
        __builtin_amdgcn_global_load_lds((const unsigned*)((const char*)(gbase) + (voff)[_i]), (PG8_LAS unsigned*)(lds + (bufoff) + ldsw + _i * 8192), 16, 0, 0); } while (0)
#define PG8_LDA(dst, b, h) do { _Pragma("unroll") for (int m = 0; m < 4; ++m) _Pragma("unroll") for (int k = 0; k < 2; ++k) dst[m][k] = *(const PG8_LAS bf16x8*)(lds + PG8_SA(b, h) + aoff + m * 2048 + k * 1024); } while (0)
#define PG8_LDB(dst, b, h) do { _Pragma("unroll") for (int n = 0; n < 2; ++n) _Pragma("unroll") for (int k = 0; k < 2; ++k) dst[n][k] = *(const PG8_LAS bf16x8*)(lds + PG8_SB(b, h) + boff + n * 2048 + k * 1024); } while (0)
#define PG8_MMA(ai, bj, At, Bt) do { __builtin_amdgcn_s_setprio(1); _Pragma("unroll") for (int m = 0; m < 4; ++m) _Pragma("unroll") for (int n = 0; n < 2; ++n) _Pragma("unroll") for (int k = 0; k < 2; ++k) \
        acc[ai][bj][m][n] = __builtin_amdgcn_mfma_f32_16x16x32_bf16(Bt[n][k], At[m][k], acc[ai][bj][m][n], 0, 0, 0); __builtin_amdgcn_s_setprio(0); } while (0)
#define PG8_WAIT_V(n) asm volatile("s_waitcnt vmcnt(" #n ")" ::: "memory")
#define PG8_WAIT_L(n) asm volatile("s_waitcnt lgkmcnt(" #n ")" ::: "memory")
#define PG8_BAR __builtin_amdgcn_s_barrier()
#define PG8_SCHED __builtin_amdgcn_sched_barrier(0)
    Unit cur, nxt; int ui = 0;
    if (!S.next(0, cur)) return;
    f32x4 acc[2][2][4][2];
#pragma unroll
    for (int a = 0; a < 2; ++a)
#pragma unroll
        for (int b = 0; b < 2; ++b)
#pragma unroll
            for (int m = 0; m < 4; ++m)
#pragma unroll
                for (int n = 0; n < 2; ++n) acc[a][b][m][n] = (f32x4){0.f, 0.f, 0.f, 0.f};
    bf16x8 At[4][2], B0[2][2], B1[2][2];
    const char* cA = (const char*)g.A + (size_t)cur.pm * tstep; const char* cB = (const char*)g.Bt + (size_t)cur.pn * tstep;
    S.a_ready(cur);
    if constexpr (SP2) {
        PG8_STAGE(PG8_SB(0, 0), cB, voffB); PG8_STAGE(PG8_SB(0, 1), cB + hstep, voffB); PG8_STAGE(PG8_SA(0, 0), cA, voffA); PG8_STAGE(PG8_SA(0, 1), cA + hstep, voffA);
        if (wr == 1) PG8_BAR;
        PG8_WAIT_V(2); PG8_BAR;
        PG8_STAGE(PG8_SB(1, 0), cB + kstep, voffB); PG8_STAGE(PG8_SA(1, 0), cA + kstep, voffA); PG8_STAGE(PG8_SB(1, 1), cB + hstep + kstep, voffB);
        PG8_WAIT_V(6); PG8_BAR;
    } else {
        PG8_STAGE(PG8_SB(0, 0), cB, voffB); PG8_STAGE(PG8_SA(0, 0), cA, voffA); PG8_STAGE(PG8_SB(0, 1), cB + hstep, voffB); PG8_STAGE(PG8_SA(0, 1), cA + hstep, voffA);
        if (wr == 1) PG8_BAR;
        PG8_WAIT_V(4); PG8_BAR;
        PG8_STAGE(PG8_SB(1, 0), cB + kstep, voffB); PG8_STAGE(PG8_SA(1, 0), cA + kstep, voffA); PG8_STAGE(PG8_SB(1, 1), cB + hstep + kstep, voffB);
        PG8_WAIT_V(6); PG8_BAR;
    }
    for (;;) {
        const bool has_next = S.next(ui + 1, nxt);
        const char* nA = has_next ? (const char*)g.A + (size_t)nxt.pm * tstep : cA; const char* nB = has_next ? (const char*)g.Bt + (size_t)nxt.pn * tstep : cB;
        for (int t = 0; t < nt; t += 2) {
            const bool last = (t == nt - 2);
            const char* a1 = cA + (size_t)(t + 1) * kstep;
            const char* a2 = last ? nA : cA + (size_t)(t + 2) * kstep; const char* b2 = last ? nB : cB + (size_t)(t + 2) * kstep;
            const char* a3 = a2 + kstep; const char* b3 = b2 + kstep;
            if (last && has_next) S.a_ready(nxt);
            if constexpr (SP2) {
            PG8_LDB(B0, 0, 0); PG8_LDB(B1, 0, 1); PG8_SCHED; PG8_LDA(At, 0, 0); PG8_STAGE(PG8_SA(1, 1), a1 + hstep, voffA);
            PG8_WAIT_V(8); PG8_WAIT_L(0); PG8_BAR; PG8_MMA(0, 0, At, B0); PG8_MMA(0, 1, At, B1); PG8_BAR; PG8_SCHED;
            PG8_LDA(At, 0, 1); PG8_STAGE(PG8_SB(0, 0), b2, voffB); PG8_STAGE(PG8_SB(0, 1), b2 + hstep, voffB); PG8_STAGE(PG8_SA(0, 0), a2, voffA);
            PG8_WAIT_V(8); PG8_WAIT_L(0); PG8_BAR; PG8_MMA(1, 0, At, B0); PG8_MMA(1, 1, At, B1); PG8_BAR; PG8_SCHED;
            PG8_LDB(B0, 1, 0); PG8_LDB(B1, 1, 1); PG8_SCHED; PG8_LDA(At, 1, 0); PG8_STAGE(PG8_SA(0, 1), a2 + hstep, voffA);
            PG8_WAIT_V(8); PG8_WAIT_L(0); PG8_BAR; PG8_MMA(0, 0, At, B0); PG8_MMA(0, 1, At, B1); PG8_BAR; PG8_SCHED;
            PG8_LDA(At, 1, 1); PG8_STAGE(PG8_SB(1, 0), b3, voffB); PG8_STAGE(PG8_SB(1, 1), b3 + hstep, voffB); PG8_STAGE(PG8_SA(1, 0), a3, voffA);
            PG8_WAIT_V(8); PG8_WAIT_L(0); PG8_BAR; PG8_MMA(1, 0, At, B0); PG8_MMA(1, 1, At, B1); PG8_BAR; PG8_SCHED;
            } else {
            PG8_LDB(B0, 0, 0); PG8_SCHED; PG8_LDA(At, 0, 0); PG8_STAGE(PG8_SA(1, 1), a1 + hstep, voffA);
            PG8_WAIT_L(8); PG8_BAR; PG8_WAIT_L(0); PG8_MMA(0, 0, At, B0); PG8_BAR; PG8_SCHED;
            PG8_LDB(B1, 0, 1); PG8_STAGE(PG8_SB(0, 0), b2, voffB);
            PG8_BAR; PG8_WAIT_L(0); PG8_MMA(0, 1, At, B1); PG8_BAR;
            PG8_LDA(At, 0, 1); PG8_STAGE(PG8_SA(0, 0), a2, voffA);
            PG8_BAR; PG8_WAIT_L(0); PG8_MMA(1, 0, At, B0); PG8_BAR; PG8_SCHED;
            PG8_STAGE(PG8_SB(0, 1), b2 + hstep, voffB);
            PG8_WAIT_V(6); PG8_BAR; PG8_MMA(1, 1, At, B1); PG8_BAR;
            PG8_LDB(B0, 1, 0); PG8_SCHED; PG8_LDA(At, 1, 0); PG8_STAGE(PG8_SA(0, 1), a2 + hstep, voffA);
            PG8_WAIT_L(8); PG8_BAR; PG8_WAIT_L(0); PG8_MMA(0, 0, At, B0); PG8_BAR; PG8_SCHED;
            PG8_LDB(B1, 1, 1); PG8_STAGE(PG8_SB(1, 0), b3, voffB);
            PG8_BAR; PG8_WAIT_L(0); PG8_MMA(0, 1, At, B1); PG8_BAR;
            PG8_LDA(At, 1, 1); PG8_STAGE(PG8_SA(1, 0), a3, voffA);
            PG8_BAR; PG8_WAIT_L(0); PG8_MMA(1, 0, At, B0); PG8_BAR; PG8_SCHED;
            PG8_STAGE(PG8_SB(1, 1), b3 + hstep, voffB);
            PG8_WAIT_V(6); PG8_BAR; PG8_MMA(1, 1, At, B1); PG8_BAR;
            }
        }
        if constexpr (ALIGN_EPI) { if (wr == 0) PG8_BAR; }
        if constexpr (!Epi::AFTER_DRAIN) { E(acc, cur, wr, wc, fr, fq); S.done(cur); }
        if (!has_next) break;
#pragma unroll
        for (int a = 0; a < 2; ++a)
#pragma unroll
            for (int b = 0; b < 2; ++b)
#pragma unroll
                for (int m = 0; m < 4; ++m)
#pragma unroll
                    for (int n = 0; n < 2; ++n) acc[a][b][m][n] = (f32x4){0.f, 0.f, 0.f, 0.f};
        cur = nxt; cA = nA; cB = nB; ++ui;
        if constexpr (ALIGN_EPI) { if (wr == 1) PG8_BAR; }
    }
    PG8_WAIT_V(0);
    if constexpr (!ALIGN_EPI) { if (wr == 0) PG8_BAR; }
    PG8_BAR;
    if constexpr (Epi::AFTER_DRAIN) { E.fused(acc, cur, wr, wc, fr, fq, lds, wid, lane); S.done(cur); }
#undef PG8_SA
#undef PG8_SB
#undef PG8_STAGE
#undef PG8_LDA
#undef PG8_LDB
#undef PG8_MMA
#undef PG8_WAIT_V
#undef PG8_WAIT_L
#undef PG8_BAR
#undef PG8_SCHED
}
}

constexpr int NWAVES = 8;
constexpr int BATCH = 4, SEQ = 8192, D = 1024, M = BATCH * SEQ;
constexpr int PIN = 3592, NP = 3584;
constexpr int FF = 2816, NCH = 128, NBH = 16;
constexpr int PH_END = 12;
constexpr float EPS = 1e-6f;
constexpr size_t MiB = 1u << 20;
constexpr size_t WS_MOD = 1 * MiB;
constexpr size_t WS_GB = 2 * MiB;
constexpr size_t WS_EGL = 3 * MiB;
constexpr size_t WS_WIN = 4 * MiB, WS_WO = 11 * MiB, WS_WGU = 13 * MiB, WS_WD = 24 * MiB;
constexpr size_t WS_H = 32 * MiB;
constexpr size_t WS_CH = 32 * MiB;
constexpr size_t WS_P = 208 * MiB;
constexpr size_t WS_YC = 432 * MiB;
constexpr size_t WS_END = 496 * MiB;
constexpr int REC = 74752;
constexpr int REC_A = 57344;
constexpr int LDS_BYTES = 155648;

#define LAS __attribute__((address_space(3)))
typedef unsigned short bf16;
typedef unsigned v4u __attribute__((ext_vector_type(4)));
typedef unsigned v2u __attribute__((ext_vector_type(2)));
typedef float f32x4 __attribute__((ext_vector_type(4)));
typedef float f32x16 __attribute__((ext_vector_type(16)));
typedef short bf16x8 __attribute__((ext_vector_type(8)));
#define LDS_WAIT() asm volatile("s_waitcnt lgkmcnt(0)" ::: "memory")
using pg8::cvt_pk_bf16; using pg8::silu_f;
__device__ __forceinline__ float bf2f(unsigned short u) { return __uint_as_float((unsigned)u << 16); }
__device__ __forceinline__ float bflo(unsigned w) { return __uint_as_float(w << 16); }
__device__ __forceinline__ float bfhi(unsigned w) { return __uint_as_float(w & 0xffff0000u); }
__device__ __forceinline__ float wave_sum(float v) {
#pragma unroll
    for (int o = 1; o < 64; o <<= 1) v += __shfl_xor(v, o);
    return v;
}
__device__ __forceinline__ void unpack8(v4u w, float (&f)[8]) { f[0] = bflo(w.x); f[1] = bfhi(w.x); f[2] = bflo(w.y); f[3] = bfhi(w.y); f[4] = bflo(w.z); f[5] = bfhi(w.z); f[6] = bflo(w.w); f[7] = bfhi(w.w); }
__device__ __forceinline__ v4u pack8(const float (&f)[8]) { v4u w; w.x = cvt_pk_bf16(f[0], f[1]); w.y = cvt_pk_bf16(f[2], f[3]); w.z = cvt_pk_bf16(f[4], f[5]); w.w = cvt_pk_bf16(f[6], f[7]); return w; }

struct Args { const float* in[19]; float* out; unsigned char* ws; int ph_lo, ph_hi; };
enum { I_X = 0, I_C, I_WADA, I_BADA, I_WADAF, I_BADAF, I_GMIX, I_GFFN, I_GFIN, I_WIN, I_CWM, I_CWQ, I_ALOG, I_DTB, I_GCO, I_GDN, I_WOUT, I_WGU, I_WDN };

template <int MODE>
__device__ __forceinline__ void p0_transpose_item(const float* W, int K, int ld, int nblk, bf16* WT, LAS float* scr, int item, int lane) {
    const int kb = item / nblk, nb = item % nblk, k0 = 64 * kb, n0 = 32 * nb;
    f32x4 ld4[8];
#pragma unroll
    for (int i = 0; i < 8; ++i) ld4[i] = *(const f32x4*)(W + (size_t)(k0 + 8 * i + (lane >> 3)) * ld + n0 + 4 * (lane & 7));
#pragma unroll
    for (int i = 0; i < 8; ++i) { LAS float* d = scr + (8 * i + (lane >> 3)) * 33 + 4 * (lane & 7); d[0] = ld4[i].x; d[1] = ld4[i].y; d[2] = ld4[i].z; d[3] = ld4[i].w; }
    LDS_WAIT(); asm volatile("" ::: "memory");
    int r0 = n0;
    if (MODE == 1) { r0 = n0 < FF ? 256 * (n0 / 128) + (n0 % 128) : 256 * ((n0 - FF) / 128) + 128 + ((n0 - FF) % 128); }
    const int c = lane & 7;
#pragma unroll
    for (int j = 0; j < 4; ++j) { const int n = (lane >> 3) + 8 * j; const LAS float* s = scr + (8 * c) * 33 + n;
        v4u o; o.x = cvt_pk_bf16(s[0 * 33], s[1 * 33]); o.y = cvt_pk_bf16(s[2 * 33], s[3 * 33]); o.z = cvt_pk_bf16(s[4 * 33], s[5 * 33]); o.w = cvt_pk_bf16(s[6 * 33], s[7 * 33]);
        *(v4u*)(WT + (size_t)(r0 + n) * K + k0 + 8 * c) = o; }
    LDS_WAIT(); asm volatile("" ::: "memory");
}
__device__ __forceinline__ void p0_mod_item(const Args& a, float* MOD, const LAS float* SC, LAS float* red, int item, int tid) {
    const int c4 = tid & 7, ks = tid >> 3, col0 = item * 32;
    const bool fin = col0 >= 6144; const float* W = fin ? a.in[I_WADAF] : a.in[I_WADA]; const int ld = fin ? 2048 : 6144, cb = (fin ? col0 - 6144 : col0);
    f32x4 w[16];
#pragma unroll
    for (int kk = 0; kk < 16; ++kk) w[kk] = *(const f32x4*)(W + (size_t)(16 * ks + kk) * ld + cb + 4 * c4);
    f32x4 acc[4];
#pragma unroll
    for (int b = 0; b < 4; ++b) acc[b] = (f32x4){0.f, 0.f, 0.f, 0.f};
#pragma unroll
    for (int kk = 0; kk < 16; ++kk) { const f32x4 s = *(const LAS f32x4*)(SC + (16 * ks + kk) * 4); acc[0] += s.x * w[kk]; acc[1] += s.y * w[kk]; acc[2] += s.z * w[kk]; acc[3] += s.w * w[kk]; }
#pragma unroll
    for (int b = 0; b < 4; ++b) *(LAS f32x4*)(red + (ks * 4 + b) * 32 + 4 * c4) = acc[b];
    __syncthreads();
    if (tid < 128) { const int b = tid >> 5, cl = tid & 31; float s = 0.f;
#pragma unroll 16
        for (int k = 0; k < 64; ++k) s += red[(k * 4 + b) * 32 + cl];
        const int c = cb + cl;
        s += fin ? a.in[I_BADAF][c] : a.in[I_BADA][c];
        if (fin) MOD[4 * 6144 + b * 2048 + c] = s; else MOD[b * 6144 + c] = s; }
    __syncthreads();
}

template <int MODE>
__device__ __forceinline__ void adaln_one(const f32x4 (&xin)[4], const f32x4 (&gs)[4], const f32x4 (&sh)[4], int m, bf16* Hout, float* Fout, const LAS float* TT, const float* a_log, const float* dt_bias, float* GB, int lane) {
    f32x4 v[4]; float ss = 0.f;
#pragma unroll
    for (int j = 0; j < 4; ++j) { v[j] = xin[j]; ss += (v[j].x * v[j].x + v[j].y * v[j].y) + (v[j].z * v[j].z + v[j].w * v[j].w); }
    const float rinv = 1.0f / sqrtf(wave_sum(ss) * (1.0f / D) + EPS);
#pragma unroll
    for (int j = 0; j < 4; ++j) v[j] = (v[j] * rinv) * gs[j] + sh[j];
    if (MODE == 2) { f32x4* o = (f32x4*)(Fout + (size_t)m * D) + lane;
#pragma unroll
        for (int j = 0; j < 4; ++j) o[64 * j] = v[j];
    } else { v2u* o = (v2u*)(Hout + (size_t)m * D) + lane;
#pragma unroll
        for (int j = 0; j < 4; ++j) { v2u w; w.x = cvt_pk_bf16(v[j].x, v[j].y); w.y = cvt_pk_bf16(v[j].z, v[j].w); o[64 * j] = w; } }
    if (MODE == 0) {
        float d[8];
#pragma unroll
        for (int e = 0; e < 8; ++e) { float s = 0.f;
#pragma unroll
            for (int j = 0; j < 4; ++j) { const f32x4 t = *(const LAS f32x4*)(TT + e * 1024 + 4 * (lane + 64 * j)); s += (v[j].x * t.x + v[j].y * t.y) + (v[j].z * t.z + v[j].w * t.w); }
            asm volatile("" : "+v"(s) :: "memory"); d[e] = s; }
        float k4[4], k2[2], k1;
        { const bool hi = (lane & 32) != 0;
#pragma unroll
          for (int i = 0; i < 4; ++i) { const float snd = hi ? d[i] : d[4 + i]; const float kp = hi ? d[4 + i] : d[i]; k4[i] = kp + __shfl_xor(snd, 32); } }
        { const bool hi = (lane & 16) != 0;
#pragma unroll
          for (int i = 0; i < 2; ++i) { const float snd = hi ? k4[i] : k4[2 + i]; const float kp = hi ? k4[2 + i] : k4[i]; k2[i] = kp + __shfl_xor(snd, 16); } }
        { const bool hi = (lane & 8) != 0; const float snd = hi ? k2[0] : k2[1]; const float kp = hi ? k2[1] : k2[0]; k1 = kp + __shfl_xor(snd, 8); }
        k1 += __shfl_xor(k1, 4); k1 += __shfl_xor(k1, 2); k1 += __shfl_xor(k1, 1);
        if ((lane & 7) == 0) { const int e = lane >> 3; float r;
            if (e < 4) { const float xx = k1 + dt_bias[e]; const float sp = fmaxf(xx, 0.f) + log1pf(__expf(-fabsf(xx))); r = -__expf(a_log[e]) * sp; }
            else r = 1.0f / (1.0f + __expf(-k1));
            GB[(size_t)m * 8 + e] = r; }
    }
}
template <int MODE>
__device__ __forceinline__ void adaln_rows(const float* X, const float* gain, const float* shiftp, const float* scalep, int mstride, bf16* Hout, float* Fout,
                                           const LAS float* TT, const float* a_log, const float* dt_bias, float* GB, int gw, int NGW, int lane) {
    for (int blk = gw; blk < M / 16; blk += NGW) {
        const int m0 = blk * 16, b = m0 >> 13;
        f32x4 gs[4], sh[4];
        { const f32x4* g4 = (const f32x4*)gain + lane; const f32x4* sh4 = (const f32x4*)(shiftp + (size_t)b * mstride) + lane; const f32x4* sc4 = (const f32x4*)(scalep + (size_t)b * mstride) + lane;
#pragma unroll
          for (int j = 0; j < 4; ++j) { gs[j] = g4[64 * j] * (1.0f + sc4[64 * j]); sh[j] = sh4[64 * j]; } }
        f32x4 c0[4], c1[4];
        { const f32x4* xr = (const f32x4*)(X + (size_t)m0 * D) + lane;
#pragma unroll
          for (int j = 0; j < 4; ++j) { c0[j] = xr[64 * j]; c1[j] = xr[256 + 64 * j]; } }
#pragma unroll 1
        for (int i = 0; i < 16; i += 2) {
            f32x4 n0[4], n1[4];
            { const int mn = (i + 2 < 16) ? m0 + i + 2 : m0; const f32x4* xr = (const f32x4*)(X + (size_t)mn * D) + lane;
#pragma unroll
              for (int j = 0; j < 4; ++j) { n0[j] = xr[64 * j]; n1[j] = xr[256 + 64 * j]; } }
            adaln_one<MODE>(c0, gs, sh, m0 + i, Hout, Fout, TT, a_log, dt_bias, GB, lane);
            adaln_one<MODE>(c1, gs, sh, m0 + i + 1, Hout, Fout, TT, a_log, dt_bias, GB, lane);
#pragma unroll
            for (int j = 0; j < 4; ++j) { c0[j] = n0[j]; c1[j] = n1[j]; }
        }
    }
}

__device__ __forceinline__ void conv_qkv(const bf16* P, const float* cwq, bf16* QKV, int X, int t0, bool first, int lane) {
    const int colp = 1536 + 512 * X + 8 * lane, colo = 512 * X + 8 * lane;
    v4u raw[19];
#pragma unroll
    for (int t = 0; t < 19; ++t) { raw[t] = (v4u){0u, 0u, 0u, 0u}; if (t >= 3 || !first) raw[t] = *(const v4u*)(P + (size_t)(t0 - 3 + t) * NP + colp); }
    float w0[8], w1[8], w2[8], w3[8], h3[8], h2[8], h1[8];
#pragma unroll
    for (int e = 0; e < 8; ++e) { w0[e] = cwq[0 * 1536 + colo + e]; w1[e] = cwq[1 * 1536 + colo + e]; w2[e] = cwq[2 * 1536 + colo + e]; w3[e] = cwq[3 * 1536 + colo + e]; }
    unpack8(raw[0], h3); unpack8(raw[1], h2); unpack8(raw[2], h1);
#pragma unroll
    for (int t = 0; t < 16; ++t) { const int m = t0 + t; float x[8], y[8]; unpack8(raw[3 + t], x); float ss = 0.f;
#pragma unroll
        for (int e = 0; e < 8; ++e) { const float c = w0[e] * h3[e] + w1[e] * h2[e] + w2[e] * h1[e] + w3[e] * x[e]; y[e] = silu_f(c); ss += y[e] * y[e]; h3[e] = h2[e]; h2[e] = h1[e]; h1[e] = x[e]; }
        if (X < 2) { ss += __shfl_xor(ss, 1); ss += __shfl_xor(ss, 2); ss += __shfl_xor(ss, 4); ss += __shfl_xor(ss, 8);
            float r = 1.0f / sqrtf(ss + EPS); if (X == 0) r *= 0.08838834764831845f;
#pragma unroll
            for (int e = 0; e < 8; ++e) y[e] *= r; }
        *(v4u*)(QKV + (size_t)m * 1536 + colo) = pack8(y); }
}
__device__ __forceinline__ void conv_pass(const bf16* P, const float* cwm, const float* cwq, const float* gco, bf16* YC, bf16* QKV, int gw, int NGW, int lane) {
    for (int run = gw; run < M / 16; run += NGW) {
        const int t0 = run * 16; const bool first = (t0 & (SEQ - 1)) == 0;
        { float w0[8], w1[8], w2[8], gc[8], u2[8], u1[8]; const int c0 = 8 * lane;
#pragma unroll
          for (int e = 0; e < 8; ++e) { w0[e] = cwm[c0 + e]; w1[e] = cwm[512 + c0 + e]; w2[e] = cwm[1024 + c0 + e]; gc[e] = gco[c0 + e]; u2[e] = 0.f; u1[e] = 0.f; }
          if (!first) { float a[8], b[8]; unpack8(*(const v4u*)(P + (size_t)(t0 - 2) * NP + 512 + c0), a); unpack8(*(const v4u*)(P + (size_t)(t0 - 2) * NP + 1024 + c0), b);
#pragma unroll
              for (int e = 0; e < 8; ++e) u2[e] = a[e] * b[e];
              unpack8(*(const v4u*)(P + (size_t)(t0 - 1) * NP + 512 + c0), a); unpack8(*(const v4u*)(P + (size_t)(t0 - 1) * NP + 1024 + c0), b);
#pragma unroll
              for (int e = 0; e < 8; ++e) u1[e] = a[e] * b[e]; }
#pragma unroll 1
          for (int tb = 0; tb < 16; tb += 8) {
              v4u rb[8], rc[8], rh[8];
#pragma unroll
              for (int t = 0; t < 8; ++t) { const bf16* pr = P + (size_t)(t0 + tb + t) * NP + c0; rb[t] = *(const v4u*)pr; rc[t] = *(const v4u*)(pr + 512); rh[t] = *(const v4u*)(pr + 1024); }
#pragma unroll
              for (int t = 0; t < 8; ++t) { const int m = t0 + tb + t; float gb[8], a[8], b[8], y[8]; unpack8(rb[t], gb); unpack8(rc[t], a); unpack8(rh[t], b); float ss = 0.f;
#pragma unroll
                  for (int e = 0; e < 8; ++e) { const float u0 = a[e] * b[e]; y[e] = gb[e] * (w0[e] * u2[e] + w1[e] * u1[e] + w2[e] * u0); ss += y[e] * y[e]; u2[e] = u1[e]; u1[e] = u0; }
                  ss += __shfl_xor(ss, 1); ss += __shfl_xor(ss, 2); ss += __shfl_xor(ss, 4);
                  const float r = 1.0f / sqrtf(ss * (1.0f / 64.0f) + EPS);
#pragma unroll
                  for (int e = 0; e < 8; ++e) y[e] = y[e] * r * gc[e];
                  *(v4u*)(YC + (size_t)m * D + c0) = pack8(y); } } }
        conv_qkv(P, cwq, QKV, 0, t0, first, lane); conv_qkv(P, cwq, QKV, 1, t0, first, lane); conv_qkv(P, cwq, QKV, 2, t0, first, lane);
    }
}


constexpr int PREP_HALF = 69632, PK_KN = 0, PK_QN = 17408, PK_VV = 34816, PK_LM = 52224, PK_GC = 68608, PK_BT = 68864, PK_EG = 69120, PROW = 272;
template <bool SC>
__device__ __forceinline__ v4u afrag_piece_rows(const LAS unsigned char* tile, const LAS float* sc, int p) {
    const int f = p >> 6, ln = p & 63, mt = f >> 3, kt = (f >> 1) & 3, s = f & 1, r = ln & 31, hh = ln >> 5, row = 32 * mt + r, kb = 32 * kt + 16 * s + 4 * hh;
    const v2u a = *(const LAS v2u*)(tile + row * PROW + kb * 2), b = *(const LAS v2u*)(tile + row * PROW + (kb + 8) * 2);
    float scv = 1.0f; if (SC) scv = sc[row];
    v4u o; o.x = cvt_pk_bf16(bflo(a.x) * scv, bfhi(a.x) * scv); o.y = cvt_pk_bf16(bflo(a.y) * scv, bfhi(a.y) * scv); o.z = cvt_pk_bf16(bflo(b.x) * scv, bfhi(b.x) * scv); o.w = cvt_pk_bf16(bflo(b.y) * scv, bfhi(b.y) * scv);
    return o;
}
#define LBAR() do { asm volatile("s_waitcnt lgkmcnt(0)" ::: "memory"); __builtin_amdgcn_s_barrier(); asm volatile("" ::: "memory"); } while (0)
__device__ __forceinline__ void st_wt16(void* p, v4u v) { asm volatile("global_store_dwordx4 %0, %1, off sc1\n\ts_nop 1" :: "v"(p), "v"(v) : "memory"); }
__device__ __forceinline__ void st_wt4(void* p, float v) { asm volatile("global_store_dword %0, %1, off sc1\n\ts_nop 1" :: "v"(p), "v"(v) : "memory"); }
__device__ __forceinline__ void prep_phase(LAS unsigned char* lds, const bf16* QKV, const float* GB, float* EGL, unsigned char* CH, unsigned* FLG, int ublk, int nblk, int tid) {
    const int half = tid >> 8, t = tid & 255, lane = tid & 63, w = (tid >> 6) & 3, r = lane & 31, hh = lane >> 5;
    LAS unsigned char* L = lds + half * PREP_HALF;
    LAS float* LM = (LAS float*)(L + PK_LM); LAS float* GC = (LAS float*)(L + PK_GC); LAS float* BT = (LAS float*)(L + PK_BT); LAS float* EG = (LAS float*)(L + PK_EG);
    for (int pu = ublk; pu < NBH * NCH / 2; pu += nblk) {
        const int n = pu >> 3, bh = 2 * (pu & 7) + half, cid = bh * NCH + n, b = bh >> 2, h = bh & 3, m0 = b * SEQ + n * 64;
        unsigned char* rec = CH + (size_t)cid * REC;
        LBAR();
#pragma unroll
        for (int X = 0; X < 3; ++X)
#pragma unroll
            for (int i = 0; i < 4; ++i) { const int p = t + 256 * i, row = p >> 4, c16 = p & 15;
                const v4u v = *(const v4u*)(QKV + (size_t)(m0 + row) * 1536 + 512 * X + 128 * h + 8 * c16);
                *(LAS v4u*)(L + (X == 0 ? PK_QN : (X == 1 ? PK_KN : PK_VV)) + row * PROW + c16 * 16) = v; }
        if (w == 0) { float g = GB[(size_t)(m0 + lane) * 8 + h];
#pragma unroll
            for (int d = 1; d < 64; d <<= 1) { const float o = __shfl_up(g, d); if (lane >= d) g += o; }
            GC[lane] = g; EG[lane] = __expf(g); BT[lane] = GB[(size_t)(m0 + lane) * 8 + 4 + h];
            if (lane == 63) st_wt4(rec + 73728, __expf(g)); }
        LBAR();
        { const int mi = w >> 1, nj = w & 1;
          f32x16 kk, qk;
#pragma unroll
          for (int i = 0; i < 16; ++i) { kk[i] = 0.f; qk[i] = 0.f; }
#pragma unroll
          for (int st = 0; st < 8; ++st) {
              const bf16x8 ka = *(const LAS bf16x8*)(L + PK_KN + (32 * mi + r) * PROW + (16 * st + 8 * hh) * 2);
              const bf16x8 kb = *(const LAS bf16x8*)(L + PK_KN + (32 * nj + r) * PROW + (16 * st + 8 * hh) * 2);
              const bf16x8 qb = *(const LAS bf16x8*)(L + PK_QN + (32 * mi + r) * PROW + (16 * st + 8 * hh) * 2);
              kk = __builtin_amdgcn_mfma_f32_32x32x16_bf16(ka, kb, kk, 0, 0, 0);
              qk = __builtin_amdgcn_mfma_f32_32x32x16_bf16(kb, qb, qk, 0, 0, 0);
          }
          const float gj = GC[32 * nj + r], gq = GC[32 * mi + r];
          float av[16];
#pragma unroll
          for (int reg = 0; reg < 16; ++reg) { const int cr = (reg & 3) + 8 * (reg >> 2) + 4 * hh;
              const int i = 32 * mi + cr, j = 32 * nj + r;
              LM[i * 64 + j] = (i > j) ? BT[i] * kk[reg] * __expf(GC[i] - gj) : 0.f;
              const int key = 32 * nj + cr, qr = 32 * mi + r;
              av[reg] = (qr >= key) ? qk[reg] * __expf(gq - GC[key]) : 0.f; }
#pragma unroll
          for (int s = 0; s < 2; ++s) { v4u o; o.x = cvt_pk_bf16(av[8 * s], av[8 * s + 1]); o.y = cvt_pk_bf16(av[8 * s + 2], av[8 * s + 3]); o.z = cvt_pk_bf16(av[8 * s + 4], av[8 * s + 5]); o.w = cvt_pk_bf16(av[8 * s + 6], av[8 * s + 7]);
              st_wt16(rec + 49152 + ((mi * 2 + nj) * 2 + s) * 1024 + lane * 16, o); }
        }
#pragma unroll
        for (int i = 0; i < 4; ++i) { const int p = t + 256 * i; st_wt16(rec + 16384 + p * 16, afrag_piece_rows<true>(L + PK_QN, EG, p)); }
        { const float gl = GC[63];
#pragma unroll
          for (int i = 0; i < 4; ++i) { const int p = t + 256 * i, f = p >> 6, ln = p & 63, mt = f >> 2, ct = (f >> 1) & 1, s = f & 1, dk = 32 * mt + (ln & 31), cb = 32 * ct + 16 * s + 4 * (ln >> 5);
              float e[8];
#pragma unroll
              for (int j = 0; j < 8; ++j) { const int c = cb + 8 * (j >> 2) + (j & 3); e[j] = bf2f(*(const LAS unsigned short*)(L + PK_KN + c * PROW + dk * 2)) * __expf(gl - GC[c]); }
              st_wt16(rec + 32768 + p * 16, pack8(e)); } }
        LBAR();
        { float X[64]; const bool isu = t < 128; const int col = t & 127;
          const LAS unsigned char* src = L + (isu ? PK_VV : PK_KN) + col * 2;
#pragma unroll
          for (int i = 0; i < 64; ++i) {
              const float egi = EG[i]; const float rhs = bf2f(*(const LAS unsigned short*)(src + i * PROW)) * BT[i] * (isu ? 1.0f : egi);
              float a0 = 0.f, a1 = 0.f, a2 = 0.f, a3 = 0.f;
#pragma unroll
              for (int j4 = 0; j4 < (i + 3) / 4; ++j4) { const f32x4 l = *(const LAS f32x4*)(LM + i * 64 + 4 * j4);
                  if (4 * j4 + 0 < i) a0 += l.x * X[4 * j4 + 0]; if (4 * j4 + 1 < i) a1 += l.y * X[4 * j4 + 1]; if (4 * j4 + 2 < i) a2 += l.z * X[4 * j4 + 2]; if (4 * j4 + 3 < i) a3 += l.w * X[4 * j4 + 3]; }
              X[i] = rhs - ((a0 + a1) + (a2 + a3)); asm volatile("" : "+v"(X[i]) :: "memory"); }
          LBAR();
          if (isu) { const int vs = col >> 5, dvl = col & 31;
#pragma unroll
              for (int mt = 0; mt < 2; ++mt)
#pragma unroll
                  for (int h2 = 0; h2 < 2; ++h2) { v4u* dst = (v4u*)(rec + REC_A + (size_t)(((vs * 2 + mt) * 64 + dvl + 32 * h2) * 32));
#pragma unroll
                      for (int a2 = 0; a2 < 2; ++a2) { const int i0 = 32 * mt + 4 * h2 + 16 * a2; v4u w;
                          w.x = cvt_pk_bf16(X[i0], X[i0 + 1]); w.y = cvt_pk_bf16(X[i0 + 2], X[i0 + 3]); w.z = cvt_pk_bf16(X[i0 + 8], X[i0 + 9]); w.w = cvt_pk_bf16(X[i0 + 10], X[i0 + 11]); st_wt16(dst + a2, w); } }
          } else {
#pragma unroll
              for (int i = 0; i < 64; ++i) *(LAS unsigned short*)(L + PK_VV + i * PROW + col * 2) = (unsigned short)(cvt_pk_bf16(-X[i], 0.f) & 0xffffu);
          }
        }
        LBAR();
#pragma unroll
        for (int i = 0; i < 4; ++i) { const int p = t + 256 * i; st_wt16(rec + p * 16, afrag_piece_rows<false>(L + PK_VV, EG, p)); }
        asm volatile("s_waitcnt vmcnt(0)" ::: "memory"); __syncthreads();
        if (tid == 0) {
            __hip_atomic_store(FLG + (2 * (pu & 7)) * NCH + n, 1u, __ATOMIC_RELAXED, __HIP_MEMORY_SCOPE_AGENT); __hip_atomic_store(FLG + (2 * (pu & 7) + 1) * NCH + n, 1u, __ATOMIC_RELAXED, __HIP_MEMORY_SCOPE_AGENT); }
    }
}

__device__ __forceinline__ bf16x8 pack_acc(const f32x16& x, int s) {
    v4u p; p.x = cvt_pk_bf16(x[8 * s], x[8 * s + 1]); p.y = cvt_pk_bf16(x[8 * s + 2], x[8 * s + 3]); p.z = cvt_pk_bf16(x[8 * s + 4], x[8 * s + 5]); p.w = cvt_pk_bf16(x[8 * s + 6], x[8 * s + 7]);
    return __builtin_bit_cast(bf16x8, p);
}
#define MFMA32(a, b, c) __builtin_amdgcn_mfma_f32_32x32x16_bf16((a), (b), (c), 0, 0, 0)
#define PIN_SCHED() __builtin_amdgcn_sched_barrier(0)
__device__ __forceinline__ int chain_ready(const unsigned* fl, int have, int lane) {
    for (;;) {
        const int idx = have + 1 + lane;
        const unsigned f = (idx < NCH) ? __hip_atomic_load(fl + idx, __ATOMIC_RELAXED, __HIP_MEMORY_SCOPE_AGENT) : 0u;
        const unsigned long long m = __ballot(f != 0u);
        const int pre = (m == ~0ull) ? 64 : __builtin_ctzll(~m);
        if (pre > 0) { __builtin_amdgcn_fence(__ATOMIC_ACQUIRE, "agent"); asm volatile("s_waitcnt vmcnt(0)" ::: "memory"); return have + pre; }
        __builtin_amdgcn_s_sleep(16);
    }
}
__device__ __forceinline__ void chain_phase(LAS unsigned char* lds, const unsigned char* CH, const unsigned* FLG, bf16* Oraw, int bh, int tid) {
    const int wid = __builtin_amdgcn_readfirstlane(tid >> 6), lane = tid & 63, b = bh >> 2, h = bh & 3, vs = wid & 3;
    const unsigned char* rec0 = CH + (size_t)bh * NCH * REC;
    const bool comp = wid < 4, stager = (wid >= 4);
    const int hw = wid - 4;
#define CH_MOVE(n, dstbase) do { _Pragma("unroll") for (int _i = 0; _i < 19; ++_i) { const int _pc = hw * 19 + _i; if (_pc < 73) \
        __builtin_amdgcn_global_load_lds((const unsigned*)(rec0 + (size_t)(n) * REC + _pc * 1024 + lane * 16), (LAS unsigned*)((dstbase) + _pc * 1024), 16, 0, 0); } } while (0)
#define CH_WARM(n) do { _Pragma("unroll") for (int _i = 0; _i < 10; ++_i) { const int _o = (_i * 64 + lane) * 128; \
        __builtin_amdgcn_global_load_lds((const unsigned*)(rec0 + (size_t)(n) * REC + (_o < REC ? _o : 0)), (LAS unsigned*)(dummy), 4, 0, 0); } } while (0)
    constexpr int WARM_AHEAD = 8;
    LAS unsigned char* dummy = lds + 2 * REC;
    f32x16 S[4], o0, o1;
#pragma unroll
    for (int k = 0; k < 4; ++k)
#pragma unroll
        for (int i = 0; i < 16; ++i) S[k][i] = 0.f;
#pragma unroll
    for (int i = 0; i < 16; ++i) { o0[i] = 0.f; o1[i] = 0.f; }
    const unsigned* fl = FLG + bh * NCH; int have = -1;
    if (stager) { while (have < 0) have = chain_ready(fl, have, lane); CH_MOVE(0, lds); }
    if (!comp) asm volatile("s_waitcnt vmcnt(0)" ::: "memory");
    __builtin_amdgcn_s_barrier(); asm volatile("" ::: "memory");
    for (int n = 0; n < NCH; ++n) {
        const int buf = n & 1;
        if (!comp) {
            if (stager) { if (n + 1 < NCH) { while (have < n + 1) have = chain_ready(fl, have, lane); CH_MOVE(n + 1, lds + (buf ^ 1) * REC); } asm volatile("s_waitcnt vmcnt(0)" ::: "memory"); }
            else { const int wn = n + 1 + WARM_AHEAD; if (wn < NCH) { if (have < wn) { const int idx = have + 1 + lane; const unsigned f = (idx < NCH) ? __hip_atomic_load(fl + idx, __ATOMIC_RELAXED, __HIP_MEMORY_SCOPE_AGENT) : 0u;
                        const unsigned long long m = __ballot(f != 0u); const int pre = (m == ~0ull) ? 64 : __builtin_ctzll(~m); if (pre > 0) { __builtin_amdgcn_fence(__ATOMIC_ACQUIRE, "agent"); have += pre; } }
                    if (have >= wn) CH_WARM(wn); }
                   asm volatile("s_waitcnt vmcnt(20)" ::: "memory"); }
        } else {
            const LAS unsigned char* B = lds + buf * REC + lane * 16;
            const float egl = *(const LAS float*)(lds + buf * REC + 73728);
            f32x16 v0, v1;
            { const LAS v4u* ul = (const LAS v4u*)(lds + buf * REC + 57344 + ((vs * 2) * 64 + lane) * 32);
              const v4u a0 = ul[0], a1 = ul[1], b0 = ul[128], b1 = ul[129];
              v0[0] = bflo(a0.x); v0[1] = bfhi(a0.x); v0[2] = bflo(a0.y); v0[3] = bfhi(a0.y); v0[4] = bflo(a0.z); v0[5] = bfhi(a0.z); v0[6] = bflo(a0.w); v0[7] = bfhi(a0.w);
              v0[8] = bflo(a1.x); v0[9] = bfhi(a1.x); v0[10] = bflo(a1.y); v0[11] = bfhi(a1.y); v0[12] = bflo(a1.z); v0[13] = bfhi(a1.z); v0[14] = bflo(a1.w); v0[15] = bfhi(a1.w);
              v1[0] = bflo(b0.x); v1[1] = bfhi(b0.x); v1[2] = bflo(b0.y); v1[3] = bfhi(b0.y); v1[4] = bflo(b0.z); v1[5] = bfhi(b0.z); v1[6] = bflo(b0.w); v1[7] = bfhi(b0.w);
              v1[8] = bflo(b1.x); v1[9] = bfhi(b1.x); v1[10] = bflo(b1.y); v1[11] = bfhi(b1.y); v1[12] = bflo(b1.z); v1[13] = bfhi(b1.z); v1[14] = bflo(b1.w); v1[15] = bfhi(b1.w); }
#pragma unroll
            for (int i = 0; i < 16; ++i) { o0[i] = 0.f; o1[i] = 0.f; }
#define LDF(dst, off) dst = *(const LAS bf16x8*)(B + (off))
#define LD_WQ(F, kt, s) do { LDF(F[0], ((0 * 4 + (kt)) * 2 + (s)) * 1024); LDF(F[1], ((1 * 4 + (kt)) * 2 + (s)) * 1024); LDF(F[2], 16384 + ((0 * 4 + (kt)) * 2 + (s)) * 1024); LDF(F[3], 16384 + ((1 * 4 + (kt)) * 2 + (s)) * 1024); } while (0)
#define MM_WQ(F, kt, s) do { const bf16x8 sb = pack_acc(S[kt], s); v0 = MFMA32(F[0], sb, v0); v1 = MFMA32(F[1], sb, v1); o0 = MFMA32(F[2], sb, o0); o1 = MFMA32(F[3], sb, o1); asm volatile("" : "+v"(o0), "+v"(o1)); } while (0)
#define LD_AT(F, ct) do { LDF(F[0], 49152 + ((0 * 2 + (ct)) * 2 + 0) * 1024); LDF(F[1], 49152 + ((1 * 2 + (ct)) * 2 + 0) * 1024); LDF(F[2], 49152 + ((0 * 2 + (ct)) * 2 + 1) * 1024); LDF(F[3], 49152 + ((1 * 2 + (ct)) * 2 + 1) * 1024); } while (0)
#define MM_AT(F, ct) do { o0 = MFMA32(F[0], vb[ct][0], o0); o1 = MFMA32(F[1], vb[ct][0], o1); o0 = MFMA32(F[2], vb[ct][1], o0); o1 = MFMA32(F[3], vb[ct][1], o1); } while (0)
#define LD_KD(F, ct, s) do { _Pragma("unroll") for (int q = 0; q < 4; ++q) LDF(F[q], 32768 + ((q * 2 + (ct)) * 2 + (s)) * 1024); } while (0)
#define MM_KD(F, ct, s) do { _Pragma("unroll") for (int q = 0; q < 4; ++q) S[q] = MFMA32(F[q], vb[ct][s], S[q]); } while (0)
            bf16x8 FA[4], FB[4];
            LD_WQ(FA, 0, 0); PIN_SCHED();
            LD_WQ(FB, 0, 1); PIN_SCHED(); MM_WQ(FA, 0, 0); PIN_SCHED();
            LD_WQ(FA, 1, 0); PIN_SCHED(); MM_WQ(FB, 0, 1); PIN_SCHED();
            LD_WQ(FB, 1, 1); PIN_SCHED(); MM_WQ(FA, 1, 0); PIN_SCHED();
            LD_WQ(FA, 2, 0); PIN_SCHED(); MM_WQ(FB, 1, 1); PIN_SCHED();
            LD_WQ(FB, 2, 1); PIN_SCHED(); MM_WQ(FA, 2, 0); PIN_SCHED();
            LD_WQ(FA, 3, 0); PIN_SCHED(); MM_WQ(FB, 2, 1); PIN_SCHED();
            LD_WQ(FB, 3, 1); PIN_SCHED(); MM_WQ(FA, 3, 0); PIN_SCHED();
            LD_AT(FA, 0); PIN_SCHED(); MM_WQ(FB, 3, 1); PIN_SCHED();
            bf16x8 vb[2][2];
            vb[0][0] = pack_acc(v0, 0); vb[0][1] = pack_acc(v0, 1); vb[1][0] = pack_acc(v1, 0); vb[1][1] = pack_acc(v1, 1);
            LD_AT(FB, 1); PIN_SCHED(); MM_AT(FA, 0); PIN_SCHED();
#pragma unroll
            for (int kt = 0; kt < 4; ++kt)
#pragma unroll
                for (int i = 0; i < 16; ++i) S[kt][i] *= egl;
            LD_KD(FA, 0, 0); PIN_SCHED(); MM_AT(FB, 1); PIN_SCHED();
            { bf16* op = Oraw + (size_t)(b * SEQ + n * 64 + 4 * (lane >> 5)) * 512 + h * 128 + vs * 32 + (lane & 31); asm volatile("" : "+v"(op));
#pragma unroll
              for (int reg = 0; reg < 16; ++reg) { const int cr = (reg & 3) + 8 * (reg >> 2); const unsigned pk = cvt_pk_bf16(o0[reg], o1[reg]); op[cr * 512] = (bf16)(pk & 0xffffu); op[(32 + cr) * 512] = (bf16)(pk >> 16); } }
            PIN_SCHED();
            LD_KD(FB, 0, 1); PIN_SCHED(); MM_KD(FA, 0, 0); PIN_SCHED();
            LD_KD(FA, 1, 0); PIN_SCHED(); MM_KD(FB, 0, 1); PIN_SCHED();
            LD_KD(FB, 1, 1); PIN_SCHED(); MM_KD(FA, 1, 0); PIN_SCHED();
            MM_KD(FB, 1, 1);
#undef MM_AT
#undef MM_KD
#undef LDF
#undef LD_WQ
#undef MM_WQ
#undef LD_AT
#undef LD_KD
            asm volatile("s_waitcnt lgkmcnt(0)" ::: "memory");
        }
        __builtin_amdgcn_s_barrier(); asm volatile("" ::: "memory");
    }
    asm volatile("s_waitcnt vmcnt(0)" ::: "memory");
#undef CH_MOVE
#undef CH_WARM
}
#if DN_NAIVE
__device__ __forceinline__ void naive_dn(const bf16* QKV, const float* GB, float* Oraw, int unit, int lane) {
    const int bh = unit >> 1, dv = (unit & 1) * 64 + lane, b = bh >> 2, h = bh & 3;
    float S[128];
#pragma unroll
    for (int i = 0; i < 128; ++i) S[i] = 0.f;
    for (int t = 0; t < SEQ; ++t) { const size_t m = (size_t)b * SEQ + t;
        const float al = __expf(GB[m * 8 + h]), be = GB[m * 8 + 4 + h];
        const bf16* qp = QKV + m * 1536 + h * 128; const bf16* kp = qp + 512; const float v = bf2f(qp[1024 + dv]);
        float r = 0.f;
#pragma unroll
        for (int i = 0; i < 128; ++i) { S[i] *= al; r += bf2f(kp[i]) * S[i]; if ((i & 15) == 15) asm volatile("" : "+v"(r) :: "memory"); }
        const float d = be * (v - r); float o = 0.f;
#pragma unroll
        for (int i = 0; i < 128; ++i) { S[i] += bf2f(kp[i]) * d; o += bf2f(qp[i]) * S[i]; if ((i & 15) == 15) asm volatile("" : "+v"(o) :: "memory"); }
        Oraw[m * 512 + h * 128 + dv] = o; }
}
#endif
template <bool OB16>
__device__ __forceinline__ void opost_rows(const void* Oraw_, const bf16* P, const float* gdn, bf16* YC, int gw, int NGW, int lane) {
    const float* Oraw = (const float*)Oraw_; const bf16* Ob = (const bf16*)Oraw_;
    float gd[8];
#pragma unroll
    for (int e = 0; e < 8; ++e) gd[e] = gdn[(8 * lane + e) & 127];
    for (int blk = gw; blk < M / 16; blk += NGW) { const int m0 = blk * 16;
#pragma unroll 1
        for (int i = 0; i < 16; i += 8) {
            f32x4 oa[8], ob[8]; v4u zz[8];
#pragma unroll
            for (int t = 0; t < 8; ++t) { const int m = m0 + i + t;
                if (OB16) { float f[8]; unpack8(*(const v4u*)(Ob + (size_t)m * 512 + 8 * lane), f); oa[t] = (f32x4){f[0], f[1], f[2], f[3]}; ob[t] = (f32x4){f[4], f[5], f[6], f[7]}; }
                else { const f32x4* op = (const f32x4*)(Oraw + (size_t)m * 512 + 8 * lane); oa[t] = op[0]; ob[t] = op[1]; }
                zz[t] = *(const v4u*)(P + (size_t)m * NP + 3072 + 8 * lane); }
#pragma unroll
            for (int t = 0; t < 8; ++t) { const int m = m0 + i + t; float z[8]; unpack8(zz[t], z);
                float o[8] = {oa[t].x, oa[t].y, oa[t].z, oa[t].w, ob[t].x, ob[t].y, ob[t].z, ob[t].w}; float ss = 0.f;
#pragma unroll
                for (int e = 0; e < 8; ++e) ss += o[e] * o[e];
                ss += __shfl_xor(ss, 1); ss += __shfl_xor(ss, 2); ss += __shfl_xor(ss, 4); ss += __shfl_xor(ss, 8);
                const float r = 1.0f / sqrtf(ss * (1.0f / 128.0f) + EPS);
#pragma unroll
                for (int e = 0; e < 8; ++e) o[e] = o[e] * r * gd[e] * silu_f(z[e]);
                *(v4u*)(YC + (size_t)m * D + 512 + 8 * lane) = pack8(o); } } }
}

typedef __attribute__((address_space(1))) unsigned gu32;
#define XB_TMO      128
#define XB_XCNT(j)  (256  + 64 * (j))
#define XB_XSUB(j)  (1280 + 64 * (j))
#define XB_XGEN(j)  (2304 + 64 * (j))
#define XB_TOP      3328
#define XB_TOPGEN   3392
#define XCD_BAR_WORDS 3456
#define XB_SPIN_CAP (1u << 18)

__device__ __forceinline__ unsigned xb_ld(unsigned* p)              { return __hip_atomic_load(p, __ATOMIC_RELAXED, __HIP_MEMORY_SCOPE_AGENT); }
__device__ __forceinline__ unsigned xb_add(unsigned* p, unsigned v) { return __hip_atomic_fetch_add(p, v, __ATOMIC_RELAXED, __HIP_MEMORY_SCOPE_AGENT); }
__device__ __forceinline__ unsigned xb_xcc_id() { return (unsigned)__builtin_amdgcn_s_getreg((3 << 11) | 20) & 0xFu; }
#define XB_SPIN(cond, bar) do { unsigned _sp = 0; while (cond) { __builtin_amdgcn_s_sleep(1); \
    if ((++_sp & 255u) == 0u) { if (xb_ld(&(bar)[XB_TMO])) break; if (_sp > XB_SPIN_CAP) { atomicAdd(&(bar)[XB_TMO], 1u); break; } } } } while (0)

struct XcdBarrier {
    unsigned* bar; unsigned x;
    volatile LAS unsigned* st;
};

__device__ __forceinline__ XcdBarrier xcd_barrier_post(unsigned* bar, volatile LAS unsigned* st) {
    XcdBarrier b; b.bar = bar; b.x = xb_xcc_id(); b.st = st;
    if (threadIdx.x == 0) (void)xb_add(&bar[XB_XCNT(b.x)], 1u);
    return b;
}
__device__ __forceinline__ void xcd_barrier_complete(unsigned* bar, unsigned x, unsigned& nloc, unsigned& nx) {
    const unsigned G = gridDim.x * gridDim.y * gridDim.z;
    unsigned sum, cnt, mine, sp = 0u;
    for (;;) {
        sum = 0u; cnt = 0u; mine = 0u;
#pragma unroll
        for (unsigned j = 0; j < 16; ++j) { const unsigned c = xb_ld(&bar[XB_XCNT(j)]); sum += c; cnt += (c > 0u) ? 1u : 0u; mine = (j == x) ? c : mine; }
        if (sum == G) break;
        __builtin_amdgcn_s_sleep(1);
        if ((++sp & 255u) == 0u) { if (xb_ld(&bar[XB_TMO])) break; if (sp > XB_SPIN_CAP) { atomicAdd(&bar[XB_TMO], 1u); break; } }
    }
    nloc = mine > 0u ? mine : 1u; nx = cnt > 0u ? cnt : 1u;
}

__device__ __forceinline__ void xcd_barrier(const XcdBarrier& b) {
    asm volatile("s_waitcnt vmcnt(0)" ::: "memory");
    __syncthreads();
    if (threadIdx.x == 0) {
        unsigned* bar = b.bar;
        __builtin_amdgcn_s_waitcnt(0);
        unsigned nloc = b.st[0], nx = b.st[1];
        if (nloc == 0u) { xcd_barrier_complete(bar, b.x, nloc, nx); b.st[0] = nloc; b.st[1] = nx; }
        const unsigned old = xb_add(&bar[XB_XSUB(b.x)], 1u);
        const unsigned gen = old / nloc;
        if (old + 1u == (gen + 1u) * nloc) {
            __builtin_amdgcn_fence(__ATOMIC_RELEASE, "agent");
            asm volatile("s_waitcnt vmcnt(0)" ::: "memory");
            const unsigned og = xb_add(&bar[XB_TOP], 1u);
            const unsigned tg = og / nx;
            if (og + 1u == (tg + 1u) * nx) xb_add(&bar[XB_TOPGEN], 1u);
            else XB_SPIN(xb_ld(&bar[XB_TOPGEN]) == tg, bar);
            __builtin_amdgcn_fence(__ATOMIC_ACQUIRE, "agent");
            xb_add(&bar[XB_XGEN(b.x)], 1u);
            asm volatile("s_waitcnt vmcnt(0)" ::: "memory");
        } else {
            XB_SPIN(xb_ld(&bar[XB_XGEN(b.x)]) == gen, bar);
            __builtin_amdgcn_fence(__ATOMIC_ACQUIRE, "agent");
            asm volatile("s_waitcnt vmcnt(0)" ::: "memory");
        }
    }
    __syncthreads();
}

__global__ void __launch_bounds__(NWAVES * 64, 2) fwd(Args args) {
    extern __shared__ __attribute__((aligned(16))) unsigned char lds_raw[];
    LAS unsigned char* lds = (LAS unsigned char*)lds_raw;
    int tid = threadIdx.x, lane = tid & 63, wave = __builtin_amdgcn_readfirstlane(tid >> 6);
    const int G = gridDim.x; const int bx = blockIdx.x; const int vcu = (G % 8 == 0) ? (bx % 8) * (G / 8) + bx / 8 : bx;
    int gw = vcu * NWAVES + wave; const int NGW = G * NWAVES;
#define LAUNDER() do { int tv_ = threadIdx.x; asm volatile("" : "+v"(tv_)); tid = tv_; lane = tid & 63; wave = __builtin_amdgcn_readfirstlane(tid >> 6); gw = vcu * NWAVES + wave; } while (0)
    unsigned char* ws = args.ws;
    float* MOD = (float*)(ws + WS_MOD); float* GB = (float*)(ws + WS_GB); float* EGL = (float*)(ws + WS_EGL);
    bf16* WinT = (bf16*)(ws + WS_WIN); bf16* WoT = (bf16*)(ws + WS_WO); bf16* WguT = (bf16*)(ws + WS_WGU); bf16* WdT = (bf16*)(ws + WS_WD);
    bf16* H = (bf16*)(ws + WS_H); unsigned char* CH = ws + WS_CH; bf16* P = (bf16*)(ws + WS_P); bf16* ACT = (bf16*)(ws + WS_P); bf16* YC = (bf16*)(ws + WS_YC);
    bf16* QKV = (bf16*)args.out; bf16* Oraw = (bf16*)((unsigned char*)args.out + 96 * MiB); float* OUT = args.out;
    const int lo = args.ph_lo, hi = args.ph_hi;
    volatile LAS unsigned* MISC = (volatile LAS unsigned*)(lds + LDS_BYTES - 64);
    if (tid < 16) MISC[tid] = 0u;
    __syncthreads();
    XcdBarrier bar = xcd_barrier_post((unsigned*)ws, MISC);
    if (lo < 0) cg::this_grid().sync();
#ifndef PH_MASK
#define PH_MASK 0xFFF
#endif
#define IN(k) (((PH_MASK >> (k)) & 1) && lo <= (k) && (k) < hi)
#if MK_N_LAUNCHES == 1
#define SEAM(k) do { if (IN(k) && IN((k) + 1) && (k) != 5) xcd_barrier(bar); } while (0)
#else
#define SEAM(k) do { } while (0)
#endif
#ifndef REP_MASK
#define REP_MASK 0
#endif
#define BEGIN_REP(k) for (int rep_ = 0; rep_ <= ((REP_MASK >> (k)) & 1); ++rep_) { if (rep_) xcd_barrier(bar); LAUNDER();
#define END_REP }
    BEGIN_REP(0)
    if (IN(0)) {
        LAS float* scr = (LAS float*)(lds + wave * 16384);
        constexpr int I_IN = 16 * 112, I_O = 16 * 32, I_GU = 16 * 176, I_DN = 44 * 32, NITEMS = I_IN + I_O + I_GU + I_DN;
        for (int it = gw; it < NITEMS; it += NGW) { int r = it;
            if (r < I_IN) { p0_transpose_item<0>(args.in[I_WIN], D, PIN, 112, WinT, scr, r, lane); continue; } r -= I_IN;
            if (r < I_O) { p0_transpose_item<0>(args.in[I_WOUT], D, D, 32, WoT, scr, r, lane); continue; } r -= I_O;
            if (r < I_GU) { p0_transpose_item<1>(args.in[I_WGU], D, 2 * FF, 176, WguT, scr, r, lane); continue; } r -= I_GU;
            p0_transpose_item<0>(args.in[I_WDN], FF, D, 32, WdT, scr, r, lane); }
        __syncthreads();
        { LAS float* SC = (LAS float*)lds; const float* cin = args.in[I_C];
          for (int idx = tid; idx < 4096; idx += NWAVES * 64) { const int b = idx >> 10, k = idx & 1023; const float cv = cin[idx]; SC[k * 4 + b] = cv / (1.0f + __expf(-cv)); }
          __syncthreads();
          for (int it = bx; it < 256; it += G) p0_mod_item(args, MOD, SC, (LAS float*)(lds + 16384), it, tid); }
    }
    END_REP
    SEAM(0);
    BEGIN_REP(1)
    if (IN(1)) { LAS float* TT = (LAS float*)lds; const float* wi = args.in[I_WIN];
        for (int idx = tid; idx < 8192; idx += NWAVES * 64) { const int k = idx >> 3, e = idx & 7; TT[e * 1024 + k] = wi[(size_t)k * PIN + NP + e]; }
        __syncthreads();
        adaln_rows<0>(args.in[I_X], args.in[I_GMIX], MOD + 0, MOD + 1024, 6144, H, nullptr, TT, args.in[I_ALOG], args.in[I_DTB], GB, gw, NGW, lane);
        __syncthreads(); }
    END_REP
    SEAM(1);
    BEGIN_REP(2)
    if (IN(2)) { pg8::Gemm g{H, WinT, M, NP, D}; pg8::StaticOrder S; S.init(M, NP, G, bx); pg8::EpiBf16 E{P, NP};
        pg8::gemm_phase<pg8::EpiBf16, pg8::StaticOrder, true, true>(lds, g, S, E); }
    END_REP
    SEAM(2);
    BEGIN_REP(3)
    if (IN(3)) conv_pass(P, args.in[I_CWM], args.in[I_CWQ], args.in[I_GCO], YC, QKV, gw, NGW, lane);
    END_REP
    SEAM(3);
#if DN_NAIVE
    SEAM(4);
    if (IN(5)) { if (bx < 32 && wave == 0) naive_dn(QKV, GB, (float*)(ws + WS_CH), bx, lane); }
    SEAM(5);
    if (IN(6)) opost_rows<false>((const float*)(ws + WS_CH), P, args.in[I_GDN], YC, gw, NGW, lane);
#else
    BEGIN_REP(4)
    if (IN(4)) { unsigned* FLG = (unsigned*)(ws + 16384);
        if (bx < NBH) chain_phase(lds, CH, FLG, Oraw, bx, tid); else prep_phase(lds, QKV, GB, EGL, CH, FLG, bx - NBH, G - NBH, tid); }
    END_REP
    SEAM(4);
    BEGIN_REP(6)
    if (IN(6)) opost_rows<true>(Oraw, P, args.in[I_GDN], YC, gw, NGW, lane);
    END_REP
#endif
    SEAM(6);
    BEGIN_REP(7)
    if (IN(7)) { pg8::Gemm g{YC, WoT, M, D, D}; pg8::StaticOrder S; S.init(M, D, G, bx); pg8::EpiResGate E{args.in[I_X], OUT, MOD + 2048, 6144};
        pg8::gemm_phase<pg8::EpiResGate, pg8::StaticOrder, true, true>(lds, g, S, E); }
    END_REP
    SEAM(7);
    BEGIN_REP(8)
    if (IN(8)) adaln_rows<1>(OUT, args.in[I_GFFN], MOD + 3072, MOD + 4096, 6144, H, nullptr, nullptr, nullptr, nullptr, nullptr, gw, NGW, lane);
    END_REP
    SEAM(8);
    BEGIN_REP(9)
    if (IN(9)) { pg8::Gemm g{H, WguT, M, 2 * FF, D}; pg8::StaticOrder S; S.init(M, 2 * FF, G, bx); pg8::EpiSwiglu E{ACT, FF};
        pg8::gemm_phase<pg8::EpiSwiglu, pg8::StaticOrder, true, true>(lds, g, S, E); }
    END_REP
    SEAM(9);
    BEGIN_REP(10)
    if (IN(10)) { pg8::Gemm g{ACT, WdT, M, D, FF}; pg8::StaticOrder S; S.init(M, D, G, bx);
        pg8::EpiResGateNorm E{OUT, OUT, MOD + 5120, 6144, args.in[I_GFIN], MOD + 4 * 6144, MOD + 4 * 6144 + 1024, 2048, (float*)(ws + WS_EGL), (unsigned*)(ws + 32768), lds + 131072};
        pg8::gemm_phase<pg8::EpiResGateNorm, pg8::StaticOrder, true, true>(lds, g, S, E); }
    END_REP
    LAUNDER();
    if (IN(11) && G != 256) adaln_rows<2>(OUT, args.in[I_GFIN], MOD + 4 * 6144, MOD + 4 * 6144 + 1024, 2048, nullptr, OUT, nullptr, nullptr, nullptr, nullptr, gw, NGW, lane);
#undef IN
#undef SEAM
}

extern "C" void kernel_launch(void* const* d_in, const int* in_sizes, int n_in, void* d_out, int out_size, void* d_ws, size_t ws_size, hipStream_t stream) {
    static int grid = 0;
    if (grid == 0) {
        if (n_in != 19 || out_size != M * D || ws_size < WS_END) { fprintf(stderr, "kernel_launch: unexpected shapes (n_in %d, out %d, ws %zu)\n", n_in, out_size, ws_size); grid = -1; return; }
        int dev = 0, cus = 0;
        if (hipGetDevice(&dev) != hipSuccess || hipDeviceGetAttribute(&cus, hipDeviceAttributeMultiprocessorCount, dev) != hipSuccess) { grid = -1; return; }
        if (hipFuncSetAttribute((const void*)fwd, hipFuncAttributeMaxDynamicSharedMemorySize, LDS_BYTES) != hipSuccess) { fprintf(stderr, "kernel_launch: hipFuncSetAttribute failed\n"); grid = -1; return; }
        int per_cu = 0;
        if (hipOccupancyMaxActiveBlocksPerMultiprocessor(&per_cu, (const void*)fwd, NWAVES * 64, LDS_BYTES) != hipSuccess || per_cu < 1) { fprintf(stderr, "kernel_launch: occupancy query says %d blocks per CU\n", per_cu); }
        (void)hipGetLastError();
        grid = cus;
    }
    if (grid < 0) return;
    Args a{};
    for (int i = 0; i < 19; ++i) a.in[i] = (const float*)d_in[i];
    a.out = (float*)d_out; a.ws = (unsigned char*)d_ws;
#if MK_N_LAUNCHES == 1
    if (hipMemsetAsync(d_ws, 0, 49152, stream) != hipSuccess) { fprintf(stderr, "kernel_launch: memset of the barrier words failed\n"); return; }
    a.ph_lo = 0; a.ph_hi = PH_END;
    void* kargs[] = {&a};
    hipError_t e = hipLaunchCooperativeKernel((const void*)fwd, dim3(grid), dim3(NWAVES * 64), kargs, LDS_BYTES, stream);
    if (e != hipSuccess) fprintf(stderr, "kernel_launch: cooperative launch failed: %s (grid %d)\n", hipGetErrorString(e), grid);
#else
    for (int ph = 0; ph < PH_END; ++ph) { a.ph_lo = ph; a.ph_hi = ph + 1; hipLaunchKernelGGL(fwd, dim3(grid), dim3(NWAVES * 64), LDS_BYTES, stream, a); }
#endif
}
```

```cpp
#include <hip/hip_runtime.h>
#include <hip/hip_cooperative_groups.h>
#include <cstdio>
#include <cstdint>
namespace cg = cooperative_groups;
#ifndef MK_N_LAUNCHES
#define MK_N_LAUNCHES 1
#endif
#ifndef DN_NAIVE
#define DN_NAIVE 0
#endif
namespace pg8 {
#define PG8_LAS __attribute__((address_space(3)))
typedef unsigned short bf16_t;
typedef short bf16x8 __attribute__((ext_vector_type(8)));
typedef float f32x4 __attribute__((ext_vector_type(4)));
typedef unsigned u32x4 __attribute__((ext_vector_type(4)));
constexpr int BM = 256, BK = 64, HALF = 128, HTB = HALF * BK * 2  , STAGE_BYTES = 8 * HTB, NXCD = 8, WGM = 8;

__host__ __device__ __forceinline__ int lds_byte(int r, int c) { const int st = (r >> 4) * 2 + (c >> 5), rr = r & 15, cc = c & 31, ob = rr * 64 + cc * 2; return st * 1024 + (ob ^ (((ob >> 9) & 1) << 5)); }
__host__ __device__ __forceinline__ void stage_rc(int b, int& R, int& C) { const int st = b / 1024, sb = b % 1024, swz = sb ^ (((sb >> 9) & 1) << 5); R = (st >> 1) * 16 + swz / 64; C = (st & 1) * 32 + (swz % 64) / 2; }
__host__ __device__ __forceinline__ int perm32(int rho) { const int n = rho >> 4, i = rho & 15; return 8 * (i >> 2) + 4 * n + (i & 3); }

struct Unit { int pm, pn; };
struct Gemm { const bf16_t* A; const bf16_t* Bt; int M, N, K; };

struct StaticOrder {
    int nM, nN, nwg, G, c;
    __host__ __device__ void init(int M, int N, int G_, int c_) { nM = M / BM; nN = N / BM; nwg = nM * nN; G = G_; c = c_; }
    __host__ __device__ bool next(int i, Unit& u) const {
        const long L = (long)i * G + c; if (L >= nwg) return false;
        int wgid = (int)L; { const int q = nwg / NXCD, r = nwg % NXCD, xcd = wgid % NXCD, off = wgid / NXCD; wgid = (xcd < r ? xcd * (q + 1) : r * (q + 1) + (xcd - r) * q) + off; }
        const int nig = WGM * nN, gid = wgid / nig, fm = gid * WGM, gsz = (nM - fm) < WGM ? (nM - fm) : WGM;
        u.pm = fm + ((wgid % nig) % gsz); u.pn = (wgid % nig) / gsz; return true;
    }
    __device__ __forceinline__ void a_ready(const Unit&) const {}
    __device__ __forceinline__ void done(const Unit&) const {}
};

typedef float f32x2 __attribute__((ext_vector_type(2)));
typedef __bf16 bf16x2v __attribute__((ext_vector_type(2)));
__device__ __forceinline__ unsigned cvt_pk_bf16(float lo, float hi) { f32x2 v = {lo, hi}; bf16x2v r = __builtin_convertvector(v, bf16x2v); return __builtin_bit_cast(unsigned, r); }
__device__ __forceinline__ float silu_f(float x) { return x * __builtin_amdgcn_rcpf(1.0f + __builtin_amdgcn_exp2f(-1.4426950408889634f * x)); }

struct EpiBf16 {
    static constexpr bool PERM = true, AFTER_DRAIN = false;
    bf16_t* O; int ldc;
    __device__ __forceinline__ void operator()(const f32x4 (&acc)[2][2][4][2], const Unit& u, int wr, int wc, int fr, int fq) const {
        const int row0 = u.pm * BM + wr * 64 + fr; const int col0 = u.pn * BM + wc * 32 + 8 * fq;
#pragma unroll
        for (int ai = 0; ai < 2; ++ai)
#pragma unroll
            for (int m = 0; m < 4; ++m) { bf16_t* rowp = O + (size_t)(row0 + ai * HALF + m * 16) * ldc + col0;
#pragma unroll
                for (int bj = 0; bj < 2; ++bj) { const f32x4 v0 = acc[ai][bj][m][0], v1 = acc[ai][bj][m][1];
                    u32x4 w; w.x = cvt_pk_bf16(v0[0], v0[1]); w.y = cvt_pk_bf16(v0[2], v0[3]); w.z = cvt_pk_bf16(v1[0], v1[1]); w.w = cvt_pk_bf16(v1[2], v1[3]);
                    *(u32x4*)(rowp + bj * HALF) = w; } }
    }
};
struct EpiSwiglu {
    static constexpr bool PERM = true, AFTER_DRAIN = false;
    bf16_t* O; int ldc;
    __device__ __forceinline__ void operator()(const f32x4 (&acc)[2][2][4][2], const Unit& u, int wr, int wc, int fr, int fq) const {
        const int row0 = u.pm * BM + wr * 64 + fr; const int col0 = u.pn * HALF + wc * 32 + 8 * fq;
#pragma unroll
        for (int ai = 0; ai < 2; ++ai)
#pragma unroll
            for (int m = 0; m < 4; ++m) { bf16_t* rowp = O + (size_t)(row0 + ai * HALF + m * 16) * ldc + col0;
                const f32x4 g0 = acc[ai][0][m][0], g1 = acc[ai][0][m][1], u0 = acc[ai][1][m][0], u1 = acc[ai][1][m][1];
                u32x4 w; w.x = cvt_pk_bf16(silu_f(g0[0]) * u0[0], silu_f(g0[1]) * u0[1]); w.y = cvt_pk_bf16(silu_f(g0[2]) * u0[2], silu_f(g0[3]) * u0[3]);
                w.z = cvt_pk_bf16(silu_f(g1[0]) * u1[0], silu_f(g1[1]) * u1[1]); w.w = cvt_pk_bf16(silu_f(g1[2]) * u1[2], silu_f(g1[3]) * u1[3]);
                *(u32x4*)rowp = w; }
    }
};
struct EpiResGate {
    static constexpr bool PERM = false, AFTER_DRAIN = false;
    const float* base; float* out; const float* gate;
    int gstride;
    __device__ __forceinline__ void operator()(const f32x4 (&acc)[2][2][4][2], const Unit& u, int wr, int wc, int fr, int fq) const {
        const int b = u.pm >> 5;
        const int col0 = u.pn * BM + wc * 32 + 4 * fq; const float* gp = gate + (size_t)b * gstride + col0;
        f32x4 gv[2][2];
#pragma unroll
        for (int bj = 0; bj < 2; ++bj)
#pragma unroll
            for (int n = 0; n < 2; ++n) gv[bj][n] = *(const f32x4*)(gp + bj * HALF + n * 16);
#pragma unroll
        for (int ai = 0; ai < 2; ++ai)
#pragma unroll
            for (int m = 0; m < 4; ++m) { const size_t off = (size_t)(u.pm * BM + ai * HALF + wr * 64 + m * 16 + fr) * 1024 + col0;
#pragma unroll
                for (int bj = 0; bj < 2; ++bj)
#pragma unroll
                    for (int n = 0; n < 2; ++n) { const f32x4 bs = *(const f32x4*)(base + off + bj * HALF + n * 16);
                        *(f32x4*)(out + off + bj * HALF + n * 16) = bs + gv[bj][n] * acc[ai][bj][m][n]; } }
    }
};

template <bool MID> struct EpiResGateNorm {
    static constexpr bool PERM = false, AFTER_DRAIN = false;
    const float* base; float* out; bf16_t* hb; const float* gate; int gstride;
    const float* gain; const float* shiftp; const float* scalep; int mstride;
    float* SS; unsigned* cnt; PG8_LAS unsigned char* xl;
    __device__ __forceinline__ void operator()(f32x4 (&acc)[2][2][4][2], const Unit& u, int wr, int wc, int fr, int fq) const {
        const int tid = threadIdx.x, lane = tid & 63, wid = __builtin_amdgcn_readfirstlane(tid >> 6);
        const int b = u.pm >> 5;
        const int col0 = u.pn * BM + wc * 32 + 4 * fq; const float* gp = gate + (size_t)b * gstride + col0;
        PG8_LAS float* Pt = (PG8_LAS float*)xl; PG8_LAS float* St = (PG8_LAS float*)(xl + 4096);
        f32x4 gv[2][2];
#pragma unroll
        for (int bj = 0; bj < 2; ++bj)
#pragma unroll
            for (int n = 0; n < 2; ++n) gv[bj][n] = *(const f32x4*)(gp + bj * HALF + n * 16);
#pragma unroll
        for (int ai = 0; ai < 2; ++ai)
#pragma unroll
            for (int m = 0; m < 4; ++m) { const size_t off = (size_t)(u.pm * BM + ai * HALF + wr * 64 + m * 16 + fr) * 1024 + col0; float s = 0.f;
#pragma unroll
                for (int bj = 0; bj < 2; ++bj)
#pragma unroll
                    for (int n = 0; n < 2; ++n) { const f32x4 v = *(const f32x4*)(base + off + bj * HALF + n * 16) + gv[bj][n] * acc[ai][bj][m][n]; acc[ai][bj][m][n] = v; if (MID) *(f32x4*)(out + off + bj * HALF + n * 16) = v; s += (v.x * v.x + v.y * v.y) + (v.z * v.z + v.w * v.w); }
                s += __shfl_xor(s, 16); s += __shfl_xor(s, 32);
                if (fq == 0) Pt[(ai * HALF + wr * 64 + m * 16 + fr) * 4 + wc] = s; }
        asm volatile("s_waitcnt lgkmcnt(0)" ::: "memory"); __builtin_amdgcn_s_barrier(); asm volatile("" ::: "memory");
        if (tid < 256) { const f32x4 p = *(const PG8_LAS f32x4*)(Pt + tid * 4); const float part = (p.x + p.y) + (p.z + p.w);
            float* slot = SS + (size_t)(u.pm * BM + tid) * 4 + u.pn; asm volatile("global_store_dword %0, %1, off sc1\n\ts_nop 1" :: "v"(slot), "v"(part) : "memory"); }
        asm volatile("s_waitcnt vmcnt(0)" ::: "memory"); __builtin_amdgcn_s_barrier(); asm volatile("" ::: "memory");
        if (wid == 0) { unsigned* c = cnt + u.pm * 16;
            if (lane == 0) __hip_atomic_fetch_add(c, 1u, __ATOMIC_RELAXED, __HIP_MEMORY_SCOPE_AGENT);
            unsigned spins = 0;
            while ((unsigned)__builtin_amdgcn_readfirstlane(__hip_atomic_load(c, __ATOMIC_RELAXED, __HIP_MEMORY_SCOPE_AGENT)) < 4u && ++spins < 4000000u) __builtin_amdgcn_s_sleep(2);
            __builtin_amdgcn_fence(__ATOMIC_ACQUIRE, "agent"); asm volatile("s_waitcnt vmcnt(0)" ::: "memory"); }
        __builtin_amdgcn_s_barrier(); asm volatile("" ::: "memory");
        if (tid < 256) { const f32x4 q = *(const f32x4*)(SS + (size_t)(u.pm * BM + tid) * 4); St[tid] = 1.0f / sqrtf(((q.x + q.y) + (q.z + q.w)) * (1.0f / 1024.0f) + 1e-6f); }
        asm volatile("s_waitcnt lgkmcnt(0)" ::: "memory"); __builtin_amdgcn_s_barrier(); asm volatile("" ::: "memory");
        float rinv[2][4];
#pragma unroll
        for (int ai = 0; ai < 2; ++ai)
#pragma unroll
            for (int m = 0; m < 4; ++m) rinv[ai][m] = St[ai * HALF + wr * 64 + m * 16 + fr];
#pragma unroll
        for (int bj = 0; bj < 2; ++bj)
#pragma unroll
            for (int n = 0; n < 2; ++n) { const int c = col0 + bj * HALF + n * 16;
                const f32x4 gs = *(const f32x4*)(gain + c) * (1.0f + *(const f32x4*)(scalep + (size_t)b * mstride + c)), sh = *(const f32x4*)(shiftp + (size_t)b * mstride + c);
#pragma unroll
                for (int ai = 0; ai < 2; ++ai)
#pragma unroll
                    for (int m = 0; m < 4; ++m) { const size_t off = (size_t)(u.pm * BM + ai * HALF + wr * 64 + m * 16 + fr) * 1024 + c; const f32x4 o = (acc[ai][bj][m][n] * rinv[ai][m]) * gs + sh;
                        if (MID) { typedef unsigned u32x2v __attribute__((ext_vector_type(2))); u32x2v w; w.x = cvt_pk_bf16(o.x, o.y); w.y = cvt_pk_bf16(o.z, o.w); *(u32x2v*)(hb + off) = w; }
                        else *(f32x4*)(out + off) = o; }
                asm volatile("" ::: "memory"); }
        asm volatile("s_waitcnt lgkmcnt(0)" ::: "memory"); __builtin_amdgcn_s_barrier(); asm volatile("" ::: "memory");
    }
};

template <class Epi, class Sched, bool ALIGN_EPI = false, bool SP2 = false>
__device__ __forceinline__ void gemm_phase(PG8_LAS unsigned char* lds, const Gemm g, const Sched& S, const Epi& E) {
    const int tid = threadIdx.x, wid = __builtin_amdgcn_readfirstlane(tid >> 6), lane = tid & 63, wr = wid >> 2, wc = wid & 3, fr = lane & 15, fq = lane >> 4;
    const int K = g.K, nt = K / BK;
    unsigned voffA[2], voffB[2];
#pragma unroll
    for (int i = 0; i < 2; ++i) { int R, C; stage_rc(tid * 16 + i * 8192, R, C); const int Rb = Epi::PERM ? ((R & ~31) + perm32(R & 31)) : R;
        voffA[i] = (unsigned)(R * K + C) * 2u; voffB[i] = (unsigned)(Rb * K + C) * 2u; }
    const size_t kstep = (size_t)(BK * 2);
    const size_t hstep = (size_t)HALF * K * 2;
    const size_t tstep = 2 * hstep;
    const unsigned ldsw = (unsigned)wid * 1024u;
    const int aoff = lds_byte(wr * 64 + fr, fq * 8), boff = lds_byte(wc * 32 + fr, fq * 8);
#define PG8_SA(b, h) (((b) * 2 + (h)) * HTB)
#define PG8_SB(b, h) ((4 + (b) * 2 + (h)) * HTB)
#define PG8_STAGE(bufoff, gbase, voff) do { _Pragma("unroll") for (int _i = 0; _i < 2; ++_i) \
        __builtin_amdgcn_global_load_lds((const unsigned*)((const char*)(gbase) + (voff)[_i]), (PG8_LAS unsigned*)(lds + (bufoff) + ldsw + _i * 8192), 16, 0, 0); } while (0)
#define PG8_LDA(dst, b, h) do { _Pragma("unroll") for (int m = 0; m < 4; ++m) _Pragma("unroll") for (int k = 0; k < 2; ++k) dst[m][k] = *(const PG8_LAS bf16x8*)(lds + PG8_SA(b, h) + aoff + m * 2048 + k * 1024); } while (0)
#define PG8_LDB(dst, b, h) do { _Pragma("unroll") for (int n = 0; n < 2; ++n) _Pragma("unroll") for (int k = 0; k < 2; ++k) dst[n][k] = *(const PG8_LAS bf16x8*)(lds + PG8_SB(b, h) + boff + n * 2048 + k * 1024); } while (0)
#define PG8_MMA(ai, bj, At, Bt) do { __builtin_amdgcn_s_setprio(1); _Pragma("unroll") for (int m = 0; m < 4; ++m) _Pragma("unroll") for (int n = 0; n < 2; ++n) _Pragma("unroll") for (int k = 0; k < 2; ++k) \
        acc[ai][bj][m][n] = __builtin_amdgcn_mfma_f32_16x16x32_bf16(Bt[n][k], At[m][k], acc[ai][bj][m][n], 0, 0, 0); __builtin_amdgcn_s_setprio(0); } while (0)
#define PG8_WAIT_V(n) asm volatile("s_waitcnt vmcnt(" #n ")" ::: "memory")
#define PG8_WAIT_L(n) asm volatile("s_waitcnt lgkmcnt(" #n ")" ::: "memory")
#define PG8_BAR __builtin_amdgcn_s_barrier()
#define PG8_SCHED __builtin_amdgcn_sched_barrier(0)
    Unit cur, nxt; int ui = 0;
    if (!S.next(0, cur)) return;
    f32x4 acc[2][2][4][2];
#pragma unroll
    for (int a = 0; a < 2; ++a)
#pragma unroll
        for (int b = 0; b < 2; ++b)
#pragma unroll
            for (int m = 0; m < 4; ++m)
#pragma unroll
                for (int n = 0; n < 2; ++n) acc[a][b][m][n] = (f32x4){0.f, 0.f, 0.f, 0.f};
    bf16x8 At[4][2], B0[2][2], B1[2][2];
    const char* cA = (const char*)g.A + (size_t)cur.pm * tstep; const char* cB = (const char*)g.Bt + (size_t)cur.pn * tstep;
    S.a_ready(cur);
    if constexpr (SP2) {
        PG8_STAGE(PG8_SB(0, 0), cB, voffB); PG8_STAGE(PG8_SB(0, 1), cB + hstep, voffB); PG8_STAGE(PG8_SA(0, 0), cA, voffA); PG8_STAGE(PG8_SA(0, 1), cA + hstep, voffA);
        if (wr == 1) PG8_BAR;
        PG8_WAIT_V(2); PG8_BAR;
        PG8_STAGE(PG8_SB(1, 0), cB + kstep, voffB); PG8_STAGE(PG8_SA(1, 0), cA + kstep, voffA); PG8_STAGE(PG8_SB(1, 1), cB + hstep + kstep, voffB);
        PG8_WAIT_V(6); PG8_BAR;
    } else {
        PG8_STAGE(PG8_SB(0, 0), cB, voffB); PG8_STAGE(PG8_SA(0, 0), cA, voffA); PG8_STAGE(PG8_SB(0, 1), cB + hstep, voffB); PG8_STAGE(PG8_SA(0, 1), cA + hstep, voffA);
        if (wr == 1) PG8_BAR;
        PG8_WAIT_V(4); PG8_BAR;
        PG8_STAGE(PG8_SB(1, 0), cB + kstep, voffB); PG8_STAGE(PG8_SA(1, 0), cA + kstep, voffA); PG8_STAGE(PG8_SB(1, 1), cB + hstep + kstep, voffB);
        PG8_WAIT_V(6); PG8_BAR;
    }
    for (;;) {
        const bool has_next = S.next(ui + 1, nxt);
        const char* nA = has_next ? (const char*)g.A + (size_t)nxt.pm * tstep : cA; const char* nB = has_next ? (const char*)g.Bt + (size_t)nxt.pn * tstep : cB;
        for (int t = 0; t < nt; t += 2) {
            const bool last = (t == nt - 2);
            const char* a1 = cA + (size_t)(t + 1) * kstep;
            const char* a2 = last ? nA : cA + (size_t)(t + 2) * kstep; const char* b2 = last ? nB : cB + (size_t)(t + 2) * kstep;
            const char* a3 = a2 + kstep; const char* b3 = b2 + kstep;
            if (last && has_next) S.a_ready(nxt);
            if constexpr (SP2) {
            PG8_LDB(B0, 0, 0); PG8_LDB(B1, 0, 1); PG8_SCHED; PG8_LDA(At, 0, 0); PG8_STAGE(PG8_SA(1, 1), a1 + hstep, voffA);
            PG8_WAIT_V(8); PG8_WAIT_L(0); PG8_BAR; PG8_MMA(0, 0, At, B0); PG8_MMA(0, 1, At, B1); PG8_BAR; PG8_SCHED;
            PG8_LDA(At, 0, 1); PG8_STAGE(PG8_SB(0, 0), b2, voffB); PG8_STAGE(PG8_SB(0, 1), b2 + hstep, voffB); PG8_STAGE(PG8_SA(0, 0), a2, voffA);
            PG8_WAIT_V(8); PG8_WAIT_L(0); PG8_BAR; PG8_MMA(1, 0, At, B0); PG8_MMA(1, 1, At, B1); PG8_BAR; PG8_SCHED;
            PG8_LDB(B0, 1, 0); PG8_LDB(B1, 1, 1); PG8_SCHED; PG8_LDA(At, 1, 0); PG8_STAGE(PG8_SA(0, 1), a2 + hstep, voffA);
            PG8_WAIT_V(8); PG8_WAIT_L(0); PG8_BAR; PG8_MMA(0, 0, At, B0); PG8_MMA(0, 1, At, B1); PG8_BAR; PG8_SCHED;
            PG8_LDA(At, 1, 1); PG8_STAGE(PG8_SB(1, 0), b3, voffB); PG8_STAGE(PG8_SB(1, 1), b3 + hstep, voffB); PG8_STAGE(PG8_SA(1, 0), a3, voffA);
            PG8_WAIT_V(8); PG8_WAIT_L(0); PG8_BAR; PG8_MMA(1, 0, At, B0); PG8_MMA(1, 1, At, B1); PG8_BAR; PG8_SCHED;
            } else {
            PG8_LDB(B0, 0, 0); PG8_SCHED; PG8_LDA(At, 0, 0); PG8_STAGE(PG8_SA(1, 1), a1 + hstep, voffA);
            PG8_WAIT_L(8); PG8_BAR; PG8_WAIT_L(0); PG8_MMA(0, 0, At, B0); PG8_BAR; PG8_SCHED;
            PG8_LDB(B1, 0, 1); PG8_STAGE(PG8_SB(0, 0), b2, voffB);
            PG8_BAR; PG8_WAIT_L(0); PG8_MMA(0, 1, At, B1); PG8_BAR;
            PG8_LDA(At, 0, 1); PG8_STAGE(PG8_SA(0, 0), a2, voffA);
            PG8_BAR; PG8_WAIT_L(0); PG8_MMA(1, 0, At, B0); PG8_BAR; PG8_SCHED;
            PG8_STAGE(PG8_SB(0, 1), b2 + hstep, voffB);
            PG8_WAIT_V(6); PG8_BAR; PG8_MMA(1, 1, At, B1); PG8_BAR;
            PG8_LDB(B0, 1, 0); PG8_SCHED; PG8_LDA(At, 1, 0); PG8_STAGE(PG8_SA(0, 1), a2 + hstep, voffA);
            PG8_WAIT_L(8); PG8_BAR; PG8_WAIT_L(0); PG8_MMA(0, 0, At, B0); PG8_BAR; PG8_SCHED;
            PG8_LDB(B1, 1, 1); PG8_STAGE(PG8_SB(1, 0), b3, voffB);
            PG8_BAR; PG8_WAIT_L(0); PG8_MMA(0, 1, At, B1); PG8_BAR;
            PG8_LDA(At, 1, 1); PG8_STAGE(PG8_SA(1, 0), a3, voffA);
            PG8_BAR; PG8_WAIT_L(0); PG8_MMA(1, 0, At, B0); PG8_BAR; PG8_SCHED;
            PG8_STAGE(PG8_SB(1, 1), b3 + hstep, voffB);
            PG8_WAIT_V(6); PG8_BAR; PG8_MMA(1, 1, At, B1); PG8_BAR;
            }
        }
        if constexpr (ALIGN_EPI) { if (wr == 0) PG8_BAR; }
        if constexpr (!Epi::AFTER_DRAIN) { E(acc, cur, wr, wc, fr, fq); S.done(cur); }
        if (!has_next) break;
#pragma unroll
        for (int a = 0; a < 2; ++a)
#pragma unroll
            for (int b = 0; b < 2; ++b)
#pragma unroll
                for (int m = 0; m < 4; ++m)
#pragma unroll
                    for (int n = 0; n < 2; ++n) acc[a][b][m][n] = (f32x4){0.f, 0.f, 0.f, 0.f};
        cur = nxt; cA = nA; cB = nB; ++ui;
        if constexpr (ALIGN_EPI) { if (wr == 1) PG8_BAR; }
    }
    PG8_WAIT_V(0);
    if constexpr (!ALIGN_EPI) { if (wr == 0) PG8_BAR; }
    PG8_BAR;
    if constexpr (Epi::AFTER_DRAIN) { E.fused(acc, cur, wr, wc, fr, fq, lds, wid, lane); S.done(cur); }
#undef PG8_SA
#undef PG8_SB
#undef PG8_STAGE
#undef PG8_LDA
#undef PG8_LDB
#undef PG8_MMA
#undef PG8_WAIT_V
#undef PG8_WAIT_L
#undef PG8_BAR
#undef PG8_SCHED
}
}

constexpr int NWAVES = 8;
constexpr int BATCH = 4, SEQ = 8192, D = 1024, M = BATCH * SEQ;
constexpr int PIN = 3592, NP = 3584;
constexpr int FF = 2816, NCH = 128, NBH = 16;
constexpr int PH_END = 12;
constexpr float EPS = 1e-6f;
constexpr size_t MiB = 1u << 20;
constexpr size_t WS_MOD = 1 * MiB;
constexpr size_t WS_GB = 2 * MiB;
constexpr size_t WS_EGL = 3 * MiB;
constexpr size_t WS_WIN = 4 * MiB, WS_WO = 11 * MiB, WS_WGU = 13 * MiB, WS_WD = 24 * MiB;
constexpr size_t WS_H = 32 * MiB;
constexpr size_t WS_CH = 32 * MiB;
constexpr size_t WS_P = 208 * MiB;
constexpr size_t WS_YC = 432 * MiB;
constexpr size_t WS_END = 496 * MiB;
constexpr int REC = 74752;
constexpr int REC_A = 57344;
constexpr int LDS_BYTES = 155648;

#define LAS __attribute__((address_space(3)))
typedef unsigned short bf16;
typedef unsigned v4u __attribute__((ext_vector_type(4)));
typedef unsigned v2u __attribute__((ext_vector_type(2)));
typedef float f32x4 __attribute__((ext_vector_type(4)));
typedef float f32x16 __attribute__((ext_vector_type(16)));
typedef short bf16x8 __attribute__((ext_vector_type(8)));
#define LDS_WAIT() asm volatile("s_waitcnt lgkmcnt(0)" ::: "memory")
using pg8::cvt_pk_bf16; using pg8::silu_f;
__device__ __forceinline__ float bf2f(unsigned short u) { return __uint_as_float((unsigned)u << 16); }
__device__ __forceinline__ float bflo(unsigned w) { return __uint_as_float(w << 16); }
__device__ __forceinline__ float bfhi(unsigned w) { return __uint_as_float(w & 0xffff0000u); }
__device__ __forceinline__ float wave_sum(float v) {
#pragma unroll
    for (int o = 1; o < 64; o <<= 1) v += __shfl_xor(v, o);
    return v;
}
__device__ __forceinline__ void unpack8(v4u w, float (&f)[8]) { f[0] = bflo(w.x); f[1] = bfhi(w.x); f[2] = bflo(w.y); f[3] = bfhi(w.y); f[4] = bflo(w.z); f[5] = bfhi(w.z); f[6] = bflo(w.w); f[7] = bfhi(w.w); }
__device__ __forceinline__ v4u pack8(const float (&f)[8]) { v4u w; w.x = cvt_pk_bf16(f[0], f[1]); w.y = cvt_pk_bf16(f[2], f[3]); w.z = cvt_pk_bf16(f[4], f[5]); w.w = cvt_pk_bf16(f[6], f[7]); return w; }

struct Args { const float* in[19]; float* out; unsigned char* ws; int ph_lo, ph_hi; };
enum { I_X = 0, I_C, I_WADA, I_BADA, I_WADAF, I_BADAF, I_GMIX, I_GFFN, I_GFIN, I_WIN, I_CWM, I_CWQ, I_ALOG, I_DTB, I_GCO, I_GDN, I_WOUT, I_WGU, I_WDN };

template <int MODE>
__device__ __forceinline__ void p0_transpose_item(const float* W, int K, int ld, int nblk, bf16* WT, LAS float* scr, int item, int lane) {
    const int kb = item / nblk, nb = item % nblk, k0 = 64 * kb, n0 = 32 * nb;
    f32x4 ld4[8];
#pragma unroll
    for (int i = 0; i < 8; ++i) ld4[i] = *(const f32x4*)(W + (size_t)(k0 + 8 * i + (lane >> 3)) * ld + n0 + 4 * (lane & 7));
#pragma unroll
    for (int i = 0; i < 8; ++i) { LAS float* d = scr + (8 * i + (lane >> 3)) * 33 + 4 * (lane & 7); d[0] = ld4[i].x; d[1] = ld4[i].y; d[2] = ld4[i].z; d[3] = ld4[i].w; }
    LDS_WAIT(); asm volatile("" ::: "memory");
    int r0 = n0;
    if (MODE == 1) { r0 = n0 < FF ? 256 * (n0 / 128) + (n0 % 128) : 256 * ((n0 - FF) / 128) + 128 + ((n0 - FF) % 128); }
    const int c = lane & 7;
#pragma unroll
    for (int j = 0; j < 4; ++j) { const int n = (lane >> 3) + 8 * j; const LAS float* s = scr + (8 * c) * 33 + n;
        v4u o; o.x = cvt_pk_bf16(s[0 * 33], s[1 * 33]); o.y = cvt_pk_bf16(s[2 * 33], s[3 * 33]); o.z = cvt_pk_bf16(s[4 * 33], s[5 * 33]); o.w = cvt_pk_bf16(s[6 * 33], s[7 * 33]);
        *(v4u*)(WT + (size_t)(r0 + n) * K + k0 + 8 * c) = o; }
    LDS_WAIT(); asm volatile("" ::: "memory");
}
__device__ __forceinline__ void p0_mod_item(const Args& a, float* MOD, const LAS float* SC, LAS float* red, int item, int tid) {
    const int c4 = tid & 7, ks = tid >> 3, col0 = item * 32;
    const bool fin = col0 >= 6144; const float* W = fin ? a.in[I_WADAF] : a.in[I_WADA]; const int ld = fin ? 2048 : 6144, cb = (fin ? col0 - 6144 : col0);
    f32x4 w[16];
#pragma unroll
    for (int kk = 0; kk < 16; ++kk) w[kk] = *(const f32x4*)(W + (size_t)(16 * ks + kk) * ld + cb + 4 * c4);
    f32x4 acc[4];
#pragma unroll
    for (int b = 0; b < 4; ++b) acc[b] = (f32x4){0.f, 0.f, 0.f, 0.f};
#pragma unroll
    for (int kk = 0; kk < 16; ++kk) { const f32x4 s = *(const LAS f32x4*)(SC + (16 * ks + kk) * 4); acc[0] += s.x * w[kk]; acc[1] += s.y * w[kk]; acc[2] += s.z * w[kk]; acc[3] += s.w * w[kk]; }
#pragma unroll
    for (int b = 0; b < 4; ++b) *(LAS f32x4*)(red + (ks * 4 + b) * 32 + 4 * c4) = acc[b];
    __syncthreads();
    if (tid < 128) { const int b = tid >> 5, cl = tid & 31; float s = 0.f;
#pragma unroll 16
        for (int k = 0; k < 64; ++k) s += red[(k * 4 + b) * 32 + cl];
        const int c = cb + cl;
        s += fin ? a.in[I_BADAF][c] : a.in[I_BADA][c];
        if (fin) MOD[4 * 6144 + b * 2048 + c] = s; else MOD[b * 6144 + c] = s; }
    __syncthreads();
}

template <int MODE>
__device__ __forceinline__ void adaln_one(const f32x4 (&xin)[4], const f32x4 (&gs)[4], const f32x4 (&sh)[4], int m, bf16* Hout, float* Fout, const LAS float* TT, const float* a_log, const float* dt_bias, float* GB, int lane) {
    f32x4 v[4]; float ss = 0.f;
#pragma unroll
    for (int j = 0; j < 4; ++j) { v[j] = xin[j]; ss += (v[j].x * v[j].x + v[j].y * v[j].y) + (v[j].z * v[j].z + v[j].w * v[j].w); }
    const float rinv = 1.0f / sqrtf(wave_sum(ss) * (1.0f / D) + EPS);
#pragma unroll
    for (int j = 0; j < 4; ++j) v[j] = (v[j] * rinv) * gs[j] + sh[j];
    if (MODE == 2) { f32x4* o = (f32x4*)(Fout + (size_t)m * D) + lane;
#pragma unroll
        for (int j = 0; j < 4; ++j) o[64 * j] = v[j];
    } else { v2u* o = (v2u*)(Hout + (size_t)m * D) + lane;
#pragma unroll
        for (int j = 0; j < 4; ++j) { v2u w; w.x = cvt_pk_bf16(v[j].x, v[j].y); w.y = cvt_pk_bf16(v[j].z, v[j].w); o[64 * j] = w; } }
    if (MODE == 0) {
        float d[8];
#pragma unroll
        for (int e = 0; e < 8; ++e) { float s = 0.f;
#pragma unroll
            for (int j = 0; j < 4; ++j) { const f32x4 t = *(const LAS f32x4*)(TT + e * 1024 + 4 * (lane + 64 * j)); s += (v[j].x * t.x + v[j].y * t.y) + (v[j].z * t.z + v[j].w * t.w); }
            asm volatile("" : "+v"(s) :: "memory"); d[e] = s; }
        float k4[4], k2[2], k1;
        { const bool hi = (lane & 32) != 0;
#pragma unroll
          for (int i = 0; i < 4; ++i) { const float snd = hi ? d[i] : d[4 + i]; const float kp = hi ? d[4 + i] : d[i]; k4[i] = kp + __shfl_xor(snd, 32); } }
        { const bool hi = (lane & 16) != 0;
#pragma unroll
          for (int i = 0; i < 2; ++i) { const float snd = hi ? k4[i] : k4[2 + i]; const float kp = hi ? k4[2 + i] : k4[i]; k2[i] = kp + __shfl_xor(snd, 16); } }
        { const bool hi = (lane & 8) != 0; const float snd = hi ? k2[0] : k2[1]; const float kp = hi ? k2[1] : k2[0]; k1 = kp + __shfl_xor(snd, 8); }
        k1 += __shfl_xor(k1, 4); k1 += __shfl_xor(k1, 2); k1 += __shfl_xor(k1, 1);
        if ((lane & 7) == 0) { const int e = lane >> 3; float r;
            if (e < 4) { const float xx = k1 + dt_bias[e]; const float sp = fmaxf(xx, 0.f) + log1pf(__expf(-fabsf(xx))); r = -__expf(a_log[e]) * sp; }
            else r = 1.0f / (1.0f + __expf(-k1));
            GB[(size_t)m * 8 + e] = r; }
    }
}
template <int MODE>
__device__ __forceinline__ void adaln_rows(const float* X, const float* gain, const float* shiftp, const float* scalep, int mstride, bf16* Hout, float* Fout,
                                           const LAS float* TT, const float* a_log, const float* dt_bias, float* GB, int gw, int NGW, int lane) {
    for (int blk = gw; blk < M / 16; blk += NGW) {
        const int m0 = blk * 16, b = m0 >> 13;
        f32x4 gs[4], sh[4];
        { const f32x4* g4 = (const f32x4*)gain + lane; const f32x4* sh4 = (const f32x4*)(shiftp + (size_t)b * mstride) + lane; const f32x4* sc4 = (const f32x4*)(scalep + (size_t)b * mstride) + lane;
#pragma unroll
          for (int j = 0; j < 4; ++j) { gs[j] = g4[64 * j] * (1.0f + sc4[64 * j]); sh[j] = sh4[64 * j]; } }
        f32x4 c0[4], c1[4];
        { const f32x4* xr = (const f32x4*)(X + (size_t)m0 * D) + lane;
#pragma unroll
          for (int j = 0; j < 4; ++j) { c0[j] = xr[64 * j]; c1[j] = xr[256 + 64 * j]; } }
#pragma unroll 1
        for (int i = 0; i < 16; i += 2) {
            f32x4 n0[4], n1[4];
            { const int mn = (i + 2 < 16) ? m0 + i + 2 : m0; const f32x4* xr = (const f32x4*)(X + (size_t)mn * D) + lane;
#pragma unroll
              for (int j = 0; j < 4; ++j) { n0[j] = xr[64 * j]; n1[j] = xr[256 + 64 * j]; } }
            adaln_one<MODE>(c0, gs, sh, m0 + i, Hout, Fout, TT, a_log, dt_bias, GB, lane);
            adaln_one<MODE>(c1, gs, sh, m0 + i + 1, Hout, Fout, TT, a_log, dt_bias, GB, lane);
#pragma unroll
            for (int j = 0; j < 4; ++j) { c0[j] = n0[j]; c1[j] = n1[j]; }
        }
    }
}

__device__ __forceinline__ void conv_qkv(const bf16* P, const float* cwq, bf16* QKV, int X, int t0, bool first, int lane) {
    const int colp = 1536 + 512 * X + 8 * lane, colo = 512 * X + 8 * lane;
    v4u raw[19];
#pragma unroll
    for (int t = 0; t < 19; ++t) { raw[t] = (v4u){0u, 0u, 0u, 0u}; if (t >= 3 || !first) raw[t] = *(const v4u*)(P + (size_t)(t0 - 3 + t) * NP + colp); }
    float w0[8], w1[8], w2[8], w3[8], h3[8], h2[8], h1[8];
#pragma unroll
    for (int e = 0; e < 8; ++e) { w0[e] = cwq[0 * 1536 + colo + e]; w1[e] = cwq[1 * 1536 + colo + e]; w2[e] = cwq[2 * 1536 + colo + e]; w3[e] = cwq[3 * 1536 + colo + e]; }
    unpack8(raw[0], h3); unpack8(raw[1], h2); unpack8(raw[2], h1);
#pragma unroll
    for (int t = 0; t < 16; ++t) { const int m = t0 + t; float x[8], y[8]; unpack8(raw[3 + t], x); float ss = 0.f;
#pragma unroll
        for (int e = 0; e < 8; ++e) { const float c = w0[e] * h3[e] + w1[e] * h2[e] + w2[e] * h1[e] + w3[e] * x[e]; y[e] = silu_f(c); ss += y[e] * y[e]; h3[e] = h2[e]; h2[e] = h1[e]; h1[e] = x[e]; }
        if (X < 2) { ss += __shfl_xor(ss, 1); ss += __shfl_xor(ss, 2); ss += __shfl_xor(ss, 4); ss += __shfl_xor(ss, 8);
            float r = 1.0f / sqrtf(ss + EPS); if (X == 0) r *= 0.08838834764831845f;
#pragma unroll
            for (int e = 0; e < 8; ++e) y[e] *= r; }
        *(v4u*)(QKV + (size_t)m * 1536 + colo) = pack8(y); }
}
__device__ __forceinline__ void conv_pass(const bf16* P, const float* cwm, const float* cwq, const float* gco, bf16* YC, bf16* QKV, int gw, int NGW, int lane) {
    for (int run = gw; run < M / 16; run += NGW) {
        const int t0 = run * 16; const bool first = (t0 & (SEQ - 1)) == 0;
        { float w0[8], w1[8], w2[8], gc[8], u2[8], u1[8]; const int c0 = 8 * lane;
#pragma unroll
          for (int e = 0; e < 8; ++e) { w0[e] = cwm[c0 + e]; w1[e] = cwm[512 + c0 + e]; w2[e] = cwm[1024 + c0 + e]; gc[e] = gco[c0 + e]; u2[e] = 0.f; u1[e] = 0.f; }
          if (!first) { float a[8], b[8]; unpack8(*(const v4u*)(P + (size_t)(t0 - 2) * NP + 512 + c0), a); unpack8(*(const v4u*)(P + (size_t)(t0 - 2) * NP + 1024 + c0), b);
#pragma unroll
              for (int e = 0; e < 8; ++e) u2[e] = a[e] * b[e];
              unpack8(*(const v4u*)(P + (size_t)(t0 - 1) * NP + 512 + c0), a); unpack8(*(const v4u*)(P + (size_t)(t0 - 1) * NP + 1024 + c0), b);
#pragma unroll
              for (int e = 0; e < 8; ++e) u1[e] = a[e] * b[e]; }
#pragma unroll 1
          for (int tb = 0; tb < 16; tb += 8) {
              v4u rb[8], rc[8], rh[8];
#pragma unroll
              for (int t = 0; t < 8; ++t) { const bf16* pr = P + (size_t)(t0 + tb + t) * NP + c0; rb[t] = *(const v4u*)pr; rc[t] = *(const v4u*)(pr + 512); rh[t] = *(const v4u*)(pr + 1024); }
#pragma unroll
              for (int t = 0; t < 8; ++t) { const int m = t0 + tb + t; float gb[8], a[8], b[8], y[8]; unpack8(rb[t], gb); unpack8(rc[t], a); unpack8(rh[t], b); float ss = 0.f;
#pragma unroll
                  for (int e = 0; e < 8; ++e) { const float u0 = a[e] * b[e]; y[e] = gb[e] * (w0[e] * u2[e] + w1[e] * u1[e] + w2[e] * u0); ss += y[e] * y[e]; u2[e] = u1[e]; u1[e] = u0; }
                  ss += __shfl_xor(ss, 1); ss += __shfl_xor(ss, 2); ss += __shfl_xor(ss, 4);
                  const float r = 1.0f / sqrtf(ss * (1.0f / 64.0f) + EPS);
#pragma unroll
                  for (int e = 0; e < 8; ++e) y[e] = y[e] * r * gc[e];
                  *(v4u*)(YC + (size_t)m * D + c0) = pack8(y); } } }
        conv_qkv(P, cwq, QKV, 0, t0, first, lane); conv_qkv(P, cwq, QKV, 1, t0, first, lane); conv_qkv(P, cwq, QKV, 2, t0, first, lane);
    }
}


constexpr int PREP_HALF = 69632, PK_KN = 0, PK_QN = 17408, PK_VV = 34816, PK_LM = 52224, PK_GC = 68608, PK_BT = 68864, PK_EG = 69120, PROW = 272;
template <bool SC>
__device__ __forceinline__ v4u afrag_piece_rows(const LAS unsigned char* tile, const LAS float* sc, int p) {
    const int f = p >> 6, ln = p & 63, mt = f >> 3, kt = (f >> 1) & 3, s = f & 1, r = ln & 31, hh = ln >> 5, row = 32 * mt + r, kb = 32 * kt + 16 * s + 4 * hh;
    const v2u a = *(const LAS v2u*)(tile + row * PROW + kb * 2), b = *(const LAS v2u*)(tile + row * PROW + (kb + 8) * 2);
    float scv = 1.0f; if (SC) scv = sc[row];
    v4u o; o.x = cvt_pk_bf16(bflo(a.x) * scv, bfhi(a.x) * scv); o.y = cvt_pk_bf16(bflo(a.y) * scv, bfhi(a.y) * scv); o.z = cvt_pk_bf16(bflo(b.x) * scv, bfhi(b.x) * scv); o.w = cvt_pk_bf16(bflo(b.y) * scv, bfhi(b.y) * scv);
    return o;
}
#define LBAR() do { asm volatile("s_waitcnt lgkmcnt(0)" ::: "memory"); __builtin_amdgcn_s_barrier(); asm volatile("" ::: "memory"); } while (0)
__device__ __forceinline__ void st_wt16(void* p, v4u v) { asm volatile("global_store_dwordx4 %0, %1, off sc1\n\ts_nop 1" :: "v"(p), "v"(v) : "memory"); }
__device__ __forceinline__ void st_wt4(void* p, float v) { asm volatile("global_store_dword %0, %1, off sc1\n\ts_nop 1" :: "v"(p), "v"(v) : "memory"); }
__device__ __forceinline__ void prep_phase(LAS unsigned char* lds, const bf16* QKV, const float* GB, float* EGL, unsigned char* CH, unsigned* FLG, int ublk, int nblk, int tid) {
    const int half = tid >> 8, t = tid & 255, lane = tid & 63, w = (tid >> 6) & 3, r = lane & 31, hh = lane >> 5;
    LAS unsigned char* L = lds + half * PREP_HALF;
    LAS float* LM = (LAS float*)(L + PK_LM); LAS float* GC = (LAS float*)(L + PK_GC); LAS float* BT = (LAS float*)(L + PK_BT); LAS float* EG = (LAS float*)(L + PK_EG);
    for (int pu = ublk; pu < NBH * NCH / 2; pu += nblk) {
        const int n = pu >> 3, bh = 2 * (pu & 7) + half, cid = bh * NCH + n, b = bh >> 2, h = bh & 3, m0 = b * SEQ + n * 64;
        unsigned char* rec = CH + (size_t)cid * REC;
        LBAR();
#pragma unroll
        for (int X = 0; X < 3; ++X)
#pragma unroll
            for (int i = 0; i < 4; ++i) { const int p = t + 256 * i, row = p >> 4, c16 = p & 15;
                const v4u v = *(const v4u*)(QKV + (size_t)(m0 + row) * 1536 + 512 * X + 128 * h + 8 * c16);
                *(LAS v4u*)(L + (X == 0 ? PK_QN : (X == 1 ? PK_KN : PK_VV)) + row * PROW + c16 * 16) = v; }
        if (w == 0) { float g = GB[(size_t)(m0 + lane) * 8 + h];
#pragma unroll
            for (int d = 1; d < 64; d <<= 1) { const float o = __shfl_up(g, d); if (lane >= d) g += o; }
            GC[lane] = g; EG[lane] = __expf(g); BT[lane] = GB[(size_t)(m0 + lane) * 8 + 4 + h];
            if (lane == 63) st_wt4(rec + 73728, __expf(g)); }
        LBAR();
        { const int mi = w >> 1, nj = w & 1;
          f32x16 kk, qk;
#pragma unroll
          for (int i = 0; i < 16; ++i) { kk[i] = 0.f; qk[i] = 0.f; }
#pragma unroll
          for (int st = 0; st < 8; ++st) {
              const bf16x8 ka = *(const LAS bf16x8*)(L + PK_KN + (32 * mi + r) * PROW + (16 * st + 8 * hh) * 2);
              const bf16x8 kb = *(const LAS bf16x8*)(L + PK_KN + (32 * nj + r) * PROW + (16 * st + 8 * hh) * 2);
              const bf16x8 qb = *(const LAS bf16x8*)(L + PK_QN + (32 * mi + r) * PROW + (16 * st + 8 * hh) * 2);
              kk = __builtin_amdgcn_mfma_f32_32x32x16_bf16(ka, kb, kk, 0, 0, 0);
              qk = __builtin_amdgcn_mfma_f32_32x32x16_bf16(kb, qb, qk, 0, 0, 0);
          }
          const float gj = GC[32 * nj + r], gq = GC[32 * mi + r];
          float av[16];
#pragma unroll
          for (int reg = 0; reg < 16; ++reg) { const int cr = (reg & 3) + 8 * (reg >> 2) + 4 * hh;
              const int i = 32 * mi + cr, j = 32 * nj + r;
              LM[i * 64 + j] = (i > j) ? BT[i] * kk[reg] * __expf(GC[i] - gj) : 0.f;
              const int key = 32 * nj + cr, qr = 32 * mi + r;
              av[reg] = (qr >= key) ? qk[reg] * __expf(gq - GC[key]) : 0.f; }
#pragma unroll
          for (int s = 0; s < 2; ++s) { v4u o; o.x = cvt_pk_bf16(av[8 * s], av[8 * s + 1]); o.y = cvt_pk_bf16(av[8 * s + 2], av[8 * s + 3]); o.z = cvt_pk_bf16(av[8 * s + 4], av[8 * s + 5]); o.w = cvt_pk_bf16(av[8 * s + 6], av[8 * s + 7]);
              st_wt16(rec + 49152 + ((mi * 2 + nj) * 2 + s) * 1024 + lane * 16, o); }
        }
#pragma unroll
        for (int i = 0; i < 4; ++i) { const int p = t + 256 * i; st_wt16(rec + 16384 + p * 16, afrag_piece_rows<true>(L + PK_QN, EG, p)); }
        { const float gl = GC[63];
#pragma unroll
          for (int i = 0; i < 4; ++i) { const int p = t + 256 * i, f = p >> 6, ln = p & 63, mt = f >> 2, ct = (f >> 1) & 1, s = f & 1, dk = 32 * mt + (ln & 31), cb = 32 * ct + 16 * s + 4 * (ln >> 5);
              float e[8];
#pragma unroll
              for (int j = 0; j < 8; ++j) { const int c = cb + 8 * (j >> 2) + (j & 3); e[j] = bf2f(*(const LAS unsigned short*)(L + PK_KN + c * PROW + dk * 2)) * __expf(gl - GC[c]); }
              st_wt16(rec + 32768 + p * 16, pack8(e)); } }
        LBAR();
        { float X[64]; const bool isu = t < 128; const int col = t & 127;
          const LAS unsigned char* src = L + (isu ? PK_VV : PK_KN) + col * 2;
#pragma unroll
          for (int i = 0; i < 64; ++i) {
              const float egi = EG[i]; const float rhs = bf2f(*(const LAS unsigned short*)(src + i * PROW)) * BT[i] * (isu ? 1.0f : egi);
              float a0 = 0.f, a1 = 0.f, a2 = 0.f, a3 = 0.f;
#pragma unroll
              for (int j4 = 0; j4 < (i + 3) / 4; ++j4) { const f32x4 l = *(const LAS f32x4*)(LM + i * 64 + 4 * j4);
                  if (4 * j4 + 0 < i) a0 += l.x * X[4 * j4 + 0]; if (4 * j4 + 1 < i) a1 += l.y * X[4 * j4 + 1]; if (4 * j4 + 2 < i) a2 += l.z * X[4 * j4 + 2]; if (4 * j4 + 3 < i) a3 += l.w * X[4 * j4 + 3]; }
              X[i] = rhs - ((a0 + a1) + (a2 + a3)); asm volatile("" : "+v"(X[i]) :: "memory"); }
          LBAR();
          if (isu) { const int vs = col >> 5, dvl = col & 31;
#pragma unroll
              for (int mt = 0; mt < 2; ++mt)
#pragma unroll
                  for (int h2 = 0; h2 < 2; ++h2) { v4u* dst = (v4u*)(rec + REC_A + (size_t)(((vs * 2 + mt) * 64 + dvl + 32 * h2) * 32));
#pragma unroll
                      for (int a2 = 0; a2 < 2; ++a2) { const int i0 = 32 * mt + 4 * h2 + 16 * a2; v4u w;
                          w.x = cvt_pk_bf16(X[i0], X[i0 + 1]); w.y = cvt_pk_bf16(X[i0 + 2], X[i0 + 3]); w.z = cvt_pk_bf16(X[i0 + 8], X[i0 + 9]); w.w = cvt_pk_bf16(X[i0 + 10], X[i0 + 11]); st_wt16(dst + a2, w); } }
          } else {
#pragma unroll
              for (int i = 0; i < 64; ++i) *(LAS unsigned short*)(L + PK_VV + i * PROW + col * 2) = (unsigned short)(cvt_pk_bf16(-X[i], 0.f) & 0xffffu);
          }
        }
        LBAR();
#pragma unroll
        for (int i = 0; i < 4; ++i) { const int p = t + 256 * i; st_wt16(rec + p * 16, afrag_piece_rows<false>(L + PK_VV, EG, p)); }
        asm volatile("s_waitcnt vmcnt(0)" ::: "memory"); __syncthreads();
        if (tid == 0) {
            __hip_atomic_store(FLG + (2 * (pu & 7)) * NCH + n, 1u, __ATOMIC_RELAXED, __HIP_MEMORY_SCOPE_AGENT); __hip_atomic_store(FLG + (2 * (pu & 7) + 1) * NCH + n, 1u, __ATOMIC_RELAXED, __HIP_MEMORY_SCOPE_AGENT); }
    }
}

__device__ __forceinline__ bf16x8 pack_acc(const f32x16& x, int s) {
    v4u p; p.x = cvt_pk_bf16(x[8 * s], x[8 * s + 1]); p.y = cvt_pk_bf16(x[8 * s + 2], x[8 * s + 3]); p.z = cvt_pk_bf16(x[8 * s + 4], x[8 * s + 5]); p.w = cvt_pk_bf16(x[8 * s + 6], x[8 * s + 7]);
    return __builtin_bit_cast(bf16x8, p);
}
#define MFMA32(a, b, c) __builtin_amdgcn_mfma_f32_32x32x16_bf16((a), (b), (c), 0, 0, 0)
#define PIN_SCHED() __builtin_amdgcn_sched_barrier(0)
__device__ __forceinline__ int chain_ready(const unsigned* fl, int have, int lane) {
    for (;;) {
        const int idx = have + 1 + lane;
        const unsigned f = (idx < NCH) ? __hip_atomic_load(fl + idx, __ATOMIC_RELAXED, __HIP_MEMORY_SCOPE_AGENT) : 0u;
        const unsigned long long m = __ballot(f != 0u);
        const int pre = (m == ~0ull) ? 64 : __builtin_ctzll(~m);
        if (pre > 0) { __builtin_amdgcn_fence(__ATOMIC_ACQUIRE, "agent"); asm volatile("s_waitcnt vmcnt(0)" ::: "memory"); return have + pre; }
        __builtin_amdgcn_s_sleep(16);
    }
}
__device__ __forceinline__ void chain_phase(LAS unsigned char* lds, const unsigned char* CH, const unsigned* FLG, bf16* Oraw, int bh, int tid) {
    const int wid = __builtin_amdgcn_readfirstlane(tid >> 6), lane = tid & 63, b = bh >> 2, h = bh & 3, vs = wid & 3;
    const unsigned char* rec0 = CH + (size_t)bh * NCH * REC;
    const bool comp = wid < 4, stager = (wid >= 4);
    const int hw = wid - 4;
#define CH_MOVE(n, dstbase) do { _Pragma("unroll") for (int _i = 0; _i < 19; ++_i) { const int _pc = hw * 19 + _i; if (_pc < 73) \
        __builtin_amdgcn_global_load_lds((const unsigned*)(rec0 + (size_t)(n) * REC + _pc * 1024 + lane * 16), (LAS unsigned*)((dstbase) + _pc * 1024), 16, 0, 0); } } while (0)
#define CH_WARM(n) do { _Pragma("unroll") for (int _i = 0; _i < 10; ++_i) { const int _o = (_i * 64 + lane) * 128; \
        __builtin_amdgcn_global_load_lds((const unsigned*)(rec0 + (size_t)(n) * REC + (_o < REC ? _o : 0)), (LAS unsigned*)(dummy), 4, 0, 0); } } while (0)
    constexpr int WARM_AHEAD = 8;
    LAS unsigned char* dummy = lds + 2 * REC;
    f32x16 S[4], o0, o1;
#pragma unroll
    for (int k = 0; k < 4; ++k)
#pragma unroll
        for (int i = 0; i < 16; ++i) S[k][i] = 0.f;
#pragma unroll
    for (int i = 0; i < 16; ++i) { o0[i] = 0.f; o1[i] = 0.f; }
    const unsigned* fl = FLG + bh * NCH; int have = -1;
    if (stager) { while (have < 0) have = chain_ready(fl, have, lane); CH_MOVE(0, lds); }
    if (!comp) asm volatile("s_waitcnt vmcnt(0)" ::: "memory");
    __builtin_amdgcn_s_barrier(); asm volatile("" ::: "memory");
    for (int n = 0; n < NCH; ++n) {
        const int buf = n & 1;
        if (!comp) {
            if (stager) { if (n + 1 < NCH) { while (have < n + 1) have = chain_ready(fl, have, lane); CH_MOVE(n + 1, lds + (buf ^ 1) * REC); } asm volatile("s_waitcnt vmcnt(0)" ::: "memory"); }
            else { const int wn = n + 1 + WARM_AHEAD; if (wn < NCH) { if (have < wn) { const int idx = have + 1 + lane; const unsigned f = (idx < NCH) ? __hip_atomic_load(fl + idx, __ATOMIC_RELAXED, __HIP_MEMORY_SCOPE_AGENT) : 0u;
                        const unsigned long long m = __ballot(f != 0u); const int pre = (m == ~0ull) ? 64 : __builtin_ctzll(~m); if (pre > 0) { __builtin_amdgcn_fence(__ATOMIC_ACQUIRE, "agent"); have += pre; } }
                    if (have >= wn) CH_WARM(wn); }
                   asm volatile("s_waitcnt vmcnt(20)" ::: "memory"); }
        } else {
            const LAS unsigned char* B = lds + buf * REC + lane * 16;
            const float egl = *(const LAS float*)(lds + buf * REC + 73728);
            f32x16 v0, v1;
            { const LAS v4u* ul = (const LAS v4u*)(lds + buf * REC + 57344 + ((vs * 2) * 64 + lane) * 32);
              const v4u a0 = ul[0], a1 = ul[1], b0 = ul[128], b1 = ul[129];
              v0[0] = bflo(a0.x); v0[1] = bfhi(a0.x); v0[2] = bflo(a0.y); v0[3] = bfhi(a0.y); v0[4] = bflo(a0.z); v0[5] = bfhi(a0.z); v0[6] = bflo(a0.w); v0[7] = bfhi(a0.w);
              v0[8] = bflo(a1.x); v0[9] = bfhi(a1.x); v0[10] = bflo(a1.y); v0[11] = bfhi(a1.y); v0[12] = bflo(a1.z); v0[13] = bfhi(a1.z); v0[14] = bflo(a1.w); v0[15] = bfhi(a1.w);
              v1[0] = bflo(b0.x); v1[1] = bfhi(b0.x); v1[2] = bflo(b0.y); v1[3] = bfhi(b0.y); v1[4] = bflo(b0.z); v1[5] = bfhi(b0.z); v1[6] = bflo(b0.w); v1[7] = bfhi(b0.w);
              v1[8] = bflo(b1.x); v1[9] = bfhi(b1.x); v1[10] = bflo(b1.y); v1[11] = bfhi(b1.y); v1[12] = bflo(b1.z); v1[13] = bfhi(b1.z); v1[14] = bflo(b1.w); v1[15] = bfhi(b1.w); }
#pragma unroll
            for (int i = 0; i < 16; ++i) { o0[i] = 0.f; o1[i] = 0.f; }
#define LDF(dst, off) dst = *(const LAS bf16x8*)(B + (off))
#define LD_WQ(F, kt, s) do { LDF(F[0], ((0 * 4 + (kt)) * 2 + (s)) * 1024); LDF(F[1], ((1 * 4 + (kt)) * 2 + (s)) * 1024); LDF(F[2], 16384 + ((0 * 4 + (kt)) * 2 + (s)) * 1024); LDF(F[3], 16384 + ((1 * 4 + (kt)) * 2 + (s)) * 1024); } while (0)
#define MM_WQ(F, kt, s) do { const bf16x8 sb = pack_acc(S[kt], s); v0 = MFMA32(F[0], sb, v0); v1 = MFMA32(F[1], sb, v1); o0 = MFMA32(F[2], sb, o0); o1 = MFMA32(F[3], sb, o1); asm volatile("" : "+v"(o0), "+v"(o1)); } while (0)
#define LD_AT(F, ct) do { LDF(F[0], 49152 + ((0 * 2 + (ct)) * 2 + 0) * 1024); LDF(F[1], 49152 + ((1 * 2 + (ct)) * 2 + 0) * 1024); LDF(F[2], 49152 + ((0 * 2 + (ct)) * 2 + 1) * 1024); LDF(F[3], 49152 + ((1 * 2 + (ct)) * 2 + 1) * 1024); } while (0)
#define MM_AT(F, ct) do { o0 = MFMA32(F[0], vb[ct][0], o0); o1 = MFMA32(F[1], vb[ct][0], o1); o0 = MFMA32(F[2], vb[ct][1], o0); o1 = MFMA32(F[3], vb[ct][1], o1); } while (0)
#define LD_KD(F, ct, s) do { _Pragma("unroll") for (int q = 0; q < 4; ++q) LDF(F[q], 32768 + ((q * 2 + (ct)) * 2 + (s)) * 1024); } while (0)
#define MM_KD(F, ct, s) do { _Pragma("unroll") for (int q = 0; q < 4; ++q) S[q] = MFMA32(F[q], vb[ct][s], S[q]); } while (0)
            bf16x8 FA[4], FB[4];
            LD_WQ(FA, 0, 0); PIN_SCHED();
            LD_WQ(FB, 0, 1); PIN_SCHED(); MM_WQ(FA, 0, 0); PIN_SCHED();
            LD_WQ(FA, 1, 0); PIN_SCHED(); MM_WQ(FB, 0, 1); PIN_SCHED();
            LD_WQ(FB, 1, 1); PIN_SCHED(); MM_WQ(FA, 1, 0); PIN_SCHED();
            LD_WQ(FA, 2, 0); PIN_SCHED(); MM_WQ(FB, 1, 1); PIN_SCHED();
            LD_WQ(FB, 2, 1); PIN_SCHED(); MM_WQ(FA, 2, 0); PIN_SCHED();
            LD_WQ(FA, 3, 0); PIN_SCHED(); MM_WQ(FB, 2, 1); PIN_SCHED();
            LD_WQ(FB, 3, 1); PIN_SCHED(); MM_WQ(FA, 3, 0); PIN_SCHED();
            LD_AT(FA, 0); PIN_SCHED(); MM_WQ(FB, 3, 1); PIN_SCHED();
            bf16x8 vb[2][2];
            vb[0][0] = pack_acc(v0, 0); vb[0][1] = pack_acc(v0, 1); vb[1][0] = pack_acc(v1, 0); vb[1][1] = pack_acc(v1, 1);
            LD_AT(FB, 1); PIN_SCHED(); MM_AT(FA, 0); PIN_SCHED();
#pragma unroll
            for (int kt = 0; kt < 4; ++kt)
#pragma unroll
                for (int i = 0; i < 16; ++i) S[kt][i] *= egl;
            LD_KD(FA, 0, 0); PIN_SCHED(); MM_AT(FB, 1); PIN_SCHED();
            { bf16* op = Oraw + (size_t)(b * SEQ + n * 64 + 4 * (lane >> 5)) * 512 + h * 128 + vs * 32 + (lane & 31); asm volatile("" : "+v"(op));
#pragma unroll
              for (int reg = 0; reg < 16; ++reg) { const int cr = (reg & 3) + 8 * (reg >> 2); const unsigned pk = cvt_pk_bf16(o0[reg], o1[reg]); op[cr * 512] = (bf16)(pk & 0xffffu); op[(32 + cr) * 512] = (bf16)(pk >> 16); } }
            PIN_SCHED();
            LD_KD(FB, 0, 1); PIN_SCHED(); MM_KD(FA, 0, 0); PIN_SCHED();
            LD_KD(FA, 1, 0); PIN_SCHED(); MM_KD(FB, 0, 1); PIN_SCHED();
            LD_KD(FB, 1, 1); PIN_SCHED(); MM_KD(FA, 1, 0); PIN_SCHED();
            MM_KD(FB, 1, 1);
#undef MM_AT
#undef MM_KD
#undef LDF
#undef LD_WQ
#undef MM_WQ
#undef LD_AT
#undef LD_KD
            asm volatile("s_waitcnt lgkmcnt(0)" ::: "memory");
        }
        __builtin_amdgcn_s_barrier(); asm volatile("" ::: "memory");
    }
    asm volatile("s_waitcnt vmcnt(0)" ::: "memory");
#undef CH_MOVE
#undef CH_WARM
}
#if DN_NAIVE
__device__ __forceinline__ void naive_dn(const bf16* QKV, const float* GB, float* Oraw, int unit, int lane) {
    const int bh = unit >> 1, dv = (unit & 1) * 64 + lane, b = bh >> 2, h = bh & 3;
    float S[128];
#pragma unroll
    for (int i = 0; i < 128; ++i) S[i] = 0.f;
    for (int t = 0; t < SEQ; ++t) { const size_t m = (size_t)b * SEQ + t;
        const float al = __expf(GB[m * 8 + h]), be = GB[m * 8 + 4 + h];
        const bf16* qp = QKV + m * 1536 + h * 128; const bf16* kp = qp + 512; const float v = bf2f(qp[1024 + dv]);
        float r = 0.f;
#pragma unroll
        for (int i = 0; i < 128; ++i) { S[i] *= al; r += bf2f(kp[i]) * S[i]; if ((i & 15) == 15) asm volatile("" : "+v"(r) :: "memory"); }
        const float d = be * (v - r); float o = 0.f;
#pragma unroll
        for (int i = 0; i < 128; ++i) { S[i] += bf2f(kp[i]) * d; o += bf2f(qp[i]) * S[i]; if ((i & 15) == 15) asm volatile("" : "+v"(o) :: "memory"); }
        Oraw[m * 512 + h * 128 + dv] = o; }
}
#endif
template <bool OB16>
__device__ __forceinline__ void opost_rows(const void* Oraw_, const bf16* P, const float* gdn, bf16* YC, int gw, int NGW, int lane) {
    const float* Oraw = (const float*)Oraw_; const bf16* Ob = (const bf16*)Oraw_;
    float gd[8];
#pragma unroll
    for (int e = 0; e < 8; ++e) gd[e] = gdn[(8 * lane + e) & 127];
    for (int blk = gw; blk < M / 16; blk += NGW) { const int m0 = blk * 16;
#pragma unroll 1
        for (int i = 0; i < 16; i += 8) {
            f32x4 oa[8], ob[8]; v4u zz[8];
#pragma unroll
            for (int t = 0; t < 8; ++t) { const int m = m0 + i + t;
                if (OB16) { float f[8]; unpack8(*(const v4u*)(Ob + (size_t)m * 512 + 8 * lane), f); oa[t] = (f32x4){f[0], f[1], f[2], f[3]}; ob[t] = (f32x4){f[4], f[5], f[6], f[7]}; }
                else { const f32x4* op = (const f32x4*)(Oraw + (size_t)m * 512 + 8 * lane); oa[t] = op[0]; ob[t] = op[1]; }
                zz[t] = *(const v4u*)(P + (size_t)m * NP + 3072 + 8 * lane); }
#pragma unroll
            for (int t = 0; t < 8; ++t) { const int m = m0 + i + t; float z[8]; unpack8(zz[t], z);
                float o[8] = {oa[t].x, oa[t].y, oa[t].z, oa[t].w, ob[t].x, ob[t].y, ob[t].z, ob[t].w}; float ss = 0.f;
#pragma unroll
                for (int e = 0; e < 8; ++e) ss += o[e] * o[e];
                ss += __shfl_xor(ss, 1); ss += __shfl_xor(ss, 2); ss += __shfl_xor(ss, 4); ss += __shfl_xor(ss, 8);
                const float r = 1.0f / sqrtf(ss * (1.0f / 128.0f) + EPS);
#pragma unroll
                for (int e = 0; e < 8; ++e) o[e] = o[e] * r * gd[e] * silu_f(z[e]);
                *(v4u*)(YC + (size_t)m * D + 512 + 8 * lane) = pack8(o); } } }
}

typedef __attribute__((address_space(1))) unsigned gu32;
#define XB_TMO      128
#define XB_XCNT(j)  (256  + 64 * (j))
#define XB_XSUB(j)  (1280 + 64 * (j))
#define XB_XGEN(j)  (2304 + 64 * (j))
#define XB_TOP      3328
#define XB_TOPGEN   3392
#define XCD_BAR_WORDS 3456
#define XB_SPIN_CAP (1u << 18)

__device__ __forceinline__ unsigned xb_ld(unsigned* p)              { return __hip_atomic_load(p, __ATOMIC_RELAXED, __HIP_MEMORY_SCOPE_AGENT); }
__device__ __forceinline__ unsigned xb_add(unsigned* p, unsigned v) { return __hip_atomic_fetch_add(p, v, __ATOMIC_RELAXED, __HIP_MEMORY_SCOPE_AGENT); }
__device__ __forceinline__ unsigned xb_xcc_id() { return (unsigned)__builtin_amdgcn_s_getreg((3 << 11) | 20) & 0xFu; }
#define XB_SPIN(cond, bar) do { unsigned _sp = 0; while (cond) { __builtin_amdgcn_s_sleep(1); \
    if ((++_sp & 255u) == 0u) { if (xb_ld(&(bar)[XB_TMO])) break; if (_sp > XB_SPIN_CAP) { atomicAdd(&(bar)[XB_TMO], 1u); break; } } } } while (0)

struct XcdBarrier {
    unsigned* bar; unsigned x;
    volatile LAS unsigned* st;
};

__device__ __forceinline__ XcdBarrier xcd_barrier_post(unsigned* bar, volatile LAS unsigned* st) {
    XcdBarrier b; b.bar = bar; b.x = xb_xcc_id(); b.st = st;
    if (threadIdx.x == 0) (void)xb_add(&bar[XB_XCNT(b.x)], 1u);
    return b;
}
__device__ __forceinline__ void xcd_barrier_complete(unsigned* bar, unsigned x, unsigned& nloc, unsigned& nx) {
    const unsigned G = gridDim.x * gridDim.y * gridDim.z;
    unsigned sum, cnt, mine, sp = 0u;
    for (;;) {
        sum = 0u; cnt = 0u; mine = 0u;
#pragma unroll
        for (unsigned j = 0; j < 16; ++j) { const unsigned c = xb_ld(&bar[XB_XCNT(j)]); sum += c; cnt += (c > 0u) ? 1u : 0u; mine = (j == x) ? c : mine; }
        if (sum == G) break;
        __builtin_amdgcn_s_sleep(1);
        if ((++sp & 255u) == 0u) { if (xb_ld(&bar[XB_TMO])) break; if (sp > XB_SPIN_CAP) { atomicAdd(&bar[XB_TMO], 1u); break; } }
    }
    nloc = mine > 0u ? mine : 1u; nx = cnt > 0u ? cnt : 1u;
}

__device__ __forceinline__ void xcd_barrier(const XcdBarrier& b) {
    asm volatile("s_waitcnt vmcnt(0)" ::: "memory");
    __syncthreads();
    if (threadIdx.x == 0) {
        unsigned* bar = b.bar;
        __builtin_amdgcn_s_waitcnt(0);
        unsigned nloc = b.st[0], nx = b.st[1];
        if (nloc == 0u) { xcd_barrier_complete(bar, b.x, nloc, nx); b.st[0] = nloc; b.st[1] = nx; }
        const unsigned old = xb_add(&bar[XB_XSUB(b.x)], 1u);
        const unsigned gen = old / nloc;
        if (old + 1u == (gen + 1u) * nloc) {
            __builtin_amdgcn_fence(__ATOMIC_RELEASE, "agent");
            asm volatile("s_waitcnt vmcnt(0)" ::: "memory");
            const unsigned og = xb_add(&bar[XB_TOP], 1u);
            const unsigned tg = og / nx;
            if (og + 1u == (tg + 1u) * nx) xb_add(&bar[XB_TOPGEN], 1u);
            else XB_SPIN(xb_ld(&bar[XB_TOPGEN]) == tg, bar);
            __builtin_amdgcn_fence(__ATOMIC_ACQUIRE, "agent");
            xb_add(&bar[XB_XGEN(b.x)], 1u);
            asm volatile("s_waitcnt vmcnt(0)" ::: "memory");
        } else {
            XB_SPIN(xb_ld(&bar[XB_XGEN(b.x)]) == gen, bar);
            __builtin_amdgcn_fence(__ATOMIC_ACQUIRE, "agent");
            asm volatile("s_waitcnt vmcnt(0)" ::: "memory");
        }
    }
    __syncthreads();
}

__global__ void __launch_bounds__(NWAVES * 64, 2) fwd(Args args) {
    extern __shared__ __attribute__((aligned(16))) unsigned char lds_raw[];
    LAS unsigned char* lds = (LAS unsigned char*)lds_raw;
    int tid = threadIdx.x, lane = tid & 63, wave = __builtin_amdgcn_readfirstlane(tid >> 6);
    const int G = gridDim.x; const int bx = blockIdx.x; const int vcu = (G % 8 == 0) ? (bx % 8) * (G / 8) + bx / 8 : bx;
    int gw = vcu * NWAVES + wave; const int NGW = G * NWAVES;
#define LAUNDER() do { int tv_ = threadIdx.x; asm volatile("" : "+v"(tv_)); tid = tv_; lane = tid & 63; wave = __builtin_amdgcn_readfirstlane(tid >> 6); gw = vcu * NWAVES + wave; } while (0)
    unsigned char* ws = args.ws;
    float* MOD = (float*)(ws + WS_MOD); float* GB = (float*)(ws + WS_GB); float* EGL = (float*)(ws + WS_EGL);
    bf16* WinT = (bf16*)(ws + WS_WIN); bf16* WoT = (bf16*)(ws + WS_WO); bf16* WguT = (bf16*)(ws + WS_WGU); bf16* WdT = (bf16*)(ws + WS_WD);
    bf16* H = (bf16*)(ws + WS_H); unsigned char* CH = ws + WS_CH; bf16* P = (bf16*)(ws + WS_P); bf16* ACT = (bf16*)(ws + WS_P); bf16* YC = (bf16*)(ws + WS_YC);
    bf16* QKV = (bf16*)args.out; bf16* Oraw = (bf16*)((unsigned char*)args.out + 96 * MiB); float* OUT = args.out;
    const int lo = args.ph_lo, hi = args.ph_hi;
    volatile LAS unsigned* MISC = (volatile LAS unsigned*)(lds + LDS_BYTES - 64);
    if (tid < 16) MISC[tid] = 0u;
    __syncthreads();
    XcdBarrier bar = xcd_barrier_post((unsigned*)ws, MISC);
    if (lo < 0) cg::this_grid().sync();
#ifndef PH_MASK
#define PH_MASK 0xFFF
#endif
#define IN(k) (((PH_MASK >> (k)) & 1) && lo <= (k) && (k) < hi)
#if MK_N_LAUNCHES == 1
#define SEAM(k) do { if (IN(k) && IN((k) + 1) && (k) != 5) xcd_barrier(bar); } while (0)
#else
#define SEAM(k) do { } while (0)
#endif
#ifndef REP_MASK
#define REP_MASK 0
#endif
#define BEGIN_REP(k) for (int rep_ = 0; rep_ <= ((REP_MASK >> (k)) & 1); ++rep_) { if (rep_) xcd_barrier(bar); LAUNDER();
#define END_REP }
    BEGIN_REP(0)
    if (IN(0)) {
        LAS float* scr = (LAS float*)(lds + wave * 16384);
        constexpr int I_IN = 16 * 112, I_O = 16 * 32, I_GU = 16 * 176, I_DN = 44 * 32, NITEMS = I_IN + I_O + I_GU + I_DN;
        for (int it = gw; it < NITEMS; it += NGW) { int r = it;
            if (r < I_IN) { p0_transpose_item<0>(args.in[I_WIN], D, PIN, 112, WinT, scr, r, lane); continue; } r -= I_IN;
            if (r < I_O) { p0_transpose_item<0>(args.in[I_WOUT], D, D, 32, WoT, scr, r, lane); continue; } r -= I_O;
            if (r < I_GU) { p0_transpose_item<1>(args.in[I_WGU], D, 2 * FF, 176, WguT, scr, r, lane); continue; } r -= I_GU;
            p0_transpose_item<0>(args.in[I_WDN], FF, D, 32, WdT, scr, r, lane); }
        __syncthreads();
        { LAS float* SC = (LAS float*)lds; const float* cin = args.in[I_C];
          for (int idx = tid; idx < 4096; idx += NWAVES * 64) { const int b = idx >> 10, k = idx & 1023; const float cv = cin[idx]; SC[k * 4 + b] = cv / (1.0f + __expf(-cv)); }
          __syncthreads();
          for (int it = bx; it < 256; it += G) p0_mod_item(args, MOD, SC, (LAS float*)(lds + 16384), it, tid); }
    }
    END_REP
    SEAM(0);
    BEGIN_REP(1)
    if (IN(1)) { LAS float* TT = (LAS float*)lds; const float* wi = args.in[I_WIN];
        for (int idx = tid; idx < 8192; idx += NWAVES * 64) { const int k = idx >> 3, e = idx & 7; TT[e * 1024 + k] = wi[(size_t)k * PIN + NP + e]; }
        __syncthreads();
        adaln_rows<0>(args.in[I_X], args.in[I_GMIX], MOD + 0, MOD + 1024, 6144, H, nullptr, TT, args.in[I_ALOG], args.in[I_DTB], GB, gw, NGW, lane);
        __syncthreads(); }
    END_REP
    SEAM(1);
    BEGIN_REP(2)
    if (IN(2)) { pg8::Gemm g{H, WinT, M, NP, D}; pg8::StaticOrder S; S.init(M, NP, G, bx); pg8::EpiBf16 E{P, NP};
        pg8::gemm_phase<pg8::EpiBf16, pg8::StaticOrder, true, true>(lds, g, S, E); }
    END_REP
    SEAM(2);
    BEGIN_REP(3)
    if (IN(3)) conv_pass(P, args.in[I_CWM], args.in[I_CWQ], args.in[I_GCO], YC, QKV, gw, NGW, lane);
    END_REP
    SEAM(3);
#if DN_NAIVE
    SEAM(4);
    if (IN(5)) { if (bx < 32 && wave == 0) naive_dn(QKV, GB, (float*)(ws + WS_CH), bx, lane); }
    SEAM(5);
    if (IN(6)) opost_rows<false>((const float*)(ws + WS_CH), P, args.in[I_GDN], YC, gw, NGW, lane);
#else
    BEGIN_REP(4)
    if (IN(4)) { unsigned* FLG = (unsigned*)(ws + 16384);
        if (bx < NBH) chain_phase(lds, CH, FLG, Oraw, bx, tid); else prep_phase(lds, QKV, GB, EGL, CH, FLG, bx - NBH, G - NBH, tid); }
    END_REP
    SEAM(4);
    BEGIN_REP(6)
    if (IN(6)) opost_rows<true>(Oraw, P, args.in[I_GDN], YC, gw, NGW, lane);
    END_REP
#endif
    SEAM(6);
    BEGIN_REP(7)
    if (IN(7)) { pg8::Gemm g{YC, WoT, M, D, D}; pg8::StaticOrder S; S.init(M, D, G, bx);
        pg8::EpiResGateNorm<true> E{args.in[I_X], OUT, H, MOD + 2048, 6144, args.in[I_GFFN], MOD + 3072, MOD + 4096, 6144, (float*)(ws + WS_EGL + 524288), (unsigned*)(ws + 32768 + 8192), lds + 131072};
        pg8::gemm_phase<pg8::EpiResGateNorm<true>, pg8::StaticOrder, true, true>(lds, g, S, E); }
    END_REP
    SEAM(7);
    BEGIN_REP(8)
    if (false && IN(8)) adaln_rows<1>(OUT, args.in[I_GFFN], MOD + 3072, MOD + 4096, 6144, H, nullptr, nullptr, nullptr, nullptr, nullptr, gw, NGW, lane);
    END_REP
    BEGIN_REP(9)
    if (IN(9)) { pg8::Gemm g{H, WguT, M, 2 * FF, D}; pg8::StaticOrder S; S.init(M, 2 * FF, G, bx); pg8::EpiSwiglu E{ACT, FF};
        pg8::gemm_phase<pg8::EpiSwiglu, pg8::StaticOrder, true, true>(lds, g, S, E); }
    END_REP
    SEAM(9);
    BEGIN_REP(10)
    if (IN(10)) { pg8::Gemm g{ACT, WdT, M, D, FF}; pg8::StaticOrder S; S.init(M, D, G, bx);
        pg8::EpiResGateNorm<false> E{OUT, OUT, nullptr, MOD + 5120, 6144, args.in[I_GFIN], MOD + 4 * 6144, MOD + 4 * 6144 + 1024, 2048, (float*)(ws + WS_EGL), (unsigned*)(ws + 32768), lds + 131072};
        pg8::gemm_phase<pg8::EpiResGateNorm<false>, pg8::StaticOrder, true, true>(lds, g, S, E); }
    END_REP
    LAUNDER();
    if (IN(11) && G != 256) adaln_rows<2>(OUT, args.in[I_GFIN], MOD + 4 * 6144, MOD + 4 * 6144 + 1024, 2048, nullptr, OUT, nullptr, nullptr, nullptr, nullptr, gw, NGW, lane);
#undef IN
#undef SEAM
}

extern "C" void kernel_launch(void* const* d_in, const int* in_sizes, int n_in, void* d_out, int out_size, void* d_ws, size_t ws_size, hipStream_t stream) {
    static int grid = 0;
    if (grid == 0) {
        if (n_in != 19 || out_size != M * D || ws_size < WS_END) { fprintf(stderr, "kernel_launch: unexpected shapes (n_in %d, out %d, ws %zu)\n", n_in, out_size, ws_size); grid = -1; return; }
        int dev = 0, cus = 0;
        if (hipGetDevice(&dev) != hipSuccess || hipDeviceGetAttribute(&cus, hipDeviceAttributeMultiprocessorCount, dev) != hipSuccess) { grid = -1; return; }
        if (hipFuncSetAttribute((const void*)fwd, hipFuncAttributeMaxDynamicSharedMemorySize, LDS_BYTES) != hipSuccess) { fprintf(stderr, "kernel_launch: hipFuncSetAttribute failed\n"); grid = -1; return; }
        int per_cu = 0;
        if (hipOccupancyMaxActiveBlocksPerMultiprocessor(&per_cu, (const void*)fwd, NWAVES * 64, LDS_BYTES) != hipSuccess || per_cu < 1) { fprintf(stderr, "kernel_launch: occupancy query says %d blocks per CU\n", per_cu); }
        (void)hipGetLastError();
        grid = cus;
    }
    if (grid < 0) return;
    Args a{};
    for (int i = 0; i < 19; ++i) a.in[i] = (const float*)d_in[i];
    a.out = (float*)d_out; a.ws = (unsigned char*)d_ws;
#if MK_N_LAUNCHES == 1
    if (hipMemsetAsync(d_ws, 0, 49152, stream) != hipSuccess) { fprintf(stderr, "kernel_launch: memset of the barrier words failed\n"); return; }
    a.ph_lo = 0; a.ph_hi = PH_END;
    void* kargs[] = {&a};
    hipError_t e = hipLaunchCooperativeKernel((const void*)fwd, dim3(grid), dim3(NWAVES * 64), kargs, LDS_BYTES, stream);
    if (e != hipSuccess) fprintf(stderr, "kernel_launch: cooperative launch failed: %s (grid %d)\n", hipGetErrorString(e), grid);
#else
    for (int ph = 0; ph < PH_END; ++ph) { a.ph_lo = ph; a.ph_hi = ph + 1; hipLaunchKernelGGL(fwd, dim3(grid), dim3(NWAVES * 64), LDS_BYTES, stream, a); }
#endif
}
```

```cpp
#include <hip/hip_runtime.h>
#include <hip/hip_cooperative_groups.h>
#include <cstdio>
#include <cstdint>
namespace cg = cooperative_groups;
#ifndef MK_N_LAUNCHES
#define MK_N_LAUNCHES 1
#endif
#ifndef DN_NAIVE
#define DN_NAIVE 0
#endif
namespace pg8 {
#define PG8_LAS __attribute__((address_space(3)))
typedef unsigned short bf16_t;
typedef short bf16x8 __attribute__((ext_vector_type(8)));
typedef float f32x4 __attribute__((ext_vector_type(4)));
typedef unsigned u32x4 __attribute__((ext_vector_type(4)));
constexpr int BM = 256, BK = 64, HALF = 128, HTB = HALF * BK * 2  , STAGE_BYTES = 8 * HTB, NXCD = 8, WGM = 8;

__host__ __device__ __forceinline__ int lds_byte(int r, int c) { const int st = (r >> 4) * 2 + (c >> 5), rr = r & 15, cc = c & 31, ob = rr * 64 + cc * 2; return st * 1024 + (ob ^ (((ob >> 9) & 1) << 5)); }
__host__ __device__ __forceinline__ void stage_rc(int b, int& R, int& C) { const int st = b / 1024, sb = b % 1024, swz = sb ^ (((sb >> 9) & 1) << 5); R = (st >> 1) * 16 + swz / 64; C = (st & 1) * 32 + (swz % 64) / 2; }
__host__ __device__ __forceinline__ int perm32(int rho) { const int n = rho >> 4, i = rho & 15; return 8 * (i >> 2) + 4 * n + (i & 3); }

struct Unit { int pm, pn; };
struct Gemm { const bf16_t* A; const bf16_t* Bt; int M, N, K; };

struct StaticOrder {
    int nM, nN, nwg, G, c;
    __host__ __device__ void init(int M, int N, int G_, int c_) { nM = M / BM; nN = N / BM; nwg = nM * nN; G = G_; c = c_; }
    __host__ __device__ bool next(int i, Unit& u) const {
        const long L = (long)i * G + c; if (L >= nwg) return false;
        int wgid = (int)L; { const int q = nwg / NXCD, r = nwg % NXCD, xcd = wgid % NXCD, off = wgid / NXCD; wgid = (xcd < r ? xcd * (q + 1) : r * (q + 1) + (xcd - r) * q) + off; }
        const int nig = WGM * nN, gid = wgid / nig, fm = gid * WGM, gsz = (nM - fm) < WGM ? (nM - fm) : WGM;
        u.pm = fm + ((wgid % nig) % gsz); u.pn = (wgid % nig) / gsz; return true;
    }
    __device__ __forceinline__ void a_ready(const Unit&) const {}
    __device__ __forceinline__ void done(const Unit&) const {}
};

typedef float f32x2 __attribute__((ext_vector_type(2)));
typedef __bf16 bf16x2v __attribute__((ext_vector_type(2)));
__device__ __forceinline__ unsigned cvt_pk_bf16(float lo, float hi) { f32x2 v = {lo, hi}; bf16x2v r = __builtin_convertvector(v, bf16x2v); return __builtin_bit_cast(unsigned, r); }
__device__ __forceinline__ float silu_f(float x) { return x * __builtin_amdgcn_rcpf(1.0f + __builtin_amdgcn_exp2f(-1.4426950408889634f * x)); }

struct EpiBf16 {
    static constexpr bool PERM = true, AFTER_DRAIN = false;
    bf16_t* O; int ldc;
    __device__ __forceinline__ void operator()(const f32x4 (&acc)[2][2][4][2], const Unit& u, int wr, int wc, int fr, int fq) const {
        const int row0 = u.pm * BM + wr * 64 + fr; const int col0 = u.pn * BM + wc * 32 + 8 * fq;
#pragma unroll
        for (int ai = 0; ai < 2; ++ai)
#pragma unroll
            for (int m = 0; m < 4; ++m) { bf16_t* rowp = O + (size_t)(row0 + ai * HALF + m * 16) * ldc + col0;
#pragma unroll
                for (int bj = 0; bj < 2; ++bj) { const f32x4 v0 = acc[ai][bj][m][0], v1 = acc[ai][bj][m][1];
                    u32x4 w; w.x = cvt_pk_bf16(v0[0], v0[1]); w.y = cvt_pk_bf16(v0[2], v0[3]); w.z = cvt_pk_bf16(v1[0], v1[1]); w.w = cvt_pk_bf16(v1[2], v1[3]);
                    *(u32x4*)(rowp + bj * HALF) = w; } }
    }
};
struct EpiSwiglu {
    static constexpr bool PERM = true, AFTER_DRAIN = false;
    bf16_t* O; int ldc;
    __device__ __forceinline__ void operator()(const f32x4 (&acc)[2][2][4][2], const Unit& u, int wr, int wc, int fr, int fq) const {
        const int row0 = u.pm * BM + wr * 64 + fr; const int col0 = u.pn * HALF + wc * 32 + 8 * fq;
#pragma unroll
        for (int ai = 0; ai < 2; ++ai)
#pragma unroll
            for (int m = 0; m < 4; ++m) { bf16_t* rowp = O + (size_t)(row0 + ai * HALF + m * 16) * ldc + col0;
                const f32x4 g0 = acc[ai][0][m][0], g1 = acc[ai][0][m][1], u0 = acc[ai][1][m][0], u1 = acc[ai][1][m][1];
                u32x4 w; w.x = cvt_pk_bf16(silu_f(g0[0]) * u0[0], silu_f(g0[1]) * u0[1]); w.y = cvt_pk_bf16(silu_f(g0[2]) * u0[2], silu_f(g0[3]) * u0[3]);
                w.z = cvt_pk_bf16(silu_f(g1[0]) * u1[0], silu_f(g1[1]) * u1[1]); w.w = cvt_pk_bf16(silu_f(g1[2]) * u1[2], silu_f(g1[3]) * u1[3]);
                *(u32x4*)rowp = w; }
    }
};
struct EpiResGate {
    static constexpr bool PERM = false, AFTER_DRAIN = false;
    const float* base; float* out; const float* gate;
    int gstride;
    __device__ __forceinline__ void operator()(const f32x4 (&acc)[2][2][4][2], const Unit& u, int wr, int wc, int fr, int fq) const {
        const int b = u.pm >> 5;
        const int col0 = u.pn * BM + wc * 32 + 4 * fq; const float* gp = gate + (size_t)b * gstride + col0;
        f32x4 gv[2][2];
#pragma unroll
        for (int bj = 0; bj < 2; ++bj)
#pragma unroll
            for (int n = 0; n < 2; ++n) gv[bj][n] = *(const f32x4*)(gp + bj * HALF + n * 16);
#pragma unroll
        for (int ai = 0; ai < 2; ++ai)
#pragma unroll
            for (int m = 0; m < 4; ++m) { const size_t off = (size_t)(u.pm * BM + ai * HALF + wr * 64 + m * 16 + fr) * 1024 + col0;
#pragma unroll
                for (int bj = 0; bj < 2; ++bj)
#pragma unroll
                    for (int n = 0; n < 2; ++n) { const f32x4 bs = *(const f32x4*)(base + off + bj * HALF + n * 16);
                        *(f32x4*)(out + off + bj * HALF + n * 16) = bs + gv[bj][n] * acc[ai][bj][m][n]; } }
    }
};

template <bool MID> struct EpiResGateNorm {
    static constexpr bool PERM = false, AFTER_DRAIN = false;
    const float* base; float* out; bf16_t* hb; const float* gate; int gstride;
    const float* gain; const float* shiftp; const float* scalep; int mstride;
    float* SS; unsigned* cnt; PG8_LAS unsigned char* xl;
    __device__ __forceinline__ void operator()(f32x4 (&acc)[2][2][4][2], const Unit& u, int wr, int wc, int fr, int fq) const {
        const int tid = threadIdx.x, lane = tid & 63, wid = __builtin_amdgcn_readfirstlane(tid >> 6);
        const int b = u.pm >> 5;
        const int col0 = u.pn * BM + wc * 32 + 4 * fq; const float* gp = gate + (size_t)b * gstride + col0;
        PG8_LAS float* Pt = (PG8_LAS float*)xl; PG8_LAS float* St = (PG8_LAS float*)(xl + 4096);
        f32x4 gv[2][2];
#pragma unroll
        for (int bj = 0; bj < 2; ++bj)
#pragma unroll
            for (int n = 0; n < 2; ++n) gv[bj][n] = *(const f32x4*)(gp + bj * HALF + n * 16);
#pragma unroll
        for (int ai = 0; ai < 2; ++ai)
#pragma unroll
            for (int m = 0; m < 4; ++m) { const size_t off = (size_t)(u.pm * BM + ai * HALF + wr * 64 + m * 16 + fr) * 1024 + col0; float s = 0.f;
#pragma unroll
                for (int bj = 0; bj < 2; ++bj)
#pragma unroll
                    for (int n = 0; n < 2; ++n) { const f32x4 v = *(const f32x4*)(base + off + bj * HALF + n * 16) + gv[bj][n] * acc[ai][bj][m][n]; acc[ai][bj][m][n] = v; if (MID) *(f32x4*)(out + off + bj * HALF + n * 16) = v; s += (v.x * v.x + v.y * v.y) + (v.z * v.z + v.w * v.w); }
                s += __shfl_xor(s, 16); s += __shfl_xor(s, 32);
                if (fq == 0) Pt[(ai * HALF + wr * 64 + m * 16 + fr) * 4 + wc] = s; }
        asm volatile("s_waitcnt lgkmcnt(0)" ::: "memory"); __builtin_amdgcn_s_barrier(); asm volatile("" ::: "memory");
        if (tid < 256) { const f32x4 p = *(const PG8_LAS f32x4*)(Pt + tid * 4); const float part = (p.x + p.y) + (p.z + p.w);
            float* slot = SS + (size_t)(u.pm * BM + tid) * 4 + u.pn; asm volatile("global_store_dword %0, %1, off sc1\n\ts_nop 1" :: "v"(slot), "v"(part) : "memory"); }
        asm volatile("s_waitcnt vmcnt(0)" ::: "memory"); __builtin_amdgcn_s_barrier(); asm volatile("" ::: "memory");
        if (wid == 0) { unsigned* c = cnt + u.pm * 16;
            if (lane == 0) __hip_atomic_fetch_add(c, 1u, __ATOMIC_RELAXED, __HIP_MEMORY_SCOPE_AGENT);
            unsigned spins = 0;
            while ((unsigned)__builtin_amdgcn_readfirstlane(__hip_atomic_load(c, __ATOMIC_RELAXED, __HIP_MEMORY_SCOPE_AGENT)) < 4u && ++spins < 4000000u) __builtin_amdgcn_s_sleep(2);
            __builtin_amdgcn_fence(__ATOMIC_ACQUIRE, "agent"); asm volatile("s_waitcnt vmcnt(0)" ::: "memory"); }
        __builtin_amdgcn_s_barrier(); asm volatile("" ::: "memory");
        if (tid < 256) { const f32x4 q = *(const f32x4*)(SS + (size_t)(u.pm * BM + tid) * 4); St[tid] = 1.0f / sqrtf(((q.x + q.y) + (q.z + q.w)) * (1.0f / 1024.0f) + 1e-6f); }
        asm volatile("s_waitcnt lgkmcnt(0)" ::: "memory"); __builtin_amdgcn_s_barrier(); asm volatile("" ::: "memory");
        float rinv[2][4];
#pragma unroll
        for (int ai = 0; ai < 2; ++ai)
#pragma unroll
            for (int m = 0; m < 4; ++m) rinv[ai][m] = St[ai * HALF + wr * 64 + m * 16 + fr];
#pragma unroll
        for (int bj = 0; bj < 2; ++bj)
#pragma unroll
            for (int n = 0; n < 2; ++n) { const int c = col0 + bj * HALF + n * 16;
                const f32x4 gs = *(const f32x4*)(gain + c) * (1.0f + *(const f32x4*)(scalep + (size_t)b * mstride + c)), sh = *(const f32x4*)(shiftp + (size_t)b * mstride + c);
#pragma unroll
                for (int ai = 0; ai < 2; ++ai)
#pragma unroll
                    for (int m = 0; m < 4; ++m) { const size_t off = (size_t)(u.pm * BM + ai * HALF + wr * 64 + m * 16 + fr) * 1024 + c; const f32x4 o = (acc[ai][bj][m][n] * rinv[ai][m]) * gs + sh;
                        if (MID) { typedef unsigned u32x2v __attribute__((ext_vector_type(2))); u32x2v w; w.x = cvt_pk_bf16(o.x, o.y); w.y = cvt_pk_bf16(o.z, o.w); *(u32x2v*)(hb + off) = w; }
                        else *(f32x4*)(out + off) = o; }
                asm volatile("" ::: "memory"); }
        asm volatile("s_waitcnt lgkmcnt(0)" ::: "memory"); __builtin_amdgcn_s_barrier(); asm volatile("" ::: "memory");
    }
};

template <class Epi, class Sched, bool ALIGN_EPI = false, bool SP2 = false>
__device__ __forceinline__ void gemm_phase(PG8_LAS unsigned char* lds, const Gemm g, const Sched& S, const Epi& E) {
    const int tid = threadIdx.x, wid = __builtin_amdgcn_readfirstlane(tid >> 6), lane = tid & 63, wr = wid >> 2, wc = wid & 3, fr = lane & 15, fq = lane >> 4;
    const int K = g.K, nt = K / BK;
    unsigned voffA[2], voffB[2];
#pragma unroll
    for (int i = 0; i < 2; ++i) { int R, C; stage_rc(tid * 16 + i * 8192, R, C); const int Rb = Epi::PERM ? ((R & ~31) + perm32(R & 31)) : R;
        voffA[i] = (unsigned)(R * K + C) * 2u; voffB[i] = (unsigned)(Rb * K + C) * 2u; }
    const size_t kstep = (size_t)(BK * 2);
    const size_t hstep = (size_t)HALF * K * 2;
    const size_t tstep = 2 * hstep;
    const unsigned ldsw = (unsigned)wid * 1024u;
    const int aoff = lds_byte(wr * 64 + fr, fq * 8), boff = lds_byte(wc * 32 + fr, fq * 8);
#define PG8_SA(b, h) (((b) * 2 + (h)) * HTB)
#define PG8_SB(b, h) ((4 + (b) * 2 + (h)) * HTB)
#define PG8_STAGE(bufoff, gbase, voff) do { _Pragma("unroll") for (int _i = 0; _i < 2; ++_i) \
        __builtin_amdgcn_global_load_lds((const unsigned*)((const char*)(gbase) + (voff)[_i]), (PG8_LAS unsigned*)(lds + (bufoff) + ldsw + _i * 8192), 16, 0, 0); } while (0)
#define PG8_LDA(dst, b, h) do { _Pragma("unroll") for (int m = 0; m < 4; ++m) _Pragma("unroll") for (int k = 0; k < 2; ++k) dst[m][k] = *(const PG8_LAS bf16x8*)(lds + PG8_SA(b, h) + aoff + m * 2048 + k * 1024); } while (0)
#define PG8_LDB(dst, b, h) do { _Pragma("unroll") for (int n = 0; n < 2; ++n) _Pragma("unroll") for (int k = 0; k < 2; ++k) dst[n][k] = *(const PG8_LAS bf16x8*)(lds + PG8_SB(b, h) + boff + n * 2048 + k * 1024); } while (0)
#define PG8_MMA(ai, bj, At, Bt) do { __builtin_amdgcn_s_setprio(1); _Pragma("unroll") for (int m = 0; m < 4; ++m) _Pragma("unroll") for (int n = 0; n < 2; ++n) _Pragma("unroll") for (int k = 0; k < 2; ++k) \
        acc[ai][bj][m][n] = __builtin_amdgcn_mfma_f32_16x16x32_bf16(Bt[n][k], At[m][k], acc[ai][bj][m][n], 0, 0, 0); __builtin_amdgcn_s_setprio(0); } while (0)
#define PG8_WAIT_V(n) asm volatile("s_waitcnt vmcnt(" #n ")" ::: "memory")
#define PG8_WAIT_L(n) asm volatile("s_waitcnt lgkmcnt(" #n ")" ::: "memory")
#define PG8_BAR __builtin_amdgcn_s_barrier()
#define PG8_SCHED __builtin_amdgcn_sched_barrier(0)
    Unit cur, nxt; int ui = 0;
    if (!S.next(0, cur)) return;
    f32x4 acc[2][2][4][2];
#pragma unroll
    for (int a = 0; a < 2; ++a)
#pragma unroll
        for (int b = 0; b < 2; ++b)
#pragma unroll
            for (int m = 0; m < 4; ++m)
#pragma unroll
                for (int n = 0; n < 2; ++n) acc[a][b][m][n] = (f32x4){0.f, 0.f, 0.f, 0.f};
    bf16x8 At[4][2], B0[2][2], B1[2][2];
    const char* cA = (const char*)g.A + (size_t)cur.pm * tstep; const char* cB = (const char*)g.Bt + (size_t)cur.pn * tstep;
    S.a_ready(cur);
    if constexpr (SP2) {
        PG8_STAGE(PG8_SB(0, 0), cB, voffB); PG8_STAGE(PG8_SB(0, 1), cB + hstep, voffB); PG8_STAGE(PG8_SA(0, 0), cA, voffA); PG8_STAGE(PG8_SA(0, 1), cA + hstep, voffA);
        if (wr == 1) PG8_BAR;
        PG8_WAIT_V(2); PG8_BAR;
        PG8_STAGE(PG8_SB(1, 0), cB + kstep, voffB); PG8_STAGE(PG8_SA(1, 0), cA + kstep, voffA); PG8_STAGE(PG8_SB(1, 1), cB + hstep + kstep, voffB);
        PG8_WAIT_V(6); PG8_BAR;
    } else {
        PG8_STAGE(PG8_SB(0, 0), cB, voffB); PG8_STAGE(PG8_SA(0, 0), cA, voffA); PG8_STAGE(PG8_SB(0, 1), cB + hstep, voffB); PG8_STAGE(PG8_SA(0, 1), cA + hstep, voffA);
        if (wr == 1) PG8_BAR;
        PG8_WAIT_V(4); PG8_BAR;
        PG8_STAGE(PG8_SB(1, 0), cB + kstep, voffB); PG8_STAGE(PG8_SA(1, 0), cA + kstep, voffA); PG8_STAGE(PG8_SB(1, 1), cB + hstep + kstep, voffB);
        PG8_WAIT_V(6); PG8_BAR;
    }
    for (;;) {
        const bool has_next = S.next(ui + 1, nxt);
        const char* nA = has_next ? (const char*)g.A + (size_t)nxt.pm * tstep : cA; const char* nB = has_next ? (const char*)g.Bt + (size_t)nxt.pn * tstep : cB;
        for (int t = 0; t < nt; t += 2) {
            const bool last = (t == nt - 2);
            const char* a1 = cA + (size_t)(t + 1) * kstep;
            const char* a2 = last ? nA : cA + (size_t)(t + 2) * kstep; const char* b2 = last ? nB : cB + (size_t)(t + 2) * kstep;
            const char* a3 = a2 + kstep; const char* b3 = b2 + kstep;
            if (last && has_next) S.a_ready(nxt);
            if constexpr (SP2) {
            PG8_LDB(B0, 0, 0); PG8_LDB(B1, 0, 1); PG8_SCHED; PG8_LDA(At, 0, 0); PG8_STAGE(PG8_SA(1, 1), a1 + hstep, voffA);
            PG8_WAIT_V(8); PG8_WAIT_L(0); PG8_BAR; PG8_MMA(0, 0, At, B0); PG8_MMA(0, 1, At, B1); PG8_BAR; PG8_SCHED;
            PG8_LDA(At, 0, 1); PG8_STAGE(PG8_SB(0, 0), b2, voffB); PG8_STAGE(PG8_SB(0, 1), b2 + hstep, voffB); PG8_STAGE(PG8_SA(0, 0), a2, voffA);
            PG8_WAIT_V(8); PG8_WAIT_L(0); PG8_BAR; PG8_MMA(1, 0, At, B0); PG8_MMA(1, 1, At, B1); PG8_BAR; PG8_SCHED;
            PG8_LDB(B0, 1, 0); PG8_LDB(B1, 1, 1); PG8_SCHED; PG8_LDA(At, 1, 0); PG8_STAGE(PG8_SA(0, 1), a2 + hstep, voffA);
            PG8_WAIT_V(8); PG8_WAIT_L(0); PG8_BAR; PG8_MMA(0, 0, At, B0); PG8_MMA(0, 1, At, B1); PG8_BAR; PG8_SCHED;
            PG8_LDA(At, 1, 1); PG8_STAGE(PG8_SB(1, 0), b3, voffB); PG8_STAGE(PG8_SB(1, 1), b3 + hstep, voffB); PG8_STAGE(PG8_SA(1, 0), a3, voffA);
            PG8_WAIT_V(8); PG8_WAIT_L(0); PG8_BAR; PG8_MMA(1, 0, At, B0); PG8_MMA(1, 1, At, B1); PG8_BAR; PG8_SCHED;
            } else {
            PG8_LDB(B0, 0, 0); PG8_SCHED; PG8_LDA(At, 0, 0); PG8_STAGE(PG8_SA(1, 1), a1 + hstep, voffA);
            PG8_WAIT_L(8); PG8_BAR; PG8_WAIT_L(0); PG8_MMA(0, 0, At, B0); PG8_BAR; PG8_SCHED;
            PG8_LDB(B1, 0, 1); PG8_STAGE(PG8_SB(0, 0), b2, voffB);
            PG8_BAR; PG8_WAIT_L(0); PG8_MMA(0, 1, At, B1); PG8_BAR;
            PG8_LDA(At, 0, 1); PG8_STAGE(PG8_SA(0, 0), a2, voffA);
            PG8_BAR; PG8_WAIT_L(0); PG8_MMA(1, 0, At, B0); PG8_BAR; PG8_SCHED;
            PG8_STAGE(PG8_SB(0, 1), b2 + hstep, voffB);
            PG8_WAIT_V(6); PG8_BAR; PG8_MMA(1, 1, At, B1); PG8_BAR;
            PG8_LDB(B0, 1, 0); PG8_SCHED; PG8_LDA(At, 1, 0); PG8_STAGE(PG8_SA(0, 1), a2 + hstep, voffA);
            PG8_WAIT_L(8); PG8_BAR; PG8_WAIT_L(0); PG8_MMA(0, 0, At, B0); PG8_BAR; PG8_SCHED;
            PG8_LDB(B1, 1, 1); PG8_STAGE(PG8_SB(1, 0), b3, voffB);
            PG8_BAR; PG8_WAIT_L(0); PG8_MMA(0, 1, At, B1); PG8_BAR;
            PG8_LDA(At, 1, 1); PG8_STAGE(PG8_SA(1, 0), a3, voffA);
            PG8_BAR; PG8_WAIT_L(0); PG8_MMA(1, 0, At, B0); PG8_BAR; PG8_SCHED;
            PG8_STAGE(PG8_SB(1, 1), b3 + hstep, voffB);
            PG8_WAIT_V(6); PG8_BAR; PG8_MMA(1, 1, At, B1); PG8_BAR;
            }
        }
        if constexpr (ALIGN_EPI) { if (wr == 0) PG8_BAR; }
        if constexpr (!Epi::AFTER_DRAIN) { E(acc, cur, wr, wc, fr, fq); S.done(cur); }
        if (!has_next) break;
#pragma unroll
        for (int a = 0; a < 2; ++a)
#pragma unroll
            for (int b = 0; b < 2; ++b)
#pragma unroll
                for (int m = 0; m < 4; ++m)
#pragma unroll
                    for (int n = 0; n < 2; ++n) acc[a][b][m][n] = (f32x4){0.f, 0.f, 0.f, 0.f};
        cur = nxt; cA = nA; cB = nB; ++ui;
        if constexpr (ALIGN_EPI) { if (wr == 1) PG8_BAR; }
    }
    PG8_WAIT_V(0);
    if constexpr (!ALIGN_EPI) { if (wr == 0) PG8_BAR; }
    PG8_BAR;
    if constexpr (Epi::AFTER_DRAIN) { E.fused(acc, cur, wr, wc, fr, fq, lds, wid, lane); S.done(cur); }
#undef PG8_SA
#undef PG8_SB
#undef PG8_STAGE
#undef PG8_LDA
#undef PG8_LDB
#undef PG8_MMA
#undef PG8_WAIT_V
#undef PG8_WAIT_L
#undef PG8_BAR
#undef PG8_SCHED
}
}

constexpr int NWAVES = 8;
constexpr int BATCH = 4, SEQ = 8192, D = 1024, M = BATCH * SEQ;
constexpr int PIN = 3592, NP = 3584;
constexpr int FF = 2816, NCH = 128, NBH = 16;
constexpr int PH_END = 12;
constexpr float EPS = 1e-6f;
constexpr size_t MiB = 1u << 20;
constexpr size_t WS_MOD = 1 * MiB;
constexpr size_t WS_GB = 2 * MiB;
constexpr size_t WS_EGL = 3 * MiB;
constexpr size_t WS_WIN = 4 * MiB, WS_WO = 11 * MiB, WS_WGU = 13 * MiB, WS_WD = 24 * MiB;
constexpr size_t WS_H = 32 * MiB;
constexpr size_t WS_CH = 32 * MiB;
constexpr size_t WS_P = 208 * MiB;
constexpr size_t WS_YC = 432 * MiB;
constexpr size_t WS_END = 496 * MiB;
constexpr int REC = 74752;
constexpr int REC_A = 57344;
constexpr int LDS_BYTES = 155648;

#define LAS __attribute__((address_space(3)))
typedef unsigned short bf16;
typedef unsigned v4u __attribute__((ext_vector_type(4)));
typedef unsigned v2u __attribute__((ext_vector_type(2)));
typedef float f32x4 __attribute__((ext_vector_type(4)));
typedef float f32x16 __attribute__((ext_vector_type(16)));
typedef short bf16x8 __attribute__((ext_vector_type(8)));
#define LDS_WAIT() asm volatile("s_waitcnt lgkmcnt(0)" ::: "memory")
using pg8::cvt_pk_bf16; using pg8::silu_f;
__device__ __forceinline__ float bf2f(unsigned short u) { return __uint_as_float((unsigned)u << 16); }
__device__ __forceinline__ float bflo(unsigned w) { return __uint_as_float(w << 16); }
__device__ __forceinline__ float bfhi(unsigned w) { return __uint_as_float(w & 0xffff0000u); }
__device__ __forceinline__ float wave_sum(float v) {
#pragma unroll
    for (int o = 1; o < 64; o <<= 1) v += __shfl_xor(v, o);
    return v;
}
__device__ __forceinline__ void unpack8(v4u w, float (&f)[8]) { f[0] = bflo(w.x); f[1] = bfhi(w.x); f[2] = bflo(w.y); f[3] = bfhi(w.y); f[4] = bflo(w.z); f[5] = bfhi(w.z); f[6] = bflo(w.w); f[7] = bfhi(w.w); }
__device__ __forceinline__ v4u pack8(const float (&f)[8]) { v4u w; w.x = cvt_pk_bf16(f[0], f[1]); w.y = cvt_pk_bf16(f[2], f[3]); w.z = cvt_pk_bf16(f[4], f[5]); w.w = cvt_pk_bf16(f[6], f[7]); return w; }

struct Args { const float* in[19]; float* out; unsigned char* ws; int ph_lo, ph_hi; };
enum { I_X = 0, I_C, I_WADA, I_BADA, I_WADAF, I_BADAF, I_GMIX, I_GFFN, I_GFIN, I_WIN, I_CWM, I_CWQ, I_ALOG, I_DTB, I_GCO, I_GDN, I_WOUT, I_WGU, I_WDN };

template <int MODE>
__device__ __forceinline__ void p0_transpose_item(const float* W, int K, int ld, int nblk, bf16* WT, LAS float* scr, int item, int lane) {
    const int kb = item / nblk, nb = item % nblk, k0 = 64 * kb, n0 = 32 * nb;
    f32x4 ld4[8];
#pragma unroll
    for (int i = 0; i < 8; ++i) ld4[i] = *(const f32x4*)(W + (size_t)(k0 + 8 * i + (lane >> 3)) * ld + n0 + 4 * (lane & 7));
#pragma unroll
    for (int i = 0; i < 8; ++i) { LAS float* d = scr + (8 * i + (lane >> 3)) * 33 + 4 * (lane & 7); d[0] = ld4[i].x; d[1] = ld4[i].y; d[2] = ld4[i].z; d[3] = ld4[i].w; }
    LDS_WAIT(); asm volatile("" ::: "memory");
    int r0 = n0;
    if (MODE == 1) { r0 = n0 < FF ? 256 * (n0 / 128) + (n0 % 128) : 256 * ((n0 - FF) / 128) + 128 + ((n0 - FF) % 128); }
    const int c = lane & 7;
#pragma unroll
    for (int j = 0; j < 4; ++j) { const int n = (lane >> 3) + 8 * j; const LAS float* s = scr + (8 * c) * 33 + n;
        v4u o; o.x = cvt_pk_bf16(s[0 * 33], s[1 * 33]); o.y = cvt_pk_bf16(s[2 * 33], s[3 * 33]); o.z = cvt_pk_bf16(s[4 * 33], s[5 * 33]); o.w = cvt_pk_bf16(s[6 * 33], s[7 * 33]);
        *(v4u*)(WT + (size_t)(r0 + n) * K + k0 + 8 * c) = o; }
    LDS_WAIT(); asm volatile("" ::: "memory");
}
__device__ __forceinline__ void p0_mod_item(const Args& a, float* MOD, const LAS float* SC, LAS float* red, int item, int tid) {
    const int c4 = tid & 7, ks = tid >> 3, col0 = item * 32;
    const bool fin = col0 >= 6144; const float* W = fin ? a.in[I_WADAF] : a.in[I_WADA]; const int ld = fin ? 2048 : 6144, cb = (fin ? col0 - 6144 : col0);
    f32x4 w[16];
#pragma unroll
    for (int kk = 0; kk < 16; ++kk) w[kk] = *(const f32x4*)(W + (size_t)(16 * ks + kk) * ld + cb + 4 * c4);
    f32x4 acc[4];
#pragma unroll
    for (int b = 0; b < 4; ++b) acc[b] = (f32x4){0.f, 0.f, 0.f, 0.f};
#pragma unroll
    for (int kk = 0; kk < 16; ++kk) { const f32x4 s = *(const LAS f32x4*)(SC + (16 * ks + kk) * 4); acc[0] += s.x * w[kk]; acc[1] += s.y * w[kk]; acc[2] += s.z * w[kk]; acc[3] += s.w * w[kk]; }
#pragma unroll
    for (int b = 0; b < 4; ++b) *(LAS f32x4*)(red + (ks * 4 + b) * 32 + 4 * c4) = acc[b];
    __syncthreads();
    if (tid < 128) { const int b = tid >> 5, cl = tid & 31; float s = 0.f;
#pragma unroll 16
        for (int k = 0; k < 64; ++k) s += red[(k * 4 + b) * 32 + cl];
        const int c = cb + cl;
        s += fin ? a.in[I_BADAF][c] : a.in[I_BADA][c];
        if (fin) MOD[4 * 6144 + b * 2048 + c] = s; else MOD[b * 6144 + c] = s; }
    __syncthreads();
}

template <int MODE>
__device__ __forceinline__ void adaln_one(const f32x4 (&xin)[4], const f32x4 (&gs)[4], const f32x4 (&sh)[4], int m, bf16* Hout, float* Fout, const LAS float* TT, const float* a_log, const float* dt_bias, float* GB, int lane) {
    f32x4 v[4]; float ss = 0.f;
#pragma unroll
    for (int j = 0; j < 4; ++j) { v[j] = xin[j]; ss += (v[j].x * v[j].x + v[j].y * v[j].y) + (v[j].z * v[j].z + v[j].w * v[j].w); }
    const float rinv = 1.0f / sqrtf(wave_sum(ss) * (1.0f / D) + EPS);
#pragma unroll
    for (int j = 0; j < 4; ++j) v[j] = (v[j] * rinv) * gs[j] + sh[j];
    if (MODE == 2) { f32x4* o = (f32x4*)(Fout + (size_t)m * D) + lane;
#pragma unroll
        for (int j = 0; j < 4; ++j) o[64 * j] = v[j];
    } else { v2u* o = (v2u*)(Hout + (size_t)m * D) + lane;
#pragma unroll
        for (int j = 0; j < 4; ++j) { v2u w; w.x = cvt_pk_bf16(v[j].x, v[j].y); w.y = cvt_pk_bf16(v[j].z, v[j].w); o[64 * j] = w; } }
    if (MODE == 0) {
        float d[8];
#pragma unroll
        for (int e = 0; e < 8; ++e) { float s = 0.f;
#pragma unroll
            for (int j = 0; j < 4; ++j) { const f32x4 t = *(const LAS f32x4*)(TT + e * 1024 + 4 * (lane + 64 * j)); s += (v[j].x * t.x + v[j].y * t.y) + (v[j].z * t.z + v[j].w * t.w); }
            asm volatile("" : "+v"(s) :: "memory"); d[e] = s; }
        float k4[4], k2[2], k1;
        { const bool hi = (lane & 32) != 0;
#pragma unroll
          for (int i = 0; i < 4; ++i) { const float snd = hi ? d[i] : d[4 + i]; const float kp = hi ? d[4 + i] : d[i]; k4[i] = kp + __shfl_xor(snd, 32); } }
        { const bool hi = (lane & 16) != 0;
#pragma unroll
          for (int i = 0; i < 2; ++i) { const float snd = hi ? k4[i] : k4[2 + i]; const float kp = hi ? k4[2 + i] : k4[i]; k2[i] = kp + __shfl_xor(snd, 16); } }
        { const bool hi = (lane & 8) != 0; const float snd = hi ? k2[0] : k2[1]; const float kp = hi ? k2[1] : k2[0]; k1 = kp + __shfl_xor(snd, 8); }
        k1 += __shfl_xor(k1, 4); k1 += __shfl_xor(k1, 2); k1 += __shfl_xor(k1, 1);
        if ((lane & 7) == 0) { const int e = lane >> 3; float r;
            if (e < 4) { const float xx = k1 + dt_bias[e]; const float sp = fmaxf(xx, 0.f) + log1pf(__expf(-fabsf(xx))); r = -__expf(a_log[e]) * sp; }
            else r = 1.0f / (1.0f + __expf(-k1));
            GB[(size_t)m * 8 + e] = r; }
    }
}
template <int MODE>
__device__ __forceinline__ void adaln_rows(const float* X, const float* gain, const float* shiftp, const float* scalep, int mstride, bf16* Hout, float* Fout,
                                           const LAS float* TT, const float* a_log, const float* dt_bias, float* GB, int gw, int NGW, int lane) {
    for (int blk = gw; blk < M / 16; blk += NGW) {
        const int m0 = blk * 16, b = m0 >> 13;
        f32x4 gs[4], sh[4];
        { const f32x4* g4 = (const f32x4*)gain + lane; const f32x4* sh4 = (const f32x4*)(shiftp + (size_t)b * mstride) + lane; const f32x4* sc4 = (const f32x4*)(scalep + (size_t)b * mstride) + lane;
#pragma unroll
          for (int j = 0; j < 4; ++j) { gs[j] = g4[64 * j] * (1.0f + sc4[64 * j]); sh[j] = sh4[64 * j]; } }
        f32x4 c0[4], c1[4];
        { const f32x4* xr = (const f32x4*)(X + (size_t)m0 * D) + lane;
#pragma unroll
          for (int j = 0; j < 4; ++j) { c0[j] = xr[64 * j]; c1[j] = xr[256 + 64 * j]; } }
#pragma unroll 1
        for (int i = 0; i < 16; i += 2) {
            f32x4 n0[4], n1[4];
            { const int mn = (i + 2 < 16) ? m0 + i + 2 : m0; const f32x4* xr = (const f32x4*)(X + (size_t)mn * D) + lane;
#pragma unroll
              for (int j = 0; j < 4; ++j) { n0[j] = xr[64 * j]; n1[j] = xr[256 + 64 * j]; } }
            adaln_one<MODE>(c0, gs, sh, m0 + i, Hout, Fout, TT, a_log, dt_bias, GB, lane);
            adaln_one<MODE>(c1, gs, sh, m0 + i + 1, Hout, Fout, TT, a_log, dt_bias, GB, lane);
#pragma unroll
            for (int j = 0; j < 4; ++j) { c0[j] = n0[j]; c1[j] = n1[j]; }
        }
    }
}

__device__ __forceinline__ void conv_qkv(const bf16* P, const float* cwq, bf16* QKV, int X, int t0, bool first, int lane) {
    const int colp = 1536 + 512 * X + 8 * lane, colo = 512 * X + 8 * lane;
    v4u raw[19];
#pragma unroll
    for (int t = 0; t < 19; ++t) { raw[t] = (v4u){0u, 0u, 0u, 0u}; if (t >= 3 || !first) raw[t] = *(const v4u*)(P + (size_t)(t0 - 3 + t) * NP + colp); }
    float w0[8], w1[8], w2[8], w3[8], h3[8], h2[8], h1[8];
#pragma unroll
    for (int e = 0; e < 8; ++e) { w0[e] = cwq[0 * 1536 + colo + e]; w1[e] = cwq[1 * 1536 + colo + e]; w2[e] = cwq[2 * 1536 + colo + e]; w3[e] = cwq[3 * 1536 + colo + e]; }
    unpack8(raw[0], h3); unpack8(raw[1], h2); unpack8(raw[2], h1);
#pragma unroll
    for (int t = 0; t < 16; ++t) { const int m = t0 + t; float x[8], y[8]; unpack8(raw[3 + t], x); float ss = 0.f;
#pragma unroll
        for (int e = 0; e < 8; ++e) { const float c = w0[e] * h3[e] + w1[e] * h2[e] + w2[e] * h1[e] + w3[e] * x[e]; y[e] = silu_f(c); ss += y[e] * y[e]; h3[e] = h2[e]; h2[e] = h1[e]; h1[e] = x[e]; }
        if (X < 2) { ss += __shfl_xor(ss, 1); ss += __shfl_xor(ss, 2); ss += __shfl_xor(ss, 4); ss += __shfl_xor(ss, 8);
            float r = 1.0f / sqrtf(ss + EPS); if (X == 0) r *= 0.08838834764831845f;
#pragma unroll
            for (int e = 0; e < 8; ++e) y[e] *= r; }
        *(v4u*)(QKV + (size_t)m * 1536 + colo) = pack8(y); }
}
__device__ __forceinline__ void conv_pass(const bf16* P, const float* cwm, const float* cwq, const float* gco, bf16* YC, bf16* QKV, int gw, int NGW, int lane) {
    for (int run = gw; run < M / 16; run += NGW) {
        const int t0 = run * 16; const bool first = (t0 & (SEQ - 1)) == 0;
        { float w0[8], w1[8], w2[8], gc[8], u2[8], u1[8]; const int c0 = 8 * lane;
#pragma unroll
          for (int e = 0; e < 8; ++e) { w0[e] = cwm[c0 + e]; w1[e] = cwm[512 + c0 + e]; w2[e] = cwm[1024 + c0 + e]; gc[e] = gco[c0 + e]; u2[e] = 0.f; u1[e] = 0.f; }
          if (!first) { float a[8], b[8]; unpack8(*(const v4u*)(P + (size_t)(t0 - 2) * NP + 512 + c0), a); unpack8(*(const v4u*)(P + (size_t)(t0 - 2) * NP + 1024 + c0), b);
#pragma unroll
              for (int e = 0; e < 8; ++e) u2[e] = a[e] * b[e];
              unpack8(*(const v4u*)(P + (size_t)(t0 - 1) * NP + 512 + c0), a); unpack8(*(const v4u*)(P + (size_t)(t0 - 1) * NP + 1024 + c0), b);
#pragma unroll
              for (int e = 0; e < 8; ++e) u1[e] = a[e] * b[e]; }
#pragma unroll 1
          for (int tb = 0; tb < 16; tb += 8) {
              v4u rb[8], rc[8], rh[8];
#pragma unroll
              for (int t = 0; t < 8; ++t) { const bf16* pr = P + (size_t)(t0 + tb + t) * NP + c0; rb[t] = *(const v4u*)pr; rc[t] = *(const v4u*)(pr + 512); rh[t] = *(const v4u*)(pr + 1024); }
#pragma unroll
              for (int t = 0; t < 8; ++t) { const int m = t0 + tb + t; float gb[8], a[8], b[8], y[8]; unpack8(rb[t], gb); unpack8(rc[t], a); unpack8(rh[t], b); float ss = 0.f;
#pragma unroll
                  for (int e = 0; e < 8; ++e) { const float u0 = a[e] * b[e]; y[e] = gb[e] * (w0[e] * u2[e] + w1[e] * u1[e] + w2[e] * u0); ss += y[e] * y[e]; u2[e] = u1[e]; u1[e] = u0; }
                  ss += __shfl_xor(ss, 1); ss += __shfl_xor(ss, 2); ss += __shfl_xor(ss, 4);
                  const float r = 1.0f / sqrtf(ss * (1.0f / 64.0f) + EPS);
#pragma unroll
                  for (int e = 0; e < 8; ++e) y[e] = y[e] * r * gc[e];
                  *(v4u*)(YC + (size_t)m * D + c0) = pack8(y); } } }
    }
}


constexpr int PREP_HALF = 69632, PK_KN = 0, PK_QN = 17408, PK_VV = 34816, PK_LM = 52224, PK_GC = 68608, PK_BT = 68864, PK_EG = 69120, PROW = 272;
template <bool SC>
__device__ __forceinline__ v4u afrag_piece_rows(const LAS unsigned char* tile, const LAS float* sc, int p) {
    const int f = p >> 6, ln = p & 63, mt = f >> 3, kt = (f >> 1) & 3, s = f & 1, r = ln & 31, hh = ln >> 5, row = 32 * mt + r, kb = 32 * kt + 16 * s + 4 * hh;
    const v2u a = *(const LAS v2u*)(tile + row * PROW + kb * 2), b = *(const LAS v2u*)(tile + row * PROW + (kb + 8) * 2);
    float scv = 1.0f; if (SC) scv = sc[row];
    v4u o; o.x = cvt_pk_bf16(bflo(a.x) * scv, bfhi(a.x) * scv); o.y = cvt_pk_bf16(bflo(a.y) * scv, bfhi(a.y) * scv); o.z = cvt_pk_bf16(bflo(b.x) * scv, bfhi(b.x) * scv); o.w = cvt_pk_bf16(bflo(b.y) * scv, bfhi(b.y) * scv);
    return o;
}
#define LBAR() do { asm volatile("s_waitcnt lgkmcnt(0)" ::: "memory"); __builtin_amdgcn_s_barrier(); asm volatile("" ::: "memory"); } while (0)
__device__ __forceinline__ void st_wt16(void* p, v4u v) { asm volatile("global_store_dwordx4 %0, %1, off sc1\n\ts_nop 1" :: "v"(p), "v"(v) : "memory"); }
__device__ __forceinline__ void st_wt4(void* p, float v) { asm volatile("global_store_dword %0, %1, off sc1\n\ts_nop 1" :: "v"(p), "v"(v) : "memory"); }
__device__ __forceinline__ void prep_phase(LAS unsigned char* lds, const bf16* P, const float* cwq, const float* GB, float* EGL, unsigned char* CH, unsigned* FLG, int ublk, int nblk, int tid) {
    const int half = tid >> 8, t = tid & 255, lane = tid & 63, w = (tid >> 6) & 3, r = lane & 31, hh = lane >> 5;
    LAS unsigned char* L = lds + half * PREP_HALF;
    LAS float* LM = (LAS float*)(L + PK_LM); LAS float* GC = (LAS float*)(L + PK_GC); LAS float* BT = (LAS float*)(L + PK_BT); LAS float* EG = (LAS float*)(L + PK_EG);
    for (int pu = ublk; pu < NBH * NCH / 2; pu += nblk) {
        const int n = pu >> 3, bh = 2 * (pu & 7) + half, cid = bh * NCH + n, b = bh >> 2, h = bh & 3, m0 = b * SEQ + n * 64;
        unsigned char* rec = CH + (size_t)cid * REC;
        LBAR();
        { const int c8 = t & 15, tg = t >> 4;
#pragma unroll
          for (int X = 0; X < 3; ++X) {
              const int colp = 1536 + 512 * X + 128 * h + 8 * c8, colw = 512 * X + 128 * h + 8 * c8;
              v4u raw[7];
#pragma unroll
              for (int i = 0; i < 7; ++i) { const int tok = 4 * tg - 3 + i; raw[i] = (v4u){0u, 0u, 0u, 0u}; if (tok >= 0 || n > 0) raw[i] = *(const v4u*)(P + (size_t)(m0 + tok) * NP + colp); }
              float w0[8], w1[8], w2[8], w3[8], h3[8], h2[8], h1[8];
#pragma unroll
              for (int e = 0; e < 8; ++e) { w0[e] = cwq[0 * 1536 + colw + e]; w1[e] = cwq[1 * 1536 + colw + e]; w2[e] = cwq[2 * 1536 + colw + e]; w3[e] = cwq[3 * 1536 + colw + e]; }
              unpack8(raw[0], h3); unpack8(raw[1], h2); unpack8(raw[2], h1);
#pragma unroll
              for (int i = 0; i < 4; ++i) { float x[8], y[8]; unpack8(raw[3 + i], x); float ss = 0.f;
#pragma unroll
                  for (int e = 0; e < 8; ++e) { const float c = w0[e] * h3[e] + w1[e] * h2[e] + w2[e] * h1[e] + w3[e] * x[e]; y[e] = silu_f(c); ss += y[e] * y[e]; h3[e] = h2[e]; h2[e] = h1[e]; h1[e] = x[e]; }
                  if (X < 2) { ss += __shfl_xor(ss, 1); ss += __shfl_xor(ss, 2); ss += __shfl_xor(ss, 4); ss += __shfl_xor(ss, 8);
                      float rr = 1.0f / sqrtf(ss + EPS); if (X == 0) rr *= 0.08838834764831845f;
#pragma unroll
                      for (int e = 0; e < 8; ++e) y[e] *= rr; }
                  *(LAS v4u*)(L + (X == 0 ? PK_QN : (X == 1 ? PK_KN : PK_VV)) + (4 * tg + i) * PROW + c8 * 16) = pack8(y); } } }
        if (w == 0) { float g = GB[(size_t)(m0 + lane) * 8 + h];
#pragma unroll
            for (int d = 1; d < 64; d <<= 1) { const float o = __shfl_up(g, d); if (lane >= d) g += o; }
            GC[lane] = g; EG[lane] = __expf(g); BT[lane] = GB[(size_t)(m0 + lane) * 8 + 4 + h];
            if (lane == 63) st_wt4(rec + 73728, __expf(g)); }
        LBAR();
        { const int mi = w >> 1, nj = w & 1;
          f32x16 kk, qk;
#pragma unroll
          for (int i = 0; i < 16; ++i) { kk[i] = 0.f; qk[i] = 0.f; }
#pragma unroll
          for (int st = 0; st < 8; ++st) {
              const bf16x8 ka = *(const LAS bf16x8*)(L + PK_KN + (32 * mi + r) * PROW + (16 * st + 8 * hh) * 2);
              const bf16x8 kb = *(const LAS bf16x8*)(L + PK_KN + (32 * nj + r) * PROW + (16 * st + 8 * hh) * 2);
              const bf16x8 qb = *(const LAS bf16x8*)(L + PK_QN + (32 * mi + r) * PROW + (16 * st + 8 * hh) * 2);
              kk = __builtin_amdgcn_mfma_f32_32x32x16_bf16(ka, kb, kk, 0, 0, 0);
              qk = __builtin_amdgcn_mfma_f32_32x32x16_bf16(kb, qb, qk, 0, 0, 0);
          }
          const float gj = GC[32 * nj + r], gq = GC[32 * mi + r];
          float av[16];
#pragma unroll
          for (int reg = 0; reg < 16; ++reg) { const int cr = (reg & 3) + 8 * (reg >> 2) + 4 * hh;
              const int i = 32 * mi + cr, j = 32 * nj + r;
              LM[i * 64 + j] = (i > j) ? BT[i] * kk[reg] * __expf(GC[i] - gj) : 0.f;
              const int key = 32 * nj + cr, qr = 32 * mi + r;
              av[reg] = (qr >= key) ? qk[reg] * __expf(gq - GC[key]) : 0.f; }
#pragma unroll
          for (int s = 0; s < 2; ++s) { v4u o; o.x = cvt_pk_bf16(av[8 * s], av[8 * s + 1]); o.y = cvt_pk_bf16(av[8 * s + 2], av[8 * s + 3]); o.z = cvt_pk_bf16(av[8 * s + 4], av[8 * s + 5]); o.w = cvt_pk_bf16(av[8 * s + 6], av[8 * s + 7]);
              st_wt16(rec + 49152 + ((mi * 2 + nj) * 2 + s) * 1024 + lane * 16, o); }
        }
#pragma unroll
        for (int i = 0; i < 4; ++i) { const int p = t + 256 * i; st_wt16(rec + 16384 + p * 16, afrag_piece_rows<true>(L + PK_QN, EG, p)); }
        { const float gl = GC[63];
#pragma unroll
          for (int i = 0; i < 4; ++i) { const int p = t + 256 * i, f = p >> 6, ln = p & 63, mt = f >> 2, ct = (f >> 1) & 1, s = f & 1, dk = 32 * mt + (ln & 31), cb = 32 * ct + 16 * s + 4 * (ln >> 5);
              float e[8];
#pragma unroll
              for (int j = 0; j < 8; ++j) { const int c = cb + 8 * (j >> 2) + (j & 3); e[j] = bf2f(*(const LAS unsigned short*)(L + PK_KN + c * PROW + dk * 2)) * __expf(gl - GC[c]); }
              st_wt16(rec + 32768 + p * 16, pack8(e)); } }
        LBAR();
        { float X[64]; const bool isu = t < 128; const int col = t & 127;
          const LAS unsigned char* src = L + (isu ? PK_VV : PK_KN) + col * 2;
#pragma unroll
          for (int i = 0; i < 64; ++i) {
              const float egi = EG[i]; const float rhs = bf2f(*(const LAS unsigned short*)(src + i * PROW)) * BT[i] * (isu ? 1.0f : egi);
              float a0 = 0.f, a1 = 0.f, a2 = 0.f, a3 = 0.f;
#pragma unroll
              for (int j4 = 0; j4 < (i + 3) / 4; ++j4) { const f32x4 l = *(const LAS f32x4*)(LM + i * 64 + 4 * j4);
                  if (4 * j4 + 0 < i) a0 += l.x * X[4 * j4 + 0]; if (4 * j4 + 1 < i) a1 += l.y * X[4 * j4 + 1]; if (4 * j4 + 2 < i) a2 += l.z * X[4 * j4 + 2]; if (4 * j4 + 3 < i) a3 += l.w * X[4 * j4 + 3]; }
              X[i] = rhs - ((a0 + a1) + (a2 + a3)); asm volatile("" : "+v"(X[i]) :: "memory"); }
          LBAR();
          if (isu) { const int vs = col >> 5, dvl = col & 31;
#pragma unroll
              for (int mt = 0; mt < 2; ++mt)
#pragma unroll
                  for (int h2 = 0; h2 < 2; ++h2) { v4u* dst = (v4u*)(rec + REC_A + (size_t)(((vs * 2 + mt) * 64 + dvl + 32 * h2) * 32));
#pragma unroll
                      for (int a2 = 0; a2 < 2; ++a2) { const int i0 = 32 * mt + 4 * h2 + 16 * a2; v4u w;
                          w.x = cvt_pk_bf16(X[i0], X[i0 + 1]); w.y = cvt_pk_bf16(X[i0 + 2], X[i0 + 3]); w.z = cvt_pk_bf16(X[i0 + 8], X[i0 + 9]); w.w = cvt_pk_bf16(X[i0 + 10], X[i0 + 11]); st_wt16(dst + a2, w); } }
          } else {
#pragma unroll
              for (int i = 0; i < 64; ++i) *(LAS unsigned short*)(L + PK_VV + i * PROW + col * 2) = (unsigned short)(cvt_pk_bf16(-X[i], 0.f) & 0xffffu);
          }
        }
        LBAR();
#pragma unroll
        for (int i = 0; i < 4; ++i) { const int p = t + 256 * i; st_wt16(rec + p * 16, afrag_piece_rows<false>(L + PK_VV, EG, p)); }
        asm volatile("s_waitcnt vmcnt(0)" ::: "memory"); __syncthreads();
        if (tid == 0) {
            __hip_atomic_store(FLG + (2 * (pu & 7)) * NCH + n, 1u, __ATOMIC_RELAXED, __HIP_MEMORY_SCOPE_AGENT); __hip_atomic_store(FLG + (2 * (pu & 7) + 1) * NCH + n, 1u, __ATOMIC_RELAXED, __HIP_MEMORY_SCOPE_AGENT); }
    }
}

__device__ __forceinline__ bf16x8 pack_acc(const f32x16& x, int s) {
    v4u p; p.x = cvt_pk_bf16(x[8 * s], x[8 * s + 1]); p.y = cvt_pk_bf16(x[8 * s + 2], x[8 * s + 3]); p.z = cvt_pk_bf16(x[8 * s + 4], x[8 * s + 5]); p.w = cvt_pk_bf16(x[8 * s + 6], x[8 * s + 7]);
    return __builtin_bit_cast(bf16x8, p);
}
#define MFMA32(a, b, c) __builtin_amdgcn_mfma_f32_32x32x16_bf16((a), (b), (c), 0, 0, 0)
#define PIN_SCHED() __builtin_amdgcn_sched_barrier(0)
__device__ __forceinline__ int chain_ready(const unsigned* fl, int have, int lane) {
    for (;;) {
        const int idx = have + 1 + lane;
        const unsigned f = (idx < NCH) ? __hip_atomic_load(fl + idx, __ATOMIC_RELAXED, __HIP_MEMORY_SCOPE_AGENT) : 0u;
        const unsigned long long m = __ballot(f != 0u);
        const int pre = (m == ~0ull) ? 64 : __builtin_ctzll(~m);
        if (pre > 0) { __builtin_amdgcn_fence(__ATOMIC_ACQUIRE, "agent"); asm volatile("s_waitcnt vmcnt(0)" ::: "memory"); return have + pre; }
        __builtin_amdgcn_s_sleep(16);
    }
}
__device__ __forceinline__ void chain_phase(LAS unsigned char* lds, const unsigned char* CH, const unsigned* FLG, bf16* Oraw, int bh, int tid) {
    const int wid = __builtin_amdgcn_readfirstlane(tid >> 6), lane = tid & 63, b = bh >> 2, h = bh & 3, vs = wid & 3;
    const unsigned char* rec0 = CH + (size_t)bh * NCH * REC;
    const bool comp = wid < 4, stager = (wid >= 4);
    const int hw = wid - 4;
#define CH_MOVE(n, dstbase) do { _Pragma("unroll") for (int _i = 0; _i < 19; ++_i) { const int _pc = hw * 19 + _i; if (_pc < 73) \
        __builtin_amdgcn_global_load_lds((const unsigned*)(rec0 + (size_t)(n) * REC + _pc * 1024 + lane * 16), (LAS unsigned*)((dstbase) + _pc * 1024), 16, 0, 0); } } while (0)
#define CH_WARM(n) do { _Pragma("unroll") for (int _i = 0; _i < 10; ++_i) { const int _o = (_i * 64 + lane) * 128; \
        __builtin_amdgcn_global_load_lds((const unsigned*)(rec0 + (size_t)(n) * REC + (_o < REC ? _o : 0)), (LAS unsigned*)(dummy), 4, 0, 0); } } while (0)
    constexpr int WARM_AHEAD = 8;
    LAS unsigned char* dummy = lds + 2 * REC;
    f32x16 S[4], o0, o1;
#pragma unroll
    for (int k = 0; k < 4; ++k)
#pragma unroll
        for (int i = 0; i < 16; ++i) S[k][i] = 0.f;
#pragma unroll
    for (int i = 0; i < 16; ++i) { o0[i] = 0.f; o1[i] = 0.f; }
    const unsigned* fl = FLG + bh * NCH; int have = -1;
    if (stager) { while (have < 0) have = chain_ready(fl, have, lane); CH_MOVE(0, lds); }
    if (!comp) asm volatile("s_waitcnt vmcnt(0)" ::: "memory");
    __builtin_amdgcn_s_barrier(); asm volatile("" ::: "memory");
    for (int n = 0; n < NCH; ++n) {
        const int buf = n & 1;
        if (!comp) {
            if (stager) { if (n + 1 < NCH) { while (have < n + 1) have = chain_ready(fl, have, lane); CH_MOVE(n + 1, lds + (buf ^ 1) * REC); } asm volatile("s_waitcnt vmcnt(0)" ::: "memory"); }
            else { const int wn = n + 1 + WARM_AHEAD; if (wn < NCH) { if (have < wn) { const int idx = have + 1 + lane; const unsigned f = (idx < NCH) ? __hip_atomic_load(fl + idx, __ATOMIC_RELAXED, __HIP_MEMORY_SCOPE_AGENT) : 0u;
                        const unsigned long long m = __ballot(f != 0u); const int pre = (m == ~0ull) ? 64 : __builtin_ctzll(~m); if (pre > 0) { __builtin_amdgcn_fence(__ATOMIC_ACQUIRE, "agent"); have += pre; } }
                    if (have >= wn) CH_WARM(wn); }
                   asm volatile("s_waitcnt vmcnt(20)" ::: "memory"); }
        } else {
            const LAS unsigned char* B = lds + buf * REC + lane * 16;
            const float egl = *(const LAS float*)(lds + buf * REC + 73728);
            f32x16 v0, v1;
            { const LAS v4u* ul = (const LAS v4u*)(lds + buf * REC + 57344 + ((vs * 2) * 64 + lane) * 32);
              const v4u a0 = ul[0], a1 = ul[1], b0 = ul[128], b1 = ul[129];
              v0[0] = bflo(a0.x); v0[1] = bfhi(a0.x); v0[2] = bflo(a0.y); v0[3] = bfhi(a0.y); v0[4] = bflo(a0.z); v0[5] = bfhi(a0.z); v0[6] = bflo(a0.w); v0[7] = bfhi(a0.w);
              v0[8] = bflo(a1.x); v0[9] = bfhi(a1.x); v0[10] = bflo(a1.y); v0[11] = bfhi(a1.y); v0[12] = bflo(a1.z); v0[13] = bfhi(a1.z); v0[14] = bflo(a1.w); v0[15] = bfhi(a1.w);
              v1[0] = bflo(b0.x); v1[1] = bfhi(b0.x); v1[2] = bflo(b0.y); v1[3] = bfhi(b0.y); v1[4] = bflo(b0.z); v1[5] = bfhi(b0.z); v1[6] = bflo(b0.w); v1[7] = bfhi(b0.w);
              v1[8] = bflo(b1.x); v1[9] = bfhi(b1.x); v1[10] = bflo(b1.y); v1[11] = bfhi(b1.y); v1[12] = bflo(b1.z); v1[13] = bfhi(b1.z); v1[14] = bflo(b1.w); v1[15] = bfhi(b1.w); }
#pragma unroll
            for (int i = 0; i < 16; ++i) { o0[i] = 0.f; o1[i] = 0.f; }
#define LDF(dst, off) dst = *(const LAS bf16x8*)(B + (off))
#define LD_WQ(F, kt, s) do { LDF(F[0], ((0 * 4 + (kt)) * 2 + (s)) * 1024); LDF(F[1], ((1 * 4 + (kt)) * 2 + (s)) * 1024); LDF(F[2], 16384 + ((0 * 4 + (kt)) * 2 + (s)) * 1024); LDF(F[3], 16384 + ((1 * 4 + (kt)) * 2 + (s)) * 1024); } while (0)
#define MM_WQ(F, kt, s) do { const bf16x8 sb = pack_acc(S[kt], s); v0 = MFMA32(F[0], sb, v0); v1 = MFMA32(F[1], sb, v1); o0 = MFMA32(F[2], sb, o0); o1 = MFMA32(F[3], sb, o1); asm volatile("" : "+v"(o0), "+v"(o1)); } while (0)
#define LD_AT(F, ct) do { LDF(F[0], 49152 + ((0 * 2 + (ct)) * 2 + 0) * 1024); LDF(F[1], 49152 + ((1 * 2 + (ct)) * 2 + 0) * 1024); LDF(F[2], 49152 + ((0 * 2 + (ct)) * 2 + 1) * 1024); LDF(F[3], 49152 + ((1 * 2 + (ct)) * 2 + 1) * 1024); } while (0)
#define MM_AT(F, ct) do { o0 = MFMA32(F[0], vb[ct][0], o0); o1 = MFMA32(F[1], vb[ct][0], o1); o0 = MFMA32(F[2], vb[ct][1], o0); o1 = MFMA32(F[3], vb[ct][1], o1); } while (0)
#define LD_KD(F, ct, s) do { _Pragma("unroll") for (int q = 0; q < 4; ++q) LDF(F[q], 32768 + ((q * 2 + (ct)) * 2 + (s)) * 1024); } while (0)
#define MM_KD(F, ct, s) do { _Pragma("unroll") for (int q = 0; q < 4; ++q) S[q] = MFMA32(F[q], vb[ct][s], S[q]); } while (0)
            bf16x8 FA[4], FB[4];
            LD_WQ(FA, 0, 0); PIN_SCHED();
            LD_WQ(FB, 0, 1); PIN_SCHED(); MM_WQ(FA, 0, 0); PIN_SCHED();
            LD_WQ(FA, 1, 0); PIN_SCHED(); MM_WQ(FB, 0, 1); PIN_SCHED();
            LD_WQ(FB, 1, 1); PIN_SCHED(); MM_WQ(FA, 1, 0); PIN_SCHED();
            LD_WQ(FA, 2, 0); PIN_SCHED(); MM_WQ(FB, 1, 1); PIN_SCHED();
            LD_WQ(FB, 2, 1); PIN_SCHED(); MM_WQ(FA, 2, 0); PIN_SCHED();
            LD_WQ(FA, 3, 0); PIN_SCHED(); MM_WQ(FB, 2, 1); PIN_SCHED();
            LD_WQ(FB, 3, 1); PIN_SCHED(); MM_WQ(FA, 3, 0); PIN_SCHED();
            LD_AT(FA, 0); PIN_SCHED(); MM_WQ(FB, 3, 1); PIN_SCHED();
            bf16x8 vb[2][2];
            vb[0][0] = pack_acc(v0, 0); vb[0][1] = pack_acc(v0, 1); vb[1][0] = pack_acc(v1, 0); vb[1][1] = pack_acc(v1, 1);
            LD_AT(FB, 1); PIN_SCHED(); MM_AT(FA, 0); PIN_SCHED();
#pragma unroll
            for (int kt = 0; kt < 4; ++kt)
#pragma unroll
                for (int i = 0; i < 16; ++i) S[kt][i] *= egl;
            LD_KD(FA, 0, 0); PIN_SCHED(); MM_AT(FB, 1); PIN_SCHED();
            { bf16* op = Oraw + (size_t)(b * SEQ + n * 64 + 4 * (lane >> 5)) * 512 + h * 128 + vs * 32 + (lane & 31); asm volatile("" : "+v"(op));
#pragma unroll
              for (int reg = 0; reg < 16; ++reg) { const int cr = (reg & 3) + 8 * (reg >> 2); const unsigned pk = cvt_pk_bf16(o0[reg], o1[reg]); op[cr * 512] = (bf16)(pk & 0xffffu); op[(32 + cr) * 512] = (bf16)(pk >> 16); } }
            PIN_SCHED();
            LD_KD(FB, 0, 1); PIN_SCHED(); MM_KD(FA, 0, 0); PIN_SCHED();
            LD_KD(FA, 1, 0); PIN_SCHED(); MM_KD(FB, 0, 1); PIN_SCHED();
            LD_KD(FB, 1, 1); PIN_SCHED(); MM_KD(FA, 1, 0); PIN_SCHED();
            MM_KD(FB, 1, 1);
#undef MM_AT
#undef MM_KD
#undef LDF
#undef LD_WQ
#undef MM_WQ
#undef LD_AT
#undef LD_KD
            asm volatile("s_waitcnt lgkmcnt(0)" ::: "memory");
        }
        __builtin_amdgcn_s_barrier(); asm volatile("" ::: "memory");
    }
    asm volatile("s_waitcnt vmcnt(0)" ::: "memory");
#undef CH_MOVE
#undef CH_WARM
}
#if DN_NAIVE
__device__ __forceinline__ void naive_dn(const bf16* QKV, const float* GB, float* Oraw, int unit, int lane) {
    const int bh = unit >> 1, dv = (unit & 1) * 64 + lane, b = bh >> 2, h = bh & 3;
    float S[128];
#pragma unroll
    for (int i = 0; i < 128; ++i) S[i] = 0.f;
    for (int t = 0; t < SEQ; ++t) { const size_t m = (size_t)b * SEQ + t;
        const float al = __expf(GB[m * 8 + h]), be = GB[m * 8 + 4 + h];
        const bf16* qp = QKV + m * 1536 + h * 128; const bf16* kp = qp + 512; const float v = bf2f(qp[1024 + dv]);
        float r = 0.f;
#pragma unroll
        for (int i = 0; i < 128; ++i) { S[i] *= al; r += bf2f(kp[i]) * S[i]; if ((i & 15) == 15) asm volatile("" : "+v"(r) :: "memory"); }
        const float d = be * (v - r); float o = 0.f;
#pragma unroll
        for (int i = 0; i < 128; ++i) { S[i] += bf2f(kp[i]) * d; o += bf2f(qp[i]) * S[i]; if ((i & 15) == 15) asm volatile("" : "+v"(o) :: "memory"); }
        Oraw[m * 512 + h * 128 + dv] = o; }
}
#endif
template <bool OB16>
__device__ __forceinline__ void opost_rows(const void* Oraw_, const bf16* P, const float* gdn, bf16* YC, int gw, int NGW, int lane) {
    const float* Oraw = (const float*)Oraw_; const bf16* Ob = (const bf16*)Oraw_;
    float gd[8];
#pragma unroll
    for (int e = 0; e < 8; ++e) gd[e] = gdn[(8 * lane + e) & 127];
    for (int blk = gw; blk < M / 16; blk += NGW) { const int m0 = blk * 16;
#pragma unroll 1
        for (int i = 0; i < 16; i += 8) {
            f32x4 oa[8], ob[8]; v4u zz[8];
#pragma unroll
            for (int t = 0; t < 8; ++t) { const int m = m0 + i + t;
                if (OB16) { float f[8]; unpack8(*(const v4u*)(Ob + (size_t)m * 512 + 8 * lane), f); oa[t] = (f32x4){f[0], f[1], f[2], f[3]}; ob[t] = (f32x4){f[4], f[5], f[6], f[7]}; }
                else { const f32x4* op = (const f32x4*)(Oraw + (size_t)m * 512 + 8 * lane); oa[t] = op[0]; ob[t] = op[1]; }
                zz[t] = *(const v4u*)(P + (size_t)m * NP + 3072 + 8 * lane); }
#pragma unroll
            for (int t = 0; t < 8; ++t) { const int m = m0 + i + t; float z[8]; unpack8(zz[t], z);
                float o[8] = {oa[t].x, oa[t].y, oa[t].z, oa[t].w, ob[t].x, ob[t].y, ob[t].z, ob[t].w}; float ss = 0.f;
#pragma unroll
                for (int e = 0; e < 8; ++e) ss += o[e] * o[e];
                ss += __shfl_xor(ss, 1); ss += __shfl_xor(ss, 2); ss += __shfl_xor(ss, 4); ss += __shfl_xor(ss, 8);
                const float r = 1.0f / sqrtf(ss * (1.0f / 128.0f) + EPS);
#pragma unroll
                for (int e = 0; e < 8; ++e) o[e] = o[e] * r * gd[e] * silu_f(z[e]);
                *(v4u*)(YC + (size_t)m * D + 512 + 8 * lane) = pack8(o); } } }
}

typedef __attribute__((address_space(1))) unsigned gu32;
#define XB_TMO      128
#define XB_XCNT(j)  (256  + 64 * (j))
#define XB_XSUB(j)  (1280 + 64 * (j))
#define XB_XGEN(j)  (2304 + 64 * (j))
#define XB_TOP      3328
#define XB_TOPGEN   3392
#define XCD_BAR_WORDS 3456
#define XB_SPIN_CAP (1u << 18)

__device__ __forceinline__ unsigned xb_ld(unsigned* p)              { return __hip_atomic_load(p, __ATOMIC_RELAXED, __HIP_MEMORY_SCOPE_AGENT); }
__device__ __forceinline__ unsigned xb_add(unsigned* p, unsigned v) { return __hip_atomic_fetch_add(p, v, __ATOMIC_RELAXED, __HIP_MEMORY_SCOPE_AGENT); }
__device__ __forceinline__ unsigned xb_xcc_id() { return (unsigned)__builtin_amdgcn_s_getreg((3 << 11) | 20) & 0xFu; }
#define XB_SPIN(cond, bar) do { unsigned _sp = 0; while (cond) { __builtin_amdgcn_s_sleep(1); \
    if ((++_sp & 255u) == 0u) { if (xb_ld(&(bar)[XB_TMO])) break; if (_sp > XB_SPIN_CAP) { atomicAdd(&(bar)[XB_TMO], 1u); break; } } } } while (0)

struct XcdBarrier {
    unsigned* bar; unsigned x;
    volatile LAS unsigned* st;
};

__device__ __forceinline__ XcdBarrier xcd_barrier_post(unsigned* bar, volatile LAS unsigned* st) {
    XcdBarrier b; b.bar = bar; b.x = xb_xcc_id(); b.st = st;
    if (threadIdx.x == 0) (void)xb_add(&bar[XB_XCNT(b.x)], 1u);
    return b;
}
__device__ __forceinline__ void xcd_barrier_complete(unsigned* bar, unsigned x, unsigned& nloc, unsigned& nx) {
    const unsigned G = gridDim.x * gridDim.y * gridDim.z;
    unsigned sum, cnt, mine, sp = 0u;
    for (;;) {
        sum = 0u; cnt = 0u; mine = 0u;
#pragma unroll
        for (unsigned j = 0; j < 16; ++j) { const unsigned c = xb_ld(&bar[XB_XCNT(j)]); sum += c; cnt += (c > 0u) ? 1u : 0u; mine = (j == x) ? c : mine; }
        if (sum == G) break;
        __builtin_amdgcn_s_sleep(1);
        if ((++sp & 255u) == 0u) { if (xb_ld(&bar[XB_TMO])) break; if (sp > XB_SPIN_CAP) { atomicAdd(&bar[XB_TMO], 1u); break; } }
    }
    nloc = mine > 0u ? mine : 1u; nx = cnt > 0u ? cnt : 1u;
}

__device__ __forceinline__ void xcd_barrier(const XcdBarrier& b) {
    asm volatile("s_waitcnt vmcnt(0)" ::: "memory");
    __syncthreads();
    if (threadIdx.x == 0) {
        unsigned* bar = b.bar;
        __builtin_amdgcn_s_waitcnt(0);
        unsigned nloc = b.st[0], nx = b.st[1];
        if (nloc == 0u) { xcd_barrier_complete(bar, b.x, nloc, nx); b.st[0] = nloc; b.st[1] = nx; }
        const unsigned old = xb_add(&bar[XB_XSUB(b.x)], 1u);
        const unsigned gen = old / nloc;
        if (old + 1u == (gen + 1u) * nloc) {
            __builtin_amdgcn_fence(__ATOMIC_RELEASE, "agent");
            asm volatile("s_waitcnt vmcnt(0)" ::: "memory");
            const unsigned og = xb_add(&bar[XB_TOP], 1u);
            const unsigned tg = og / nx;
            if (og + 1u == (tg + 1u) * nx) xb_add(&bar[XB_TOPGEN], 1u);
            else XB_SPIN(xb_ld(&bar[XB_TOPGEN]) == tg, bar);
            __builtin_amdgcn_fence(__ATOMIC_ACQUIRE, "agent");
            xb_add(&bar[XB_XGEN(b.x)], 1u);
            asm volatile("s_waitcnt vmcnt(0)" ::: "memory");
        } else {
            XB_SPIN(xb_ld(&bar[XB_XGEN(b.x)]) == gen, bar);
            __builtin_amdgcn_fence(__ATOMIC_ACQUIRE, "agent");
            asm volatile("s_waitcnt vmcnt(0)" ::: "memory");
        }
    }
    __syncthreads();
}

__global__ void __launch_bounds__(NWAVES * 64, 2) fwd(Args args) {
    extern __shared__ __attribute__((aligned(16))) unsigned char lds_raw[];
    LAS unsigned char* lds = (LAS unsigned char*)lds_raw;
    int tid = threadIdx.x, lane = tid & 63, wave = __builtin_amdgcn_readfirstlane(tid >> 6);
    const int G = gridDim.x; const int bx = blockIdx.x; const int vcu = (G % 8 == 0) ? (bx % 8) * (G / 8) + bx / 8 : bx;
    int gw = vcu * NWAVES + wave; const int NGW = G * NWAVES;
#define LAUNDER() do { int tv_ = threadIdx.x; asm volatile("" : "+v"(tv_)); tid = tv_; lane = tid & 63; wave = __builtin_amdgcn_readfirstlane(tid >> 6); gw = vcu * NWAVES + wave; } while (0)
    unsigned char* ws = args.ws;
    float* MOD = (float*)(ws + WS_MOD); float* GB = (float*)(ws + WS_GB); float* EGL = (float*)(ws + WS_EGL);
    bf16* WinT = (bf16*)(ws + WS_WIN); bf16* WoT = (bf16*)(ws + WS_WO); bf16* WguT = (bf16*)(ws + WS_WGU); bf16* WdT = (bf16*)(ws + WS_WD);
    bf16* H = (bf16*)(ws + WS_H); unsigned char* CH = ws + WS_CH; bf16* P = (bf16*)(ws + WS_P); bf16* ACT = (bf16*)(ws + WS_P); bf16* YC = (bf16*)(ws + WS_YC);
    bf16* QKV = (bf16*)args.out; bf16* Oraw = (bf16*)((unsigned char*)args.out + 96 * MiB); float* OUT = args.out;
    const int lo = args.ph_lo, hi = args.ph_hi;
    volatile LAS unsigned* MISC = (volatile LAS unsigned*)(lds + LDS_BYTES - 64);
    if (tid < 16) MISC[tid] = 0u;
    __syncthreads();
    XcdBarrier bar = xcd_barrier_post((unsigned*)ws, MISC);
    if (lo < 0) cg::this_grid().sync();
#ifndef PH_MASK
#define PH_MASK 0xFFF
#endif
#define IN(k) (((PH_MASK >> (k)) & 1) && lo <= (k) && (k) < hi)
#if MK_N_LAUNCHES == 1
#define SEAM(k) do { if (IN(k) && IN((k) + 1) && (k) != 5) xcd_barrier(bar); } while (0)
#else
#define SEAM(k) do { } while (0)
#endif
#ifndef REP_MASK
#define REP_MASK 0
#endif
#define BEGIN_REP(k) for (int rep_ = 0; rep_ <= ((REP_MASK >> (k)) & 1); ++rep_) { if (rep_) xcd_barrier(bar); LAUNDER();
#define END_REP }
    BEGIN_REP(0)
    if (IN(0)) {
        LAS float* scr = (LAS float*)(lds + wave * 16384);
        constexpr int I_IN = 16 * 112, I_O = 16 * 32, I_GU = 16 * 176, I_DN = 44 * 32, NITEMS = I_IN + I_O + I_GU + I_DN;
        for (int it = gw; it < NITEMS; it += NGW) { int r = it;
            if (r < I_IN) { p0_transpose_item<0>(args.in[I_WIN], D, PIN, 112, WinT, scr, r, lane); continue; } r -= I_IN;
            if (r < I_O) { p0_transpose_item<0>(args.in[I_WOUT], D, D, 32, WoT, scr, r, lane); continue; } r -= I_O;
            if (r < I_GU) { p0_transpose_item<1>(args.in[I_WGU], D, 2 * FF, 176, WguT, scr, r, lane); continue; } r -= I_GU;
            p0_transpose_item<0>(args.in[I_WDN], FF, D, 32, WdT, scr, r, lane); }
        __syncthreads();
        { LAS float* SC = (LAS float*)lds; const float* cin = args.in[I_C];
          for (int idx = tid; idx < 4096; idx += NWAVES * 64) { const int b = idx >> 10, k = idx & 1023; const float cv = cin[idx]; SC[k * 4 + b] = cv / (1.0f + __expf(-cv)); }
          __syncthreads();
          for (int it = bx; it < 256; it += G) p0_mod_item(args, MOD, SC, (LAS float*)(lds + 16384), it, tid); }
    }
    END_REP
    SEAM(0);
    BEGIN_REP(1)
    if (IN(1)) { LAS float* TT = (LAS float*)lds; const float* wi = args.in[I_WIN];
        for (int idx = tid; idx < 8192; idx += NWAVES * 64) { const int k = idx >> 3, e = idx & 7; TT[e * 1024 + k] = wi[(size_t)k * PIN + NP + e]; }
        __syncthreads();
        adaln_rows<0>(args.in[I_X], args.in[I_GMIX], MOD + 0, MOD + 1024, 6144, H, nullptr, TT, args.in[I_ALOG], args.in[I_DTB], GB, gw, NGW, lane);
        __syncthreads(); }
    END_REP
    SEAM(1);
    BEGIN_REP(2)
    if (IN(2)) { pg8::Gemm g{H, WinT, M, NP, D}; pg8::StaticOrder S; S.init(M, NP, G, bx); pg8::EpiBf16 E{P, NP};
        pg8::gemm_phase<pg8::EpiBf16, pg8::StaticOrder, true, true>(lds, g, S, E); }
    END_REP
    SEAM(2);
    BEGIN_REP(3)
    if (IN(3)) conv_pass(P, args.in[I_CWM], args.in[I_CWQ], args.in[I_GCO], YC, QKV, gw, NGW, lane);
    END_REP
    SEAM(3);
#if DN_NAIVE
    SEAM(4);
    if (IN(5)) { if (bx < 32 && wave == 0) naive_dn(QKV, GB, (float*)(ws + WS_CH), bx, lane); }
    SEAM(5);
    if (IN(6)) opost_rows<false>((const float*)(ws + WS_CH), P, args.in[I_GDN], YC, gw, NGW, lane);
#else
    BEGIN_REP(4)
    if (IN(4)) { unsigned* FLG = (unsigned*)(ws + 16384);
        if (bx < NBH) chain_phase(lds, CH, FLG, Oraw, bx, tid); else prep_phase(lds, P, args.in[I_CWQ], GB, EGL, CH, FLG, bx - NBH, G - NBH, tid); }
    END_REP
    SEAM(4);
    BEGIN_REP(6)
    if (IN(6)) opost_rows<true>(Oraw, P, args.in[I_GDN], YC, gw, NGW, lane);
    END_REP
#endif
    SEAM(6);
    BEGIN_REP(7)
    if (IN(7)) { pg8::Gemm g{YC, WoT, M, D, D}; pg8::StaticOrder S; S.init(M, D, G, bx);
        pg8::EpiResGateNorm<true> E{args.in[I_X], OUT, H, MOD + 2048, 6144, args.in[I_GFFN], MOD + 3072, MOD + 4096, 6144, (float*)(ws + WS_EGL + 524288), (unsigned*)(ws + 32768 + 8192), lds + 131072};
        pg8::gemm_phase<pg8::EpiResGateNorm<true>, pg8::StaticOrder, true, true>(lds, g, S, E); }
    END_REP
    SEAM(7);
    BEGIN_REP(8)
    if (false && IN(8)) adaln_rows<1>(OUT, args.in[I_GFFN], MOD + 3072, MOD + 4096, 6144, H, nullptr, nullptr, nullptr, nullptr, nullptr, gw, NGW, lane);
    END_REP
    BEGIN_REP(9)
    if (IN(9)) { pg8::Gemm g{H, WguT, M, 2 * FF, D}; pg8::StaticOrder S; S.init(M, 2 * FF, G, bx); pg8::EpiSwiglu E{ACT, FF};
        pg8::gemm_phase<pg8::EpiSwiglu, pg8::StaticOrder, true, true>(lds, g, S, E); }
    END_REP
    SEAM(9);
    BEGIN_REP(10)
    if (IN(10)) { pg8::Gemm g{ACT, WdT, M, D, FF}; pg8::StaticOrder S; S.init(M, D, G, bx);
        pg8::EpiResGateNorm<false> E{OUT, OUT, nullptr, MOD + 5120, 6144, args.in[I_GFIN], MOD + 4 * 6144, MOD + 4 * 6144 + 1024, 2048, (float*)(ws + WS_EGL), (unsigned*)(ws + 32768), lds + 131072};
        pg8::gemm_phase<pg8::EpiResGateNorm<false>, pg8::StaticOrder, true, true>(lds, g, S, E); }
    END_REP
    LAUNDER();
    if (IN(11) && G != 256) adaln_rows<2>(OUT, args.in[I_GFIN], MOD + 4 * 6144, MOD + 4 * 6144 + 1024, 2048, nullptr, OUT, nullptr, nullptr, nullptr, nullptr, gw, NGW, lane);
#undef IN
#undef SEAM
}

extern "C" void kernel_launch(void* const* d_in, const int* in_sizes, int n_in, void* d_out, int out_size, void* d_ws, size_t ws_size, hipStream_t stream) {
    static int grid = 0;
    if (grid == 0) {
        if (n_in != 19 || out_size != M * D || ws_size < WS_END) { fprintf(stderr, "kernel_launch: unexpected shapes (n_in %d, out %d, ws %zu)\n", n_in, out_size, ws_size); grid = -1; return; }
        int dev = 0, cus = 0;
        if (hipGetDevice(&dev) != hipSuccess || hipDeviceGetAttribute(&cus, hipDeviceAttributeMultiprocessorCount, dev) != hipSuccess) { grid = -1; return; }
        if (hipFuncSetAttribute((const void*)fwd, hipFuncAttributeMaxDynamicSharedMemorySize, LDS_BYTES) != hipSuccess) { fprintf(stderr, "kernel_launch: hipFuncSetAttribute failed\n"); grid = -1; return; }
        int per_cu = 0;
        if (hipOccupancyMaxActiveBlocksPerMultiprocessor(&per_cu, (const void*)fwd, NWAVES * 64, LDS_BYTES) != hipSuccess || per_cu < 1) { fprintf(stderr, "kernel_launch: occupancy query says %d blocks per CU\n", per_cu); }
        (void)hipGetLastError();
        grid = cus;
    }
    if (grid < 0) return;
    Args a{};
    for (int i = 0; i < 19; ++i) a.in[i] = (const float*)d_in[i];
    a.out = (float*)d_out; a.ws = (unsigned char*)d_ws;
#if MK_N_LAUNCHES == 1
    if (hipMemsetAsync(d_ws, 0, 49152, stream) != hipSuccess) { fprintf(stderr, "kernel_launch: memset of the barrier words failed\n"); return; }
    a.ph_lo = 0; a.ph_hi = PH_END;
    void* kargs[] = {&a};
    hipError_t e = hipLaunchCooperativeKernel((const void*)fwd, dim3(grid), dim3(NWAVES * 64), kargs, LDS_BYTES, stream);
    if (e != hipSuccess) fprintf(stderr, "kernel_launch: cooperative launch failed: %s (grid %d)\n", hipGetErrorString(e), grid);
#else
    for (int ph = 0; ph < PH_END; ++ph) { a.ph_lo = ph; a.ph_hi = ph + 1; hipLaunchKernelGGL(fwd, dim3(grid), dim3(NWAVES * 64), LDS_BYTES, stream, a); }
#endif
}
```

```cpp
#include <hip/hip_runtime.h>
#include <hip/hip_cooperative_groups.h>
#include <cstdio>
#include <cstdint>
namespace cg = cooperative_groups;
#ifndef MK_N_LAUNCHES
#define MK_N_LAUNCHES 1
#endif
#ifndef DN_NAIVE
#define DN_NAIVE 0
#endif
namespace pg8 {
#define PG8_LAS __attribute__((address_space(3)))
typedef unsigned short bf16_t;
typedef short bf16x8 __attribute__((ext_vector_type(8)));
typedef float f32x4 __attribute__((ext_vector_type(4)));
typedef unsigned u32x4 __attribute__((ext_vector_type(4)));
constexpr int BM = 256, BK = 64, HALF = 128, HTB = HALF * BK * 2  , STAGE_BYTES = 8 * HTB, NXCD = 8, WGM = 8;

__host__ __device__ __forceinline__ int lds_byte(int r, int c) { const int st = (r >> 4) * 2 + (c >> 5), rr = r & 15, cc = c & 31, ob = rr * 64 + cc * 2; return st * 1024 + (ob ^ (((ob >> 9) & 1) << 5)); }
__host__ __device__ __forceinline__ void stage_rc(int b, int& R, int& C) { const int st = b / 1024, sb = b % 1024, swz = sb ^ (((sb >> 9) & 1) << 5); R = (st >> 1) * 16 + swz / 64; C = (st & 1) * 32 + (swz % 64) / 2; }
__host__ __device__ __forceinline__ int perm32(int rho) { const int n = rho >> 4, i = rho & 15; return 8 * (i >> 2) + 4 * n + (i & 3); }

struct Unit { int pm, pn; };
struct Gemm { const bf16_t* A; const bf16_t* Bt; int M, N, K; };

struct StaticOrder {
    int nM, nN, nwg, G, c;
    __host__ __device__ void init(int M, int N, int G_, int c_) { nM = M / BM; nN = N / BM; nwg = nM * nN; G = G_; c = c_; }
    __host__ __device__ bool next(int i, Unit& u) const {
        const long L = (long)i * G + c; if (L >= nwg) return false;
        int wgid = (int)L; { const int q = nwg / NXCD, r = nwg % NXCD, xcd = wgid % NXCD, off = wgid / NXCD; wgid = (xcd < r ? xcd * (q + 1) : r * (q + 1) + (xcd - r) * q) + off; }
        const int nig = WGM * nN, gid = wgid / nig, fm = gid * WGM, gsz = (nM - fm) < WGM ? (nM - fm) : WGM;
        u.pm = fm + ((wgid % nig) % gsz); u.pn = (wgid % nig) / gsz; return true;
    }
    __device__ __forceinline__ void a_ready(const Unit&) const {}
    __device__ __forceinline__ void done(const Unit&) const {}
};

typedef float f32x2 __attribute__((ext_vector_type(2)));
typedef __bf16 bf16x2v __attribute__((ext_vector_type(2)));
__device__ __forceinline__ unsigned cvt_pk_bf16(float lo, float hi) { f32x2 v = {lo, hi}; bf16x2v r = __builtin_convertvector(v, bf16x2v); return __builtin_bit_cast(unsigned, r); }
__device__ __forceinline__ float silu_f(float x) { return x * __builtin_amdgcn_rcpf(1.0f + __builtin_amdgcn_exp2f(-1.4426950408889634f * x)); }

struct EpiBf16 {
    static constexpr bool PERM = true, AFTER_DRAIN = false;
    bf16_t* O; int ldc;
    __device__ __forceinline__ void operator()(const f32x4 (&acc)[2][2][4][2], const Unit& u, int wr, int wc, int fr, int fq) const {
        const int row0 = u.pm * BM + wr * 64 + fr; const int col0 = u.pn * BM + wc * 32 + 8 * fq;
#pragma unroll
        for (int ai = 0; ai < 2; ++ai)
#pragma unroll
            for (int m = 0; m < 4; ++m) { bf16_t* rowp = O + (size_t)(row0 + ai * HALF + m * 16) * ldc + col0;
#pragma unroll
                for (int bj = 0; bj < 2; ++bj) { const f32x4 v0 = acc[ai][bj][m][0], v1 = acc[ai][bj][m][1];
                    u32x4 w; w.x = cvt_pk_bf16(v0[0], v0[1]); w.y = cvt_pk_bf16(v0[2], v0[3]); w.z = cvt_pk_bf16(v1[0], v1[1]); w.w = cvt_pk_bf16(v1[2], v1[3]);
                    *(u32x4*)(rowp + bj * HALF) = w; } }
    }
};
struct EpiSwiglu {
    static constexpr bool PERM = true, AFTER_DRAIN = false;
    bf16_t* O; int ldc;
    __device__ __forceinline__ void operator()(const f32x4 (&acc)[2][2][4][2], const Unit& u, int wr, int wc, int fr, int fq) const {
        const int row0 = u.pm * BM + wr * 64 + fr; const int col0 = u.pn * HALF + wc * 32 + 8 * fq;
#pragma unroll
        for (int ai = 0; ai < 2; ++ai)
#pragma unroll
            for (int m = 0; m < 4; ++m) { bf16_t* rowp = O + (size_t)(row0 + ai * HALF + m * 16) * ldc + col0;
                const f32x4 g0 = acc[ai][0][m][0], g1 = acc[ai][0][m][1], u0 = acc[ai][1][m][0], u1 = acc[ai][1][m][1];
                u32x4 w; w.x = cvt_pk_bf16(silu_f(g0[0]) * u0[0], silu_f(g0[1]) * u0[1]); w.y = cvt_pk_bf16(silu_f(g0[2]) * u0[2], silu_f(g0[3]) * u0[3]);
                w.z = cvt_pk_bf16(silu_f(g1[0]) * u1[0], silu_f(g1[1]) * u1[1]); w.w = cvt_pk_bf16(silu_f(g1[2]) * u1[2], silu_f(g1[3]) * u1[3]);
                *(u32x4*)rowp = w; }
    }
};
struct EpiResGate {
    static constexpr bool PERM = false, AFTER_DRAIN = false;
    const float* base; float* out; const float* gate;
    int gstride;
    __device__ __forceinline__ void operator()(const f32x4 (&acc)[2][2][4][2], const Unit& u, int wr, int wc, int fr, int fq) const {
        const int b = u.pm >> 5;
        const int col0 = u.pn * BM + wc * 32 + 4 * fq; const float* gp = gate + (size_t)b * gstride + col0;
        f32x4 gv[2][2];
#pragma unroll
        for (int bj = 0; bj < 2; ++bj)
#pragma unroll
            for (int n = 0; n < 2; ++n) gv[bj][n] = *(const f32x4*)(gp + bj * HALF + n * 16);
#pragma unroll
        for (int ai = 0; ai < 2; ++ai)
#pragma unroll
            for (int m = 0; m < 4; ++m) { const size_t off = (size_t)(u.pm * BM + ai * HALF + wr * 64 + m * 16 + fr) * 1024 + col0;
#pragma unroll
                for (int bj = 0; bj < 2; ++bj)
#pragma unroll
                    for (int n = 0; n < 2; ++n) { const f32x4 bs = *(const f32x4*)(base + off + bj * HALF + n * 16);
                        *(f32x4*)(out + off + bj * HALF + n * 16) = bs + gv[bj][n] * acc[ai][bj][m][n]; } }
    }
};

template <bool MID> struct EpiResGateNorm {
    static constexpr bool PERM = false, AFTER_DRAIN = false;
    const float* base; float* out; bf16_t* hb; const float* gate; int gstride;
    const float* gain; const float* shiftp; const float* scalep; int mstride;
    float* SS; unsigned* cnt; PG8_LAS unsigned char* xl;
    __device__ __forceinline__ void operator()(f32x4 (&acc)[2][2][4][2], const Unit& u, int wr, int wc, int fr, int fq) const {
        const int tid = threadIdx.x, lane = tid & 63, wid = __builtin_amdgcn_readfirstlane(tid >> 6);
        const int b = u.pm >> 5;
        const int col0 = u.pn * BM + wc * 32 + 4 * fq; const float* gp = gate + (size_t)b * gstride + col0;
        PG8_LAS float* Pt = (PG8_LAS float*)xl; PG8_LAS float* St = (PG8_LAS float*)(xl + 4096);
        f32x4 gv[2][2];
#pragma unroll
        for (int bj = 0; bj < 2; ++bj)
#pragma unroll
            for (int n = 0; n < 2; ++n) gv[bj][n] = *(const f32x4*)(gp + bj * HALF + n * 16);
#pragma unroll
        for (int ai = 0; ai < 2; ++ai)
#pragma unroll
            for (int m = 0; m < 4; ++m) { const size_t off = (size_t)(u.pm * BM + ai * HALF + wr * 64 + m * 16 + fr) * 1024 + col0; float s = 0.f;
#pragma unroll
                for (int bj = 0; bj < 2; ++bj)
#pragma unroll
                    for (int n = 0; n < 2; ++n) { const f32x4 v = *(const f32x4*)(base + off + bj * HALF + n * 16) + gv[bj][n] * acc[ai][bj][m][n]; acc[ai][bj][m][n] = v; if (MID) *(f32x4*)(out + off + bj * HALF + n * 16) = v; s += (v.x * v.x + v.y * v.y) + (v.z * v.z + v.w * v.w); }
                s += __shfl_xor(s, 16); s += __shfl_xor(s, 32);
                if (fq == 0) Pt[(ai * HALF + wr * 64 + m * 16 + fr) * 4 + wc] = s; }
        asm volatile("s_waitcnt lgkmcnt(0)" ::: "memory"); __builtin_amdgcn_s_barrier(); asm volatile("" ::: "memory");
        if (tid < 256) { const f32x4 p = *(const PG8_LAS f32x4*)(Pt + tid * 4); const float part = (p.x + p.y) + (p.z + p.w);
            float* slot = SS + (size_t)(u.pm * BM + tid) * 4 + u.pn; asm volatile("global_store_dword %0, %1, off sc1\n\ts_nop 1" :: "v"(slot), "v"(part) : "memory"); }
        asm volatile("s_waitcnt vmcnt(0)" ::: "memory"); __builtin_amdgcn_s_barrier(); asm volatile("" ::: "memory");
        if (wid == 0) { unsigned* c = cnt + u.pm * 16;
            if (lane == 0) __hip_atomic_fetch_add(c, 1u, __ATOMIC_RELAXED, __HIP_MEMORY_SCOPE_AGENT);
            unsigned spins = 0;
            while ((unsigned)__builtin_amdgcn_readfirstlane(__hip_atomic_load(c, __ATOMIC_RELAXED, __HIP_MEMORY_SCOPE_AGENT)) < 4u && ++spins < 4000000u) __builtin_amdgcn_s_sleep(2);
            __builtin_amdgcn_fence(__ATOMIC_ACQUIRE, "agent"); asm volatile("s_waitcnt vmcnt(0)" ::: "memory"); }
        __builtin_amdgcn_s_barrier(); asm volatile("" ::: "memory");
        if (tid < 256) { const f32x4 q = *(const f32x4*)(SS + (size_t)(u.pm * BM + tid) * 4); St[tid] = 1.0f / sqrtf(((q.x + q.y) + (q.z + q.w)) * (1.0f / 1024.0f) + 1e-6f); }
        asm volatile("s_waitcnt lgkmcnt(0)" ::: "memory"); __builtin_amdgcn_s_barrier(); asm volatile("" ::: "memory");
        float rinv[2][4];
#pragma unroll
        for (int ai = 0; ai < 2; ++ai)
#pragma unroll
            for (int m = 0; m < 4; ++m) rinv[ai][m] = St[ai * HALF + wr * 64 + m * 16 + fr];
#pragma unroll
        for (int bj = 0; bj < 2; ++bj)
#pragma unroll
            for (int n = 0; n < 2; ++n) { const int c = col0 + bj * HALF + n * 16;
                const f32x4 gs = *(const f32x4*)(gain + c) * (1.0f + *(const f32x4*)(scalep + (size_t)b * mstride + c)), sh = *(const f32x4*)(shiftp + (size_t)b * mstride + c);
#pragma unroll
                for (int ai = 0; ai < 2; ++ai)
#pragma unroll
                    for (int m = 0; m < 4; ++m) { const size_t off = (size_t)(u.pm * BM + ai * HALF + wr * 64 + m * 16 + fr) * 1024 + c; const f32x4 o = (acc[ai][bj][m][n] * rinv[ai][m]) * gs + sh;
                        if (MID) { typedef unsigned u32x2v __attribute__((ext_vector_type(2))); u32x2v w; w.x = cvt_pk_bf16(o.x, o.y); w.y = cvt_pk_bf16(o.z, o.w); *(u32x2v*)(hb + off) = w; }
                        else *(f32x4*)(out + off) = o; }
                asm volatile("" ::: "memory"); }
        asm volatile("s_waitcnt lgkmcnt(0)" ::: "memory"); __builtin_amdgcn_s_barrier(); asm volatile("" ::: "memory");
    }
};

template <class Epi, class Sched, bool ALIGN_EPI = false, bool SP2 = false>
__device__ __forceinline__ void gemm_phase(PG8_LAS unsigned char* lds, const Gemm g, const Sched& S, const Epi& E) {
    const int tid = threadIdx.x, wid = __builtin_amdgcn_readfirstlane(tid >> 6), lane = tid & 63, wr = wid >> 2, wc = wid & 3, fr = lane & 15, fq = lane >> 4;
    const int K = g.K, nt = K / BK;
    unsigned voffA[2], voffB[2];
#pragma unroll
    for (int i = 0; i < 2; ++i) { int R, C; stage_rc(tid * 16 + i * 8192, R, C); const int Rb = Epi::PERM ? ((R & ~31) + perm32(R & 31)) : R;
        voffA[i] = (unsigned)(R * K + C) * 2u; voffB[i] = (unsigned)(Rb * K + C) * 2u; }
    const size_t kstep = (size_t)(BK * 2);
    const size_t hstep = (size_t)HALF * K * 2;
    const size_t tstep = 2 * hstep;
    const unsigned ldsw = (unsigned)wid * 1024u;
    const int aoff = lds_byte(wr * 64 + fr, fq * 8), boff = lds_byte(wc * 32 + fr, fq * 8);
#define PG8_SA(b, h) (((b) * 2 + (h)) * HTB)
#define PG8_SB(b, h) ((4 + (b) * 2 + (h)) * HTB)
#define PG8_STAGE(bufoff, gbase, voff) do { _Pragma("unroll") for (int _i = 0; _i < 2; ++_i) \
        __builtin_amdgcn_global_load_lds((const unsigned*)((const char*)(gbase) + (voff)[_i]), (PG8_LAS unsigned*)(lds + (bufoff) + ldsw + _i * 8192), 16, 0, 0); } while (0)
#define PG8_LDA(dst, b, h) do { _Pragma("unroll") for (int m = 0; m < 4; ++m) _Pragma("unroll") for (int k = 0; k < 2; ++k) dst[m][k] = *(const PG8_LAS bf16x8*)(lds + PG8_SA(b, h) + aoff + m * 2048 + k * 1024); } while (0)
#define PG8_LDB(dst, b, h) do { _Pragma("unroll") for (int n = 0; n < 2; ++n) _Pragma("unroll") for (int k = 0; k < 2; ++k) dst[n][k] = *(const PG8_LAS bf16x8*)(lds + PG8_SB(b, h) + boff + n * 2048 + k * 1024); } while (0)
#define PG8_MMA(ai, bj, At, Bt) do { __builtin_amdgcn_s_setprio(1); _Pragma("unroll") for (int m = 0; m < 4; ++m) _Pragma("unroll") for (int n = 0; n < 2; ++n) _Pragma("unroll") for (int k = 0; k < 2; ++k) \
        acc[ai][bj][m][n] = __builtin_amdgcn_mfma_f32_16x16x32_bf16(Bt[n][k], At[m][k], acc[ai][bj][m][n], 0, 0, 0); __builtin_amdgcn_s_setprio(0); } while (0)
#define PG8_WAIT_V(n) asm volatile("s_waitcnt vmcnt(" #n ")" ::: "memory")
#define PG8_WAIT_L(n) asm volatile("s_waitcnt lgkmcnt(" #n ")" ::: "memory")
#define PG8_BAR __builtin_amdgcn_s_barrier()
#define PG8_SCHED __builtin_amdgcn_sched_barrier(0)
    Unit cur, nxt; int ui = 0;
    if (!S.next(0, cur)) return;
    f32x4 acc[2][2][4][2];
#pragma unroll
    for (int a = 0; a < 2; ++a)
#pragma unroll
        for (int b = 0; b < 2; ++b)
#pragma unroll
            for (int m = 0; m < 4; ++m)
#pragma unroll
                for (int n = 0; n < 2; ++n) acc[a][b][m][n] = (f32x4){0.f, 0.f, 0.f, 0.f};
    bf16x8 At[4][2], B0[2][2], B1[2][2];
    const char* cA = (const char*)g.A + (size_t)cur.pm * tstep; const char* cB = (const char*)g.Bt + (size_t)cur.pn * tstep;
    S.a_ready(cur);
    if constexpr (SP2) {
        PG8_STAGE(PG8_SB(0, 0), cB, voffB); PG8_STAGE(PG8_SB(0, 1), cB + hstep, voffB); PG8_STAGE(PG8_SA(0, 0), cA, voffA); PG8_STAGE(PG8_SA(0, 1), cA + hstep, voffA);
        if (wr == 1) PG8_BAR;
        PG8_WAIT_V(2); PG8_BAR;
        PG8_STAGE(PG8_SB(1, 0), cB + kstep, voffB); PG8_STAGE(PG8_SA(1, 0), cA + kstep, voffA); PG8_STAGE(PG8_SB(1, 1), cB + hstep + kstep, voffB);
        PG8_WAIT_V(6); PG8_BAR;
    } else {
        PG8_STAGE(PG8_SB(0, 0), cB, voffB); PG8_STAGE(PG8_SA(0, 0), cA, voffA); PG8_STAGE(PG8_SB(0, 1), cB + hstep, voffB); PG8_STAGE(PG8_SA(0, 1), cA + hstep, voffA);
        if (wr == 1) PG8_BAR;
        PG8_WAIT_V(4); PG8_BAR;
        PG8_STAGE(PG8_SB(1, 0), cB + kstep, voffB); PG8_STAGE(PG8_SA(1, 0), cA + kstep, voffA); PG8_STAGE(PG8_SB(1, 1), cB + hstep + kstep, voffB);
        PG8_WAIT_V(6); PG8_BAR;
    }
    for (;;) {
        const bool has_next = S.next(ui + 1, nxt);
        const char* nA = has_next ? (const char*)g.A + (size_t)nxt.pm * tstep : cA; const char* nB = has_next ? (const char*)g.Bt + (size_t)nxt.pn * tstep : cB;
        for (int t = 0; t < nt; t += 2) {
            const bool last = (t == nt - 2);
            const char* a1 = cA + (size_t)(t + 1) * kstep;
            const char* a2 = last ? nA : cA + (size_t)(t + 2) * kstep; const char* b2 = last ? nB : cB + (size_t)(t + 2) * kstep;
            const char* a3 = a2 + kstep; const char* b3 = b2 + kstep;
            if (last && has_next) S.a_ready(nxt);
            if constexpr (SP2) {
            PG8_LDB(B0, 0, 0); PG8_LDB(B1, 0, 1); PG8_SCHED; PG8_LDA(At, 0, 0); PG8_STAGE(PG8_SA(1, 1), a1 + hstep, voffA);
            PG8_WAIT_V(8); PG8_WAIT_L(0); PG8_BAR; PG8_MMA(0, 0, At, B0); PG8_MMA(0, 1, At, B1); PG8_BAR; PG8_SCHED;
            PG8_LDA(At, 0, 1); PG8_STAGE(PG8_SB(0, 0), b2, voffB); PG8_STAGE(PG8_SB(0, 1), b2 + hstep, voffB); PG8_STAGE(PG8_SA(0, 0), a2, voffA);
            PG8_WAIT_V(8); PG8_WAIT_L(0); PG8_BAR; PG8_MMA(1, 0, At, B0); PG8_MMA(1, 1, At, B1); PG8_BAR; PG8_SCHED;
            PG8_LDB(B0, 1, 0); PG8_LDB(B1, 1, 1); PG8_SCHED; PG8_LDA(At, 1, 0); PG8_STAGE(PG8_SA(0, 1), a2 + hstep, voffA);
            PG8_WAIT_V(8); PG8_WAIT_L(0); PG8_BAR; PG8_MMA(0, 0, At, B0); PG8_MMA(0, 1, At, B1); PG8_BAR; PG8_SCHED;
            PG8_LDA(At, 1, 1); PG8_STAGE(PG8_SB(1, 0), b3, voffB); PG8_STAGE(PG8_SB(1, 1), b3 + hstep, voffB); PG8_STAGE(PG8_SA(1, 0), a3, voffA);
            PG8_WAIT_V(8); PG8_WAIT_L(0); PG8_BAR; PG8_MMA(1, 0, At, B0); PG8_MMA(1, 1, At, B1); PG8_BAR; PG8_SCHED;
            } else {
            PG8_LDB(B0, 0, 0); PG8_SCHED; PG8_LDA(At, 0, 0); PG8_STAGE(PG8_SA(1, 1), a1 + hstep, voffA);
            PG8_WAIT_L(8); PG8_BAR; PG8_WAIT_L(0); PG8_MMA(0, 0, At, B0); PG8_BAR; PG8_SCHED;
            PG8_LDB(B1, 0, 1); PG8_STAGE(PG8_SB(0, 0), b2, voffB);
            PG8_BAR; PG8_WAIT_L(0); PG8_MMA(0, 1, At, B1); PG8_BAR;
            PG8_LDA(At, 0, 1); PG8_STAGE(PG8_SA(0, 0), a2, voffA);
            PG8_BAR; PG8_WAIT_L(0); PG8_MMA(1, 0, At, B0); PG8_BAR; PG8_SCHED;
            PG8_STAGE(PG8_SB(0, 1), b2 + hstep, voffB);
            PG8_WAIT_V(6); PG8_BAR; PG8_MMA(1, 1, At, B1); PG8_BAR;
            PG8_LDB(B0, 1, 0); PG8_SCHED; PG8_LDA(At, 1, 0); PG8_STAGE(PG8_SA(0, 1), a2 + hstep, voffA);
            PG8_WAIT_L(8); PG8_BAR; PG8_WAIT_L(0); PG8_MMA(0, 0, At, B0); PG8_BAR; PG8_SCHED;
            PG8_LDB(B1, 1, 1); PG8_STAGE(PG8_SB(1, 0), b3, voffB);
            PG8_BAR; PG8_WAIT_L(0); PG8_MMA(0, 1, At, B1); PG8_BAR;
            PG8_LDA(At, 1, 1); PG8_STAGE(PG8_SA(1, 0), a3, voffA);
            PG8_BAR; PG8_WAIT_L(0); PG8_MMA(1, 0, At, B0); PG8_BAR; PG8_SCHED;
            PG8_STAGE(PG8_SB(1, 1), b3 + hstep, voffB);
            PG8_WAIT_V(6); PG8_BAR; PG8_MMA(1, 1, At, B1); PG8_BAR;
            }
        }
        if constexpr (ALIGN_EPI) { if (wr == 0) PG8_BAR; }
        if constexpr (!Epi::AFTER_DRAIN) { E(acc, cur, wr, wc, fr, fq); S.done(cur); }
        if (!has_next) break;
#pragma unroll
        for (int a = 0; a < 2; ++a)
#pragma unroll
            for (int b = 0; b < 2; ++b)
#pragma unroll
                for (int m = 0; m < 4; ++m)
#pragma unroll
                    for (int n = 0; n < 2; ++n) acc[a][b][m][n] = (f32x4){0.f, 0.f, 0.f, 0.f};
        cur = nxt; cA = nA; cB = nB; ++ui;
        if constexpr (ALIGN_EPI) { if (wr == 1) PG8_BAR; }
    }
    PG8_WAIT_V(0);
    if constexpr (!ALIGN_EPI) { if (wr == 0) PG8_BAR; }
    PG8_BAR;
    if constexpr (Epi::AFTER_DRAIN) { E.fused(acc, cur, wr, wc, fr, fq, lds, wid, lane); S.done(cur); }
#undef PG8_SA
#undef PG8_SB
#undef PG8_STAGE
#undef PG8_LDA
#undef PG8_LDB
#undef PG8_MMA
#undef PG8_WAIT_V
#undef PG8_WAIT_L
#undef PG8_BAR
#undef PG8_SCHED
}
}

constexpr int NWAVES = 8;
constexpr int BATCH = 4, SEQ = 8192, D = 1024, M = BATCH * SEQ;
constexpr int PIN = 3592, NP = 3584;
constexpr int FF = 2816, NCH = 128, NBH = 16;
constexpr int PH_END = 12;
constexpr float EPS = 1e-6f;
constexpr size_t MiB = 1u << 20;
constexpr size_t WS_MOD = 1 * MiB;
constexpr size_t WS_GB = 2 * MiB;
constexpr size_t WS_EGL = 3 * MiB;
constexpr size_t WS_WIN = 4 * MiB, WS_WO = 11 * MiB, WS_WGU = 13 * MiB, WS_WD = 24 * MiB;
constexpr size_t WS_H = 32 * MiB;
constexpr size_t WS_CH = 32 * MiB;
constexpr size_t WS_P = 208 * MiB;
constexpr size_t WS_YC = 432 * MiB;
constexpr size_t WS_END = 496 * MiB;
constexpr int REC = 74752;
constexpr int REC_A = 57344;
constexpr int LDS_BYTES = 155648;

#define LAS __attribute__((address_space(3)))
typedef unsigned short bf16;
typedef unsigned v4u __attribute__((ext_vector_type(4)));
typedef unsigned v2u __attribute__((ext_vector_type(2)));
typedef float f32x4 __attribute__((ext_vector_type(4)));
typedef float f32x16 __attribute__((ext_vector_type(16)));
typedef short bf16x8 __attribute__((ext_vector_type(8)));
#define LDS_WAIT() asm volatile("s_waitcnt lgkmcnt(0)" ::: "memory")
using pg8::cvt_pk_bf16; using pg8::silu_f;
__device__ __forceinline__ float bf2f(unsigned short u) { return __uint_as_float((unsigned)u << 16); }
__device__ __forceinline__ float bflo(unsigned w) { return __uint_as_float(w << 16); }
__device__ __forceinline__ float bfhi(unsigned w) { return __uint_as_float(w & 0xffff0000u); }
__device__ __forceinline__ float wave_sum(float v) {
#pragma unroll
    for (int o = 1; o < 64; o <<= 1) v += __shfl_xor(v, o);
    return v;
}
__device__ __forceinline__ void unpack8(v4u w, float (&f)[8]) { f[0] = bflo(w.x); f[1] = bfhi(w.x); f[2] = bflo(w.y); f[3] = bfhi(w.y); f[4] = bflo(w.z); f[5] = bfhi(w.z); f[6] = bflo(w.w); f[7] = bfhi(w.w); }
__device__ __forceinline__ v4u pack8(const float (&f)[8]) { v4u w; w.x = cvt_pk_bf16(f[0], f[1]); w.y = cvt_pk_bf16(f[2], f[3]); w.z = cvt_pk_bf16(f[4], f[5]); w.w = cvt_pk_bf16(f[6], f[7]); return w; }

struct Args { const float* in[19]; float* out; unsigned char* ws; int ph_lo, ph_hi; };
enum { I_X = 0, I_C, I_WADA, I_BADA, I_WADAF, I_BADAF, I_GMIX, I_GFFN, I_GFIN, I_WIN, I_CWM, I_CWQ, I_ALOG, I_DTB, I_GCO, I_GDN, I_WOUT, I_WGU, I_WDN };

template <int MODE>
__device__ __forceinline__ void p0_transpose_item(const float* W, int K, int ld, int nblk, bf16* WT, LAS float* scr, int item, int lane) {
    const int kb = item / nblk, nb = item % nblk, k0 = 64 * kb, n0 = 32 * nb;
    f32x4 ld4[8];
#pragma unroll
    for (int i = 0; i < 8; ++i) ld4[i] = *(const f32x4*)(W + (size_t)(k0 + 8 * i + (lane >> 3)) * ld + n0 + 4 * (lane & 7));
#pragma unroll
    for (int i = 0; i < 8; ++i) { LAS float* d = scr + (8 * i + (lane >> 3)) * 33 + 4 * (lane & 7); d[0] = ld4[i].x; d[1] = ld4[i].y; d[2] = ld4[i].z; d[3] = ld4[i].w; }
    LDS_WAIT(); asm volatile("" ::: "memory");
    int r0 = n0;
    if (MODE == 1) { r0 = n0 < FF ? 256 * (n0 / 128) + (n0 % 128) : 256 * ((n0 - FF) / 128) + 128 + ((n0 - FF) % 128); }
    const int c = lane & 7;
#pragma unroll
    for (int j = 0; j < 4; ++j) { const int n = (lane >> 3) + 8 * j; const LAS float* s = scr + (8 * c) * 33 + n;
        v4u o; o.x = cvt_pk_bf16(s[0 * 33], s[1 * 33]); o.y = cvt_pk_bf16(s[2 * 33], s[3 * 33]); o.z = cvt_pk_bf16(s[4 * 33], s[5 * 33]); o.w = cvt_pk_bf16(s[6 * 33], s[7 * 33]);
        *(v4u*)(WT + (size_t)(r0 + n) * K + k0 + 8 * c) = o; }
    LDS_WAIT(); asm volatile("" ::: "memory");
}
__device__ __forceinline__ void p0_mod_item(const Args& a, float* MOD, const LAS float* SC, LAS float* red, int item, int tid) {
    const int c4 = tid & 7, ks = tid >> 3, col0 = item * 32;
    const bool fin = col0 >= 6144; const float* W = fin ? a.in[I_WADAF] : a.in[I_WADA]; const int ld = fin ? 2048 : 6144, cb = (fin ? col0 - 6144 : col0);
    f32x4 w[16];
#pragma unroll
    for (int kk = 0; kk < 16; ++kk) w[kk] = *(const f32x4*)(W + (size_t)(16 * ks + kk) * ld + cb + 4 * c4);
    f32x4 acc[4];
#pragma unroll
    for (int b = 0; b < 4; ++b) acc[b] = (f32x4){0.f, 0.f, 0.f, 0.f};
#pragma unroll
    for (int kk = 0; kk < 16; ++kk) { const f32x4 s = *(const LAS f32x4*)(SC + (16 * ks + kk) * 4); acc[0] += s.x * w[kk]; acc[1] += s.y * w[kk]; acc[2] += s.z * w[kk]; acc[3] += s.w * w[kk]; }
#pragma unroll
    for (int b = 0; b < 4; ++b) *(LAS f32x4*)(red + (ks * 4 + b) * 32 + 4 * c4) = acc[b];
    __syncthreads();
    if (tid < 128) { const int b = tid >> 5, cl = tid & 31; float s = 0.f;
#pragma unroll 16
        for (int k = 0; k < 64; ++k) s += red[(k * 4 + b) * 32 + cl];
        const int c = cb + cl;
        s += fin ? a.in[I_BADAF][c] : a.in[I_BADA][c];
        if (fin) MOD[4 * 6144 + b * 2048 + c] = s; else MOD[b * 6144 + c] = s; }
    __syncthreads();
}

template <int MODE>
__device__ __forceinline__ void adaln_one(const f32x4 (&xin)[4], const f32x4 (&gs)[4], const f32x4 (&sh)[4], int m, bf16* Hout, float* Fout, const LAS float* TT, const float* a_log, const float* dt_bias, float* GB, int lane) {
    f32x4 v[4]; float ss = 0.f;
#pragma unroll
    for (int j = 0; j < 4; ++j) { v[j] = xin[j]; ss += (v[j].x * v[j].x + v[j].y * v[j].y) + (v[j].z * v[j].z + v[j].w * v[j].w); }
    const float rinv = 1.0f / sqrtf(wave_sum(ss) * (1.0f / D) + EPS);
#pragma unroll
    for (int j = 0; j < 4; ++j) v[j] = (v[j] * rinv) * gs[j] + sh[j];
    if (MODE == 2) { f32x4* o = (f32x4*)(Fout + (size_t)m * D) + lane;
#pragma unroll
        for (int j = 0; j < 4; ++j) o[64 * j] = v[j];
    } else { v2u* o = (v2u*)(Hout + (size_t)m * D) + lane;
#pragma unroll
        for (int j = 0; j < 4; ++j) { v2u w; w.x = cvt_pk_bf16(v[j].x, v[j].y); w.y = cvt_pk_bf16(v[j].z, v[j].w); o[64 * j] = w; } }
    if (MODE == 0) {
        float d[8];
#pragma unroll
        for (int e = 0; e < 8; ++e) { float s = 0.f;
#pragma unroll
            for (int j = 0; j < 4; ++j) { const f32x4 t = *(const LAS f32x4*)(TT + e * 1024 + 4 * (lane + 64 * j)); s += (v[j].x * t.x + v[j].y * t.y) + (v[j].z * t.z + v[j].w * t.w); }
            asm volatile("" : "+v"(s) :: "memory"); d[e] = s; }
        float k4[4], k2[2], k1;
        { const bool hi = (lane & 32) != 0;
#pragma unroll
          for (int i = 0; i < 4; ++i) { const float snd = hi ? d[i] : d[4 + i]; const float kp = hi ? d[4 + i] : d[i]; k4[i] = kp + __shfl_xor(snd, 32); } }
        { const bool hi = (lane & 16) != 0;
#pragma unroll
          for (int i = 0; i < 2; ++i) { const float snd = hi ? k4[i] : k4[2 + i]; const float kp = hi ? k4[2 + i] : k4[i]; k2[i] = kp + __shfl_xor(snd, 16); } }
        { const bool hi = (lane & 8) != 0; const float snd = hi ? k2[0] : k2[1]; const float kp = hi ? k2[1] : k2[0]; k1 = kp + __shfl_xor(snd, 8); }
        k1 += __shfl_xor(k1, 4); k1 += __shfl_xor(k1, 2); k1 += __shfl_xor(k1, 1);
        if ((lane & 7) == 0) { const int e = lane >> 3; float r;
            if (e < 4) { const float xx = k1 + dt_bias[e]; const float sp = fmaxf(xx, 0.f) + log1pf(__expf(-fabsf(xx))); r = -__expf(a_log[e]) * sp; }
            else r = 1.0f / (1.0f + __expf(-k1));
            GB[(size_t)m * 8 + e] = r; }
    }
}
template <int MODE>
__device__ __forceinline__ void adaln_rows(const float* X, const float* gain, const float* shiftp, const float* scalep, int mstride, bf16* Hout, float* Fout,
                                           const LAS float* TT, const float* a_log, const float* dt_bias, float* GB, int gw, int NGW, int lane) {
    for (int blk = gw; blk < M / 16; blk += NGW) {
        const int m0 = blk * 16, b = m0 >> 13;
        f32x4 gs[4], sh[4];
        { const f32x4* g4 = (const f32x4*)gain + lane; const f32x4* sh4 = (const f32x4*)(shiftp + (size_t)b * mstride) + lane; const f32x4* sc4 = (const f32x4*)(scalep + (size_t)b * mstride) + lane;
#pragma unroll
          for (int j = 0; j < 4; ++j) { gs[j] = g4[64 * j] * (1.0f + sc4[64 * j]); sh[j] = sh4[64 * j]; } }
        f32x4 c0[4], c1[4];
        { const f32x4* xr = (const f32x4*)(X + (size_t)m0 * D) + lane;
#pragma unroll
          for (int j = 0; j < 4; ++j) { c0[j] = xr[64 * j]; c1[j] = xr[256 + 64 * j]; } }
#pragma unroll 1
        for (int i = 0; i < 16; i += 2) {
            f32x4 n0[4], n1[4];
            { const int mn = (i + 2 < 16) ? m0 + i + 2 : m0; const f32x4* xr = (const f32x4*)(X + (size_t)mn * D) + lane;
#pragma unroll
              for (int j = 0; j < 4; ++j) { n0[j] = xr[64 * j]; n1[j] = xr[256 + 64 * j]; } }
            adaln_one<MODE>(c0, gs, sh, m0 + i, Hout, Fout, TT, a_log, dt_bias, GB, lane);
            adaln_one<MODE>(c1, gs, sh, m0 + i + 1, Hout, Fout, TT, a_log, dt_bias, GB, lane);
#pragma unroll
            for (int j = 0; j < 4; ++j) { c0[j] = n0[j]; c1[j] = n1[j]; }
        }
    }
}

__device__ __forceinline__ void conv_qkv(const bf16* P, const float* cwq, bf16* QKV, int X, int t0, bool first, int lane) {
    const int colp = 1536 + 512 * X + 8 * lane, colo = 512 * X + 8 * lane;
    v4u raw[19];
#pragma unroll
    for (int t = 0; t < 19; ++t) { raw[t] = (v4u){0u, 0u, 0u, 0u}; if (t >= 3 || !first) raw[t] = *(const v4u*)(P + (size_t)(t0 - 3 + t) * NP + colp); }
    float w0[8], w1[8], w2[8], w3[8], h3[8], h2[8], h1[8];
#pragma unroll
    for (int e = 0; e < 8; ++e) { w0[e] = cwq[0 * 1536 + colo + e]; w1[e] = cwq[1 * 1536 + colo + e]; w2[e] = cwq[2 * 1536 + colo + e]; w3[e] = cwq[3 * 1536 + colo + e]; }
    unpack8(raw[0], h3); unpack8(raw[1], h2); unpack8(raw[2], h1);
#pragma unroll
    for (int t = 0; t < 16; ++t) { const int m = t0 + t; float x[8], y[8]; unpack8(raw[3 + t], x); float ss = 0.f;
#pragma unroll
        for (int e = 0; e < 8; ++e) { const float c = w0[e] * h3[e] + w1[e] * h2[e] + w2[e] * h1[e] + w3[e] * x[e]; y[e] = silu_f(c); ss += y[e] * y[e]; h3[e] = h2[e]; h2[e] = h1[e]; h1[e] = x[e]; }
        if (X < 2) { ss += __shfl_xor(ss, 1); ss += __shfl_xor(ss, 2); ss += __shfl_xor(ss, 4); ss += __shfl_xor(ss, 8);
            float r = 1.0f / sqrtf(ss + EPS); if (X == 0) r *= 0.08838834764831845f;
#pragma unroll
            for (int e = 0; e < 8; ++e) y[e] *= r; }
        *(v4u*)(QKV + (size_t)m * 1536 + colo) = pack8(y); }
}
__device__ __forceinline__ void conv_pass(const bf16* P, const float* cwm, const float* cwq, const float* gco, bf16* YC, bf16* QKV, int gw, int NGW, int lane) {
    for (int run = gw; run < M / 16; run += NGW) {
        const int t0 = run * 16; const bool first = (t0 & (SEQ - 1)) == 0;
        { float w0[8], w1[8], w2[8], gc[8], u2[8], u1[8]; const int c0 = 8 * lane;
#pragma unroll
          for (int e = 0; e < 8; ++e) { w0[e] = cwm[c0 + e]; w1[e] = cwm[512 + c0 + e]; w2[e] = cwm[1024 + c0 + e]; gc[e] = gco[c0 + e]; u2[e] = 0.f; u1[e] = 0.f; }
          if (!first) { float a[8], b[8]; unpack8(*(const v4u*)(P + (size_t)(t0 - 2) * NP + 512 + c0), a); unpack8(*(const v4u*)(P + (size_t)(t0 - 2) * NP + 1024 + c0), b);
#pragma unroll
              for (int e = 0; e < 8; ++e) u2[e] = a[e] * b[e];
              unpack8(*(const v4u*)(P + (size_t)(t0 - 1) * NP + 512 + c0), a); unpack8(*(const v4u*)(P + (size_t)(t0 - 1) * NP + 1024 + c0), b);
#pragma unroll
              for (int e = 0; e < 8; ++e) u1[e] = a[e] * b[e]; }
#pragma unroll 1
          for (int tb = 0; tb < 16; tb += 8) {
              v4u rb[8], rc[8], rh[8];
#pragma unroll
              for (int t = 0; t < 8; ++t) { const bf16* pr = P + (size_t)(t0 + tb + t) * NP + c0; rb[t] = *(const v4u*)pr; rc[t] = *(const v4u*)(pr + 512); rh[t] = *(const v4u*)(pr + 1024); }
#pragma unroll
              for (int t = 0; t < 8; ++t) { const int m = t0 + tb + t; float gb[8], a[8], b[8], y[8]; unpack8(rb[t], gb); unpack8(rc[t], a); unpack8(rh[t], b); float ss = 0.f;
#pragma unroll
                  for (int e = 0; e < 8; ++e) { const float u0 = a[e] * b[e]; y[e] = gb[e] * (w0[e] * u2[e] + w1[e] * u1[e] + w2[e] * u0); ss += y[e] * y[e]; u2[e] = u1[e]; u1[e] = u0; }
                  ss += __shfl_xor(ss, 1); ss += __shfl_xor(ss, 2); ss += __shfl_xor(ss, 4);
                  const float r = 1.0f / sqrtf(ss * (1.0f / 64.0f) + EPS);
#pragma unroll
                  for (int e = 0; e < 8; ++e) y[e] = y[e] * r * gc[e];
                  *(v4u*)(YC + (size_t)m * D + c0) = pack8(y); } } }
    }
}


constexpr int PREP_HALF = 69632, PK_KN = 0, PK_QN = 17408, PK_VV = 34816, PK_LM = 52224, PK_GC = 68608, PK_BT = 68864, PK_EG = 69120, PROW = 272;
template <bool SC>
__device__ __forceinline__ v4u afrag_piece_rows(const LAS unsigned char* tile, const LAS float* sc, int p) {
    const int f = p >> 6, ln = p & 63, mt = f >> 3, kt = (f >> 1) & 3, s = f & 1, r = ln & 31, hh = ln >> 5, row = 32 * mt + r, kb = 32 * kt + 16 * s + 4 * hh;
    const v2u a = *(const LAS v2u*)(tile + row * PROW + kb * 2), b = *(const LAS v2u*)(tile + row * PROW + (kb + 8) * 2);
    float scv = 1.0f; if (SC) scv = sc[row];
    v4u o; o.x = cvt_pk_bf16(bflo(a.x) * scv, bfhi(a.x) * scv); o.y = cvt_pk_bf16(bflo(a.y) * scv, bfhi(a.y) * scv); o.z = cvt_pk_bf16(bflo(b.x) * scv, bfhi(b.x) * scv); o.w = cvt_pk_bf16(bflo(b.y) * scv, bfhi(b.y) * scv);
    return o;
}
#define LBAR() do { asm volatile("s_waitcnt lgkmcnt(0)" ::: "memory"); __builtin_amdgcn_s_barrier(); asm volatile("" ::: "memory"); } while (0)
__device__ __forceinline__ void st_wt16(void* p, v4u v) { asm volatile("global_store_dwordx4 %0, %1, off sc1\n\ts_nop 1" :: "v"(p), "v"(v) : "memory"); }
__device__ __forceinline__ void st_wt4(void* p, float v) { asm volatile("global_store_dword %0, %1, off sc1\n\ts_nop 1" :: "v"(p), "v"(v) : "memory"); }
__device__ __forceinline__ void prep_phase(LAS unsigned char* lds, const bf16* P, const float* cwq, const float* GB, float* EGL, unsigned char* CH, unsigned* FLG, int ublk, int nblk, int tid) {
    const int half = tid >> 8, t = tid & 255, lane = tid & 63, w = (tid >> 6) & 3, r = lane & 31, hh = lane >> 5;
    LAS unsigned char* L = lds + half * PREP_HALF;
    LAS float* LM = (LAS float*)(L + PK_LM); LAS float* GC = (LAS float*)(L + PK_GC); LAS float* BT = (LAS float*)(L + PK_BT); LAS float* EG = (LAS float*)(L + PK_EG);
    for (int pu = ublk; pu < NBH * NCH / 2; pu += nblk) {
        const int n = pu >> 3, bh = 2 * (pu & 7) + half, cid = bh * NCH + n, b = bh >> 2, h = bh & 3, m0 = b * SEQ + n * 64;
        unsigned char* rec = CH + (size_t)cid * REC;
        LBAR();
        { const int c8 = t & 15, tg = t >> 4;
#pragma unroll
          for (int X = 0; X < 3; ++X) {
              const int colp = 1536 + 512 * X + 128 * h + 8 * c8, colw = 512 * X + 128 * h + 8 * c8;
              v4u raw[7];
#pragma unroll
              for (int i = 0; i < 7; ++i) { const int tok = 4 * tg - 3 + i; raw[i] = (v4u){0u, 0u, 0u, 0u}; if (tok >= 0 || n > 0) raw[i] = *(const v4u*)(P + (size_t)(m0 + tok) * NP + colp); }
              float w0[8], w1[8], w2[8], w3[8], h3[8], h2[8], h1[8];
#pragma unroll
              for (int e = 0; e < 8; ++e) { w0[e] = cwq[0 * 1536 + colw + e]; w1[e] = cwq[1 * 1536 + colw + e]; w2[e] = cwq[2 * 1536 + colw + e]; w3[e] = cwq[3 * 1536 + colw + e]; }
              unpack8(raw[0], h3); unpack8(raw[1], h2); unpack8(raw[2], h1);
#pragma unroll
              for (int i = 0; i < 4; ++i) { float x[8], y[8]; unpack8(raw[3 + i], x); float ss = 0.f;
#pragma unroll
                  for (int e = 0; e < 8; ++e) { const float c = w0[e] * h3[e] + w1[e] * h2[e] + w2[e] * h1[e] + w3[e] * x[e]; y[e] = silu_f(c); ss += y[e] * y[e]; h3[e] = h2[e]; h2[e] = h1[e]; h1[e] = x[e]; }
                  if (X < 2) { ss += __shfl_xor(ss, 1); ss += __shfl_xor(ss, 2); ss += __shfl_xor(ss, 4); ss += __shfl_xor(ss, 8);
                      float rr = 1.0f / sqrtf(ss + EPS); if (X == 0) rr *= 0.08838834764831845f;
#pragma unroll
                      for (int e = 0; e < 8; ++e) y[e] *= rr; }
                  *(LAS v4u*)(L + (X == 0 ? PK_QN : (X == 1 ? PK_KN : PK_VV)) + (4 * tg + i) * PROW + c8 * 16) = pack8(y); } } }
        if (w == 0) { float g = GB[(size_t)(m0 + lane) * 8 + h];
#pragma unroll
            for (int d = 1; d < 64; d <<= 1) { const float o = __shfl_up(g, d); if (lane >= d) g += o; }
            GC[lane] = g; EG[lane] = __expf(g); BT[lane] = GB[(size_t)(m0 + lane) * 8 + 4 + h];
            if (lane == 63) st_wt4(rec + 73728, __expf(g)); }
        LBAR();
        { const int mi = w >> 1, nj = w & 1;
          f32x16 kk, qk;
#pragma unroll
          for (int i = 0; i < 16; ++i) { kk[i] = 0.f; qk[i] = 0.f; }
#pragma unroll
          for (int st = 0; st < 8; ++st) {
              const bf16x8 ka = *(const LAS bf16x8*)(L + PK_KN + (32 * mi + r) * PROW + (16 * st + 8 * hh) * 2);
              const bf16x8 kb = *(const LAS bf16x8*)(L + PK_KN + (32 * nj + r) * PROW + (16 * st + 8 * hh) * 2);
              const bf16x8 qb = *(const LAS bf16x8*)(L + PK_QN + (32 * mi + r) * PROW + (16 * st + 8 * hh) * 2);
              kk = __builtin_amdgcn_mfma_f32_32x32x16_bf16(ka, kb, kk, 0, 0, 0);
              qk = __builtin_amdgcn_mfma_f32_32x32x16_bf16(kb, qb, qk, 0, 0, 0);
          }
          const float gj = GC[32 * nj + r], gq = GC[32 * mi + r];
          float av[16];
#pragma unroll
          for (int reg = 0; reg < 16; ++reg) { const int cr = (reg & 3) + 8 * (reg >> 2) + 4 * hh;
              const int i = 32 * mi + cr, j = 32 * nj + r;
              LM[i * 64 + j] = (i > j) ? BT[i] * kk[reg] * __expf(GC[i] - gj) : 0.f;
              const int key = 32 * nj + cr, qr = 32 * mi + r;
              av[reg] = (qr >= key) ? qk[reg] * __expf(gq - GC[key]) : 0.f; }
#pragma unroll
          for (int s = 0; s < 2; ++s) { v4u o; o.x = cvt_pk_bf16(av[8 * s], av[8 * s + 1]); o.y = cvt_pk_bf16(av[8 * s + 2], av[8 * s + 3]); o.z = cvt_pk_bf16(av[8 * s + 4], av[8 * s + 5]); o.w = cvt_pk_bf16(av[8 * s + 6], av[8 * s + 7]);
              st_wt16(rec + 49152 + ((mi * 2 + nj) * 2 + s) * 1024 + lane * 16, o); }
        }
#pragma unroll
        for (int i = 0; i < 4; ++i) { const int p = t + 256 * i; st_wt16(rec + 16384 + p * 16, afrag_piece_rows<true>(L + PK_QN, EG, p)); }
        { const float gl = GC[63];
#pragma unroll
          for (int i = 0; i < 4; ++i) { const int p = t + 256 * i, f = p >> 6, ln = p & 63, mt = f >> 2, ct = (f >> 1) & 1, s = f & 1, dk = 32 * mt + (ln & 31), cb = 32 * ct + 16 * s + 4 * (ln >> 5);
              float e[8];
#pragma unroll
              for (int j = 0; j < 8; ++j) { const int c = cb + 8 * (j >> 2) + (j & 3); e[j] = bf2f(*(const LAS unsigned short*)(L + PK_KN + c * PROW + dk * 2)) * __expf(gl - GC[c]); }
              st_wt16(rec + 32768 + p * 16, pack8(e)); } }
        LBAR();
        { float X[64]; const bool isu = t < 128; const int col = t & 127;
          const LAS unsigned char* src = L + (isu ? PK_VV : PK_KN) + col * 2;
#pragma unroll
          for (int i = 0; i < 64; ++i) {
              f32x4 lc[12];
#pragma unroll
              for (int j4 = 0; j4 < 12; ++j4) if (j4 < (i + 3) / 4) lc[j4] = *(const LAS f32x4*)(LM + i * 64 + 4 * j4);
              const float egi = EG[i]; const float rhs = bf2f(*(const LAS unsigned short*)(src + i * PROW)) * BT[i] * (isu ? 1.0f : egi);
              __builtin_amdgcn_sched_barrier(0);
              float a0 = 0.f, a1 = 0.f, a2 = 0.f, a3 = 0.f;
#pragma unroll
              for (int j4 = 0; j4 < (i + 3) / 4; ++j4) { f32x4 l; if (j4 < 12) l = lc[j4]; else l = *(const LAS f32x4*)(LM + i * 64 + 4 * j4);
                  if (4 * j4 + 0 < i) a0 += l.x * X[4 * j4 + 0]; if (4 * j4 + 1 < i) a1 += l.y * X[4 * j4 + 1]; if (4 * j4 + 2 < i) a2 += l.z * X[4 * j4 + 2]; if (4 * j4 + 3 < i) a3 += l.w * X[4 * j4 + 3]; }
              X[i] = rhs - ((a0 + a1) + (a2 + a3)); asm volatile("" : "+v"(X[i]) :: "memory");
              __builtin_amdgcn_sched_barrier(0); }
          LBAR();
          if (isu) { const int vs = col >> 5, dvl = col & 31;
#pragma unroll
              for (int mt = 0; mt < 2; ++mt)
#pragma unroll
                  for (int h2 = 0; h2 < 2; ++h2) { v4u* dst = (v4u*)(rec + REC_A + (size_t)(((vs * 2 + mt) * 64 + dvl + 32 * h2) * 32));
#pragma unroll
                      for (int a2 = 0; a2 < 2; ++a2) { const int i0 = 32 * mt + 4 * h2 + 16 * a2; v4u w;
                          w.x = cvt_pk_bf16(X[i0], X[i0 + 1]); w.y = cvt_pk_bf16(X[i0 + 2], X[i0 + 3]); w.z = cvt_pk_bf16(X[i0 + 8], X[i0 + 9]); w.w = cvt_pk_bf16(X[i0 + 10], X[i0 + 11]); st_wt16(dst + a2, w); } }
          } else {
#pragma unroll
              for (int i = 0; i < 64; ++i) *(LAS unsigned short*)(L + PK_VV + i * PROW + col * 2) = (unsigned short)(cvt_pk_bf16(-X[i], 0.f) & 0xffffu);
          }
        }
        LBAR();
#pragma unroll
        for (int i = 0; i < 4; ++i) { const int p = t + 256 * i; st_wt16(rec + p * 16, afrag_piece_rows<false>(L + PK_VV, EG, p)); }
        asm volatile("s_waitcnt vmcnt(0)" ::: "memory"); __syncthreads();
        if (tid == 0) {
            __hip_atomic_store(FLG + (2 * (pu & 7)) * NCH + n, 1u, __ATOMIC_RELAXED, __HIP_MEMORY_SCOPE_AGENT); __hip_atomic_store(FLG + (2 * (pu & 7) + 1) * NCH + n, 1u, __ATOMIC_RELAXED, __HIP_MEMORY_SCOPE_AGENT); }
    }
}

__device__ __forceinline__ bf16x8 pack_acc(const f32x16& x, int s) {
    v4u p; p.x = cvt_pk_bf16(x[8 * s], x[8 * s + 1]); p.y = cvt_pk_bf16(x[8 * s + 2], x[8 * s + 3]); p.z = cvt_pk_bf16(x[8 * s + 4], x[8 * s + 5]); p.w = cvt_pk_bf16(x[8 * s + 6], x[8 * s + 7]);
    return __builtin_bit_cast(bf16x8, p);
}
#define MFMA32(a, b, c) __builtin_amdgcn_mfma_f32_32x32x16_bf16((a), (b), (c), 0, 0, 0)
#define PIN_SCHED() __builtin_amdgcn_sched_barrier(0)
__device__ __forceinline__ int chain_ready(const unsigned* fl, int have, int lane) {
    for (;;) {
        const int idx = have + 1 + lane;
        const unsigned f = (idx < NCH) ? __hip_atomic_load(fl + idx, __ATOMIC_RELAXED, __HIP_MEMORY_SCOPE_AGENT) : 0u;
        const unsigned long long m = __ballot(f != 0u);
        const int pre = (m == ~0ull) ? 64 : __builtin_ctzll(~m);
        if (pre > 0) { __builtin_amdgcn_fence(__ATOMIC_ACQUIRE, "agent"); asm volatile("s_waitcnt vmcnt(0)" ::: "memory"); return have + pre; }
        __builtin_amdgcn_s_sleep(16);
    }
}
__device__ __forceinline__ void chain_phase(LAS unsigned char* lds, const unsigned char* CH, const unsigned* FLG, bf16* Oraw, int bh, int tid) {
    const int wid = __builtin_amdgcn_readfirstlane(tid >> 6), lane = tid & 63, b = bh >> 2, h = bh & 3, vs = wid & 3;
    const unsigned char* rec0 = CH + (size_t)bh * NCH * REC;
    const bool comp = wid < 4, stager = (wid >= 4);
    const int hw = wid - 4;
#define CH_MOVE(n, dstbase) do { _Pragma("unroll") for (int _i = 0; _i < 19; ++_i) { const int _pc = hw * 19 + _i; if (_pc < 73) \
        __builtin_amdgcn_global_load_lds((const unsigned*)(rec0 + (size_t)(n) * REC + _pc * 1024 + lane * 16), (LAS unsigned*)((dstbase) + _pc * 1024), 16, 0, 0); } } while (0)
#define CH_WARM(n) do { _Pragma("unroll") for (int _i = 0; _i < 10; ++_i) { const int _o = (_i * 64 + lane) * 128; \
        __builtin_amdgcn_global_load_lds((const unsigned*)(rec0 + (size_t)(n) * REC + (_o < REC ? _o : 0)), (LAS unsigned*)(dummy), 4, 0, 0); } } while (0)
    constexpr int WARM_AHEAD = 8;
    LAS unsigned char* dummy = lds + 2 * REC;
    f32x16 S[4], o0, o1;
#pragma unroll
    for (int k = 0; k < 4; ++k)
#pragma unroll
        for (int i = 0; i < 16; ++i) S[k][i] = 0.f;
#pragma unroll
    for (int i = 0; i < 16; ++i) { o0[i] = 0.f; o1[i] = 0.f; }
    const unsigned* fl = FLG + bh * NCH; int have = -1;
    if (stager) { while (have < 0) have = chain_ready(fl, have, lane); CH_MOVE(0, lds); }
    if (!comp) asm volatile("s_waitcnt vmcnt(0)" ::: "memory");
    __builtin_amdgcn_s_barrier(); asm volatile("" ::: "memory");
    for (int n = 0; n < NCH; ++n) {
        const int buf = n & 1;
        if (!comp) {
            if (stager) { if (n + 1 < NCH) { while (have < n + 1) have = chain_ready(fl, have, lane); CH_MOVE(n + 1, lds + (buf ^ 1) * REC); } asm volatile("s_waitcnt vmcnt(0)" ::: "memory"); }
            else { const int wn = n + 1 + WARM_AHEAD; if (wn < NCH) { if (have < wn) { const int idx = have + 1 + lane; const unsigned f = (idx < NCH) ? __hip_atomic_load(fl + idx, __ATOMIC_RELAXED, __HIP_MEMORY_SCOPE_AGENT) : 0u;
                        const unsigned long long m = __ballot(f != 0u); const int pre = (m == ~0ull) ? 64 : __builtin_ctzll(~m); if (pre > 0) { __builtin_amdgcn_fence(__ATOMIC_ACQUIRE, "agent"); have += pre; } }
                    if (have >= wn) CH_WARM(wn); }
                   asm volatile("s_waitcnt vmcnt(20)" ::: "memory"); }
        } else {
            const LAS unsigned char* B = lds + buf * REC + lane * 16;
            const float egl = *(const LAS float*)(lds + buf * REC + 73728);
            f32x16 v0, v1;
            { const LAS v4u* ul = (const LAS v4u*)(lds + buf * REC + 57344 + ((vs * 2) * 64 + lane) * 32);
              const v4u a0 = ul[0], a1 = ul[1], b0 = ul[128], b1 = ul[129];
              v0[0] = bflo(a0.x); v0[1] = bfhi(a0.x); v0[2] = bflo(a0.y); v0[3] = bfhi(a0.y); v0[4] = bflo(a0.z); v0[5] = bfhi(a0.z); v0[6] = bflo(a0.w); v0[7] = bfhi(a0.w);
              v0[8] = bflo(a1.x); v0[9] = bfhi(a1.x); v0[10] = bflo(a1.y); v0[11] = bfhi(a1.y); v0[12] = bflo(a1.z); v0[13] = bfhi(a1.z); v0[14] = bflo(a1.w); v0[15] = bfhi(a1.w);
              v1[0] = bflo(b0.x); v1[1] = bfhi(b0.x); v1[2] = bflo(b0.y); v1[3] = bfhi(b0.y); v1[4] = bflo(b0.z); v1[5] = bfhi(b0.z); v1[6] = bflo(b0.w); v1[7] = bfhi(b0.w);
              v1[8] = bflo(b1.x); v1[9] = bfhi(b1.x); v1[10] = bflo(b1.y); v1[11] = bfhi(b1.y); v1[12] = bflo(b1.z); v1[13] = bfhi(b1.z); v1[14] = bflo(b1.w); v1[15] = bfhi(b1.w); }
#pragma unroll
            for (int i = 0; i < 16; ++i) { o0[i] = 0.f; o1[i] = 0.f; }
#define LDF(dst, off) dst = *(const LAS bf16x8*)(B + (off))
#define LD_WQ(F, kt, s) do { LDF(F[0], ((0 * 4 + (kt)) * 2 + (s)) * 1024); LDF(F[1], ((1 * 4 + (kt)) * 2 + (s)) * 1024); LDF(F[2], 16384 + ((0 * 4 + (kt)) * 2 + (s)) * 1024); LDF(F[3], 16384 + ((1 * 4 + (kt)) * 2 + (s)) * 1024); } while (0)
#define MM_WQ(F, kt, s) do { const bf16x8 sb = pack_acc(S[kt], s); v0 = MFMA32(F[0], sb, v0); v1 = MFMA32(F[1], sb, v1); o0 = MFMA32(F[2], sb, o0); o1 = MFMA32(F[3], sb, o1); asm volatile("" : "+v"(o0), "+v"(o1)); } while (0)
#define LD_AT(F, ct) do { LDF(F[0], 49152 + ((0 * 2 + (ct)) * 2 + 0) * 1024); LDF(F[1], 49152 + ((1 * 2 + (ct)) * 2 + 0) * 1024); LDF(F[2], 49152 + ((0 * 2 + (ct)) * 2 + 1) * 1024); LDF(F[3], 49152 + ((1 * 2 + (ct)) * 2 + 1) * 1024); } while (0)
#define MM_AT(F, ct) do { o0 = MFMA32(F[0], vb[ct][0], o0); o1 = MFMA32(F[1], vb[ct][0], o1); o0 = MFMA32(F[2], vb[ct][1], o0); o1 = MFMA32(F[3], vb[ct][1], o1); } while (0)
#define LD_KD(F, ct, s) do { _Pragma("unroll") for (int q = 0; q < 4; ++q) LDF(F[q], 32768 + ((q * 2 + (ct)) * 2 + (s)) * 1024); } while (0)
#define MM_KD(F, ct, s) do { _Pragma("unroll") for (int q = 0; q < 4; ++q) S[q] = MFMA32(F[q], vb[ct][s], S[q]); } while (0)
            bf16x8 FA[4], FB[4];
            LD_WQ(FA, 0, 0); PIN_SCHED();
            LD_WQ(FB, 0, 1); PIN_SCHED(); MM_WQ(FA, 0, 0); PIN_SCHED();
            LD_WQ(FA, 1, 0); PIN_SCHED(); MM_WQ(FB, 0, 1); PIN_SCHED();
            LD_WQ(FB, 1, 1); PIN_SCHED(); MM_WQ(FA, 1, 0); PIN_SCHED();
            LD_WQ(FA, 2, 0); PIN_SCHED(); MM_WQ(FB, 1, 1); PIN_SCHED();
            LD_WQ(FB, 2, 1); PIN_SCHED(); MM_WQ(FA, 2, 0); PIN_SCHED();
            LD_WQ(FA, 3, 0); PIN_SCHED(); MM_WQ(FB, 2, 1); PIN_SCHED();
            LD_WQ(FB, 3, 1); PIN_SCHED(); MM_WQ(FA, 3, 0); PIN_SCHED();
            LD_AT(FA, 0); PIN_SCHED(); MM_WQ(FB, 3, 1); PIN_SCHED();
            bf16x8 vb[2][2];
            vb[0][0] = pack_acc(v0, 0); vb[0][1] = pack_acc(v0, 1); vb[1][0] = pack_acc(v1, 0); vb[1][1] = pack_acc(v1, 1);
            LD_AT(FB, 1); PIN_SCHED(); MM_AT(FA, 0); PIN_SCHED();
#pragma unroll
            for (int kt = 0; kt < 4; ++kt)
#pragma unroll
                for (int i = 0; i < 16; ++i) S[kt][i] *= egl;
            LD_KD(FA, 0, 0); PIN_SCHED(); MM_AT(FB, 1); PIN_SCHED();
            { bf16* op = Oraw + (size_t)(b * SEQ + n * 64 + 4 * (lane >> 5)) * 512 + h * 128 + vs * 32 + (lane & 31); asm volatile("" : "+v"(op));
#pragma unroll
              for (int reg = 0; reg < 16; ++reg) { const int cr = (reg & 3) + 8 * (reg >> 2); const unsigned pk = cvt_pk_bf16(o0[reg], o1[reg]); op[cr * 512] = (bf16)(pk & 0xffffu); op[(32 + cr) * 512] = (bf16)(pk >> 16); } }
            PIN_SCHED();
            LD_KD(FB, 0, 1); PIN_SCHED(); MM_KD(FA, 0, 0); PIN_SCHED();
            LD_KD(FA, 1, 0); PIN_SCHED(); MM_KD(FB, 0, 1); PIN_SCHED();
            LD_KD(FB, 1, 1); PIN_SCHED(); MM_KD(FA, 1, 0); PIN_SCHED();
            MM_KD(FB, 1, 1);
#undef MM_AT
#undef MM_KD
#undef LDF
#undef LD_WQ
#undef MM_WQ
#undef LD_AT
#undef LD_KD
            asm volatile("s_waitcnt lgkmcnt(0)" ::: "memory");
        }
        __builtin_amdgcn_s_barrier(); asm volatile("" ::: "memory");
    }
    asm volatile("s_waitcnt vmcnt(0)" ::: "memory");
#undef CH_MOVE
#undef CH_WARM
}
#if DN_NAIVE
__device__ __forceinline__ void naive_dn(const bf16* QKV, const float* GB, float* Oraw, int unit, int lane) {
    const int bh = unit >> 1, dv = (unit & 1) * 64 + lane, b = bh >> 2, h = bh & 3;
    float S[128];
#pragma unroll
    for (int i = 0; i < 128; ++i) S[i] = 0.f;
    for (int t = 0; t < SEQ; ++t) { const size_t m = (size_t)b * SEQ + t;
        const float al = __expf(GB[m * 8 + h]), be = GB[m * 8 + 4 + h];
        const bf16* qp = QKV + m * 1536 + h * 128; const bf16* kp = qp + 512; const float v = bf2f(qp[1024 + dv]);
        float r = 0.f;
#pragma unroll
        for (int i = 0; i < 128; ++i) { S[i] *= al; r += bf2f(kp[i]) * S[i]; if ((i & 15) == 15) asm volatile("" : "+v"(r) :: "memory"); }
        const float d = be * (v - r); float o = 0.f;
#pragma unroll
        for (int i = 0; i < 128; ++i) { S[i] += bf2f(kp[i]) * d; o += bf2f(qp[i]) * S[i]; if ((i & 15) == 15) asm volatile("" : "+v"(o) :: "memory"); }
        Oraw[m * 512 + h * 128 + dv] = o; }
}
#endif
template <bool OB16>
__device__ __forceinline__ void opost_rows(const void* Oraw_, const bf16* P, const float* gdn, bf16* YC, int gw, int NGW, int lane) {
    const float* Oraw = (const float*)Oraw_; const bf16* Ob = (const bf16*)Oraw_;
    float gd[8];
#pragma unroll
    for (int e = 0; e < 8; ++e) gd[e] = gdn[(8 * lane + e) & 127];
    for (int blk = gw; blk < M / 16; blk += NGW) { const int m0 = blk * 16;
#pragma unroll 1
        for (int i = 0; i < 16; i += 8) {
            f32x4 oa[8], ob[8]; v4u zz[8];
#pragma unroll
            for (int t = 0; t < 8; ++t) { const int m = m0 + i + t;
                if (OB16) { float f[8]; unpack8(*(const v4u*)(Ob + (size_t)m * 512 + 8 * lane), f); oa[t] = (f32x4){f[0], f[1], f[2], f[3]}; ob[t] = (f32x4){f[4], f[5], f[6], f[7]}; }
                else { const f32x4* op = (const f32x4*)(Oraw + (size_t)m * 512 + 8 * lane); oa[t] = op[0]; ob[t] = op[1]; }
                zz[t] = *(const v4u*)(P + (size_t)m * NP + 3072 + 8 * lane); }
#pragma unroll
            for (int t = 0; t < 8; ++t) { const int m = m0 + i + t; float z[8]; unpack8(zz[t], z);
                float o[8] = {oa[t].x, oa[t].y, oa[t].z, oa[t].w, ob[t].x, ob[t].y, ob[t].z, ob[t].w}; float ss = 0.f;
#pragma unroll
                for (int e = 0; e < 8; ++e) ss += o[e] * o[e];
                ss += __shfl_xor(ss, 1); ss += __shfl_xor(ss, 2); ss += __shfl_xor(ss, 4); ss += __shfl_xor(ss, 8);
                const float r = 1.0f / sqrtf(ss * (1.0f / 128.0f) + EPS);
#pragma unroll
                for (int e = 0; e < 8; ++e) o[e] = o[e] * r * gd[e] * silu_f(z[e]);
                *(v4u*)(YC + (size_t)m * D + 512 + 8 * lane) = pack8(o); } } }
}

typedef __attribute__((address_space(1))) unsigned gu32;
#define XB_TMO      128
#define XB_XCNT(j)  (256  + 64 * (j))
#define XB_XSUB(j)  (1280 + 64 * (j))
#define XB_XGEN(j)  (2304 + 64 * (j))
#define XB_TOP      3328
#define XB_TOPGEN   3392
#define XCD_BAR_WORDS 3456
#define XB_SPIN_CAP (1u << 18)

__device__ __forceinline__ unsigned xb_ld(unsigned* p)              { return __hip_atomic_load(p, __ATOMIC_RELAXED, __HIP_MEMORY_SCOPE_AGENT); }
__device__ __forceinline__ unsigned xb_add(unsigned* p, unsigned v) { return __hip_atomic_fetch_add(p, v, __ATOMIC_RELAXED, __HIP_MEMORY_SCOPE_AGENT); }
__device__ __forceinline__ unsigned xb_xcc_id() { return (unsigned)__builtin_amdgcn_s_getreg((3 << 11) | 20) & 0xFu; }
#define XB_SPIN(cond, bar) do { unsigned _sp = 0; while (cond) { __builtin_amdgcn_s_sleep(1); \
    if ((++_sp & 255u) == 0u) { if (xb_ld(&(bar)[XB_TMO])) break; if (_sp > XB_SPIN_CAP) { atomicAdd(&(bar)[XB_TMO], 1u); break; } } } } while (0)

struct XcdBarrier {
    unsigned* bar; unsigned x;
    volatile LAS unsigned* st;
};

__device__ __forceinline__ XcdBarrier xcd_barrier_post(unsigned* bar, volatile LAS unsigned* st) {
    XcdBarrier b; b.bar = bar; b.x = xb_xcc_id(); b.st = st;
    if (threadIdx.x == 0) (void)xb_add(&bar[XB_XCNT(b.x)], 1u);
    return b;
}
__device__ __forceinline__ void xcd_barrier_complete(unsigned* bar, unsigned x, unsigned& nloc, unsigned& nx) {
    const unsigned G = gridDim.x * gridDim.y * gridDim.z;
    unsigned sum, cnt, mine, sp = 0u;
    for (;;) {
        sum = 0u; cnt = 0u; mine = 0u;
#pragma unroll
        for (unsigned j = 0; j < 16; ++j) { const unsigned c = xb_ld(&bar[XB_XCNT(j)]); sum += c; cnt += (c > 0u) ? 1u : 0u; mine = (j == x) ? c : mine; }
        if (sum == G) break;
        __builtin_amdgcn_s_sleep(1);
        if ((++sp & 255u) == 0u) { if (xb_ld(&bar[XB_TMO])) break; if (sp > XB_SPIN_CAP) { atomicAdd(&bar[XB_TMO], 1u); break; } }
    }
    nloc = mine > 0u ? mine : 1u; nx = cnt > 0u ? cnt : 1u;
}

__device__ __forceinline__ void xcd_barrier(const XcdBarrier& b) {
    asm volatile("s_waitcnt vmcnt(0)" ::: "memory");
    __syncthreads();
    if (threadIdx.x == 0) {
        unsigned* bar = b.bar;
        __builtin_amdgcn_s_waitcnt(0);
        unsigned nloc = b.st[0], nx = b.st[1];
        if (nloc == 0u) { xcd_barrier_complete(bar, b.x, nloc, nx); b.st[0] = nloc; b.st[1] = nx; }
        const unsigned old = xb_add(&bar[XB_XSUB(b.x)], 1u);
        const unsigned gen = old / nloc;
        if (old + 1u == (gen + 1u) * nloc) {
            __builtin_amdgcn_fence(__ATOMIC_RELEASE, "agent");
            asm volatile("s_waitcnt vmcnt(0)" ::: "memory");
            const unsigned og = xb_add(&bar[XB_TOP], 1u);
            const unsigned tg = og / nx;
            if (og + 1u == (tg + 1u) * nx) xb_add(&bar[XB_TOPGEN], 1u);
            else XB_SPIN(xb_ld(&bar[XB_TOPGEN]) == tg, bar);
            __builtin_amdgcn_fence(__ATOMIC_ACQUIRE, "agent");
            xb_add(&bar[XB_XGEN(b.x)], 1u);
            asm volatile("s_waitcnt vmcnt(0)" ::: "memory");
        } else {
            XB_SPIN(xb_ld(&bar[XB_XGEN(b.x)]) == gen, bar);
            __builtin_amdgcn_fence(__ATOMIC_ACQUIRE, "agent");
            asm volatile("s_waitcnt vmcnt(0)" ::: "memory");
        }
    }
    __syncthreads();
}

__global__ void __launch_bounds__(NWAVES * 64, 2) fwd(Args args) {
    extern __shared__ __attribute__((aligned(16))) unsigned char lds_raw[];
    LAS unsigned char* lds = (LAS unsigned char*)lds_raw;
    int tid = threadIdx.x, lane = tid & 63, wave = __builtin_amdgcn_readfirstlane(tid >> 6);
    const int G = gridDim.x; const int bx = blockIdx.x; const int vcu = (G % 8 == 0) ? (bx % 8) * (G / 8) + bx / 8 : bx;
    int gw = vcu * NWAVES + wave; const int NGW = G * NWAVES;
#define LAUNDER() do { int tv_ = threadIdx.x; asm volatile("" : "+v"(tv_)); tid = tv_; lane = tid & 63; wave = __builtin_amdgcn_readfirstlane(tid >> 6); gw = vcu * NWAVES + wave; } while (0)
    unsigned char* ws = args.ws;
    float* MOD = (float*)(ws + WS_MOD); float* GB = (float*)(ws + WS_GB); float* EGL = (float*)(ws + WS_EGL);
    bf16* WinT = (bf16*)(ws + WS_WIN); bf16* WoT = (bf16*)(ws + WS_WO); bf16* WguT = (bf16*)(ws + WS_WGU); bf16* WdT = (bf16*)(ws + WS_WD);
    bf16* H = (bf16*)(ws + WS_H); unsigned char* CH = ws + WS_CH; bf16* P = (bf16*)(ws + WS_P); bf16* ACT = (bf16*)(ws + WS_P); bf16* YC = (bf16*)(ws + WS_YC);
    bf16* QKV = (bf16*)args.out; bf16* Oraw = (bf16*)((unsigned char*)args.out + 96 * MiB); float* OUT = args.out;
    const int lo = args.ph_lo, hi = args.ph_hi;
    volatile LAS unsigned* MISC = (volatile LAS unsigned*)(lds + LDS_BYTES - 64);
    if (tid < 16) MISC[tid] = 0u;
    __syncthreads();
    XcdBarrier bar = xcd_barrier_post((unsigned*)ws, MISC);
    if (lo < 0) cg::this_grid().sync();
#ifndef PH_MASK
#define PH_MASK 0xFFF
#endif
#define IN(k) (((PH_MASK >> (k)) & 1) && lo <= (k) && (k) < hi)
#if MK_N_LAUNCHES == 1
#define SEAM(k) do { if (IN(k) && IN((k) + 1) && (k) != 5) xcd_barrier(bar); } while (0)
#else
#define SEAM(k) do { } while (0)
#endif
#ifndef REP_MASK
#define REP_MASK 0
#endif
#define BEGIN_REP(k) for (int rep_ = 0; rep_ <= ((REP_MASK >> (k)) & 1); ++rep_) { if (rep_) xcd_barrier(bar); LAUNDER();
#define END_REP }
    BEGIN_REP(0)
    if (IN(0)) {
        LAS float* scr = (LAS float*)(lds + wave * 16384);
        constexpr int I_IN = 16 * 112, I_O = 16 * 32, I_GU = 16 * 176, I_DN = 44 * 32, NITEMS = I_IN + I_O + I_GU + I_DN;
        for (int it = gw; it < NITEMS; it += NGW) { int r = it;
            if (r < I_IN) { p0_transpose_item<0>(args.in[I_WIN], D, PIN, 112, WinT, scr, r, lane); continue; } r -= I_IN;
            if (r < I_O) { p0_transpose_item<0>(args.in[I_WOUT], D, D, 32, WoT, scr, r, lane); continue; } r -= I_O;
            if (r < I_GU) { p0_transpose_item<1>(args.in[I_WGU], D, 2 * FF, 176, WguT, scr, r, lane); continue; } r -= I_GU;
            p0_transpose_item<0>(args.in[I_WDN], FF, D, 32, WdT, scr, r, lane); }
        __syncthreads();
        { LAS float* SC = (LAS float*)lds; const float* cin = args.in[I_C];
          for (int idx = tid; idx < 4096; idx += NWAVES * 64) { const int b = idx >> 10, k = idx & 1023; const float cv = cin[idx]; SC[k * 4 + b] = cv / (1.0f + __expf(-cv)); }
          __syncthreads();
          for (int it = bx; it < 256; it += G) p0_mod_item(args, MOD, SC, (LAS float*)(lds + 16384), it, tid); }
    }
    END_REP
    SEAM(0);
    BEGIN_REP(1)
    if (IN(1)) { LAS float* TT = (LAS float*)lds; const float* wi = args.in[I_WIN];
        for (int idx = tid; idx < 8192; idx += NWAVES * 64) { const int k = idx >> 3, e = idx & 7; TT[e * 1024 + k] = wi[(size_t)k * PIN + NP + e]; }
        __syncthreads();
        adaln_rows<0>(args.in[I_X], args.in[I_GMIX], MOD + 0, MOD + 1024, 6144, H, nullptr, TT, args.in[I_ALOG], args.in[I_DTB], GB, gw, NGW, lane);
        __syncthreads(); }
    END_REP
    SEAM(1);
    BEGIN_REP(2)
    if (IN(2)) { pg8::Gemm g{H, WinT, M, NP, D}; pg8::StaticOrder S; S.init(M, NP, G, bx); pg8::EpiBf16 E{P, NP};
        pg8::gemm_phase<pg8::EpiBf16, pg8::StaticOrder, true, true>(lds, g, S, E); }
    END_REP
    SEAM(2);
    BEGIN_REP(3)
    if (IN(3)) conv_pass(P, args.in[I_CWM], args.in[I_CWQ], args.in[I_GCO], YC, QKV, gw, NGW, lane);
    END_REP
    SEAM(3);
#if DN_NAIVE
    SEAM(4);
    if (IN(5)) { if (bx < 32 && wave == 0) naive_dn(QKV, GB, (float*)(ws + WS_CH), bx, lane); }
    SEAM(5);
    if (IN(6)) opost_rows<false>((const float*)(ws + WS_CH), P, args.in[I_GDN], YC, gw, NGW, lane);
#else
    BEGIN_REP(4)
    if (IN(4)) { unsigned* FLG = (unsigned*)(ws + 16384);
        if (bx < NBH) chain_phase(lds, CH, FLG, Oraw, bx, tid); else prep_phase(lds, P, args.in[I_CWQ], GB, EGL, CH, FLG, bx - NBH, G - NBH, tid); }
    END_REP
    SEAM(4);
    BEGIN_REP(6)
    if (IN(6)) opost_rows<true>(Oraw, P, args.in[I_GDN], YC, gw, NGW, lane);
    END_REP
#endif
    SEAM(6);
    BEGIN_REP(7)
    if (IN(7)) { pg8::Gemm g{YC, WoT, M, D, D}; pg8::StaticOrder S; S.init(M, D, G, bx);
        pg8::EpiResGateNorm<true> E{args.in[I_X], OUT, H, MOD + 2048, 6144, args.in[I_GFFN], MOD + 3072, MOD + 4096, 6144, (float*)(ws + WS_EGL + 524288), (unsigned*)(ws + 32768 + 8192), lds + 131072};
        pg8::gemm_phase<pg8::EpiResGateNorm<true>, pg8::StaticOrder, true, true>(lds, g, S, E); }
    END_REP
    SEAM(7);
    BEGIN_REP(8)
    if (false && IN(8)) adaln_rows<1>(OUT, args.in[I_GFFN], MOD + 3072, MOD + 4096, 6144, H, nullptr, nullptr, nullptr, nullptr, nullptr, gw, NGW, lane);
    END_REP
    BEGIN_REP(9)
    if (IN(9)) { pg8::Gemm g{H, WguT, M, 2 * FF, D}; pg8::StaticOrder S; S.init(M, 2 * FF, G, bx); pg8::EpiSwiglu E{ACT, FF};
        pg8::gemm_phase<pg8::EpiSwiglu, pg8::StaticOrder, true, true>(lds, g, S, E); }
    END_REP
    SEAM(9);
    BEGIN_REP(10)
    if (IN(10)) { pg8::Gemm g{ACT, WdT, M, D, FF}; pg8::StaticOrder S; S.init(M, D, G, bx);
        pg8::EpiResGateNorm<false> E{OUT, OUT, nullptr, MOD + 5120, 6144, args.in[I_GFIN], MOD + 4 * 6144, MOD + 4 * 6144 + 1024, 2048, (float*)(ws + WS_EGL), (unsigned*)(ws + 32768), lds + 131072};
        pg8::gemm_phase<pg8::EpiResGateNorm<false>, pg8::StaticOrder, true, true>(lds, g, S, E); }
    END_REP
    LAUNDER();
    if (IN(11) && G != 256) adaln_rows<2>(OUT, args.in[I_GFIN], MOD + 4 * 6144, MOD + 4 * 6144 + 1024, 2048, nullptr, OUT, nullptr, nullptr, nullptr, nullptr, gw, NGW, lane);
#undef IN
#undef SEAM
}

extern "C" void kernel_launch(void* const* d_in, const int* in_sizes, int n_in, void* d_out, int out_size, void* d_ws, size_t ws_size, hipStream_t stream) {
    static int grid = 0;
    if (grid == 0) {
        if (n_in != 19 || out_size != M * D || ws_size < WS_END) { fprintf(stderr, "kernel_launch: unexpected shapes (n_in %d, out %d, ws %zu)\n", n_in, out_size, ws_size); grid = -1; return; }
        int dev = 0, cus = 0;
        if (hipGetDevice(&dev) != hipSuccess || hipDeviceGetAttribute(&cus, hipDeviceAttributeMultiprocessorCount, dev) != hipSuccess) { grid = -1; return; }
        if (hipFuncSetAttribute((const void*)fwd, hipFuncAttributeMaxDynamicSharedMemorySize, LDS_BYTES) != hipSuccess) { fprintf(stderr, "kernel_launch: hipFuncSetAttribute failed\n"); grid = -1; return; }
        int per_cu = 0;
        if (hipOccupancyMaxActiveBlocksPerMultiprocessor(&per_cu, (const void*)fwd, NWAVES * 64, LDS_BYTES) != hipSuccess || per_cu < 1) { fprintf(stderr, "kernel_launch: occupancy query says %d blocks per CU\n", per_cu); }
        (void)hipGetLastError();
        grid = cus;
    }
    if (grid < 0) return;
    Args a{};
    for (int i = 0; i < 19; ++i) a.in[i] = (const float*)d_in[i];
    a.out = (float*)d_out; a.ws = (unsigned char*)d_ws;
#if MK_N_LAUNCHES == 1
    if (hipMemsetAsync(d_ws, 0, 49152, stream) != hipSuccess) { fprintf(stderr, "kernel_launch: memset of the barrier words failed\n"); return; }
    a.ph_lo = 0; a.ph_hi = PH_END;
    void* kargs[] = {&a};
    hipError_t e = hipLaunchCooperativeKernel((const void*)fwd, dim3(grid), dim3(NWAVES * 64), kargs, LDS_BYTES, stream);
    if (e != hipSuccess) fprintf(stderr, "kernel_launch: cooperative launch failed: %s (grid %d)\n", hipGetErrorString(e), grid);
#else
    for (int ph = 0; ph < PH_END; ++ph) { a.ph_lo = ph; a.ph_hi = ph + 1; hipLaunchKernelGGL(fwd, dim3(grid), dim3(NWAVES * 64), LDS_BYTES, stream, a); }
#endif
}
```

```cpp
#include <hip/hip_runtime.h>
#include <hip/hip_cooperative_groups.h>
#include <cstdio>
#include <cstdint>
namespace cg = cooperative_groups;
#ifndef MK_N_LAUNCHES
#define MK_N_LAUNCHES 1
#endif
#ifndef DN_NAIVE
#define DN_NAIVE 0
#endif
namespace pg8 {
#define PG8_LAS __attribute__((address_space(3)))
typedef unsigned short bf16_t;
typedef short bf16x8 __attribute__((ext_vector_type(8)));
typedef float f32x4 __attribute__((ext_vector_type(4)));
typedef unsigned u32x4 __attribute__((ext_vector_type(4)));
constexpr int BM = 256, BK = 64, HALF = 128, HTB = HALF * BK * 2  , STAGE_BYTES = 8 * HTB, NXCD = 8, WGM = 8;

__host__ __device__ __forceinline__ int lds_byte(int r, int c) { const int st = (r >> 4) * 2 + (c >> 5), rr = r & 15, cc = c & 31, ob = rr * 64 + cc * 2; return st * 1024 + (ob ^ (((ob >> 9) & 1) << 5)); }
__host__ __device__ __forceinline__ void stage_rc(int b, int& R, int& C) { const int st = b / 1024, sb = b % 1024, swz = sb ^ (((sb >> 9) & 1) << 5); R = (st >> 1) * 16 + swz / 64; C = (st & 1) * 32 + (swz % 64) / 2; }
__host__ __device__ __forceinline__ int perm32(int rho) { const int n = rho >> 4, i = rho & 15; return 8 * (i >> 2) + 4 * n + (i & 3); }

struct Unit { int pm, pn; };
struct Gemm { const bf16_t* A; const bf16_t* Bt; int M, N, K; };

struct StaticOrder {
    int nM, nN, nwg, G, c;
    __host__ __device__ void init(int M, int N, int G_, int c_) { nM = M / BM; nN = N / BM; nwg = nM * nN; G = G_; c = c_; }
    __host__ __device__ bool next(int i, Unit& u) const {
        const long L = (long)i * G + c; if (L >= nwg) return false;
        int wgid = (int)L; { const int q = nwg / NXCD, r = nwg % NXCD, xcd = wgid % NXCD, off = wgid / NXCD; wgid = (xcd < r ? xcd * (q + 1) : r * (q + 1) + (xcd - r) * q) + off; }
        const int nig = WGM * nN, gid = wgid / nig, fm = gid * WGM, gsz = (nM - fm) < WGM ? (nM - fm) : WGM;
        u.pm = fm + ((wgid % nig) % gsz); u.pn = (wgid % nig) / gsz; return true;
    }
    __device__ __forceinline__ void a_ready(const Unit&) const {}
    __device__ __forceinline__ void done(const Unit&) const {}
};

typedef float f32x2 __attribute__((ext_vector_type(2)));
typedef __bf16 bf16x2v __attribute__((ext_vector_type(2)));
__device__ __forceinline__ unsigned cvt_pk_bf16(float lo, float hi) { f32x2 v = {lo, hi}; bf16x2v r = __builtin_convertvector(v, bf16x2v); return __builtin_bit_cast(unsigned, r); }
__device__ __forceinline__ float silu_f(float x) { return x * __builtin_amdgcn_rcpf(1.0f + __builtin_amdgcn_exp2f(-1.4426950408889634f * x)); }

struct EpiBf16 {
    static constexpr bool PERM = true, AFTER_DRAIN = false;
    bf16_t* O; int ldc;
    __device__ __forceinline__ void operator()(const f32x4 (&acc)[2][2][4][2], const Unit& u, int wr, int wc, int fr, int fq) const {
        const int row0 = u.pm * BM + wr * 64 + fr; const int col0 = u.pn * BM + wc * 32 + 8 * fq;
#pragma unroll
        for (int ai = 0; ai < 2; ++ai)
#pragma unroll
            for (int m = 0; m < 4; ++m) { bf16_t* rowp = O + (size_t)(row0 + ai * HALF + m * 16) * ldc + col0;
#pragma unroll
                for (int bj = 0; bj < 2; ++bj) { const f32x4 v0 = acc[ai][bj][m][0], v1 = acc[ai][bj][m][1];
                    u32x4 w; w.x = cvt_pk_bf16(v0[0], v0[1]); w.y = cvt_pk_bf16(v0[2], v0[3]); w.z = cvt_pk_bf16(v1[0], v1[1]); w.w = cvt_pk_bf16(v1[2], v1[3]);
                    *(u32x4*)(rowp + bj * HALF) = w; } }
    }
};
struct EpiSwiglu {
    static constexpr bool PERM = true, AFTER_DRAIN = false;
    bf16_t* O; int ldc;
    __device__ __forceinline__ void operator()(const f32x4 (&acc)[2][2][4][2], const Unit& u, int wr, int wc, int fr, int fq) const {
        const int row0 = u.pm * BM + wr * 64 + fr; const int col0 = u.pn * HALF + wc * 32 + 8 * fq;
#pragma unroll
        for (int ai = 0; ai < 2; ++ai)
#pragma unroll
            for (int m = 0; m < 4; ++m) { bf16_t* rowp = O + (size_t)(row0 + ai * HALF + m * 16) * ldc + col0;
                const f32x4 g0 = acc[ai][0][m][0], g1 = acc[ai][0][m][1], u0 = acc[ai][1][m][0], u1 = acc[ai][1][m][1];
                u32x4 w; w.x = cvt_pk_bf16(silu_f(g0[0]) * u0[0], silu_f(g0[1]) * u0[1]); w.y = cvt_pk_bf16(silu_f(g0[2]) * u0[2], silu_f(g0[3]) * u0[3]);
                w.z = cvt_pk_bf16(silu_f(g1[0]) * u1[0], silu_f(g1[1]) * u1[1]); w.w = cvt_pk_bf16(silu_f(g1[2]) * u1[2], silu_f(g1[3]) * u1[3]);
                *(u32x4*)rowp = w; }
    }
};
struct EpiResGate {
    static constexpr bool PERM = false, AFTER_DRAIN = false;
    const float* base; float* out; const float* gate;
    int gstride;
    __device__ __forceinline__ void operator()(const f32x4 (&acc)[2][2][4][2], const Unit& u, int wr, int wc, int fr, int fq) const {
        const int b = u.pm >> 5;
        const int col0 = u.pn * BM + wc * 32 + 4 * fq; const float* gp = gate + (size_t)b * gstride + col0;
        f32x4 gv[2][2];
#pragma unroll
        for (int bj = 0; bj < 2; ++bj)
#pragma unroll
            for (int n = 0; n < 2; ++n) gv[bj][n] = *(const f32x4*)(gp + bj * HALF + n * 16);
#pragma unroll
        for (int ai = 0; ai < 2; ++ai)
#pragma unroll
            for (int m = 0; m < 4; ++m) { const size_t off = (size_t)(u.pm * BM + ai * HALF + wr * 64 + m * 16 + fr) * 1024 + col0;
#pragma unroll
                for (int bj = 0; bj < 2; ++bj)
#pragma unroll
                    for (int n = 0; n < 2; ++n) { const f32x4 bs = *(const f32x4*)(base + off + bj * HALF + n * 16);
                        *(f32x4*)(out + off + bj * HALF + n * 16) = bs + gv[bj][n] * acc[ai][bj][m][n]; } }
    }
};

template <bool MID> struct EpiResGateNorm {
    static constexpr bool PERM = false, AFTER_DRAIN = false;
    const float* base; float* out; bf16_t* hb; const float* gate; int gstride;
    const float* gain; const float* shiftp; const float* scalep; int mstride;
    float* SS; unsigned* cnt; PG8_LAS unsigned char* xl;
    __device__ __forceinline__ void operator()(f32x4 (&acc)[2][2][4][2], const Unit& u, int wr, int wc, int fr, int fq) const {
        const int tid = threadIdx.x, lane = tid & 63, wid = __builtin_amdgcn_readfirstlane(tid >> 6);
        const int b = u.pm >> 5;
        const int col0 = u.pn * BM + wc * 32 + 4 * fq; const float* gp = gate + (size_t)b * gstride + col0;
        PG8_LAS float* Pt = (PG8_LAS float*)xl; PG8_LAS float* St = (PG8_LAS float*)(xl + 4096);
        f32x4 gv[2][2];
#pragma unroll
        for (int bj = 0; bj < 2; ++bj)
#pragma unroll
            for (int n = 0; n < 2; ++n) gv[bj][n] = *(const f32x4*)(gp + bj * HALF + n * 16);
#pragma unroll
        for (int ai = 0; ai < 2; ++ai)
#pragma unroll
            for (int m = 0; m < 4; ++m) { const size_t off = (size_t)(u.pm * BM + ai * HALF + wr * 64 + m * 16 + fr) * 1024 + col0; float s = 0.f;
#pragma unroll
                for (int bj = 0; bj < 2; ++bj)
#pragma unroll
                    for (int n = 0; n < 2; ++n) { const f32x4 v = *(const f32x4*)(base + off + bj * HALF + n * 16) + gv[bj][n] * acc[ai][bj][m][n]; acc[ai][bj][m][n] = v; if (MID) *(f32x4*)(out + off + bj * HALF + n * 16) = v; s += (v.x * v.x + v.y * v.y) + (v.z * v.z + v.w * v.w); }
                s += __shfl_xor(s, 16); s += __shfl_xor(s, 32);
                if (fq == 0) Pt[(ai * HALF + wr * 64 + m * 16 + fr) * 4 + wc] = s; }
        asm volatile("s_waitcnt lgkmcnt(0)" ::: "memory"); __builtin_amdgcn_s_barrier(); asm volatile("" ::: "memory");
        if (tid < 256) { const f32x4 p = *(const PG8_LAS f32x4*)(Pt + tid * 4); const float part = (p.x + p.y) + (p.z + p.w);
            float* slot = SS + (size_t)(u.pm * BM + tid) * 4 + u.pn; asm volatile("global_store_dword %0, %1, off sc1\n\ts_nop 1" :: "v"(slot), "v"(part) : "memory"); }
        asm volatile("s_waitcnt vmcnt(0)" ::: "memory"); __builtin_amdgcn_s_barrier(); asm volatile("" ::: "memory");
        if (wid == 0) { unsigned* c = cnt + u.pm * 16;
            if (lane == 0) __hip_atomic_fetch_add(c, 1u, __ATOMIC_RELAXED, __HIP_MEMORY_SCOPE_AGENT);
            unsigned spins = 0;
            while ((unsigned)__builtin_amdgcn_readfirstlane(__hip_atomic_load(c, __ATOMIC_RELAXED, __HIP_MEMORY_SCOPE_AGENT)) < 4u && ++spins < 4000000u) __builtin_amdgcn_s_sleep(2);
            __builtin_amdgcn_fence(__ATOMIC_ACQUIRE, "agent"); asm volatile("s_waitcnt vmcnt(0)" ::: "memory"); }
        __builtin_amdgcn_s_barrier(); asm volatile("" ::: "memory");
        if (tid < 256) { const f32x4 q = *(const f32x4*)(SS + (size_t)(u.pm * BM + tid) * 4); St[tid] = 1.0f / sqrtf(((q.x + q.y) + (q.z + q.w)) * (1.0f / 1024.0f) + 1e-6f); }
        asm volatile("s_waitcnt lgkmcnt(0)" ::: "memory"); __builtin_amdgcn_s_barrier(); asm volatile("" ::: "memory");
        float rinv[2][4];
#pragma unroll
        for (int ai = 0; ai < 2; ++ai)
#pragma unroll
            for (int m = 0; m < 4; ++m) rinv[ai][m] = St[ai * HALF + wr * 64 + m * 16 + fr];
#pragma unroll
        for (int bj = 0; bj < 2; ++bj)
#pragma unroll
            for (int n = 0; n < 2; ++n) { const int c = col0 + bj * HALF + n * 16;
                const f32x4 gs = *(const f32x4*)(gain + c) * (1.0f + *(const f32x4*)(scalep + (size_t)b * mstride + c)), sh = *(const f32x4*)(shiftp + (size_t)b * mstride + c);
#pragma unroll
                for (int ai = 0; ai < 2; ++ai)
#pragma unroll
                    for (int m = 0; m < 4; ++m) { const size_t off = (size_t)(u.pm * BM + ai * HALF + wr * 64 + m * 16 + fr) * 1024 + c; const f32x4 o = (acc[ai][bj][m][n] * rinv[ai][m]) * gs + sh;
                        if (MID) { typedef unsigned u32x2v __attribute__((ext_vector_type(2))); u32x2v w; w.x = cvt_pk_bf16(o.x, o.y); w.y = cvt_pk_bf16(o.z, o.w); *(u32x2v*)(hb + off) = w; }
                        else *(f32x4*)(out + off) = o; }
                asm volatile("" ::: "memory"); }
        asm volatile("s_waitcnt lgkmcnt(0)" ::: "memory"); __builtin_amdgcn_s_barrier(); asm volatile("" ::: "memory");
    }
};

template <class Epi, class Sched, bool ALIGN_EPI = false, bool SP2 = false>
__device__ __forceinline__ void gemm_phase(PG8_LAS unsigned char* lds, const Gemm g, const Sched& S, const Epi& E) {
    const int tid = threadIdx.x, wid = __builtin_amdgcn_readfirstlane(tid >> 6), lane = tid & 63, wr = wid >> 2, wc = wid & 3, fr = lane & 15, fq = lane >> 4;
    const int K = g.K, nt = K / BK;
    unsigned voffA[2], voffB[2];
#pragma unroll
    for (int i = 0; i < 2; ++i) { int R, C; stage_rc(tid * 16 + i * 8192, R, C); const int Rb = Epi::PERM ? ((R & ~31) + perm32(R & 31)) : R;
        voffA[i] = (unsigned)(R * K + C) * 2u; voffB[i] = (unsigned)(Rb * K + C) * 2u; }
    const size_t kstep = (size_t)(BK * 2);
    const size_t hstep = (size_t)HALF * K * 2;
    const size_t tstep = 2 * hstep;
    const unsigned ldsw = (unsigned)wid * 1024u;
    const int aoff = lds_byte(wr * 64 + fr, fq * 8), boff = lds_byte(wc * 32 + fr, fq * 8);
#define PG8_SA(b, h) (((b) * 2 + (h)) * HTB)
#define PG8_SB(b, h) ((4 + (b) * 2 + (h)) * HTB)
#define PG8_STAGE(bufoff, gbase, voff) do { _Pragma("unroll") for (int _i = 0; _i < 2; ++_i) \
        __builtin_amdgcn_global_load_lds((const unsigned*)((const char*)(gbase) + (voff)[_i]), (PG8_LAS unsigned*)(lds + (bufoff) + ldsw + _i * 8192), 16, 0, 0); } while (0)
#define PG8_LDA(dst, b, h) do { _Pragma("unroll") for (int m = 0; m < 4; ++m) _Pragma("unroll") for (int k = 0; k < 2; ++k) dst[m][k] = *(const PG8_LAS bf16x8*)(lds + PG8_SA(b, h) + aoff + m * 2048 + k * 1024); } while (0)
#define PG8_LDB(dst, b, h) do { _Pragma("unroll") for (int n = 0; n < 2; ++n) _Pragma("unroll") for (int k = 0; k < 2; ++k) dst[n][k] = *(const PG8_LAS bf16x8*)(lds + PG8_SB(b, h) + boff + n * 2048 + k * 1024); } while (0)
#define PG8_MMA(ai, bj, At, Bt) do { __builtin_amdgcn_s_setprio(1); _Pragma("unroll") for (int m = 0; m < 4; ++m) _Pragma("unroll") for (int n = 0; n < 2; ++n) _Pragma("unroll") for (int k = 0; k < 2; ++k) \
        acc[ai][bj][m][n] = __builtin_amdgcn_mfma_f32_16x16x32_bf16(Bt[n][k], At[m][k], acc[ai][bj][m][n], 0, 0, 0); __builtin_amdgcn_s_setprio(0); } while (0)
#define PG8_WAIT_V(n) asm volatile("s_waitcnt vmcnt(" #n ")" ::: "memory")
#define PG8_WAIT_L(n) asm volatile("s_waitcnt lgkmcnt(" #n ")" ::: "memory")
#define PG8_BAR __builtin_amdgcn_s_barrier()
#define PG8_SCHED __builtin_amdgcn_sched_barrier(0)
    Unit cur, nxt; int ui = 0;
    if (!S.next(0, cur)) return;
    f32x4 acc[2][2][4][2];
#pragma unroll
    for (int a = 0; a < 2; ++a)
#pragma unroll
        for (int b = 0; b < 2; ++b)
#pragma unroll
            for (int m = 0; m < 4; ++m)
#pragma unroll
                for (int n = 0; n < 2; ++n) acc[a][b][m][n] = (f32x4){0.f, 0.f, 0.f, 0.f};
    bf16x8 At[4][2], B0[2][2], B1[2][2];
    const char* cA = (const char*)g.A + (size_t)cur.pm * tstep; const char* cB = (const char*)g.Bt + (size_t)cur.pn * tstep;
    S.a_ready(cur);
    if constexpr (SP2) {
        PG8_STAGE(PG8_SB(0, 0), cB, voffB); PG8_STAGE(PG8_SB(0, 1), cB + hstep, voffB); PG8_STAGE(PG8_SA(0, 0), cA, voffA); PG8_STAGE(PG8_SA(0, 1), cA + hstep, voffA);
        if (wr == 1) PG8_BAR;
        PG8_WAIT_V(2); PG8_BAR;
        PG8_STAGE(PG8_SB(1, 0), cB + kstep, voffB); PG8_STAGE(PG8_SA(1, 0), cA + kstep, voffA); PG8_STAGE(PG8_SB(1, 1), cB + hstep + kstep, voffB);
        PG8_WAIT_V(6); PG8_BAR;
    } else {
        PG8_STAGE(PG8_SB(0, 0), cB, voffB); PG8_STAGE(PG8_SA(0, 0), cA, voffA); PG8_STAGE(PG8_SB(0, 1), cB + hstep, voffB); PG8_STAGE(PG8_SA(0, 1), cA + hstep, voffA);
        if (wr == 1) PG8_BAR;
        PG8_WAIT_V(4); PG8_BAR;
        PG8_STAGE(PG8_SB(1, 0), cB + kstep, voffB); PG8_STAGE(PG8_SA(1, 0), cA + kstep, voffA); PG8_STAGE(PG8_SB(1, 1), cB + hstep + kstep, voffB);
        PG8_WAIT_V(6); PG8_BAR;
    }
    for (;;) {
        const bool has_next = S.next(ui + 1, nxt);
        const char* nA = has_next ? (const char*)g.A + (size_t)nxt.pm * tstep : cA; const char* nB = has_next ? (const char*)g.Bt + (size_t)nxt.pn * tstep : cB;
        for (int t = 0; t < nt; t += 2) {
            const bool last = (t == nt - 2);
            const char* a1 = cA + (size_t)(t + 1) * kstep;
            const char* a2 = last ? nA : cA + (size_t)(t + 2) * kstep; const char* b2 = last ? nB : cB + (size_t)(t + 2) * kstep;
            const char* a3 = a2 + kstep; const char* b3 = b2 + kstep;
            if (last && has_next) S.a_ready(nxt);
            if constexpr (SP2) {
            PG8_LDB(B0, 0, 0); PG8_LDB(B1, 0, 1); PG8_SCHED; PG8_LDA(At, 0, 0); PG8_STAGE(PG8_SA(1, 1), a1 + hstep, voffA);
            PG8_WAIT_V(8); PG8_WAIT_L(0); PG8_BAR; PG8_MMA(0, 0, At, B0); PG8_MMA(0, 1, At, B1); PG8_BAR; PG8_SCHED;
            PG8_LDA(At, 0, 1); PG8_STAGE(PG8_SB(0, 0), b2, voffB); PG8_STAGE(PG8_SB(0, 1), b2 + hstep, voffB); PG8_STAGE(PG8_SA(0, 0), a2, voffA);
            PG8_WAIT_V(8); PG8_WAIT_L(0); PG8_BAR; PG8_MMA(1, 0, At, B0); PG8_MMA(1, 1, At, B1); PG8_BAR; PG8_SCHED;
            PG8_LDB(B0, 1, 0); PG8_LDB(B1, 1, 1); PG8_SCHED; PG8_LDA(At, 1, 0); PG8_STAGE(PG8_SA(0, 1), a2 + hstep, voffA);
            PG8_WAIT_V(8); PG8_WAIT_L(0); PG8_BAR; PG8_MMA(0, 0, At, B0); PG8_MMA(0, 1, At, B1); PG8_BAR; PG8_SCHED;
            PG8_LDA(At, 1, 1); PG8_STAGE(PG8_SB(1, 0), b3, voffB); PG8_STAGE(PG8_SB(1, 1), b3 + hstep, voffB); PG8_STAGE(PG8_SA(1, 0), a3, voffA);
            PG8_WAIT_V(8); PG8_WAIT_L(0); PG8_BAR; PG8_MMA(1, 0, At, B0); PG8_MMA(1, 1, At, B1); PG8_BAR; PG8_SCHED;
            } else {
            PG8_LDB(B0, 0, 0); PG8_SCHED; PG8_LDA(At, 0, 0); PG8_STAGE(PG8_SA(1, 1), a1 + hstep, voffA);
            PG8_WAIT_L(8); PG8_BAR; PG8_WAIT_L(0); PG8_MMA(0, 0, At, B0); PG8_BAR; PG8_SCHED;
            PG8_LDB(B1, 0, 1); PG8_STAGE(PG8_SB(0, 0), b2, voffB);
            PG8_BAR; PG8_WAIT_L(0); PG8_MMA(0, 1, At, B1); PG8_BAR;
            PG8_LDA(At, 0, 1); PG8_STAGE(PG8_SA(0, 0), a2, voffA);
            PG8_BAR; PG8_WAIT_L(0); PG8_MMA(1, 0, At, B0); PG8_BAR; PG8_SCHED;
            PG8_STAGE(PG8_SB(0, 1), b2 + hstep, voffB);
            PG8_WAIT_V(6); PG8_BAR; PG8_MMA(1, 1, At, B1); PG8_BAR;
            PG8_LDB(B0, 1, 0); PG8_SCHED; PG8_LDA(At, 1, 0); PG8_STAGE(PG8_SA(0, 1), a2 + hstep, voffA);
            PG8_WAIT_L(8); PG8_BAR; PG8_WAIT_L(0); PG8_MMA(0, 0, At, B0); PG8_BAR; PG8_SCHED;
            PG8_LDB(B1, 1, 1); PG8_STAGE(PG8_SB(1, 0), b3, voffB);
            PG8_BAR; PG8_WAIT_L(0); PG8_MMA(0, 1, At, B1); PG8_BAR;
            PG8_LDA(At, 1, 1); PG8_STAGE(PG8_SA(1, 0), a3, voffA);
            PG8_BAR; PG8_WAIT_L(0); PG8_MMA(1, 0, At, B0); PG8_BAR; PG8_SCHED;
            PG8_STAGE(PG8_SB(1, 1), b3 + hstep, voffB);
            PG8_WAIT_V(6); PG8_BAR; PG8_MMA(1, 1, At, B1); PG8_BAR;
            }
        }
        if constexpr (ALIGN_EPI) { if (wr == 0) PG8_BAR; }
        if constexpr (!Epi::AFTER_DRAIN) { E(acc, cur, wr, wc, fr, fq); S.done(cur); }
        if (!has_next) break;
#pragma unroll
        for (int a = 0; a < 2; ++a)
#pragma unroll
            for (int b = 0; b < 2; ++b)
#pragma unroll
                for (int m = 0; m < 4; ++m)
#pragma unroll
                    for (int n = 0; n < 2; ++n) acc[a][b][m][n] = (f32x4){0.f, 0.f, 0.f, 0.f};
        cur = nxt; cA = nA; cB = nB; ++ui;
        if constexpr (ALIGN_EPI) { if (wr == 1) PG8_BAR; }
    }
    PG8_WAIT_V(0);
    if constexpr (!ALIGN_EPI) { if (wr == 0) PG8_BAR; }
    PG8_BAR;
    if constexpr (Epi::AFTER_DRAIN) { E.fused(acc, cur, wr, wc, fr, fq, lds, wid, lane); S.done(cur); }
#undef PG8_SA
#undef PG8_SB
#undef PG8_STAGE
#undef PG8_LDA
#undef PG8_LDB
#undef PG8_MMA
#undef PG8_WAIT_V
#undef PG8_WAIT_L
#undef PG8_BAR
#undef PG8_SCHED
}
}

constexpr int NWAVES = 8;
constexpr int BATCH = 4, SEQ = 8192, D = 1024, M = BATCH * SEQ;
constexpr int PIN = 3592, NP = 3584;
constexpr int FF = 2816, NCH = 128, NBH = 16;
constexpr int PH_END = 12;
constexpr float EPS = 1e-6f;
constexpr size_t MiB = 1u << 20;
constexpr size_t WS_MOD = 1 * MiB;
constexpr size_t WS_GB = 2 * MiB;
constexpr size_t WS_EGL = 3 * MiB;
constexpr size_t WS_WIN = 4 * MiB, WS_WO = 11 * MiB, WS_WGU = 13 * MiB, WS_WD = 24 * MiB;
constexpr size_t WS_H = 32 * MiB;
constexpr size_t WS_CH = 32 * MiB;
constexpr size_t WS_P = 208 * MiB;
constexpr size_t WS_YC = 432 * MiB;
constexpr size_t WS_END = 496 * MiB;
constexpr int REC = 74752;
constexpr int REC_A = 57344;
constexpr int LDS_BYTES = 155648;

#define LAS __attribute__((address_space(3)))
typedef unsigned short bf16;
typedef unsigned v4u __attribute__((ext_vector_type(4)));
typedef unsigned v2u __attribute__((ext_vector_type(2)));
typedef float f32x4 __attribute__((ext_vector_type(4)));
typedef float f32x16 __attribute__((ext_vector_type(16)));
typedef short bf16x8 __attribute__((ext_vector_type(8)));
#define LDS_WAIT() asm volatile("s_waitcnt lgkmcnt(0)" ::: "memory")
using pg8::cvt_pk_bf16; using pg8::silu_f;
__device__ __forceinline__ float bf2f(unsigned short u) { return __uint_as_float((unsigned)u << 16); }
__device__ __forceinline__ float bflo(unsigned w) { return __uint_as_float(w << 16); }
__device__ __forceinline__ float bfhi(unsigned w) { return __uint_as_float(w & 0xffff0000u); }
__device__ __forceinline__ float wave_sum(float v) {
#pragma unroll
    for (int o = 1; o < 64; o <<= 1) v += __shfl_xor(v, o);
    return v;
}
__device__ __forceinline__ void unpack8(v4u w, float (&f)[8]) { f[0] = bflo(w.x); f[1] = bfhi(w.x); f[2] = bflo(w.y); f[3] = bfhi(w.y); f[4] = bflo(w.z); f[5] = bfhi(w.z); f[6] = bflo(w.w); f[7] = bfhi(w.w); }
__device__ __forceinline__ v4u pack8(const float (&f)[8]) { v4u w; w.x = cvt_pk_bf16(f[0], f[1]); w.y = cvt_pk_bf16(f[2], f[3]); w.z = cvt_pk_bf16(f[4], f[5]); w.w = cvt_pk_bf16(f[6], f[7]); return w; }

struct Args { const float* in[19]; float* out; unsigned char* ws; int ph_lo, ph_hi; };
enum { I_X = 0, I_C, I_WADA, I_BADA, I_WADAF, I_BADAF, I_GMIX, I_GFFN, I_GFIN, I_WIN, I_CWM, I_CWQ, I_ALOG, I_DTB, I_GCO, I_GDN, I_WOUT, I_WGU, I_WDN };

template <int MODE>
__device__ __forceinline__ void p0_transpose_item(const float* W, int K, int ld, int nblk, bf16* WT, LAS float* scr, int item, int lane) {
    const int kb = item / nblk, nb = item % nblk, k0 = 64 * kb, n0 = 32 * nb;
    f32x4 ld4[8];
#pragma unroll
    for (int i = 0; i < 8; ++i) ld4[i] = *(const f32x4*)(W + (size_t)(k0 + 8 * i + (lane >> 3)) * ld + n0 + 4 * (lane & 7));
#pragma unroll
    for (int i = 0; i < 8; ++i) { LAS float* d = scr + (8 * i + (lane >> 3)) * 33 + 4 * (lane & 7); d[0] = ld4[i].x; d[1] = ld4[i].y; d[2] = ld4[i].z; d[3] = ld4[i].w; }
    LDS_WAIT(); asm volatile("" ::: "memory");
    int r0 = n0;
    if (MODE == 1) { r0 = n0 < FF ? 256 * (n0 / 128) + (n0 % 128) : 256 * ((n0 - FF) / 128) + 128 + ((n0 - FF) % 128); }
    const int c = lane & 7;
#pragma unroll
    for (int j = 0; j < 4; ++j) { const int n = (lane >> 3) + 8 * j; const LAS float* s = scr + (8 * c) * 33 + n;
        v4u o; o.x = cvt_pk_bf16(s[0 * 33], s[1 * 33]); o.y = cvt_pk_bf16(s[2 * 33], s[3 * 33]); o.z = cvt_pk_bf16(s[4 * 33], s[5 * 33]); o.w = cvt_pk_bf16(s[6 * 33], s[7 * 33]);
        *(v4u*)(WT + (size_t)(r0 + n) * K + k0 + 8 * c) = o; }
    LDS_WAIT(); asm volatile("" ::: "memory");
}
__device__ __forceinline__ void p0_mod_item(const Args& a, float* MOD, const LAS float* SC, LAS float* red, int item, int tid) {
    const int c4 = tid & 7, ks = tid >> 3, col0 = item * 32;
    const bool fin = col0 >= 6144; const float* W = fin ? a.in[I_WADAF] : a.in[I_WADA]; const int ld = fin ? 2048 : 6144, cb = (fin ? col0 - 6144 : col0);
    f32x4 w[16];
#pragma unroll
    for (int kk = 0; kk < 16; ++kk) w[kk] = *(const f32x4*)(W + (size_t)(16 * ks + kk) * ld + cb + 4 * c4);
    f32x4 acc[4];
#pragma unroll
    for (int b = 0; b < 4; ++b) acc[b] = (f32x4){0.f, 0.f, 0.f, 0.f};
#pragma unroll
    for (int kk = 0; kk < 16; ++kk) { const f32x4 s = *(const LAS f32x4*)(SC + (16 * ks + kk) * 4); acc[0] += s.x * w[kk]; acc[1] += s.y * w[kk]; acc[2] += s.z * w[kk]; acc[3] += s.w * w[kk]; }
#pragma unroll
    for (int b = 0; b < 4; ++b) *(LAS f32x4*)(red + (ks * 4 + b) * 32 + 4 * c4) = acc[b];
    __syncthreads();
    if (tid < 128) { const int b = tid >> 5, cl = tid & 31; float s = 0.f;
#pragma unroll 16
        for (int k = 0; k < 64; ++k) s += red[(k * 4 + b) * 32 + cl];
        const int c = cb + cl;
        s += fin ? a.in[I_BADAF][c] : a.in[I_BADA][c];
        if (fin) MOD[4 * 6144 + b * 2048 + c] = s; else MOD[b * 6144 + c] = s; }
    __syncthreads();
}

template <int MODE>
__device__ __forceinline__ void adaln_one(const f32x4 (&xin)[4], const f32x4 (&gs)[4], const f32x4 (&sh)[4], int m, bf16* Hout, float* Fout, const LAS float* TT, const float* a_log, const float* dt_bias, float* GB, int lane) {
    f32x4 v[4]; float ss = 0.f;
#pragma unroll
    for (int j = 0; j < 4; ++j) { v[j] = xin[j]; ss += (v[j].x * v[j].x + v[j].y * v[j].y) + (v[j].z * v[j].z + v[j].w * v[j].w); }
    const float rinv = 1.0f / sqrtf(wave_sum(ss) * (1.0f / D) + EPS);
#pragma unroll
    for (int j = 0; j < 4; ++j) v[j] = (v[j] * rinv) * gs[j] + sh[j];
    if (MODE == 2) { f32x4* o = (f32x4*)(Fout + (size_t)m * D) + lane;
#pragma unroll
        for (int j = 0; j < 4; ++j) o[64 * j] = v[j];
    } else { v2u* o = (v2u*)(Hout + (size_t)m * D) + lane;
#pragma unroll
        for (int j = 0; j < 4; ++j) { v2u w; w.x = cvt_pk_bf16(v[j].x, v[j].y); w.y = cvt_pk_bf16(v[j].z, v[j].w); o[64 * j] = w; } }
    if (MODE == 0) {
        float d[8];
#pragma unroll
        for (int e = 0; e < 8; ++e) { float s = 0.f;
#pragma unroll
            for (int j = 0; j < 4; ++j) { const f32x4 t = *(const LAS f32x4*)(TT + e * 1024 + 4 * (lane + 64 * j)); s += (v[j].x * t.x + v[j].y * t.y) + (v[j].z * t.z + v[j].w * t.w); }
            asm volatile("" : "+v"(s) :: "memory"); d[e] = s; }
        float k4[4], k2[2], k1;
        { const bool hi = (lane & 32) != 0;
#pragma unroll
          for (int i = 0; i < 4; ++i) { const float snd = hi ? d[i] : d[4 + i]; const float kp = hi ? d[4 + i] : d[i]; k4[i] = kp + __shfl_xor(snd, 32); } }
        { const bool hi = (lane & 16) != 0;
#pragma unroll
          for (int i = 0; i < 2; ++i) { const float snd = hi ? k4[i] : k4[2 + i]; const float kp = hi ? k4[2 + i] : k4[i]; k2[i] = kp + __shfl_xor(snd, 16); } }
        { const bool hi = (lane & 8) != 0; const float snd = hi ? k2[0] : k2[1]; const float kp = hi ? k2[1] : k2[0]; k1 = kp + __shfl_xor(snd, 8); }
        k1 += __shfl_xor(k1, 4); k1 += __shfl_xor(k1, 2); k1 += __shfl_xor(k1, 1);
        if ((lane & 7) == 0) { const int e = lane >> 3; float r;
            if (e < 4) { const float xx = k1 + dt_bias[e]; const float sp = fmaxf(xx, 0.f) + log1pf(__expf(-fabsf(xx))); r = -__expf(a_log[e]) * sp; }
            else r = 1.0f / (1.0f + __expf(-k1));
            GB[(size_t)m * 8 + e] = r; }
    }
}
template <int MODE>
__device__ __forceinline__ void adaln_rows(const float* X, const float* gain, const float* shiftp, const float* scalep, int mstride, bf16* Hout, float* Fout,
                                           const LAS float* TT, const float* a_log, const float* dt_bias, float* GB, int gw, int NGW, int lane) {
    for (int blk = gw; blk < M / 16; blk += NGW) {
        const int m0 = blk * 16, b = m0 >> 13;
        f32x4 gs[4], sh[4];
        { const f32x4* g4 = (const f32x4*)gain + lane; const f32x4* sh4 = (const f32x4*)(shiftp + (size_t)b * mstride) + lane; const f32x4* sc4 = (const f32x4*)(scalep + (size_t)b * mstride) + lane;
#pragma unroll
          for (int j = 0; j < 4; ++j) { gs[j] = g4[64 * j] * (1.0f + sc4[64 * j]); sh[j] = sh4[64 * j]; } }
        f32x4 c0[4], c1[4];
        { const f32x4* xr = (const f32x4*)(X + (size_t)m0 * D) + lane;
#pragma unroll
          for (int j = 0; j < 4; ++j) { c0[j] = xr[64 * j]; c1[j] = xr[256 + 64 * j]; } }
#pragma unroll 1
        for (int i = 0; i < 16; i += 2) {
            f32x4 n0[4], n1[4];
            { const int mn = (i + 2 < 16) ? m0 + i + 2 : m0; const f32x4* xr = (const f32x4*)(X + (size_t)mn * D) + lane;
#pragma unroll
              for (int j = 0; j < 4; ++j) { n0[j] = xr[64 * j]; n1[j] = xr[256 + 64 * j]; } }
            adaln_one<MODE>(c0, gs, sh, m0 + i, Hout, Fout, TT, a_log, dt_bias, GB, lane);
            adaln_one<MODE>(c1, gs, sh, m0 + i + 1, Hout, Fout, TT, a_log, dt_bias, GB, lane);
#pragma unroll
            for (int j = 0; j < 4; ++j) { c0[j] = n0[j]; c1[j] = n1[j]; }
        }
    }
}

__device__ __forceinline__ void conv_qkv(const bf16* P, const float* cwq, bf16* QKV, int X, int t0, bool first, int lane) {
    const int colp = 1536 + 512 * X + 8 * lane, colo = 512 * X + 8 * lane;
    v4u raw[19];
#pragma unroll
    for (int t = 0; t < 19; ++t) { raw[t] = (v4u){0u, 0u, 0u, 0u}; if (t >= 3 || !first) raw[t] = *(const v4u*)(P + (size_t)(t0 - 3 + t) * NP + colp); }
    float w0[8], w1[8], w2[8], w3[8], h3[8], h2[8], h1[8];
#pragma unroll
    for (int e = 0; e < 8; ++e) { w0[e] = cwq[0 * 1536 + colo + e]; w1[e] = cwq[1 * 1536 + colo + e]; w2[e] = cwq[2 * 1536 + colo + e]; w3[e] = cwq[3 * 1536 + colo + e]; }
    unpack8(raw[0], h3); unpack8(raw[1], h2); unpack8(raw[2], h1);
#pragma unroll
    for (int t = 0; t < 16; ++t) { const int m = t0 + t; float x[8], y[8]; unpack8(raw[3 + t], x); float ss = 0.f;
#pragma unroll
        for (int e = 0; e < 8; ++e) { const float c = w0[e] * h3[e] + w1[e] * h2[e] + w2[e] * h1[e] + w3[e] * x[e]; y[e] = silu_f(c); ss += y[e] * y[e]; h3[e] = h2[e]; h2[e] = h1[e]; h1[e] = x[e]; }
        if (X < 2) { ss += __shfl_xor(ss, 1); ss += __shfl_xor(ss, 2); ss += __shfl_xor(ss, 4); ss += __shfl_xor(ss, 8);
            float r = 1.0f / sqrtf(ss + EPS); if (X == 0) r *= 0.08838834764831845f;
#pragma unroll
            for (int e = 0; e < 8; ++e) y[e] *= r; }
        *(v4u*)(QKV + (size_t)m * 1536 + colo) = pack8(y); }
}
__device__ __forceinline__ void conv_pass(const bf16* P, const float* cwm, const float* cwq, const float* gco, bf16* YC, bf16* QKV, int gw, int NGW, int lane) {
    for (int run = gw; run < M / 16; run += NGW) {
        const int t0 = run * 16; const bool first = (t0 & (SEQ - 1)) == 0;
        { float w0[8], w1[8], w2[8], gc[8], u2[8], u1[8]; const int c0 = 8 * lane;
#pragma unroll
          for (int e = 0; e < 8; ++e) { w0[e] = cwm[c0 + e]; w1[e] = cwm[512 + c0 + e]; w2[e] = cwm[1024 + c0 + e]; gc[e] = gco[c0 + e]; u2[e] = 0.f; u1[e] = 0.f; }
          if (!first) { float a[8], b[8]; unpack8(*(const v4u*)(P + (size_t)(t0 - 2) * NP + 512 + c0), a); unpack8(*(const v4u*)(P + (size_t)(t0 - 2) * NP + 1024 + c0), b);
#pragma unroll
              for (int e = 0; e < 8; ++e) u2[e] = a[e] * b[e];
              unpack8(*(const v4u*)(P + (size_t)(t0 - 1) * NP + 512 + c0), a); unpack8(*(const v4u*)(P + (size_t)(t0 - 1) * NP + 1024 + c0), b);
#pragma unroll
              for (int e = 0; e < 8; ++e) u1[e] = a[e] * b[e]; }
#pragma unroll 1
          for (int tb = 0; tb < 16; tb += 8) {
              v4u rb[8], rc[8], rh[8];
#pragma unroll
              for (int t = 0; t < 8; ++t) { const bf16* pr = P + (size_t)(t0 + tb + t) * NP + c0; rb[t] = *(const v4u*)pr; rc[t] = *(const v4u*)(pr + 512); rh[t] = *(const v4u*)(pr + 1024); }
#pragma unroll
              for (int t = 0; t < 8; ++t) { const int m = t0 + tb + t; float gb[8], a[8], b[8], y[8]; unpack8(rb[t], gb); unpack8(rc[t], a); unpack8(rh[t], b); float ss = 0.f;
#pragma unroll
                  for (int e = 0; e < 8; ++e) { const float u0 = a[e] * b[e]; y[e] = gb[e] * (w0[e] * u2[e] + w1[e] * u1[e] + w2[e] * u0); ss += y[e] * y[e]; u2[e] = u1[e]; u1[e] = u0; }
                  ss += __shfl_xor(ss, 1); ss += __shfl_xor(ss, 2); ss += __shfl_xor(ss, 4);
                  const float r = 1.0f / sqrtf(ss * (1.0f / 64.0f) + EPS);
#pragma unroll
                  for (int e = 0; e < 8; ++e) y[e] = y[e] * r * gc[e];
                  *(v4u*)(YC + (size_t)m * D + c0) = pack8(y); } } }
    }
}


constexpr int PREP_HALF = 69632, PK_KN = 0, PK_QN = 17408, PK_VV = 34816, PK_LM = 52224, PK_GC = 68608, PK_BT = 68864, PK_EG = 69120, PROW = 272;
template <bool SC>
__device__ __forceinline__ v4u afrag_piece_rows(const LAS unsigned char* tile, const LAS float* sc, int p) {
    const int f = p >> 6, ln = p & 63, mt = f >> 3, kt = (f >> 1) & 3, s = f & 1, r = ln & 31, hh = ln >> 5, row = 32 * mt + r, kb = 32 * kt + 16 * s + 4 * hh;
    const v2u a = *(const LAS v2u*)(tile + row * PROW + kb * 2), b = *(const LAS v2u*)(tile + row * PROW + (kb + 8) * 2);
    float scv = 1.0f; if (SC) scv = sc[row];
    v4u o; o.x = cvt_pk_bf16(bflo(a.x) * scv, bfhi(a.x) * scv); o.y = cvt_pk_bf16(bflo(a.y) * scv, bfhi(a.y) * scv); o.z = cvt_pk_bf16(bflo(b.x) * scv, bfhi(b.x) * scv); o.w = cvt_pk_bf16(bflo(b.y) * scv, bfhi(b.y) * scv);
    return o;
}
#define LBAR() do { asm volatile("s_waitcnt lgkmcnt(0)" ::: "memory"); __builtin_amdgcn_s_barrier(); asm volatile("" ::: "memory"); } while (0)
__device__ __forceinline__ void st_wt16(void* p, v4u v) { asm volatile("global_store_dwordx4 %0, %1, off sc1\n\ts_nop 1" :: "v"(p), "v"(v) : "memory"); }
__device__ __forceinline__ void st_wt4(void* p, float v) { asm volatile("global_store_dword %0, %1, off sc1\n\ts_nop 1" :: "v"(p), "v"(v) : "memory"); }
__device__ __forceinline__ void prep_phase(LAS unsigned char* lds, const bf16* P, const float* cwq, const float* GB, float* EGL, unsigned char* CH, unsigned* FLG, int ublk, int nblk, int tid) {
    const int half = tid >> 8, t = tid & 255, lane = tid & 63, w = (tid >> 6) & 3, r = lane & 31, hh = lane >> 5;
    LAS unsigned char* L = lds + half * PREP_HALF;
    LAS float* LM = (LAS float*)(L + PK_LM); LAS float* GC = (LAS float*)(L + PK_GC); LAS float* BT = (LAS float*)(L + PK_BT); LAS float* EG = (LAS float*)(L + PK_EG);
    for (int pu = ublk; pu < NBH * NCH / 2; pu += nblk) {
        const int n = pu >> 3, bh = 2 * (pu & 7) + half, cid = bh * NCH + n, b = bh >> 2, h = bh & 3, m0 = b * SEQ + n * 64;
        unsigned char* rec = CH + (size_t)cid * REC;
        LBAR();
        { const int c8 = t & 15, tg = t >> 4;
#pragma unroll
          for (int X = 0; X < 3; ++X) {
              const int colp = 1536 + 512 * X + 128 * h + 8 * c8, colw = 512 * X + 128 * h + 8 * c8;
              v4u raw[7];
#pragma unroll
              for (int i = 0; i < 7; ++i) { const int tok = 4 * tg - 3 + i; raw[i] = (v4u){0u, 0u, 0u, 0u}; if (tok >= 0 || n > 0) raw[i] = *(const v4u*)(P + (size_t)(m0 + tok) * NP + colp); }
              float w0[8], w1[8], w2[8], w3[8], h3[8], h2[8], h1[8];
#pragma unroll
              for (int e = 0; e < 8; ++e) { w0[e] = cwq[0 * 1536 + colw + e]; w1[e] = cwq[1 * 1536 + colw + e]; w2[e] = cwq[2 * 1536 + colw + e]; w3[e] = cwq[3 * 1536 + colw + e]; }
              unpack8(raw[0], h3); unpack8(raw[1], h2); unpack8(raw[2], h1);
#pragma unroll
              for (int i = 0; i < 4; ++i) { float x[8], y[8]; unpack8(raw[3 + i], x); float ss = 0.f;
#pragma unroll
                  for (int e = 0; e < 8; ++e) { const float c = w0[e] * h3[e] + w1[e] * h2[e] + w2[e] * h1[e] + w3[e] * x[e]; y[e] = silu_f(c); ss += y[e] * y[e]; h3[e] = h2[e]; h2[e] = h1[e]; h1[e] = x[e]; }
                  if (X < 2) { ss += __shfl_xor(ss, 1); ss += __shfl_xor(ss, 2); ss += __shfl_xor(ss, 4); ss += __shfl_xor(ss, 8);
                      float rr = 1.0f / sqrtf(ss + EPS); if (X == 0) rr *= 0.08838834764831845f;
#pragma unroll
                      for (int e = 0; e < 8; ++e) y[e] *= rr; }
                  *(LAS v4u*)(L + (X == 0 ? PK_QN : (X == 1 ? PK_KN : PK_VV)) + (4 * tg + i) * PROW + c8 * 16) = pack8(y); } } }
        if (w == 0) { float g = GB[(size_t)(m0 + lane) * 8 + h];
#pragma unroll
            for (int d = 1; d < 64; d <<= 1) { const float o = __shfl_up(g, d); if (lane >= d) g += o; }
            GC[lane] = g; EG[lane] = __expf(g); BT[lane] = GB[(size_t)(m0 + lane) * 8 + 4 + h];
            if (lane == 63) st_wt4(rec + 73728, __expf(g)); }
        LBAR();
        { const int mi = w >> 1, nj = w & 1;
          f32x16 kk, qk;
#pragma unroll
          for (int i = 0; i < 16; ++i) { kk[i] = 0.f; qk[i] = 0.f; }
#pragma unroll
          for (int st = 0; st < 8; ++st) {
              const bf16x8 ka = *(const LAS bf16x8*)(L + PK_KN + (32 * mi + r) * PROW + (16 * st + 8 * hh) * 2);
              const bf16x8 kb = *(const LAS bf16x8*)(L + PK_KN + (32 * nj + r) * PROW + (16 * st + 8 * hh) * 2);
              const bf16x8 qb = *(const LAS bf16x8*)(L + PK_QN + (32 * mi + r) * PROW + (16 * st + 8 * hh) * 2);
              kk = __builtin_amdgcn_mfma_f32_32x32x16_bf16(ka, kb, kk, 0, 0, 0);
              qk = __builtin_amdgcn_mfma_f32_32x32x16_bf16(kb, qb, qk, 0, 0, 0);
          }
          const float gj = GC[32 * nj + r], gq = GC[32 * mi + r];
          float av[16];
#pragma unroll
          for (int reg = 0; reg < 16; ++reg) { const int cr = (reg & 3) + 8 * (reg >> 2) + 4 * hh;
              const int i = 32 * mi + cr, j = 32 * nj + r;
              LM[i * 64 + j] = (i > j) ? BT[i] * kk[reg] * __expf(GC[i] - gj) : 0.f;
              const int key = 32 * nj + cr, qr = 32 * mi + r;
              av[reg] = (qr >= key) ? qk[reg] * __expf(gq - GC[key]) : 0.f; }
#pragma unroll
          for (int s = 0; s < 2; ++s) { v4u o; o.x = cvt_pk_bf16(av[8 * s], av[8 * s + 1]); o.y = cvt_pk_bf16(av[8 * s + 2], av[8 * s + 3]); o.z = cvt_pk_bf16(av[8 * s + 4], av[8 * s + 5]); o.w = cvt_pk_bf16(av[8 * s + 6], av[8 * s + 7]);
              st_wt16(rec + 49152 + ((mi * 2 + nj) * 2 + s) * 1024 + lane * 16, o); }
        }
#pragma unroll
        for (int i = 0; i < 4; ++i) { const int p = t + 256 * i; st_wt16(rec + 16384 + p * 16, afrag_piece_rows<true>(L + PK_QN, EG, p)); }
        { const float gl = GC[63];
#pragma unroll
          for (int i = 0; i < 4; ++i) { const int p = t + 256 * i, f = p >> 6, ln = p & 63, mt = f >> 2, ct = (f >> 1) & 1, s = f & 1, dk = 32 * mt + (ln & 31), cb = 32 * ct + 16 * s + 4 * (ln >> 5);
              float e[8];
#pragma unroll
              for (int j = 0; j < 8; ++j) { const int c = cb + 8 * (j >> 2) + (j & 3); e[j] = bf2f(*(const LAS unsigned short*)(L + PK_KN + c * PROW + dk * 2)) * __expf(gl - GC[c]); }
              st_wt16(rec + 32768 + p * 16, pack8(e)); } }
        LBAR();
        { float X[64]; const bool isu = t < 128; const int col = t & 127;
          const LAS unsigned char* src = L + (isu ? PK_VV : PK_KN) + col * 2;
#pragma unroll
          for (int i = 0; i < 64; ++i) {
              f32x4 lc[12];
#pragma unroll
              for (int j4 = 0; j4 < 12; ++j4) if (j4 < (i + 3) / 4) lc[j4] = *(const LAS f32x4*)(LM + i * 64 + 4 * j4);
              const float egi = EG[i]; const float rhs = bf2f(*(const LAS unsigned short*)(src + i * PROW)) * BT[i] * (isu ? 1.0f : egi);
              __builtin_amdgcn_sched_barrier(0);
              float a0 = 0.f, a1 = 0.f, a2 = 0.f, a3 = 0.f;
#pragma unroll
              for (int j4 = 0; j4 < (i + 3) / 4; ++j4) { f32x4 l; if (j4 < 12) l = lc[j4]; else l = *(const LAS f32x4*)(LM + i * 64 + 4 * j4);
                  if (4 * j4 + 0 < i) a0 += l.x * X[4 * j4 + 0]; if (4 * j4 + 1 < i) a1 += l.y * X[4 * j4 + 1]; if (4 * j4 + 2 < i) a2 += l.z * X[4 * j4 + 2]; if (4 * j4 + 3 < i) a3 += l.w * X[4 * j4 + 3]; }
              X[i] = rhs - ((a0 + a1) + (a2 + a3)); asm volatile("" : "+v"(X[i]) :: "memory");
              __builtin_amdgcn_sched_barrier(0); }
          LBAR();
          if (isu) { const int vs = col >> 5, dvl = col & 31;
#pragma unroll
              for (int mt = 0; mt < 2; ++mt)
#pragma unroll
                  for (int h2 = 0; h2 < 2; ++h2) { v4u* dst = (v4u*)(rec + REC_A + (size_t)(((vs * 2 + mt) * 64 + dvl + 32 * h2) * 32));
#pragma unroll
                      for (int a2 = 0; a2 < 2; ++a2) { const int i0 = 32 * mt + 4 * h2 + 16 * a2; v4u w;
                          w.x = cvt_pk_bf16(X[i0], X[i0 + 1]); w.y = cvt_pk_bf16(X[i0 + 2], X[i0 + 3]); w.z = cvt_pk_bf16(X[i0 + 8], X[i0 + 9]); w.w = cvt_pk_bf16(X[i0 + 10], X[i0 + 11]); st_wt16(dst + a2, w); } }
          } else {
#pragma unroll
              for (int i = 0; i < 64; ++i) *(LAS unsigned short*)(L + PK_VV + i * PROW + col * 2) = (unsigned short)(cvt_pk_bf16(-X[i], 0.f) & 0xffffu);
          }
        }
        LBAR();
#pragma unroll
        for (int i = 0; i < 4; ++i) { const int p = t + 256 * i; st_wt16(rec + p * 16, afrag_piece_rows<false>(L + PK_VV, EG, p)); }
        asm volatile("s_waitcnt vmcnt(0)" ::: "memory"); __syncthreads();
        if (tid == 0) {
            __hip_atomic_store(FLG + (2 * (pu & 7)) * NCH + n, 1u, __ATOMIC_RELAXED, __HIP_MEMORY_SCOPE_AGENT); __hip_atomic_store(FLG + (2 * (pu & 7) + 1) * NCH + n, 1u, __ATOMIC_RELAXED, __HIP_MEMORY_SCOPE_AGENT); }
    }
}

__device__ __forceinline__ bf16x8 pack_acc(const f32x16& x, int s) {
    v4u p; p.x = cvt_pk_bf16(x[8 * s], x[8 * s + 1]); p.y = cvt_pk_bf16(x[8 * s + 2], x[8 * s + 3]); p.z = cvt_pk_bf16(x[8 * s + 4], x[8 * s + 5]); p.w = cvt_pk_bf16(x[8 * s + 6], x[8 * s + 7]);
    return __builtin_bit_cast(bf16x8, p);
}
#define MFMA32(a, b, c) __builtin_amdgcn_mfma_f32_32x32x16_bf16((a), (b), (c), 0, 0, 0)
#define PIN_SCHED() __builtin_amdgcn_sched_barrier(0)
__device__ __forceinline__ int chain_ready(const unsigned* fl, int have, int lane) {
    for (;;) {
        const int idx = have + 1 + lane;
        const unsigned f = (idx < NCH) ? __hip_atomic_load(fl + idx, __ATOMIC_RELAXED, __HIP_MEMORY_SCOPE_AGENT) : 0u;
        const unsigned long long m = __ballot(f != 0u);
        const int pre = (m == ~0ull) ? 64 : __builtin_ctzll(~m);
        if (pre > 0) { __builtin_amdgcn_fence(__ATOMIC_ACQUIRE, "agent"); asm volatile("s_waitcnt vmcnt(0)" ::: "memory"); return have + pre; }
        __builtin_amdgcn_s_sleep(16);
    }
}
__device__ __forceinline__ void chain_phase(LAS unsigned char* lds, const unsigned char* CH, const unsigned* FLG, bf16* Oraw, int bh, int tid) {
    const int wid = __builtin_amdgcn_readfirstlane(tid >> 6), lane = tid & 63, b = bh >> 2, h = bh & 3, vs = wid & 3;
    const unsigned char* rec0 = CH + (size_t)bh * NCH * REC;
    const bool comp = wid < 4, stager = (wid >= 4);
    const int hw = wid - 4;
#define CH_MOVE(n, dstbase) do { _Pragma("unroll") for (int _i = 0; _i < 19; ++_i) { const int _pc = hw * 19 + _i; if (_pc < 73) \
        __builtin_amdgcn_global_load_lds((const unsigned*)(rec0 + (size_t)(n) * REC + _pc * 1024 + lane * 16), (LAS unsigned*)((dstbase) + _pc * 1024), 16, 0, 0); } } while (0)
#define CH_WARM(n) do { _Pragma("unroll") for (int _i = 0; _i < 10; ++_i) { const int _o = (_i * 64 + lane) * 128; \
        __builtin_amdgcn_global_load_lds((const unsigned*)(rec0 + (size_t)(n) * REC + (_o < REC ? _o : 0)), (LAS unsigned*)(dummy), 4, 0, 0); } } while (0)
    constexpr int WARM_AHEAD = 8;
    LAS unsigned char* dummy = lds + 2 * REC;
    f32x16 S[4], o0, o1;
#pragma unroll
    for (int k = 0; k < 4; ++k)
#pragma unroll
        for (int i = 0; i < 16; ++i) S[k][i] = 0.f;
#pragma unroll
    for (int i = 0; i < 16; ++i) { o0[i] = 0.f; o1[i] = 0.f; }
    const unsigned* fl = FLG + bh * NCH; int have = -1;
    if (stager) { while (have < 0) have = chain_ready(fl, have, lane); CH_MOVE(0, lds); }
    if (!comp) asm volatile("s_waitcnt vmcnt(0)" ::: "memory");
    __builtin_amdgcn_s_barrier(); asm volatile("" ::: "memory");
    for (int n = 0; n < NCH; ++n) {
        const int buf = n & 1;
        if (!comp) {
            if (stager) { if (n + 1 < NCH) { while (have < n + 1) have = chain_ready(fl, have, lane); CH_MOVE(n + 1, lds + (buf ^ 1) * REC); } asm volatile("s_waitcnt vmcnt(0)" ::: "memory"); }
            else { const int wn = n + 1 + WARM_AHEAD; if (wn < NCH) { if (have < wn) { const int idx = have + 1 + lane; const unsigned f = (idx < NCH) ? __hip_atomic_load(fl + idx, __ATOMIC_RELAXED, __HIP_MEMORY_SCOPE_AGENT) : 0u;
                        const unsigned long long m = __ballot(f != 0u); const int pre = (m == ~0ull) ? 64 : __builtin_ctzll(~m); if (pre > 0) { __builtin_amdgcn_fence(__ATOMIC_ACQUIRE, "agent"); have += pre; } }
                    if (have >= wn) CH_WARM(wn); }
                   asm volatile("s_waitcnt vmcnt(20)" ::: "memory"); }
        } else {
            const LAS unsigned char* B = lds + buf * REC + lane * 16;
            const float egl = *(const LAS float*)(lds + buf * REC + 73728);
            f32x16 v0, v1;
            { const LAS v4u* ul = (const LAS v4u*)(lds + buf * REC + 57344 + ((vs * 2) * 64 + lane) * 32);
              const v4u a0 = ul[0], a1 = ul[1], b0 = ul[128], b1 = ul[129];
              v0[0] = bflo(a0.x); v0[1] = bfhi(a0.x); v0[2] = bflo(a0.y); v0[3] = bfhi(a0.y); v0[4] = bflo(a0.z); v0[5] = bfhi(a0.z); v0[6] = bflo(a0.w); v0[7] = bfhi(a0.w);
              v0[8] = bflo(a1.x); v0[9] = bfhi(a1.x); v0[10] = bflo(a1.y); v0[11] = bfhi(a1.y); v0[12] = bflo(a1.z); v0[13] = bfhi(a1.z); v0[14] = bflo(a1.w); v0[15] = bfhi(a1.w);
              v1[0] = bflo(b0.x); v1[1] = bfhi(b0.x); v1[2] = bflo(b0.y); v1[3] = bfhi(b0.y); v1[4] = bflo(b0.z); v1[5] = bfhi(b0.z); v1[6] = bflo(b0.w); v1[7] = bfhi(b0.w);
              v1[8] = bflo(b1.x); v1[9] = bfhi(b1.x); v1[10] = bflo(b1.y); v1[11] = bfhi(b1.y); v1[12] = bflo(b1.z); v1[13] = bfhi(b1.z); v1[14] = bflo(b1.w); v1[15] = bfhi(b1.w); }
#pragma unroll
            for (int i = 0; i < 16; ++i) { o0[i] = 0.f; o1[i] = 0.f; }
#define LDF(dst, off) dst = *(const LAS bf16x8*)(B + (off))
#define LD_WQ(F, kt, s) do { LDF(F[0], ((0 * 4 + (kt)) * 2 + (s)) * 1024); LDF(F[1], ((1 * 4 + (kt)) * 2 + (s)) * 1024); LDF(F[2], 16384 + ((0 * 4 + (kt)) * 2 + (s)) * 1024); LDF(F[3], 16384 + ((1 * 4 + (kt)) * 2 + (s)) * 1024); } while (0)
#define MM_WQ(F, kt, s) do { const bf16x8 sb = pack_acc(S[kt], s); v0 = MFMA32(F[0], sb, v0); v1 = MFMA32(F[1], sb, v1); o0 = MFMA32(F[2], sb, o0); o1 = MFMA32(F[3], sb, o1); asm volatile("" : "+v"(o0), "+v"(o1)); } while (0)
#define LD_AT(F, ct) do { LDF(F[0], 49152 + ((0 * 2 + (ct)) * 2 + 0) * 1024); LDF(F[1], 49152 + ((1 * 2 + (ct)) * 2 + 0) * 1024); LDF(F[2], 49152 + ((0 * 2 + (ct)) * 2 + 1) * 1024); LDF(F[3], 49152 + ((1 * 2 + (ct)) * 2 + 1) * 1024); } while (0)
#define MM_AT(F, ct) do { o0 = MFMA32(F[0], vb[ct][0], o0); o1 = MFMA32(F[1], vb[ct][0], o1); o0 = MFMA32(F[2], vb[ct][1], o0); o1 = MFMA32(F[3], vb[ct][1], o1); } while (0)
#define LD_KD(F, ct, s) do { _Pragma("unroll") for (int q = 0; q < 4; ++q) LDF(F[q], 32768 + ((q * 2 + (ct)) * 2 + (s)) * 1024); } while (0)
#define MM_KD(F, ct, s) do { _Pragma("unroll") for (int q = 0; q < 4; ++q) S[q] = MFMA32(F[q], vb[ct][s], S[q]); } while (0)
            bf16x8 FA[4], FB[4];
            LD_WQ(FA, 0, 0); PIN_SCHED();
            LD_WQ(FB, 0, 1); PIN_SCHED(); MM_WQ(FA, 0, 0); PIN_SCHED();
            LD_WQ(FA, 1, 0); PIN_SCHED(); MM_WQ(FB, 0, 1); PIN_SCHED();
            LD_WQ(FB, 1, 1); PIN_SCHED(); MM_WQ(FA, 1, 0); PIN_SCHED();
            LD_WQ(FA, 2, 0); PIN_SCHED(); MM_WQ(FB, 1, 1); PIN_SCHED();
            LD_WQ(FB, 2, 1); PIN_SCHED(); MM_WQ(FA, 2, 0); PIN_SCHED();
            LD_WQ(FA, 3, 0); PIN_SCHED(); MM_WQ(FB, 2, 1); PIN_SCHED();
            LD_WQ(FB, 3, 1); PIN_SCHED(); MM_WQ(FA, 3, 0); PIN_SCHED();
            LD_AT(FA, 0); PIN_SCHED(); MM_WQ(FB, 3, 1); PIN_SCHED();
            bf16x8 vb[2][2];
            vb[0][0] = pack_acc(v0, 0); vb[0][1] = pack_acc(v0, 1); vb[1][0] = pack_acc(v1, 0); vb[1][1] = pack_acc(v1, 1);
            LD_AT(FB, 1); PIN_SCHED(); MM_AT(FA, 0); PIN_SCHED();
#pragma unroll
            for (int kt = 0; kt < 4; ++kt)
#pragma unroll
                for (int i = 0; i < 16; ++i) S[kt][i] *= egl;
            LD_KD(FA, 0, 0); PIN_SCHED(); MM_AT(FB, 1); PIN_SCHED();
            { bf16* op = Oraw + (size_t)(b * SEQ + n * 64 + 4 * (lane >> 5)) * 512 + h * 128 + vs * 32 + (lane & 31); asm volatile("" : "+v"(op));
#pragma unroll
              for (int reg = 0; reg < 16; ++reg) { const int cr = (reg & 3) + 8 * (reg >> 2); const unsigned pk = cvt_pk_bf16(o0[reg], o1[reg]); op[cr * 512] = (bf16)(pk & 0xffffu); op[(32 + cr) * 512] = (bf16)(pk >> 16); } }
            PIN_SCHED();
            LD_KD(FB, 0, 1); PIN_SCHED(); MM_KD(FA, 0, 0); PIN_SCHED();
            LD_KD(FA, 1, 0); PIN_SCHED(); MM_KD(FB, 0, 1); PIN_SCHED();
            LD_KD(FB, 1, 1); PIN_SCHED(); MM_KD(FA, 1, 0); PIN_SCHED();
            MM_KD(FB, 1, 1);
#undef MM_AT
#undef MM_KD
#undef LDF
#undef LD_WQ
#undef MM_WQ
#undef LD_AT
#undef LD_KD
            asm volatile("s_waitcnt lgkmcnt(0)" ::: "memory");
        }
        __builtin_amdgcn_s_barrier(); asm volatile("" ::: "memory");
    }
    asm volatile("s_waitcnt vmcnt(0)" ::: "memory");
#undef CH_MOVE
#undef CH_WARM
}
#if DN_NAIVE
__device__ __forceinline__ void naive_dn(const bf16* QKV, const float* GB, float* Oraw, int unit, int lane) {
    const int bh = unit >> 1, dv = (unit & 1) * 64 + lane, b = bh >> 2, h = bh & 3;
    float S[128];
#pragma unroll
    for (int i = 0; i < 128; ++i) S[i] = 0.f;
    for (int t = 0; t < SEQ; ++t) { const size_t m = (size_t)b * SEQ + t;
        const float al = __expf(GB[m * 8 + h]), be = GB[m * 8 + 4 + h];
        const bf16* qp = QKV + m * 1536 + h * 128; const bf16* kp = qp + 512; const float v = bf2f(qp[1024 + dv]);
        float r = 0.f;
#pragma unroll
        for (int i = 0; i < 128; ++i) { S[i] *= al; r += bf2f(kp[i]) * S[i]; if ((i & 15) == 15) asm volatile("" : "+v"(r) :: "memory"); }
        const float d = be * (v - r); float o = 0.f;
#pragma unroll
        for (int i = 0; i < 128; ++i) { S[i] += bf2f(kp[i]) * d; o += bf2f(qp[i]) * S[i]; if ((i & 15) == 15) asm volatile("" : "+v"(o) :: "memory"); }
        Oraw[m * 512 + h * 128 + dv] = o; }
}
#endif
template <bool OB16>
__device__ __forceinline__ void opost_rows(const void* Oraw_, const bf16* P, const float* gdn, bf16* YC, int gw, int NGW, int lane) {
    const float* Oraw = (const float*)Oraw_; const bf16* Ob = (const bf16*)Oraw_;
    float gd[8];
#pragma unroll
    for (int e = 0; e < 8; ++e) gd[e] = gdn[(8 * lane + e) & 127];
    for (int blk = gw; blk < M / 16; blk += NGW) { const int m0 = blk * 16;
#pragma unroll 1
        for (int i = 0; i < 16; i += 8) {
            f32x4 oa[8], ob[8]; v4u zz[8];
#pragma unroll
            for (int t = 0; t < 8; ++t) { const int m = m0 + i + t;
                if (OB16) { float f[8]; unpack8(*(const v4u*)(Ob + (size_t)m * 512 + 8 * lane), f); oa[t] = (f32x4){f[0], f[1], f[2], f[3]}; ob[t] = (f32x4){f[4], f[5], f[6], f[7]}; }
                else { const f32x4* op = (const f32x4*)(Oraw + (size_t)m * 512 + 8 * lane); oa[t] = op[0]; ob[t] = op[1]; }
                zz[t] = *(const v4u*)(P + (size_t)m * NP + 3072 + 8 * lane); }
#pragma unroll
            for (int t = 0; t < 8; ++t) { const int m = m0 + i + t; float z[8]; unpack8(zz[t], z);
                float o[8] = {oa[t].x, oa[t].y, oa[t].z, oa[t].w, ob[t].x, ob[t].y, ob[t].z, ob[t].w}; float ss = 0.f;
#pragma unroll
                for (int e = 0; e < 8; ++e) ss += o[e] * o[e];
                ss += __shfl_xor(ss, 1); ss += __shfl_xor(ss, 2); ss += __shfl_xor(ss, 4); ss += __shfl_xor(ss, 8);
                const float r = 1.0f / sqrtf(ss * (1.0f / 128.0f) + EPS);
#pragma unroll
                for (int e = 0; e < 8; ++e) o[e] = o[e] * r * gd[e] * silu_f(z[e]);
                *(v4u*)(YC + (size_t)m * D + 512 + 8 * lane) = pack8(o); } } }
}

typedef __attribute__((address_space(1))) unsigned gu32;
#define XB_TMO      128
#define XB_XCNT(j)  (256  + 64 * (j))
#define XB_XSUB(j)  (1280 + 64 * (j))
#define XB_XGEN(j)  (2304 + 64 * (j))
#define XB_TOP      3328
#define XB_TOPGEN   3392
#define XCD_BAR_WORDS 3456
#define XB_SPIN_CAP (1u << 18)

__device__ __forceinline__ unsigned xb_ld(unsigned* p)              { return __hip_atomic_load(p, __ATOMIC_RELAXED, __HIP_MEMORY_SCOPE_AGENT); }
__device__ __forceinline__ unsigned xb_add(unsigned* p, unsigned v) { return __hip_atomic_fetch_add(p, v, __ATOMIC_RELAXED, __HIP_MEMORY_SCOPE_AGENT); }
__device__ __forceinline__ unsigned xb_xcc_id() { return (unsigned)__builtin_amdgcn_s_getreg((3 << 11) | 20) & 0xFu; }
#define XB_SPIN(cond, bar) do { unsigned _sp = 0; while (cond) { __builtin_amdgcn_s_sleep(1); \
    if ((++_sp & 255u) == 0u) { if (xb_ld(&(bar)[XB_TMO])) break; if (_sp > XB_SPIN_CAP) { atomicAdd(&(bar)[XB_TMO], 1u); break; } } } } while (0)

struct XcdBarrier {
    unsigned* bar; unsigned x;
    volatile LAS unsigned* st;
};

__device__ __forceinline__ XcdBarrier xcd_barrier_post(unsigned* bar, volatile LAS unsigned* st) {
    XcdBarrier b; b.bar = bar; b.x = xb_xcc_id(); b.st = st;
    if (threadIdx.x == 0) (void)xb_add(&bar[XB_XCNT(b.x)], 1u);
    return b;
}
__device__ __forceinline__ void xcd_barrier_complete(unsigned* bar, unsigned x, unsigned& nloc, unsigned& nx) {
    const unsigned G = gridDim.x * gridDim.y * gridDim.z;
    unsigned sum, cnt, mine, sp = 0u;
    for (;;) {
        sum = 0u; cnt = 0u; mine = 0u;
#pragma unroll
        for (unsigned j = 0; j < 16; ++j) { const unsigned c = xb_ld(&bar[XB_XCNT(j)]); sum += c; cnt += (c > 0u) ? 1u : 0u; mine = (j == x) ? c : mine; }
        if (sum == G) break;
        __builtin_amdgcn_s_sleep(1);
        if ((++sp & 255u) == 0u) { if (xb_ld(&bar[XB_TMO])) break; if (sp > XB_SPIN_CAP) { atomicAdd(&bar[XB_TMO], 1u); break; } }
    }
    nloc = mine > 0u ? mine : 1u; nx = cnt > 0u ? cnt : 1u;
}

__device__ __forceinline__ void xcd_barrier(const XcdBarrier& b) {
    asm volatile("s_waitcnt vmcnt(0)" ::: "memory");
    __syncthreads();
    if (threadIdx.x == 0) {
        unsigned* bar = b.bar;
        __builtin_amdgcn_s_waitcnt(0);
        unsigned nloc = b.st[0], nx = b.st[1];
        if (nloc == 0u) { xcd_barrier_complete(bar, b.x, nloc, nx); b.st[0] = nloc; b.st[1] = nx; }
        const unsigned old = xb_add(&bar[XB_XSUB(b.x)], 1u);
        const unsigned gen = old / nloc;
        if (old + 1u == (gen + 1u) * nloc) {
            __builtin_amdgcn_fence(__ATOMIC_RELEASE, "agent");
            asm volatile("s_waitcnt vmcnt(0)" ::: "memory");
            const unsigned og = xb_add(&bar[XB_TOP], 1u);
            const unsigned tg = og / nx;
            if (og + 1u == (tg + 1u) * nx) xb_add(&bar[XB_TOPGEN], 1u);
            else XB_SPIN(xb_ld(&bar[XB_TOPGEN]) == tg, bar);
            __builtin_amdgcn_fence(__ATOMIC_ACQUIRE, "agent");
            xb_add(&bar[XB_XGEN(b.x)], 1u);
            asm volatile("s_waitcnt vmcnt(0)" ::: "memory");
        } else {
            XB_SPIN(xb_ld(&bar[XB_XGEN(b.x)]) == gen, bar);
            __builtin_amdgcn_fence(__ATOMIC_ACQUIRE, "agent");
            asm volatile("s_waitcnt vmcnt(0)" ::: "memory");
        }
    }
    __syncthreads();
}

__global__ void __launch_bounds__(NWAVES * 64, 2) fwd(Args args) {
    extern __shared__ __attribute__((aligned(16))) unsigned char lds_raw[];
    LAS unsigned char* lds = (LAS unsigned char*)lds_raw;
    int tid = threadIdx.x, lane = tid & 63, wave = __builtin_amdgcn_readfirstlane(tid >> 6);
    const int G = gridDim.x; const int bx = blockIdx.x; const int vcu = (G % 8 == 0) ? (bx % 8) * (G / 8) + bx / 8 : bx;
    int gw = vcu * NWAVES + wave; const int NGW = G * NWAVES;
#define LAUNDER() do { int tv_ = threadIdx.x; asm volatile("" : "+v"(tv_)); tid = tv_; lane = tid & 63; wave = __builtin_amdgcn_readfirstlane(tid >> 6); gw = vcu * NWAVES + wave; } while (0)
    unsigned char* ws = args.ws;
    float* MOD = (float*)(ws + WS_MOD); float* GB = (float*)(ws + WS_GB); float* EGL = (float*)(ws + WS_EGL);
    bf16* WinT = (bf16*)(ws + WS_WIN); bf16* WoT = (bf16*)(ws + WS_WO); bf16* WguT = (bf16*)(ws + WS_WGU); bf16* WdT = (bf16*)(ws + WS_WD);
    bf16* H = (bf16*)(ws + WS_H); unsigned char* CH = ws + WS_CH; bf16* P = (bf16*)(ws + WS_P); bf16* ACT = (bf16*)(ws + WS_P); bf16* YC = (bf16*)(ws + WS_YC);
    bf16* QKV = (bf16*)args.out; bf16* Oraw = (bf16*)((unsigned char*)args.out + 96 * MiB); float* OUT = args.out;
    const int lo = args.ph_lo, hi = args.ph_hi;
    volatile LAS unsigned* MISC = (volatile LAS unsigned*)(lds + LDS_BYTES - 64);
    if (tid < 16) MISC[tid] = 0u;
    __syncthreads();
    XcdBarrier bar = xcd_barrier_post((unsigned*)ws, MISC);
    if (lo < 0) cg::this_grid().sync();
#ifndef PH_MASK
#define PH_MASK 0xFFF
#endif
#define IN(k) (((PH_MASK >> (k)) & 1) && lo <= (k) && (k) < hi)
#if MK_N_LAUNCHES == 1
#define SEAM(k) do { if (IN(k) && IN((k) + 1) && (k) != 5) xcd_barrier(bar); } while (0)
#else
#define SEAM(k) do { } while (0)
#endif
#ifndef REP_MASK
#define REP_MASK 0
#endif
#define BEGIN_REP(k) for (int rep_ = 0; rep_ <= ((REP_MASK >> (k)) & 1); ++rep_) { if (rep_) xcd_barrier(bar); LAUNDER();
#define END_REP }
    BEGIN_REP(0)
    if (IN(0)) {
        LAS float* scr = (LAS float*)(lds + wave * 16384);
        constexpr int I_IN = 16 * 112, I_O = 16 * 32, I_GU = 16 * 176, I_DN = 44 * 32, NITEMS = I_IN + I_O + I_GU + I_DN;
        for (int it = gw; it < NITEMS; it += NGW) { int r = it;
            if (r < I_IN) { p0_transpose_item<0>(args.in[I_WIN], D, PIN, 112, WinT, scr, r, lane); continue; } r -= I_IN;
            if (r < I_O) { p0_transpose_item<0>(args.in[I_WOUT], D, D, 32, WoT, scr, r, lane); continue; } r -= I_O;
            if (r < I_GU) { p0_transpose_item<1>(args.in[I_WGU], D, 2 * FF, 176, WguT, scr, r, lane); continue; } r -= I_GU;
            p0_transpose_item<0>(args.in[I_WDN], FF, D, 32, WdT, scr, r, lane); }
        __syncthreads();
        { LAS float* SC = (LAS float*)lds; const float* cin = args.in[I_C];
          for (int idx = tid; idx < 4096; idx += NWAVES * 64) { const int b = idx >> 10, k = idx & 1023; const float cv = cin[idx]; SC[k * 4 + b] = cv / (1.0f + __expf(-cv)); }
          __syncthreads();
          for (int it = bx; it < 256; it += G) p0_mod_item(args, MOD, SC, (LAS float*)(lds + 16384), it, tid); }
    }
    END_REP
    SEAM(0);
    BEGIN_REP(1)
    if (IN(1)) { LAS float* TT = (LAS float*)lds; const float* wi = args.in[I_WIN];
        for (int idx = tid; idx < 8192; idx += NWAVES * 64) { const int k = idx >> 3, e = idx & 7; TT[e * 1024 + k] = wi[(size_t)k * PIN + NP + e]; }
        __syncthreads();
        adaln_rows<0>(args.in[I_X], args.in[I_GMIX], MOD + 0, MOD + 1024, 6144, H, nullptr, TT, args.in[I_ALOG], args.in[I_DTB], GB, gw, NGW, lane);
        __syncthreads(); }
    END_REP
    SEAM(1);
    BEGIN_REP(2)
    if (IN(2)) { pg8::Gemm g{H, WinT, M, NP, D}; pg8::StaticOrder S; S.init(M, NP, G, bx); pg8::EpiBf16 E{P, NP};
        pg8::gemm_phase<pg8::EpiBf16, pg8::StaticOrder, true, true>(lds, g, S, E); }
    END_REP
    SEAM(2);
    BEGIN_REP(3)
    if (IN(3)) conv_pass(P, args.in[I_CWM], args.in[I_CWQ], args.in[I_GCO], YC, QKV, gw, NGW, lane);
    END_REP
#if DN_NAIVE
    SEAM(4);
    if (IN(5)) { if (bx < 32 && wave == 0) naive_dn(QKV, GB, (float*)(ws + WS_CH), bx, lane); }
    SEAM(5);
    if (IN(6)) opost_rows<false>((const float*)(ws + WS_CH), P, args.in[I_GDN], YC, gw, NGW, lane);
#else
    BEGIN_REP(4)
    if (IN(4)) { unsigned* FLG = (unsigned*)(ws + 16384);
        if (bx < NBH) chain_phase(lds, CH, FLG, Oraw, bx, tid); else prep_phase(lds, P, args.in[I_CWQ], GB, EGL, CH, FLG, bx - NBH, G - NBH, tid); }
    END_REP
    SEAM(4);
    BEGIN_REP(6)
    if (IN(6)) opost_rows<true>(Oraw, P, args.in[I_GDN], YC, gw, NGW, lane);
    END_REP
#endif
    SEAM(6);
    BEGIN_REP(7)
    if (IN(7)) { pg8::Gemm g{YC, WoT, M, D, D}; pg8::StaticOrder S; S.init(M, D, G, bx);
        pg8::EpiResGateNorm<true> E{args.in[I_X], OUT, H, MOD + 2048, 6144, args.in[I_GFFN], MOD + 3072, MOD + 4096, 6144, (float*)(ws + WS_EGL + 524288), (unsigned*)(ws + 32768 + 8192), lds + 131072};
        pg8::gemm_phase<pg8::EpiResGateNorm<true>, pg8::StaticOrder, true, true>(lds, g, S, E); }
    END_REP
    SEAM(7);
    BEGIN_REP(8)
    if (false && IN(8)) adaln_rows<1>(OUT, args.in[I_GFFN], MOD + 3072, MOD + 4096, 6144, H, nullptr, nullptr, nullptr, nullptr, nullptr, gw, NGW, lane);
    END_REP
    BEGIN_REP(9)
    if (IN(9)) { pg8::Gemm g{H, WguT, M, 2 * FF, D}; pg8::StaticOrder S; S.init(M, 2 * FF, G, bx); pg8::EpiSwiglu E{ACT, FF};
        pg8::gemm_phase<pg8::EpiSwiglu, pg8::StaticOrder, true, true>(lds, g, S, E); }
    END_REP
    SEAM(9);
    BEGIN_REP(10)
    if (IN(10)) { pg8::Gemm g{ACT, WdT, M, D, FF}; pg8::StaticOrder S; S.init(M, D, G, bx);
        pg8::EpiResGateNorm<false> E{OUT, OUT, nullptr, MOD + 5120, 6144, args.in[I_GFIN], MOD + 4 * 6144, MOD + 4 * 6144 + 1024, 2048, (float*)(ws + WS_EGL), (unsigned*)(ws + 32768), lds + 131072};
        pg8::gemm_phase<pg8::EpiResGateNorm<false>, pg8::StaticOrder, true, true>(lds, g, S, E); }
    END_REP
    LAUNDER();
    if (IN(11) && G != 256) adaln_rows<2>(OUT, args.in[I_GFIN], MOD + 4 * 6144, MOD + 4 * 6144 + 1024, 2048, nullptr, OUT, nullptr, nullptr, nullptr, nullptr, gw, NGW, lane);
#undef IN
#undef SEAM
}

extern "C" void kernel_launch(void* const* d_in, const int* in_sizes, int n_in, void* d_out, int out_size, void* d_ws, size_t ws_size, hipStream_t stream) {
    static int grid = 0;
    if (grid == 0) {
        if (n_in != 19 || out_size != M * D || ws_size < WS_END) { fprintf(stderr, "kernel_launch: unexpected shapes (n_in %d, out %d, ws %zu)\n", n_in, out_size, ws_size); grid = -1; return; }
        int dev = 0, cus = 0;
        if (hipGetDevice(&dev) != hipSuccess || hipDeviceGetAttribute(&cus, hipDeviceAttributeMultiprocessorCount, dev) != hipSuccess) { grid = -1; return; }
        if (hipFuncSetAttribute((const void*)fwd, hipFuncAttributeMaxDynamicSharedMemorySize, LDS_BYTES) != hipSuccess) { fprintf(stderr, "kernel_launch: hipFuncSetAttribute failed\n"); grid = -1; return; }
        int per_cu = 0;
        if (hipOccupancyMaxActiveBlocksPerMultiprocessor(&per_cu, (const void*)fwd, NWAVES * 64, LDS_BYTES) != hipSuccess || per_cu < 1) { fprintf(stderr, "kernel_launch: occupancy query says %d blocks per CU\n", per_cu); }
        (void)hipGetLastError();
        grid = cus;
    }
    if (grid < 0) return;
    Args a{};
    for (int i = 0; i < 19; ++i) a.in[i] = (const float*)d_in[i];
    a.out = (float*)d_out; a.ws = (unsigned char*)d_ws;
#if MK_N_LAUNCHES == 1
    if (hipMemsetAsync(d_ws, 0, 49152, stream) != hipSuccess) { fprintf(stderr, "kernel_launch: memset of the barrier words failed\n"); return; }
    a.ph_lo = 0; a.ph_hi = PH_END;
    void* kargs[] = {&a};
    hipError_t e = hipLaunchCooperativeKernel((const void*)fwd, dim3(grid), dim3(NWAVES * 64), kargs, LDS_BYTES, stream);
    if (e != hipSuccess) fprintf(stderr, "kernel_launch: cooperative launch failed: %s (grid %d)\n", hipGetErrorString(e), grid);
#else
    for (int ph = 0; ph < PH_END; ++ph) { a.ph_lo = ph; a.ph_hi = ph + 1; hipLaunchKernelGGL(fwd, dim3(grid), dim3(NWAVES * 64), LDS_BYTES, stream, a); }
#endif
}
```

```cpp
#include <hip/hip_runtime.h>
#include <hip/hip_cooperative_groups.h>
#include <cstdio>
#include <cstdint>
namespace cg = cooperative_groups;
#ifndef MK_N_LAUNCHES
#define MK_N_LAUNCHES 1
#endif
#ifndef DN_NAIVE
#define DN_NAIVE 0
#endif
namespace pg8 {
#define PG8_LAS __attribute__((address_space(3)))
typedef unsigned short bf16_t;
typedef short bf16x8 __attribute__((ext_vector_type(8)));
typedef float f32x4 __attribute__((ext_vector_type(4)));
typedef unsigned u32x4 __attribute__((ext_vector_type(4)));
constexpr int BM = 256, BK = 64, HALF = 128, HTB = HALF * BK * 2  , STAGE_BYTES = 8 * HTB, NXCD = 8, WGM = 8;

__host__ __device__ __forceinline__ int lds_byte(int r, int c) { const int st = (r >> 4) * 2 + (c >> 5), rr = r & 15, cc = c & 31, ob = rr * 64 + cc * 2; return st * 1024 + (ob ^ (((ob >> 9) & 1) << 5)); }
__host__ __device__ __forceinline__ void stage_rc(int b, int& R, int& C) { const int st = b / 1024, sb = b % 1024, swz = sb ^ (((sb >> 9) & 1) << 5); R = (st >> 1) * 16 + swz / 64; C = (st & 1) * 32 + (swz % 64) / 2; }
__host__ __device__ __forceinline__ int perm32(int rho) { const int n = rho >> 4, i = rho & 15; return 8 * (i >> 2) + 4 * n + (i & 3); }

struct Unit { int pm, pn; };
struct Gemm { const bf16_t* A; const bf16_t* Bt; int M, N, K; };

struct StaticOrder {
    int nM, nN, nwg, G, c;
    __host__ __device__ void init(int M, int N, int G_, int c_) { nM = M / BM; nN = N / BM; nwg = nM * nN; G = G_; c = c_; }
    __host__ __device__ bool next(int i, Unit& u) const {
        const long L = (long)i * G + c; if (L >= nwg) return false;
        int wgid = (int)L; { const int q = nwg / NXCD, r = nwg % NXCD, xcd = wgid % NXCD, off = wgid / NXCD; wgid = (xcd < r ? xcd * (q + 1) : r * (q + 1) + (xcd - r) * q) + off; }
        const int nig = WGM * nN, gid = wgid / nig, fm = gid * WGM, gsz = (nM - fm) < WGM ? (nM - fm) : WGM;
        u.pm = fm + ((wgid % nig) % gsz); u.pn = (wgid % nig) / gsz; return true;
    }
    __device__ __forceinline__ void a_ready(const Unit&) const {}
    __device__ __forceinline__ void done(const Unit&) const {}
};

typedef float f32x2 __attribute__((ext_vector_type(2)));
typedef __bf16 bf16x2v __attribute__((ext_vector_type(2)));
__device__ __forceinline__ unsigned cvt_pk_bf16(float lo, float hi) { f32x2 v = {lo, hi}; bf16x2v r = __builtin_convertvector(v, bf16x2v); return __builtin_bit_cast(unsigned, r); }
__device__ __forceinline__ float silu_f(float x) { return x * __builtin_amdgcn_rcpf(1.0f + __builtin_amdgcn_exp2f(-1.4426950408889634f * x)); }

struct EpiBf16 {
    static constexpr bool PERM = true, AFTER_DRAIN = false;
    bf16_t* O; int ldc;
    __device__ __forceinline__ void operator()(const f32x4 (&acc)[2][2][4][2], const Unit& u, int wr, int wc, int fr, int fq) const {
        const int row0 = u.pm * BM + wr * 64 + fr; const int col0 = u.pn * BM + wc * 32 + 8 * fq;
#pragma unroll
        for (int ai = 0; ai < 2; ++ai)
#pragma unroll
            for (int m = 0; m < 4; ++m) { bf16_t* rowp = O + (size_t)(row0 + ai * HALF + m * 16) * ldc + col0;
#pragma unroll
                for (int bj = 0; bj < 2; ++bj) { const f32x4 v0 = acc[ai][bj][m][0], v1 = acc[ai][bj][m][1];
                    u32x4 w; w.x = cvt_pk_bf16(v0[0], v0[1]); w.y = cvt_pk_bf16(v0[2], v0[3]); w.z = cvt_pk_bf16(v1[0], v1[1]); w.w = cvt_pk_bf16(v1[2], v1[3]);
                    *(u32x4*)(rowp + bj * HALF) = w; } }
    }
};
struct EpiSwiglu {
    static constexpr bool PERM = true, AFTER_DRAIN = false;
    bf16_t* O; int ldc;
    __device__ __forceinline__ void operator()(const f32x4 (&acc)[2][2][4][2], const Unit& u, int wr, int wc, int fr, int fq) const {
        const int row0 = u.pm * BM + wr * 64 + fr; const int col0 = u.pn * HALF + wc * 32 + 8 * fq;
#pragma unroll
        for (int ai = 0; ai < 2; ++ai)
#pragma unroll
            for (int m = 0; m < 4; ++m) { bf16_t* rowp = O + (size_t)(row0 + ai * HALF + m * 16) * ldc + col0;
                const f32x4 g0 = acc[ai][0][m][0], g1 = acc[ai][0][m][1], u0 = acc[ai][1][m][0], u1 = acc[ai][1][m][1];
                u32x4 w; w.x = cvt_pk_bf16(silu_f(g0[0]) * u0[0], silu_f(g0[1]) * u0[1]); w.y = cvt_pk_bf16(silu_f(g0[2]) * u0[2], silu_f(g0[3]) * u0[3]);
                w.z = cvt_pk_bf16(silu_f(g1[0]) * u1[0], silu_f(g1[1]) * u1[1]); w.w = cvt_pk_bf16(silu_f(g1[2]) * u1[2], silu_f(g1[3]) * u1[3]);
                *(u32x4*)rowp = w; }
    }
};
struct EpiResGate {
    static constexpr bool PERM = false, AFTER_DRAIN = false;
    const float* base; float* out; const float* gate;
    int gstride;
    __device__ __forceinline__ void operator()(const f32x4 (&acc)[2][2][4][2], const Unit& u, int wr, int wc, int fr, int fq) const {
        const int b = u.pm >> 5;
        const int col0 = u.pn * BM + wc * 32 + 4 * fq; const float* gp = gate + (size_t)b * gstride + col0;
        f32x4 gv[2][2];
#pragma unroll
        for (int bj = 0; bj < 2; ++bj)
#pragma unroll
            for (int n = 0; n < 2; ++n) gv[bj][n] = *(const f32x4*)(gp + bj * HALF + n * 16);
#pragma unroll
        for (int ai = 0; ai < 2; ++ai)
#pragma unroll
            for (int m = 0; m < 4; ++m) { const size_t off = (size_t)(u.pm * BM + ai * HALF + wr * 64 + m * 16 + fr) * 1024 + col0;
#pragma unroll
                for (int bj = 0; bj < 2; ++bj)
#pragma unroll
                    for (int n = 0; n < 2; ++n) { const f32x4 bs = *(const f32x4*)(base + off + bj * HALF + n * 16);
                        *(f32x4*)(out + off + bj * HALF + n * 16) = bs + gv[bj][n] * acc[ai][bj][m][n]; } }
    }
};

template <bool MID> struct EpiResGateNorm {
    static constexpr bool PERM = false, AFTER_DRAIN = false;
    const float* base; float* out; bf16_t* hb; const float* gate; int gstride;
    const float* gain; const float* shiftp; const float* scalep; int mstride;
    float* SS; unsigned* cnt; PG8_LAS unsigned char* xl;
    __device__ __forceinline__ void operator()(f32x4 (&acc)[2][2][4][2], const Unit& u, int wr, int wc, int fr, int fq) const {
        const int tid = threadIdx.x, lane = tid & 63, wid = __builtin_amdgcn_readfirstlane(tid >> 6);
        const int b = u.pm >> 5;
        const int col0 = u.pn * BM + wc * 32 + 4 * fq; const float* gp = gate + (size_t)b * gstride + col0;
        PG8_LAS float* Pt = (PG8_LAS float*)xl; PG8_LAS float* St = (PG8_LAS float*)(xl + 4096);
        f32x4 gv[2][2];
#pragma unroll
        for (int bj = 0; bj < 2; ++bj)
#pragma unroll
            for (int n = 0; n < 2; ++n) gv[bj][n] = *(const f32x4*)(gp + bj * HALF + n * 16);
#pragma unroll
        for (int ai = 0; ai < 2; ++ai)
#pragma unroll
            for (int m = 0; m < 4; ++m) { const size_t off = (size_t)(u.pm * BM + ai * HALF + wr * 64 + m * 16 + fr) * 1024 + col0; float s = 0.f;
#pragma unroll
                for (int bj = 0; bj < 2; ++bj)
#pragma unroll
                    for (int n = 0; n < 2; ++n) { const f32x4 v = *(const f32x4*)(base + off + bj * HALF + n * 16) + gv[bj][n] * acc[ai][bj][m][n]; acc[ai][bj][m][n] = v; if (MID) *(f32x4*)(out + off + bj * HALF + n * 16) = v; s += (v.x * v.x + v.y * v.y) + (v.z * v.z + v.w * v.w); }
                s += __shfl_xor(s, 16); s += __shfl_xor(s, 32);
                if (fq == 0) Pt[(ai * HALF + wr * 64 + m * 16 + fr) * 4 + wc] = s; }
        asm volatile("s_waitcnt lgkmcnt(0)" ::: "memory"); __builtin_amdgcn_s_barrier(); asm volatile("" ::: "memory");
        if (tid < 256) { const f32x4 p = *(const PG8_LAS f32x4*)(Pt + tid * 4); const float part = (p.x + p.y) + (p.z + p.w);
            float* slot = SS + (size_t)(u.pm * BM + tid) * 4 + u.pn; asm volatile("global_store_dword %0, %1, off sc1\n\ts_nop 1" :: "v"(slot), "v"(part) : "memory"); }
        asm volatile("s_waitcnt vmcnt(0)" ::: "memory"); __builtin_amdgcn_s_barrier(); asm volatile("" ::: "memory");
        if (wid == 0) { unsigned* c = cnt + u.pm * 16;
            if (lane == 0) __hip_atomic_fetch_add(c, 1u, __ATOMIC_RELAXED, __HIP_MEMORY_SCOPE_AGENT);
            unsigned spins = 0;
            while ((unsigned)__builtin_amdgcn_readfirstlane(__hip_atomic_load(c, __ATOMIC_RELAXED, __HIP_MEMORY_SCOPE_AGENT)) < 4u && ++spins < 4000000u) __builtin_amdgcn_s_sleep(2);
            __builtin_amdgcn_fence(__ATOMIC_ACQUIRE, "agent"); asm volatile("s_waitcnt vmcnt(0)" ::: "memory"); }
        __builtin_amdgcn_s_barrier(); asm volatile("" ::: "memory");
        if (tid < 256) { const f32x4 q = *(const f32x4*)(SS + (size_t)(u.pm * BM + tid) * 4); St[tid] = 1.0f / sqrtf(((q.x + q.y) + (q.z + q.w)) * (1.0f / 1024.0f) + 1e-6f); }
        asm volatile("s_waitcnt lgkmcnt(0)" ::: "memory"); __builtin_amdgcn_s_barrier(); asm volatile("" ::: "memory");
        float rinv[2][4];
#pragma unroll
        for (int ai = 0; ai < 2; ++ai)
#pragma unroll
            for (int m = 0; m < 4; ++m) rinv[ai][m] = St[ai * HALF + wr * 64 + m * 16 + fr];
#pragma unroll
        for (int bj = 0; bj < 2; ++bj)
#pragma unroll
            for (int n = 0; n < 2; ++n) { const int c = col0 + bj * HALF + n * 16;
                const f32x4 gs = *(const f32x4*)(gain + c) * (1.0f + *(const f32x4*)(scalep + (size_t)b * mstride + c)), sh = *(const f32x4*)(shiftp + (size_t)b * mstride + c);
#pragma unroll
                for (int ai = 0; ai < 2; ++ai)
#pragma unroll
                    for (int m = 0; m < 4; ++m) { const size_t off = (size_t)(u.pm * BM + ai * HALF + wr * 64 + m * 16 + fr) * 1024 + c; const f32x4 o = (acc[ai][bj][m][n] * rinv[ai][m]) * gs + sh;
                        if (MID) { typedef unsigned u32x2v __attribute__((ext_vector_type(2))); u32x2v w; w.x = cvt_pk_bf16(o.x, o.y); w.y = cvt_pk_bf16(o.z, o.w); *(u32x2v*)(hb + off) = w; }
                        else *(f32x4*)(out + off) = o; }
                asm volatile("" ::: "memory"); }
        asm volatile("s_waitcnt lgkmcnt(0)" ::: "memory"); __builtin_amdgcn_s_barrier(); asm volatile("" ::: "memory");
    }
};

template <class Epi, class Sched, bool ALIGN_EPI = false, bool SP2 = false>
__device__ __forceinline__ void gemm_phase(PG8_LAS unsigned char* lds, const Gemm g, const Sched& S, const Epi& E) {
    const int tid = threadIdx.x, wid = __builtin_amdgcn_readfirstlane(tid >> 6), lane = tid & 63, wr = wid >> 2, wc = wid & 3, fr = lane & 15, fq = lane >> 4;
    const int K = g.K, nt = K / BK;
    unsigned voffA[2], voffB[2];
#pragma unroll
    for (int i = 0; i < 2; ++i) { int R, C; stage_rc(tid * 16 + i * 8192, R, C); const int Rb = Epi::PERM ? ((R & ~31) + perm32(R & 31)) : R;
        voffA[i] = (unsigned)(R * K + C) * 2u; voffB[i] = (unsigned)(Rb * K + C) * 2u; }
    const size_t kstep = (size_t)(BK * 2);
    const size_t hstep = (size_t)HALF * K * 2;
    const size_t tstep = 2 * hstep;
    const unsigned ldsw = (unsigned)wid * 1024u;
    const int aoff = lds_byte(wr * 64 + fr, fq * 8), boff = lds_byte(wc * 32 + fr, fq * 8);
#define PG8_SA(b, h) (((b) * 2 + (h)) * HTB)
#define PG8_SB(b, h) ((4 + (b) * 2 + (h)) * HTB)
#define PG8_STAGE(bufoff, gbase, voff) do { _Pragma("unroll") for (int _i = 0; _i < 2; ++_i) \
        __builtin_amdgcn_global_load_lds((const unsigned*)((const char*)(gbase) + (voff)[_i]), (PG8_LAS unsigned*)(lds + (bufoff) + ldsw + _i * 8192), 16, 0, 0); } while (0)
#define PG8_LDA(dst, b, h) do { _Pragma("unroll") for (int m = 0; m < 4; ++m) _Pragma("unroll") for (int k = 0; k < 2; ++k) dst[m][k] = *(const PG8_LAS bf16x8*)(lds + PG8_SA(b, h) + aoff + m * 2048 + k * 1024); } while (0)
#define PG8_LDB(dst, b, h) do { _Pragma("unroll") for (int n = 0; n < 2; ++n) _Pragma("unroll") for (int k = 0; k < 2; ++k) dst[n][k] = *(const PG8_LAS bf16x8*)(lds + PG8_SB(b, h) + boff + n * 2048 + k * 1024); } while (0)
#define PG8_MMA(ai, bj, At, Bt) do { __builtin_amdgcn_s_setprio(1); _Pragma("unroll") for (int m = 0; m < 4; ++m) _Pragma("unroll") for (int n = 0; n < 2; ++n) _Pragma("unroll") for (int k = 0; k < 2; ++k) \
        acc[ai][bj][m][n] = __builtin_amdgcn_mfma_f32_16x16x32_bf16(Bt[n][k], At[m][k], acc[ai][bj][m][n], 0, 0, 0); __builtin_amdgcn_s_setprio(0); } while (0)
#define PG8_WAIT_V(n) asm volatile("s_waitcnt vmcnt(" #n ")" ::: "memory")
#define PG8_WAIT_L(n) asm volatile("s_waitcnt lgkmcnt(" #n ")" ::: "memory")
#define PG8_BAR __builtin_amdgcn_s_barrier()
#define PG8_SCHED __builtin_amdgcn_sched_barrier(0)
    Unit cur, nxt; int ui = 0;
    if (!S.next(0, cur)) return;
    f32x4 acc[2][2][4][2];
#pragma unroll
    for (int a = 0; a < 2; ++a)
#pragma unroll
        for (int b = 0; b < 2; ++b)
#pragma unroll
            for (int m = 0; m < 4; ++m)
#pragma unroll
                for (int n = 0; n < 2; ++n) acc[a][b][m][n] = (f32x4){0.f, 0.f, 0.f, 0.f};
    bf16x8 At[4][2], B0[2][2], B1[2][2];
    const char* cA = (const char*)g.A + (size_t)cur.pm * tstep; const char* cB = (const char*)g.Bt + (size_t)cur.pn * tstep;
    S.a_ready(cur);
    if constexpr (SP2) {
        PG8_STAGE(PG8_SB(0, 0), cB, voffB); PG8_STAGE(PG8_SB(0, 1), cB + hstep, voffB); PG8_STAGE(PG8_SA(0, 0), cA, voffA); PG8_STAGE(PG8_SA(0, 1), cA + hstep, voffA);
        if (wr == 1) PG8_BAR;
        PG8_WAIT_V(2); PG8_BAR;
        PG8_STAGE(PG8_SB(1, 0), cB + kstep, voffB); PG8_STAGE(PG8_SA(1, 0), cA + kstep, voffA); PG8_STAGE(PG8_SB(1, 1), cB + hstep + kstep, voffB);
        PG8_WAIT_V(6); PG8_BAR;
    } else {
        PG8_STAGE(PG8_SB(0, 0), cB, voffB); PG8_STAGE(PG8_SA(0, 0), cA, voffA); PG8_STAGE(PG8_SB(0, 1), cB + hstep, voffB); PG8_STAGE(PG8_SA(0, 1), cA + hstep, voffA);
        if (wr == 1) PG8_BAR;
        PG8_WAIT_V(4); PG8_BAR;
        PG8_STAGE(PG8_SB(1, 0), cB + kstep, voffB); PG8_STAGE(PG8_SA(1, 0), cA + kstep, voffA); PG8_STAGE(PG8_SB(1, 1), cB + hstep + kstep, voffB);
        PG8_WAIT_V(6); PG8_BAR;
    }
    for (;;) {
        const bool has_next = S.next(ui + 1, nxt);
        const char* nA = has_next ? (const char*)g.A + (size_t)nxt.pm * tstep : cA; const char* nB = has_next ? (const char*)g.Bt + (size_t)nxt.pn * tstep : cB;
        for (int t = 0; t < nt; t += 2) {
            const bool last = (t == nt - 2);
            const char* a1 = cA + (size_t)(t + 1) * kstep;
            const char* a2 = last ? nA : cA + (size_t)(t + 2) * kstep; const char* b2 = last ? nB : cB + (size_t)(t + 2) * kstep;
            const char* a3 = a2 + kstep; const char* b3 = b2 + kstep;
            if (last && has_next) S.a_ready(nxt);
            if constexpr (SP2) {
            PG8_LDB(B0, 0, 0); PG8_LDB(B1, 0, 1); PG8_SCHED; PG8_LDA(At, 0, 0); PG8_STAGE(PG8_SA(1, 1), a1 + hstep, voffA);
            PG8_WAIT_V(8); PG8_WAIT_L(0); PG8_BAR; PG8_MMA(0, 0, At, B0); PG8_MMA(0, 1, At, B1); PG8_BAR; PG8_SCHED;
            PG8_LDA(At, 0, 1); PG8_STAGE(PG8_SB(0, 0), b2, voffB); PG8_STAGE(PG8_SB(0, 1), b2 + hstep, voffB); PG8_STAGE(PG8_SA(0, 0), a2, voffA);
            PG8_WAIT_V(8); PG8_WAIT_L(0); PG8_BAR; PG8_MMA(1, 0, At, B0); PG8_MMA(1, 1, At, B1); PG8_BAR; PG8_SCHED;
            PG8_LDB(B0, 1, 0); PG8_LDB(B1, 1, 1); PG8_SCHED; PG8_LDA(At, 1, 0); PG8_STAGE(PG8_SA(0, 1), a2 + hstep, voffA);
            PG8_WAIT_V(8); PG8_WAIT_L(0); PG8_BAR; PG8_MMA(0, 0, At, B0); PG8_MMA(0, 1, At, B1); PG8_BAR; PG8_SCHED;
            PG8_LDA(At, 1, 1); PG8_STAGE(PG8_SB(1, 0), b3, voffB); PG8_STAGE(PG8_SB(1, 1), b3 + hstep, voffB); PG8_STAGE(PG8_SA(1, 0), a3, voffA);
            PG8_WAIT_V(8); PG8_WAIT_L(0); PG8_BAR; PG8_MMA(1, 0, At, B0); PG8_MMA(1, 1, At, B1); PG8_BAR; PG8_SCHED;
            } else {
            PG8_LDB(B0, 0, 0); PG8_SCHED; PG8_LDA(At, 0, 0); PG8_STAGE(PG8_SA(1, 1), a1 + hstep, voffA);
            PG8_WAIT_L(8); PG8_BAR; PG8_WAIT_L(0); PG8_MMA(0, 0, At, B0); PG8_BAR; PG8_SCHED;
            PG8_LDB(B1, 0, 1); PG8_STAGE(PG8_SB(0, 0), b2, voffB);
            PG8_BAR; PG8_WAIT_L(0); PG8_MMA(0, 1, At, B1); PG8_BAR;
            PG8_LDA(At, 0, 1); PG8_STAGE(PG8_SA(0, 0), a2, voffA);
            PG8_BAR; PG8_WAIT_L(0); PG8_MMA(1, 0, At, B0); PG8_BAR; PG8_SCHED;
            PG8_STAGE(PG8_SB(0, 1), b2 + hstep, voffB);
            PG8_WAIT_V(6); PG8_BAR; PG8_MMA(1, 1, At, B1); PG8_BAR;
            PG8_LDB(B0, 1, 0); PG8_SCHED; PG8_LDA(At, 1, 0); PG8_STAGE(PG8_SA(0, 1), a2 + hstep, voffA);
            PG8_WAIT_L(8); PG8_BAR; PG8_WAIT_L(0); PG8_MMA(0, 0, At, B0); PG8_BAR; PG8_SCHED;
            PG8_LDB(B1, 1, 1); PG8_STAGE(PG8_SB(1, 0), b3, voffB);
            PG8_BAR; PG8_WAIT_L(0); PG8_MMA(0, 1, At, B1); PG8_BAR;
            PG8_LDA(At, 1, 1); PG8_STAGE(PG8_SA(1, 0), a3, voffA);
            PG8_BAR; PG8_WAIT_L(0); PG8_MMA(1, 0, At, B0); PG8_BAR; PG8_SCHED;
            PG8_STAGE(PG8_SB(1, 1), b3 + hstep, voffB);
            PG8_WAIT_V(6); PG8_BAR; PG8_MMA(1, 1, At, B1); PG8_BAR;
            }
        }
        if constexpr (ALIGN_EPI) { if (wr == 0) PG8_BAR; }
        if constexpr (!Epi::AFTER_DRAIN) { E(acc, cur, wr, wc, fr, fq); S.done(cur); }
        if (!has_next) break;
#pragma unroll
        for (int a = 0; a < 2; ++a)
#pragma unroll
            for (int b = 0; b < 2; ++b)
#pragma unroll
                for (int m = 0; m < 4; ++m)
#pragma unroll
                    for (int n = 0; n < 2; ++n) acc[a][b][m][n] = (f32x4){0.f, 0.f, 0.f, 0.f};
        cur = nxt; cA = nA; cB = nB; ++ui;
        if constexpr (ALIGN_EPI) { if (wr == 1) PG8_BAR; }
    }
    PG8_WAIT_V(0);
    if constexpr (!ALIGN_EPI) { if (wr == 0) PG8_BAR; }
    PG8_BAR;
    if constexpr (Epi::AFTER_DRAIN) { E.fused(acc, cur, wr, wc, fr, fq, lds, wid, lane); S.done(cur); }
#undef PG8_SA
#undef PG8_SB
#undef PG8_STAGE
#undef PG8_LDA
#undef PG8_LDB
#undef PG8_MMA
#undef PG8_WAIT_V
#undef PG8_WAIT_L
#undef PG8_BAR
#undef PG8_SCHED
}
}

constexpr int NWAVES = 8;
constexpr int BATCH = 4, SEQ = 8192, D = 1024, M = BATCH * SEQ;
constexpr int PIN = 3592, NP = 3584;
constexpr int FF = 2816, NCH = 128, NBH = 16;
constexpr int PH_END = 12;
constexpr float EPS = 1e-6f;
constexpr size_t MiB = 1u << 20;
constexpr size_t WS_MOD = 1 * MiB;
constexpr size_t WS_GB = 2 * MiB;
constexpr size_t WS_EGL = 3 * MiB;
constexpr size_t WS_WIN = 4 * MiB, WS_WO = 11 * MiB, WS_WGU = 13 * MiB, WS_WD = 24 * MiB;
constexpr size_t WS_H = 32 * MiB;
constexpr size_t WS_CH = 32 * MiB;
constexpr size_t WS_P = 208 * MiB;
constexpr size_t WS_YC = 432 * MiB;
constexpr size_t WS_END = 496 * MiB;
constexpr int REC = 74752;
constexpr int REC_A = 57344;
constexpr int LDS_BYTES = 155648;

#define LAS __attribute__((address_space(3)))
typedef unsigned short bf16;
typedef unsigned v4u __attribute__((ext_vector_type(4)));
typedef unsigned v2u __attribute__((ext_vector_type(2)));
typedef float f32x4 __attribute__((ext_vector_type(4)));
typedef float f32x16 __attribute__((ext_vector_type(16)));
typedef short bf16x8 __attribute__((ext_vector_type(8)));
#define LDS_WAIT() asm volatile("s_waitcnt lgkmcnt(0)" ::: "memory")
using pg8::cvt_pk_bf16; using pg8::silu_f;
__device__ __forceinline__ float bf2f(unsigned short u) { return __uint_as_float((unsigned)u << 16); }
__device__ __forceinline__ float bflo(unsigned w) { return __uint_as_float(w << 16); }
__device__ __forceinline__ float bfhi(unsigned w) { return __uint_as_float(w & 0xffff0000u); }
__device__ __forceinline__ float wave_sum(float v) {
#pragma unroll
    for (int o = 1; o < 64; o <<= 1) v += __shfl_xor(v, o);
    return v;
}
__device__ __forceinline__ void unpack8(v4u w, float (&f)[8]) { f[0] = bflo(w.x); f[1] = bfhi(w.x); f[2] = bflo(w.y); f[3] = bfhi(w.y); f[4] = bflo(w.z); f[5] = bfhi(w.z); f[6] = bflo(w.w); f[7] = bfhi(w.w); }
__device__ __forceinline__ v4u pack8(const float (&f)[8]) { v4u w; w.x = cvt_pk_bf16(f[0], f[1]); w.y = cvt_pk_bf16(f[2], f[3]); w.z = cvt_pk_bf16(f[4], f[5]); w.w = cvt_pk_bf16(f[6], f[7]); return w; }

struct Args { const float* in[19]; float* out; unsigned char* ws; int ph_lo, ph_hi; };
enum { I_X = 0, I_C, I_WADA, I_BADA, I_WADAF, I_BADAF, I_GMIX, I_GFFN, I_GFIN, I_WIN, I_CWM, I_CWQ, I_ALOG, I_DTB, I_GCO, I_GDN, I_WOUT, I_WGU, I_WDN };

template <int MODE>
__device__ __forceinline__ void p0_transpose_item(const float* W, int K, int ld, int nblk, bf16* WT, LAS float* scr, int item, int lane) {
    const int kb = item / nblk, nb = item % nblk, k0 = 64 * kb, n0 = 32 * nb;
    f32x4 ld4[8];
#pragma unroll
    for (int i = 0; i < 8; ++i) ld4[i] = *(const f32x4*)(W + (size_t)(k0 + 8 * i + (lane >> 3)) * ld + n0 + 4 * (lane & 7));
#pragma unroll
    for (int i = 0; i < 8; ++i) { LAS float* d = scr + (8 * i + (lane >> 3)) * 33 + 4 * (lane & 7); d[0] = ld4[i].x; d[1] = ld4[i].y; d[2] = ld4[i].z; d[3] = ld4[i].w; }
    LDS_WAIT(); asm volatile("" ::: "memory");
    int r0 = n0;
    if (MODE == 1) { r0 = n0 < FF ? 256 * (n0 / 128) + (n0 % 128) : 256 * ((n0 - FF) / 128) + 128 + ((n0 - FF) % 128); }
    const int c = lane & 7;
#pragma unroll
    for (int j = 0; j < 4; ++j) { const int n = (lane >> 3) + 8 * j; const LAS float* s = scr + (8 * c) * 33 + n;
        v4u o; o.x = cvt_pk_bf16(s[0 * 33], s[1 * 33]); o.y = cvt_pk_bf16(s[2 * 33], s[3 * 33]); o.z = cvt_pk_bf16(s[4 * 33], s[5 * 33]); o.w = cvt_pk_bf16(s[6 * 33], s[7 * 33]);
        *(v4u*)(WT + (size_t)(r0 + n) * K + k0 + 8 * c) = o; }
    LDS_WAIT(); asm volatile("" ::: "memory");
}
__device__ __forceinline__ void p0_mod_item(const Args& a, float* MOD, const LAS float* SC, LAS float* red, int item, int tid) {
    const int c4 = tid & 7, ks = tid >> 3, col0 = item * 32;
    const bool fin = col0 >= 6144; const float* W = fin ? a.in[I_WADAF] : a.in[I_WADA]; const int ld = fin ? 2048 : 6144, cb = (fin ? col0 - 6144 : col0);
    f32x4 w[16];
#pragma unroll
    for (int kk = 0; kk < 16; ++kk) w[kk] = *(const f32x4*)(W + (size_t)(16 * ks + kk) * ld + cb + 4 * c4);
    f32x4 acc[4];
#pragma unroll
    for (int b = 0; b < 4; ++b) acc[b] = (f32x4){0.f, 0.f, 0.f, 0.f};
#pragma unroll
    for (int kk = 0; kk < 16; ++kk) { const f32x4 s = *(const LAS f32x4*)(SC + (16 * ks + kk) * 4); acc[0] += s.x * w[kk]; acc[1] += s.y * w[kk]; acc[2] += s.z * w[kk]; acc[3] += s.w * w[kk]; }
#pragma unroll
    for (int b = 0; b < 4; ++b) *(LAS f32x4*)(red + (ks * 4 + b) * 32 + 4 * c4) = acc[b];
    __syncthreads();
    if (tid < 128) { const int b = tid >> 5, cl = tid & 31; float s = 0.f;
#pragma unroll 16
        for (int k = 0; k < 64; ++k) s += red[(k * 4 + b) * 32 + cl];
        const int c = cb + cl;
        s += fin ? a.in[I_BADAF][c] : a.in[I_BADA][c];
        if (fin) MOD[4 * 6144 + b * 2048 + c] = s; else MOD[b * 6144 + c] = s; }
    __syncthreads();
}

template <int MODE>
__device__ __forceinline__ void adaln_one(const f32x4 (&xin)[4], const f32x4 (&gs)[4], const f32x4 (&sh)[4], int m, bf16* Hout, float* Fout, const LAS float* TT, const float* a_log, const float* dt_bias, float* GB, int lane) {
    f32x4 v[4]; float ss = 0.f;
#pragma unroll
    for (int j = 0; j < 4; ++j) { v[j] = xin[j]; ss += (v[j].x * v[j].x + v[j].y * v[j].y) + (v[j].z * v[j].z + v[j].w * v[j].w); }
    const float rinv = 1.0f / sqrtf(wave_sum(ss) * (1.0f / D) + EPS);
#pragma unroll
    for (int j = 0; j < 4; ++j) v[j] = (v[j] * rinv) * gs[j] + sh[j];
    if (MODE == 2) { f32x4* o = (f32x4*)(Fout + (size_t)m * D) + lane;
#pragma unroll
        for (int j = 0; j < 4; ++j) o[64 * j] = v[j];
    } else { v2u* o = (v2u*)(Hout + (size_t)m * D) + lane;
#pragma unroll
        for (int j = 0; j < 4; ++j) { v2u w; w.x = cvt_pk_bf16(v[j].x, v[j].y); w.y = cvt_pk_bf16(v[j].z, v[j].w); o[64 * j] = w; } }
    if (MODE == 0) {
        float d[8];
#pragma unroll
        for (int e = 0; e < 8; ++e) { float s = 0.f;
#pragma unroll
            for (int j = 0; j < 4; ++j) { const f32x4 t = *(const LAS f32x4*)(TT + e * 1024 + 4 * (lane + 64 * j)); s += (v[j].x * t.x + v[j].y * t.y) + (v[j].z * t.z + v[j].w * t.w); }
            asm volatile("" : "+v"(s) :: "memory"); d[e] = s; }
        float k4[4], k2[2], k1;
        { const bool hi = (lane & 32) != 0;
#pragma unroll
          for (int i = 0; i < 4; ++i) { const float snd = hi ? d[i] : d[4 + i]; const float kp = hi ? d[4 + i] : d[i]; k4[i] = kp + __shfl_xor(snd, 32); } }
        { const bool hi = (lane & 16) != 0;
#pragma unroll
          for (int i = 0; i < 2; ++i) { const float snd = hi ? k4[i] : k4[2 + i]; const float kp = hi ? k4[2 + i] : k4[i]; k2[i] = kp + __shfl_xor(snd, 16); } }
        { const bool hi = (lane & 8) != 0; const float snd = hi ? k2[0] : k2[1]; const float kp = hi ? k2[1] : k2[0]; k1 = kp + __shfl_xor(snd, 8); }
        k1 += __shfl_xor(k1, 4); k1 += __shfl_xor(k1, 2); k1 += __shfl_xor(k1, 1);
        if ((lane & 7) == 0) { const int e = lane >> 3; float r;
            if (e < 4) { const float xx = k1 + dt_bias[e]; const float sp = fmaxf(xx, 0.f) + log1pf(__expf(-fabsf(xx))); r = -__expf(a_log[e]) * sp; }
            else r = 1.0f / (1.0f + __expf(-k1));
            GB[(size_t)m * 8 + e] = r; }
    }
}
template <int MODE>
__device__ __forceinline__ void adaln_rows(const float* X, const float* gain, const float* shiftp, const float* scalep, int mstride, bf16* Hout, float* Fout,
                                           const LAS float* TT, const float* a_log, const float* dt_bias, float* GB, int gw, int NGW, int lane) {
    for (int blk = gw; blk < M / 16; blk += NGW) {
        const int m0 = blk * 16, b = m0 >> 13;
        f32x4 gs[4], sh[4];
        { const f32x4* g4 = (const f32x4*)gain + lane; const f32x4* sh4 = (const f32x4*)(shiftp + (size_t)b * mstride) + lane; const f32x4* sc4 = (const f32x4*)(scalep + (size_t)b * mstride) + lane;
#pragma unroll
          for (int j = 0; j < 4; ++j) { gs[j] = g4[64 * j] * (1.0f + sc4[64 * j]); sh[j] = sh4[64 * j]; } }
        f32x4 c0[4], c1[4];
        { const f32x4* xr = (const f32x4*)(X + (size_t)m0 * D) + lane;
#pragma unroll
          for (int j = 0; j < 4; ++j) { c0[j] = xr[64 * j]; c1[j] = xr[256 + 64 * j]; } }
#pragma unroll 1
        for (int i = 0; i < 16; i += 2) {
            f32x4 n0[4], n1[4];
            { const int mn = (i + 2 < 16) ? m0 + i + 2 : m0; const f32x4* xr = (const f32x4*)(X + (size_t)mn * D) + lane;
#pragma unroll
              for (int j = 0; j < 4; ++j) { n0[j] = xr[64 * j]; n1[j] = xr[256 + 64 * j]; } }
            adaln_one<MODE>(c0, gs, sh, m0 + i, Hout, Fout, TT, a_log, dt_bias, GB, lane);
            adaln_one<MODE>(c1, gs, sh, m0 + i + 1, Hout, Fout, TT, a_log, dt_bias, GB, lane);
#pragma unroll
            for (int j = 0; j < 4; ++j) { c0[j] = n0[j]; c1[j] = n1[j]; }
        }
    }
}

__device__ __forceinline__ void conv_qkv(const bf16* P, const float* cwq, bf16* QKV, int X, int t0, bool first, int lane) {
    const int colp = 1536 + 512 * X + 8 * lane, colo = 512 * X + 8 * lane;
    v4u raw[19];
#pragma unroll
    for (int t = 0; t < 19; ++t) { raw[t] = (v4u){0u, 0u, 0u, 0u}; if (t >= 3 || !first) raw[t] = *(const v4u*)(P + (size_t)(t0 - 3 + t) * NP + colp); }
    float w0[8], w1[8], w2[8], w3[8], h3[8], h2[8], h1[8];
#pragma unroll
    for (int e = 0; e < 8; ++e) { w0[e] = cwq[0 * 1536 + colo + e]; w1[e] = cwq[1 * 1536 + colo + e]; w2[e] = cwq[2 * 1536 + colo + e]; w3[e] = cwq[3 * 1536 + colo + e]; }
    unpack8(raw[0], h3); unpack8(raw[1], h2); unpack8(raw[2], h1);
#pragma unroll
    for (int t = 0; t < 16; ++t) { const int m = t0 + t; float x[8], y[8]; unpack8(raw[3 + t], x); float ss = 0.f;
#pragma unroll
        for (int e = 0; e < 8; ++e) { const float c = w0[e] * h3[e] + w1[e] * h2[e] + w2[e] * h1[e] + w3[e] * x[e]; y[e] = silu_f(c); ss += y[e] * y[e]; h3[e] = h2[e]; h2[e] = h1[e]; h1[e] = x[e]; }
        if (X < 2) { ss += __shfl_xor(ss, 1); ss += __shfl_xor(ss, 2); ss += __shfl_xor(ss, 4); ss += __shfl_xor(ss, 8);
            float r = 1.0f / sqrtf(ss + EPS); if (X == 0) r *= 0.08838834764831845f;
#pragma unroll
            for (int e = 0; e < 8; ++e) y[e] *= r; }
        *(v4u*)(QKV + (size_t)m * 1536 + colo) = pack8(y); }
}
__device__ __forceinline__ void conv_pass(const bf16* P, const float* cwm, const float* cwq, const float* gco, bf16* YC, bf16* QKV, int gw, int NGW, int lane) {
    for (int run = gw; run < M / 16; run += NGW) {
        const int t0 = run * 16; const bool first = (t0 & (SEQ - 1)) == 0;
        { float w0[8], w1[8], w2[8], gc[8], u2[8], u1[8]; const int c0 = 8 * lane;
#pragma unroll
          for (int e = 0; e < 8; ++e) { w0[e] = cwm[c0 + e]; w1[e] = cwm[512 + c0 + e]; w2[e] = cwm[1024 + c0 + e]; gc[e] = gco[c0 + e]; u2[e] = 0.f; u1[e] = 0.f; }
          if (!first) { float a[8], b[8]; unpack8(*(const v4u*)(P + (size_t)(t0 - 2) * NP + 512 + c0), a); unpack8(*(const v4u*)(P + (size_t)(t0 - 2) * NP + 1024 + c0), b);
#pragma unroll
              for (int e = 0; e < 8; ++e) u2[e] = a[e] * b[e];
              unpack8(*(const v4u*)(P + (size_t)(t0 - 1) * NP + 512 + c0), a); unpack8(*(const v4u*)(P + (size_t)(t0 - 1) * NP + 1024 + c0), b);
#pragma unroll
              for (int e = 0; e < 8; ++e) u1[e] = a[e] * b[e]; }
#pragma unroll 1
          for (int tb = 0; tb < 16; tb += 8) {
              v4u rb[8], rc[8], rh[8];
#pragma unroll
              for (int t = 0; t < 8; ++t) { const bf16* pr = P + (size_t)(t0 + tb + t) * NP + c0; rb[t] = *(const v4u*)pr; rc[t] = *(const v4u*)(pr + 512); rh[t] = *(const v4u*)(pr + 1024); }
#pragma unroll
              for (int t = 0; t < 8; ++t) { const int m = t0 + tb + t; float gb[8], a[8], b[8], y[8]; unpack8(rb[t], gb); unpack8(rc[t], a); unpack8(rh[t], b); float ss = 0.f;
#pragma unroll
                  for (int e = 0; e < 8; ++e) { const float u0 = a[e] * b[e]; y[e] = gb[e] * (w0[e] * u2[e] + w1[e] * u1[e] + w2[e] * u0); ss += y[e] * y[e]; u2[e] = u1[e]; u1[e] = u0; }
                  ss += __shfl_xor(ss, 1); ss += __shfl_xor(ss, 2); ss += __shfl_xor(ss, 4);
                  const float r = 1.0f / sqrtf(ss * (1.0f / 64.0f) + EPS);
#pragma unroll
                  for (int e = 0; e < 8; ++e) y[e] = y[e] * r * gc[e];
                  *(v4u*)(YC + (size_t)m * D + c0) = pack8(y); } } }
    }
}


constexpr int PREP_HALF = 69632, PK_KN = 0, PK_QN = 17408, PK_VV = 34816, PK_LM = 52224, PK_GC = 68608, PK_BT = 68864, PK_EG = 69120, PROW = 272;
template <bool SC>
__device__ __forceinline__ v4u afrag_piece_rows(const LAS unsigned char* tile, const LAS float* sc, int p) {
    const int f = p >> 6, ln = p & 63, mt = f >> 3, kt = (f >> 1) & 3, s = f & 1, r = ln & 31, hh = ln >> 5, row = 32 * mt + r, kb = 32 * kt + 16 * s + 4 * hh;
    const v2u a = *(const LAS v2u*)(tile + row * PROW + kb * 2), b = *(const LAS v2u*)(tile + row * PROW + (kb + 8) * 2);
    float scv = 1.0f; if (SC) scv = sc[row];
    v4u o; o.x = cvt_pk_bf16(bflo(a.x) * scv, bfhi(a.x) * scv); o.y = cvt_pk_bf16(bflo(a.y) * scv, bfhi(a.y) * scv); o.z = cvt_pk_bf16(bflo(b.x) * scv, bfhi(b.x) * scv); o.w = cvt_pk_bf16(bflo(b.y) * scv, bfhi(b.y) * scv);
    return o;
}
#define LBAR() do { asm volatile("s_waitcnt lgkmcnt(0)" ::: "memory"); __builtin_amdgcn_s_barrier(); asm volatile("" ::: "memory"); } while (0)
__device__ __forceinline__ void st_wt16(void* p, v4u v) { asm volatile("global_store_dwordx4 %0, %1, off sc1\n\ts_nop 1" :: "v"(p), "v"(v) : "memory"); }
__device__ __forceinline__ void st_wt4(void* p, float v) { asm volatile("global_store_dword %0, %1, off sc1\n\ts_nop 1" :: "v"(p), "v"(v) : "memory"); }
__device__ __forceinline__ void prep_phase(LAS unsigned char* lds, const bf16* P, const float* cwq, const float* GB, float* EGL, unsigned char* CH, unsigned* FLG, int ublk, int nblk, int tid) {
    const int half = tid >> 8, t = tid & 255, lane = tid & 63, w = (tid >> 6) & 3, r = lane & 31, hh = lane >> 5;
    LAS unsigned char* L = lds + half * PREP_HALF;
    LAS float* LM = (LAS float*)(L + PK_LM); LAS float* GC = (LAS float*)(L + PK_GC); LAS float* BT = (LAS float*)(L + PK_BT); LAS float* EG = (LAS float*)(L + PK_EG);
    for (int pu = ublk; pu < NBH * NCH / 2; pu += nblk) {
        const int n = pu >> 3, bh = 2 * (pu & 7) + half, cid = bh * NCH + n, b = bh >> 2, h = bh & 3, m0 = b * SEQ + n * 64;
        unsigned char* rec = CH + (size_t)cid * REC;
        LBAR();
        { const int c8 = t & 15, tg = t >> 4;
#pragma unroll
          for (int X = 0; X < 3; ++X) {
              const int colp = 1536 + 512 * X + 128 * h + 8 * c8, colw = 512 * X + 128 * h + 8 * c8;
              v4u raw[7];
#pragma unroll
              for (int i = 0; i < 7; ++i) { const int tok = 4 * tg - 3 + i; raw[i] = (v4u){0u, 0u, 0u, 0u}; if (tok >= 0 || n > 0) raw[i] = *(const v4u*)(P + (size_t)(m0 + tok) * NP + colp); }
              float w0[8], w1[8], w2[8], w3[8], h3[8], h2[8], h1[8];
#pragma unroll
              for (int e = 0; e < 8; ++e) { w0[e] = cwq[0 * 1536 + colw + e]; w1[e] = cwq[1 * 1536 + colw + e]; w2[e] = cwq[2 * 1536 + colw + e]; w3[e] = cwq[3 * 1536 + colw + e]; }
              unpack8(raw[0], h3); unpack8(raw[1], h2); unpack8(raw[2], h1);
#pragma unroll
              for (int i = 0; i < 4; ++i) { float x[8], y[8]; unpack8(raw[3 + i], x); float ss = 0.f;
#pragma unroll
                  for (int e = 0; e < 8; ++e) { const float c = w0[e] * h3[e] + w1[e] * h2[e] + w2[e] * h1[e] + w3[e] * x[e]; y[e] = silu_f(c); ss += y[e] * y[e]; h3[e] = h2[e]; h2[e] = h1[e]; h1[e] = x[e]; }
                  if (X < 2) { ss += __shfl_xor(ss, 1); ss += __shfl_xor(ss, 2); ss += __shfl_xor(ss, 4); ss += __shfl_xor(ss, 8);
                      float rr = 1.0f / sqrtf(ss + EPS); if (X == 0) rr *= 0.08838834764831845f;
#pragma unroll
                      for (int e = 0; e < 8; ++e) y[e] *= rr; }
                  *(LAS v4u*)(L + (X == 0 ? PK_QN : (X == 1 ? PK_KN : PK_VV)) + (4 * tg + i) * PROW + c8 * 16) = pack8(y); } } }
        if (w == 0) { float g = GB[(size_t)(m0 + lane) * 8 + h];
#pragma unroll
            for (int d = 1; d < 64; d <<= 1) { const float o = __shfl_up(g, d); if (lane >= d) g += o; }
            GC[lane] = g; EG[lane] = __expf(g); BT[lane] = GB[(size_t)(m0 + lane) * 8 + 4 + h];
            if (lane == 63) st_wt4(rec + 73728, __expf(g)); }
        LBAR();
        { const int mi = w >> 1, nj = w & 1;
          f32x16 kk, qk;
#pragma unroll
          for (int i = 0; i < 16; ++i) { kk[i] = 0.f; qk[i] = 0.f; }
#pragma unroll
          for (int st = 0; st < 8; ++st) {
              const bf16x8 ka = *(const LAS bf16x8*)(L + PK_KN + (32 * mi + r) * PROW + (16 * st + 8 * hh) * 2);
              const bf16x8 kb = *(const LAS bf16x8*)(L + PK_KN + (32 * nj + r) * PROW + (16 * st + 8 * hh) * 2);
              const bf16x8 qb = *(const LAS bf16x8*)(L + PK_QN + (32 * mi + r) * PROW + (16 * st + 8 * hh) * 2);
              kk = __builtin_amdgcn_mfma_f32_32x32x16_bf16(ka, kb, kk, 0, 0, 0);
              qk = __builtin_amdgcn_mfma_f32_32x32x16_bf16(kb, qb, qk, 0, 0, 0);
          }
          const float gj = GC[32 * nj + r], gq = GC[32 * mi + r];
          float av[16];
#pragma unroll
          for (int reg = 0; reg < 16; ++reg) { const int cr = (reg & 3) + 8 * (reg >> 2) + 4 * hh;
              const int i = 32 * mi + cr, j = 32 * nj + r;
              LM[i * 64 + j] = (i > j) ? BT[i] * kk[reg] * __expf(GC[i] - gj) : 0.f;
              const int key = 32 * nj + cr, qr = 32 * mi + r;
              av[reg] = (qr >= key) ? qk[reg] * __expf(gq - GC[key]) : 0.f; }
#pragma unroll
          for (int s = 0; s < 2; ++s) { v4u o; o.x = cvt_pk_bf16(av[8 * s], av[8 * s + 1]); o.y = cvt_pk_bf16(av[8 * s + 2], av[8 * s + 3]); o.z = cvt_pk_bf16(av[8 * s + 4], av[8 * s + 5]); o.w = cvt_pk_bf16(av[8 * s + 6], av[8 * s + 7]);
              st_wt16(rec + 49152 + ((mi * 2 + nj) * 2 + s) * 1024 + lane * 16, o); }
        }
#pragma unroll
        for (int i = 0; i < 4; ++i) { const int p = t + 256 * i; st_wt16(rec + 16384 + p * 16, afrag_piece_rows<true>(L + PK_QN, EG, p)); }
        { const float gl = GC[63];
#pragma unroll
          for (int i = 0; i < 4; ++i) { const int p = t + 256 * i, f = p >> 6, ln = p & 63, mt = f >> 2, ct = (f >> 1) & 1, s = f & 1, dk = 32 * mt + (ln & 31), cb = 32 * ct + 16 * s + 4 * (ln >> 5);
              float e[8];
#pragma unroll
              for (int j = 0; j < 8; ++j) { const int c = cb + 8 * (j >> 2) + (j & 3); e[j] = bf2f(*(const LAS unsigned short*)(L + PK_KN + c * PROW + dk * 2)) * __expf(gl - GC[c]); }
              st_wt16(rec + 32768 + p * 16, pack8(e)); } }
        LBAR();
        { float X[64]; const bool isu = t < 128; const int col = t & 127;
          const LAS unsigned char* src = L + (isu ? PK_VV : PK_KN) + col * 2;
#pragma unroll
          for (int i = 0; i < 64; ++i) {
              f32x4 lc[12];
#pragma unroll
              for (int j4 = 0; j4 < 12; ++j4) if (j4 < (i + 3) / 4) lc[j4] = *(const LAS f32x4*)(LM + i * 64 + 4 * j4);
              const float egi = EG[i]; const float rhs = bf2f(*(const LAS unsigned short*)(src + i * PROW)) * BT[i] * (isu ? 1.0f : egi);
              __builtin_amdgcn_sched_barrier(0);
              float a0 = 0.f, a1 = 0.f, a2 = 0.f, a3 = 0.f;
#pragma unroll
              for (int j4 = 0; j4 < (i + 3) / 4; ++j4) { f32x4 l; if (j4 < 12) l = lc[j4]; else l = *(const LAS f32x4*)(LM + i * 64 + 4 * j4);
                  if (4 * j4 + 0 < i) a0 += l.x * X[4 * j4 + 0]; if (4 * j4 + 1 < i) a1 += l.y * X[4 * j4 + 1]; if (4 * j4 + 2 < i) a2 += l.z * X[4 * j4 + 2]; if (4 * j4 + 3 < i) a3 += l.w * X[4 * j4 + 3]; }
              X[i] = rhs - ((a0 + a1) + (a2 + a3)); asm volatile("" : "+v"(X[i]) :: "memory");
              __builtin_amdgcn_sched_barrier(0); }
          LBAR();
          if (isu) { const int vs = col >> 5, dvl = col & 31;
#pragma unroll
              for (int mt = 0; mt < 2; ++mt)
#pragma unroll
                  for (int h2 = 0; h2 < 2; ++h2) { v4u* dst = (v4u*)(rec + REC_A + (size_t)(((vs * 2 + mt) * 64 + dvl + 32 * h2) * 32));
#pragma unroll
                      for (int a2 = 0; a2 < 2; ++a2) { const int i0 = 32 * mt + 4 * h2 + 16 * a2; v4u w;
                          w.x = cvt_pk_bf16(X[i0], X[i0 + 1]); w.y = cvt_pk_bf16(X[i0 + 2], X[i0 + 3]); w.z = cvt_pk_bf16(X[i0 + 8], X[i0 + 9]); w.w = cvt_pk_bf16(X[i0 + 10], X[i0 + 11]); st_wt16(dst + a2, w); } }
          } else {
#pragma unroll
              for (int i = 0; i < 64; ++i) *(LAS unsigned short*)(L + PK_VV + i * PROW + col * 2) = (unsigned short)(cvt_pk_bf16(-X[i], 0.f) & 0xffffu);
          }
        }
        LBAR();
#pragma unroll
        for (int i = 0; i < 4; ++i) { const int p = t + 256 * i; st_wt16(rec + p * 16, afrag_piece_rows<false>(L + PK_VV, EG, p)); }
        asm volatile("s_waitcnt vmcnt(0)" ::: "memory"); __syncthreads();
        if (tid == 0) {
            __hip_atomic_store(FLG + (2 * (pu & 7)) * NCH + n, 1u, __ATOMIC_RELAXED, __HIP_MEMORY_SCOPE_AGENT); __hip_atomic_store(FLG + (2 * (pu & 7) + 1) * NCH + n, 1u, __ATOMIC_RELAXED, __HIP_MEMORY_SCOPE_AGENT); }
    }
}

__device__ __forceinline__ bf16x8 pack_acc(const f32x16& x, int s) {
    v4u p; p.x = cvt_pk_bf16(x[8 * s], x[8 * s + 1]); p.y = cvt_pk_bf16(x[8 * s + 2], x[8 * s + 3]); p.z = cvt_pk_bf16(x[8 * s + 4], x[8 * s + 5]); p.w = cvt_pk_bf16(x[8 * s + 6], x[8 * s + 7]);
    return __builtin_bit_cast(bf16x8, p);
}
#define MFMA32(a, b, c) __builtin_amdgcn_mfma_f32_32x32x16_bf16((a), (b), (c), 0, 0, 0)
#define PIN_SCHED() __builtin_amdgcn_sched_barrier(0)
__device__ __forceinline__ int chain_ready(const unsigned* fl, int have, int lane) {
    for (;;) {
        const int idx = have + 1 + lane;
        const unsigned f = (idx < NCH) ? __hip_atomic_load(fl + idx, __ATOMIC_RELAXED, __HIP_MEMORY_SCOPE_AGENT) : 0u;
        const unsigned long long m = __ballot(f != 0u);
        const int pre = (m == ~0ull) ? 64 : __builtin_ctzll(~m);
        if (pre > 0) { __builtin_amdgcn_fence(__ATOMIC_ACQUIRE, "agent"); asm volatile("s_waitcnt vmcnt(0)" ::: "memory"); return have + pre; }
        __builtin_amdgcn_s_sleep(16);
    }
}
__device__ __forceinline__ void chain_phase(LAS unsigned char* lds, const unsigned char* CH, const unsigned* FLG, bf16* Oraw, int bh, int tid) {
    const int wid = __builtin_amdgcn_readfirstlane(tid >> 6), lane = tid & 63, b = bh >> 2, h = bh & 3, vs = wid & 3;
    const unsigned char* rec0 = CH + (size_t)bh * NCH * REC;
    const bool comp = wid < 4, stager = (wid >= 4);
    const int hw = wid - 4;
#define CH_MOVE(n, dstbase) do { _Pragma("unroll") for (int _i = 0; _i < 19; ++_i) { const int _pc = hw * 19 + _i; if (_pc < 73) \
        __builtin_amdgcn_global_load_lds((const unsigned*)(rec0 + (size_t)(n) * REC + _pc * 1024 + lane * 16), (LAS unsigned*)((dstbase) + _pc * 1024), 16, 0, 0); } } while (0)
#define CH_WARM(n) do { _Pragma("unroll") for (int _i = 0; _i < 10; ++_i) { const int _o = (_i * 64 + lane) * 128; \
        __builtin_amdgcn_global_load_lds((const unsigned*)(rec0 + (size_t)(n) * REC + (_o < REC ? _o : 0)), (LAS unsigned*)(dummy), 4, 0, 0); } } while (0)
    constexpr int WARM_AHEAD = 8;
    LAS unsigned char* dummy = lds + 2 * REC;
    f32x16 S[4], o0, o1;
#pragma unroll
    for (int k = 0; k < 4; ++k)
#pragma unroll
        for (int i = 0; i < 16; ++i) S[k][i] = 0.f;
#pragma unroll
    for (int i = 0; i < 16; ++i) { o0[i] = 0.f; o1[i] = 0.f; }
    const unsigned* fl = FLG + bh * NCH; int have = -1;
    if (stager) { while (have < 0) have = chain_ready(fl, have, lane); CH_MOVE(0, lds); }
    if (!comp) asm volatile("s_waitcnt vmcnt(0)" ::: "memory");
    __builtin_amdgcn_s_barrier(); asm volatile("" ::: "memory");
    for (int n = 0; n < NCH; ++n) {
        const int buf = n & 1;
        if (!comp) {
            if (stager) { if (n + 1 < NCH) { while (have < n + 1) have = chain_ready(fl, have, lane); CH_MOVE(n + 1, lds + (buf ^ 1) * REC); } asm volatile("s_waitcnt vmcnt(0)" ::: "memory"); }
            else { const int wn = n + 1 + WARM_AHEAD; if (wn < NCH) { if (have < wn) { const int idx = have + 1 + lane; const unsigned f = (idx < NCH) ? __hip_atomic_load(fl + idx, __ATOMIC_RELAXED, __HIP_MEMORY_SCOPE_AGENT) : 0u;
                        const unsigned long long m = __ballot(f != 0u); const int pre = (m == ~0ull) ? 64 : __builtin_ctzll(~m); if (pre > 0) { __builtin_amdgcn_fence(__ATOMIC_ACQUIRE, "agent"); have += pre; } }
                    if (have >= wn) CH_WARM(wn); }
                   asm volatile("s_waitcnt vmcnt(20)" ::: "memory"); }
        } else {
            const LAS unsigned char* B = lds + buf * REC + lane * 16;
            const unsigned Baddr = (unsigned)(unsigned long long)B;
            const float egl = *(const LAS float*)(lds + buf * REC + 73728);
            f32x16 v0, v1;
            { const LAS v4u* ul = (const LAS v4u*)(lds + buf * REC + 57344 + ((vs * 2) * 64 + lane) * 32);
              const v4u a0 = ul[0], a1 = ul[1], b0 = ul[128], b1 = ul[129];
              v0[0] = bflo(a0.x); v0[1] = bfhi(a0.x); v0[2] = bflo(a0.y); v0[3] = bfhi(a0.y); v0[4] = bflo(a0.z); v0[5] = bfhi(a0.z); v0[6] = bflo(a0.w); v0[7] = bfhi(a0.w);
              v0[8] = bflo(a1.x); v0[9] = bfhi(a1.x); v0[10] = bflo(a1.y); v0[11] = bfhi(a1.y); v0[12] = bflo(a1.z); v0[13] = bfhi(a1.z); v0[14] = bflo(a1.w); v0[15] = bfhi(a1.w);
              v1[0] = bflo(b0.x); v1[1] = bfhi(b0.x); v1[2] = bflo(b0.y); v1[3] = bfhi(b0.y); v1[4] = bflo(b0.z); v1[5] = bfhi(b0.z); v1[6] = bflo(b0.w); v1[7] = bfhi(b0.w);
              v1[8] = bflo(b1.x); v1[9] = bfhi(b1.x); v1[10] = bflo(b1.y); v1[11] = bfhi(b1.y); v1[12] = bflo(b1.z); v1[13] = bfhi(b1.z); v1[14] = bflo(b1.w); v1[15] = bfhi(b1.w); }
#pragma unroll
            for (int i = 0; i < 16; ++i) { o0[i] = 0.f; o1[i] = 0.f; }
#define LDF(dst, off) asm volatile("ds_read_b128 %0, %1 offset:%2" : "=v"(dst) : "v"(Baddr), "i"(off))
#define WAITF(F, n) asm volatile("s_waitcnt lgkmcnt(" #n ")" : "+v"(F[0]), "+v"(F[1]), "+v"(F[2]), "+v"(F[3]))
#define LD_WQ(F, kt, s) do { LDF(F[0], ((0 * 4 + (kt)) * 2 + (s)) * 1024); LDF(F[1], ((1 * 4 + (kt)) * 2 + (s)) * 1024); LDF(F[2], 16384 + ((0 * 4 + (kt)) * 2 + (s)) * 1024); LDF(F[3], 16384 + ((1 * 4 + (kt)) * 2 + (s)) * 1024); } while (0)
#define MM_WQ(F, kt, s) do { const bf16x8 sb = pack_acc(S[kt], s); v0 = MFMA32(F[0], sb, v0); v1 = MFMA32(F[1], sb, v1); o0 = MFMA32(F[2], sb, o0); o1 = MFMA32(F[3], sb, o1); asm volatile("" : "+v"(o0), "+v"(o1)); } while (0)
#define LD_AT(F, ct) do { LDF(F[0], 49152 + ((0 * 2 + (ct)) * 2 + 0) * 1024); LDF(F[1], 49152 + ((1 * 2 + (ct)) * 2 + 0) * 1024); LDF(F[2], 49152 + ((0 * 2 + (ct)) * 2 + 1) * 1024); LDF(F[3], 49152 + ((1 * 2 + (ct)) * 2 + 1) * 1024); } while (0)
#define MM_AT(F, ct) do { o0 = MFMA32(F[0], vb[ct][0], o0); o1 = MFMA32(F[1], vb[ct][0], o1); o0 = MFMA32(F[2], vb[ct][1], o0); o1 = MFMA32(F[3], vb[ct][1], o1); } while (0)
#define LD_KD(F, ct, s) do { _Pragma("unroll") for (int q = 0; q < 4; ++q) LDF(F[q], 32768 + ((q * 2 + (ct)) * 2 + (s)) * 1024); } while (0)
#define MM_KD(F, ct, s) do { _Pragma("unroll") for (int q = 0; q < 4; ++q) S[q] = MFMA32(F[q], vb[ct][s], S[q]); } while (0)
            bf16x8 FA[4], FB[4];
            LD_WQ(FA, 0, 0); PIN_SCHED();
            LD_WQ(FB, 0, 1); WAITF(FA, 4); PIN_SCHED(); MM_WQ(FA, 0, 0); PIN_SCHED();
            LD_WQ(FA, 1, 0); WAITF(FB, 4); PIN_SCHED(); MM_WQ(FB, 0, 1); PIN_SCHED();
            LD_WQ(FB, 1, 1); WAITF(FA, 4); PIN_SCHED(); MM_WQ(FA, 1, 0); PIN_SCHED();
            LD_WQ(FA, 2, 0); WAITF(FB, 4); PIN_SCHED(); MM_WQ(FB, 1, 1); PIN_SCHED();
            LD_WQ(FB, 2, 1); WAITF(FA, 4); PIN_SCHED(); MM_WQ(FA, 2, 0); PIN_SCHED();
            LD_WQ(FA, 3, 0); WAITF(FB, 4); PIN_SCHED(); MM_WQ(FB, 2, 1); PIN_SCHED();
            LD_WQ(FB, 3, 1); WAITF(FA, 4); PIN_SCHED(); MM_WQ(FA, 3, 0); PIN_SCHED();
            LD_AT(FA, 0); WAITF(FB, 4); PIN_SCHED(); MM_WQ(FB, 3, 1); PIN_SCHED();
            bf16x8 vb[2][2];
            vb[0][0] = pack_acc(v0, 0); vb[0][1] = pack_acc(v0, 1); vb[1][0] = pack_acc(v1, 0); vb[1][1] = pack_acc(v1, 1);
            LD_AT(FB, 1); WAITF(FA, 4); PIN_SCHED(); MM_AT(FA, 0); PIN_SCHED();
            LD_KD(FA, 0, 0); WAITF(FB, 4); PIN_SCHED();
#pragma unroll
            for (int kt = 0; kt < 4; ++kt)
#pragma unroll
                for (int i = 0; i < 16; ++i) S[kt][i] *= egl;
            MM_AT(FB, 1); PIN_SCHED();
            LD_KD(FB, 0, 1); WAITF(FA, 4);
            { bf16* op = Oraw + (size_t)(b * SEQ + n * 64 + 4 * (lane >> 5)) * 512 + h * 128 + vs * 32 + (lane & 31); asm volatile("" : "+v"(op));
#pragma unroll
              for (int reg = 0; reg < 16; ++reg) { const int cr = (reg & 3) + 8 * (reg >> 2); const unsigned pk = cvt_pk_bf16(o0[reg], o1[reg]); op[cr * 512] = (bf16)(pk & 0xffffu); op[(32 + cr) * 512] = (bf16)(pk >> 16); } }
            MM_KD(FA, 0, 0); PIN_SCHED();
            LD_KD(FA, 1, 0); WAITF(FB, 4); PIN_SCHED(); MM_KD(FB, 0, 1); PIN_SCHED();
            LD_KD(FB, 1, 1); WAITF(FA, 4); PIN_SCHED(); MM_KD(FA, 1, 0); PIN_SCHED();
            WAITF(FB, 0); PIN_SCHED(); MM_KD(FB, 1, 1);
#undef MM_AT
#undef MM_KD
#undef LDF
#undef WAITF
#undef LD_WQ
#undef MM_WQ
#undef LD_AT
#undef LD_KD
            asm volatile("s_waitcnt lgkmcnt(0)" ::: "memory");
        }
        __builtin_amdgcn_s_barrier(); asm volatile("" ::: "memory");
    }
    asm volatile("s_waitcnt vmcnt(0)" ::: "memory");
#undef CH_MOVE
#undef CH_WARM
}
#if DN_NAIVE
__device__ __forceinline__ void naive_dn(const bf16* QKV, const float* GB, float* Oraw, int unit, int lane) {
    const int bh = unit >> 1, dv = (unit & 1) * 64 + lane, b = bh >> 2, h = bh & 3;
    float S[128];
#pragma unroll
    for (int i = 0; i < 128; ++i) S[i] = 0.f;
    for (int t = 0; t < SEQ; ++t) { const size_t m = (size_t)b * SEQ + t;
        const float al = __expf(GB[m * 8 + h]), be = GB[m * 8 + 4 + h];
        const bf16* qp = QKV + m * 1536 + h * 128; const bf16* kp = qp + 512; const float v = bf2f(qp[1024 + dv]);
        float r = 0.f;
#pragma unroll
        for (int i = 0; i < 128; ++i) { S[i] *= al; r += bf2f(kp[i]) * S[i]; if ((i & 15) == 15) asm volatile("" : "+v"(r) :: "memory"); }
        const float d = be * (v - r); float o = 0.f;
#pragma unroll
        for (int i = 0; i < 128; ++i) { S[i] += bf2f(kp[i]) * d; o += bf2f(qp[i]) * S[i]; if ((i & 15) == 15) asm volatile("" : "+v"(o) :: "memory"); }
        Oraw[m * 512 + h * 128 + dv] = o; }
}
#endif
template <bool OB16>
__device__ __forceinline__ void opost_rows(const void* Oraw_, const bf16* P, const float* gdn, bf16* YC, int gw, int NGW, int lane) {
    const float* Oraw = (const float*)Oraw_; const bf16* Ob = (const bf16*)Oraw_;
    float gd[8];
#pragma unroll
    for (int e = 0; e < 8; ++e) gd[e] = gdn[(8 * lane + e) & 127];
    for (int blk = gw; blk < M / 16; blk += NGW) { const int m0 = blk * 16;
#pragma unroll 1
        for (int i = 0; i < 16; i += 8) {
            f32x4 oa[8], ob[8]; v4u zz[8];
#pragma unroll
            for (int t = 0; t < 8; ++t) { const int m = m0 + i + t;
                if (OB16) { float f[8]; unpack8(*(const v4u*)(Ob + (size_t)m * 512 + 8 * lane), f); oa[t] = (f32x4){f[0], f[1], f[2], f[3]}; ob[t] = (f32x4){f[4], f[5], f[6], f[7]}; }
                else { const f32x4* op = (const f32x4*)(Oraw + (size_t)m * 512 + 8 * lane); oa[t] = op[0]; ob[t] = op[1]; }
                zz[t] = *(const v4u*)(P + (size_t)m * NP + 3072 + 8 * lane); }
#pragma unroll
            for (int t = 0; t < 8; ++t) { const int m = m0 + i + t; float z[8]; unpack8(zz[t], z);
                float o[8] = {oa[t].x, oa[t].y, oa[t].z, oa[t].w, ob[t].x, ob[t].y, ob[t].z, ob[t].w}; float ss = 0.f;
#pragma unroll
                for (int e = 0; e < 8; ++e) ss += o[e] * o[e];
                ss += __shfl_xor(ss, 1); ss += __shfl_xor(ss, 2); ss += __shfl_xor(ss, 4); ss += __shfl_xor(ss, 8);
                const float r = 1.0f / sqrtf(ss * (1.0f / 128.0f) + EPS);
#pragma unroll
                for (int e = 0; e < 8; ++e) o[e] = o[e] * r * gd[e] * silu_f(z[e]);
                *(v4u*)(YC + (size_t)m * D + 512 + 8 * lane) = pack8(o); } } }
}

typedef __attribute__((address_space(1))) unsigned gu32;
#define XB_TMO      128
#define XB_XCNT(j)  (256  + 64 * (j))
#define XB_XSUB(j)  (1280 + 64 * (j))
#define XB_XGEN(j)  (2304 + 64 * (j))
#define XB_TOP      3328
#define XB_TOPGEN   3392
#define XCD_BAR_WORDS 3456
#define XB_SPIN_CAP (1u << 18)

__device__ __forceinline__ unsigned xb_ld(unsigned* p)              { return __hip_atomic_load(p, __ATOMIC_RELAXED, __HIP_MEMORY_SCOPE_AGENT); }
__device__ __forceinline__ unsigned xb_add(unsigned* p, unsigned v) { return __hip_atomic_fetch_add(p, v, __ATOMIC_RELAXED, __HIP_MEMORY_SCOPE_AGENT); }
__device__ __forceinline__ unsigned xb_xcc_id() { return (unsigned)__builtin_amdgcn_s_getreg((3 << 11) | 20) & 0xFu; }
#define XB_SPIN(cond, bar) do { unsigned _sp = 0; while (cond) { __builtin_amdgcn_s_sleep(1); \
    if ((++_sp & 255u) == 0u) { if (xb_ld(&(bar)[XB_TMO])) break; if (_sp > XB_SPIN_CAP) { atomicAdd(&(bar)[XB_TMO], 1u); break; } } } } while (0)

struct XcdBarrier {
    unsigned* bar; unsigned x;
    volatile LAS unsigned* st;
};

__device__ __forceinline__ XcdBarrier xcd_barrier_post(unsigned* bar, volatile LAS unsigned* st) {
    XcdBarrier b; b.bar = bar; b.x = xb_xcc_id(); b.st = st;
    if (threadIdx.x == 0) (void)xb_add(&bar[XB_XCNT(b.x)], 1u);
    return b;
}
__device__ __forceinline__ void xcd_barrier_complete(unsigned* bar, unsigned x, unsigned& nloc, unsigned& nx) {
    const unsigned G = gridDim.x * gridDim.y * gridDim.z;
    unsigned sum, cnt, mine, sp = 0u;
    for (;;) {
        sum = 0u; cnt = 0u; mine = 0u;
#pragma unroll
        for (unsigned j = 0; j < 16; ++j) { const unsigned c = xb_ld(&bar[XB_XCNT(j)]); sum += c; cnt += (c > 0u) ? 1u : 0u; mine = (j == x) ? c : mine; }
        if (sum == G) break;
        __builtin_amdgcn_s_sleep(1);
        if ((++sp & 255u) == 0u) { if (xb_ld(&bar[XB_TMO])) break; if (sp > XB_SPIN_CAP) { atomicAdd(&bar[XB_TMO], 1u); break; } }
    }
    nloc = mine > 0u ? mine : 1u; nx = cnt > 0u ? cnt : 1u;
}

__device__ __forceinline__ void xcd_barrier(const XcdBarrier& b) {
    asm volatile("s_waitcnt vmcnt(0)" ::: "memory");
    __syncthreads();
    if (threadIdx.x == 0) {
        unsigned* bar = b.bar;
        __builtin_amdgcn_s_waitcnt(0);
        unsigned nloc = b.st[0], nx = b.st[1];
        if (nloc == 0u) { xcd_barrier_complete(bar, b.x, nloc, nx); b.st[0] = nloc; b.st[1] = nx; }
        const unsigned old = xb_add(&bar[XB_XSUB(b.x)], 1u);
        const unsigned gen = old / nloc;
        if (old + 1u == (gen + 1u) * nloc) {
            __builtin_amdgcn_fence(__ATOMIC_RELEASE, "agent");
            asm volatile("s_waitcnt vmcnt(0)" ::: "memory");
            const unsigned og = xb_add(&bar[XB_TOP], 1u);
            const unsigned tg = og / nx;
            if (og + 1u == (tg + 1u) * nx) xb_add(&bar[XB_TOPGEN], 1u);
            else XB_SPIN(xb_ld(&bar[XB_TOPGEN]) == tg, bar);
            __builtin_amdgcn_fence(__ATOMIC_ACQUIRE, "agent");
            xb_add(&bar[XB_XGEN(b.x)], 1u);
            asm volatile("s_waitcnt vmcnt(0)" ::: "memory");
        } else {
            XB_SPIN(xb_ld(&bar[XB_XGEN(b.x)]) == gen, bar);
            __builtin_amdgcn_fence(__ATOMIC_ACQUIRE, "agent");
            asm volatile("s_waitcnt vmcnt(0)" ::: "memory");
        }
    }
    __syncthreads();
}

__global__ void __launch_bounds__(NWAVES * 64, 2) fwd(Args args) {
    extern __shared__ __attribute__((aligned(16))) unsigned char lds_raw[];
    LAS unsigned char* lds = (LAS unsigned char*)lds_raw;
    int tid = threadIdx.x, lane = tid & 63, wave = __builtin_amdgcn_readfirstlane(tid >> 6);
    const int G = gridDim.x; const int bx = blockIdx.x; const int vcu = (G % 8 == 0) ? (bx % 8) * (G / 8) + bx / 8 : bx;
    int gw = vcu * NWAVES + wave; const int NGW = G * NWAVES;
#define LAUNDER() do { int tv_ = threadIdx.x; asm volatile("" : "+v"(tv_)); tid = tv_; lane = tid & 63; wave = __builtin_amdgcn_readfirstlane(tid >> 6); gw = vcu * NWAVES + wave; } while (0)
    unsigned char* ws = args.ws;
    float* MOD = (float*)(ws + WS_MOD); float* GB = (float*)(ws + WS_GB); float* EGL = (float*)(ws + WS_EGL);
    bf16* WinT = (bf16*)(ws + WS_WIN); bf16* WoT = (bf16*)(ws + WS_WO); bf16* WguT = (bf16*)(ws + WS_WGU); bf16* WdT = (bf16*)(ws + WS_WD);
    bf16* H = (bf16*)(ws + WS_H); unsigned char* CH = ws + WS_CH; bf16* P = (bf16*)(ws + WS_P); bf16* ACT = (bf16*)(ws + WS_P); bf16* YC = (bf16*)(ws + WS_YC);
    bf16* QKV = (bf16*)args.out; bf16* Oraw = (bf16*)((unsigned char*)args.out + 96 * MiB); float* OUT = args.out;
    const int lo = args.ph_lo, hi = args.ph_hi;
    volatile LAS unsigned* MISC = (volatile LAS unsigned*)(lds + LDS_BYTES - 64);
    if (tid < 16) MISC[tid] = 0u;
    __syncthreads();
    XcdBarrier bar = xcd_barrier_post((unsigned*)ws, MISC);
    if (lo < 0) cg::this_grid().sync();
#ifndef PH_MASK
#define PH_MASK 0xFFF
#endif
#define IN(k) (((PH_MASK >> (k)) & 1) && lo <= (k) && (k) < hi)
#if MK_N_LAUNCHES == 1
#define SEAM(k) do { if (IN(k) && IN((k) + 1) && (k) != 5) xcd_barrier(bar); } while (0)
#else
#define SEAM(k) do { } while (0)
#endif
#ifndef REP_MASK
#define REP_MASK 0
#endif
#define BEGIN_REP(k) for (int rep_ = 0; rep_ <= ((REP_MASK >> (k)) & 1); ++rep_) { if (rep_) xcd_barrier(bar); LAUNDER();
#define END_REP }
    BEGIN_REP(0)
    if (IN(0)) {
        LAS float* scr = (LAS float*)(lds + wave * 16384);
        constexpr int I_IN = 16 * 112, I_O = 16 * 32, I_GU = 16 * 176, I_DN = 44 * 32, NITEMS = I_IN + I_O + I_GU + I_DN;
        for (int it = gw; it < NITEMS; it += NGW) { int r = it;
            if (r < I_IN) { p0_transpose_item<0>(args.in[I_WIN], D, PIN, 112, WinT, scr, r, lane); continue; } r -= I_IN;
            if (r < I_O) { p0_transpose_item<0>(args.in[I_WOUT], D, D, 32, WoT, scr, r, lane); continue; } r -= I_O;
            if (r < I_GU) { p0_transpose_item<1>(args.in[I_WGU], D, 2 * FF, 176, WguT, scr, r, lane); continue; } r -= I_GU;
            p0_transpose_item<0>(args.in[I_WDN], FF, D, 32, WdT, scr, r, lane); }
        __syncthreads();
        { LAS float* SC = (LAS float*)lds; const float* cin = args.in[I_C];
          for (int idx = tid; idx < 4096; idx += NWAVES * 64) { const int b = idx >> 10, k = idx & 1023; const float cv = cin[idx]; SC[k * 4 + b] = cv / (1.0f + __expf(-cv)); }
          __syncthreads();
          for (int it = bx; it < 256; it += G) p0_mod_item(args, MOD, SC, (LAS float*)(lds + 16384), it, tid); }
    }
    END_REP
    SEAM(0);
    BEGIN_REP(1)
    if (IN(1)) { LAS float* TT = (LAS float*)lds; const float* wi = args.in[I_WIN];
        for (int idx = tid; idx < 8192; idx += NWAVES * 64) { const int k = idx >> 3, e = idx & 7; TT[e * 1024 + k] = wi[(size_t)k * PIN + NP + e]; }
        __syncthreads();
        adaln_rows<0>(args.in[I_X], args.in[I_GMIX], MOD + 0, MOD + 1024, 6144, H, nullptr, TT, args.in[I_ALOG], args.in[I_DTB], GB, gw, NGW, lane);
        __syncthreads(); }
    END_REP
    SEAM(1);
    BEGIN_REP(2)
    if (IN(2)) { pg8::Gemm g{H, WinT, M, NP, D}; pg8::StaticOrder S; S.init(M, NP, G, bx); pg8::EpiBf16 E{P, NP};
        pg8::gemm_phase<pg8::EpiBf16, pg8::StaticOrder, true, true>(lds, g, S, E); }
    END_REP
    SEAM(2);
    BEGIN_REP(3)
    if (IN(3)) conv_pass(P, args.in[I_CWM], args.in[I_CWQ], args.in[I_GCO], YC, QKV, gw, NGW, lane);
    END_REP
#if DN_NAIVE
    SEAM(4);
    if (IN(5)) { if (bx < 32 && wave == 0) naive_dn(QKV, GB, (float*)(ws + WS_CH), bx, lane); }
    SEAM(5);
    if (IN(6)) opost_rows<false>((const float*)(ws + WS_CH), P, args.in[I_GDN], YC, gw, NGW, lane);
#else
    BEGIN_REP(4)
    if (IN(4)) { unsigned* FLG = (unsigned*)(ws + 16384);
        if (bx < NBH) chain_phase(lds, CH, FLG, Oraw, bx, tid); else prep_phase(lds, P, args.in[I_CWQ], GB, EGL, CH, FLG, bx - NBH, G - NBH, tid); }
    END_REP
    SEAM(4);
    BEGIN_REP(6)
    if (IN(6)) opost_rows<true>(Oraw, P, args.in[I_GDN], YC, gw, NGW, lane);
    END_REP
#endif
    SEAM(6);
    BEGIN_REP(7)
    if (IN(7)) { pg8::Gemm g{YC, WoT, M, D, D}; pg8::StaticOrder S; S.init(M, D, G, bx);
        pg8::EpiResGateNorm<true> E{args.in[I_X], OUT, H, MOD + 2048, 6144, args.in[I_GFFN], MOD + 3072, MOD + 4096, 6144, (float*)(ws + WS_EGL + 524288), (unsigned*)(ws + 32768 + 8192), lds + 131072};
        pg8::gemm_phase<pg8::EpiResGateNorm<true>, pg8::StaticOrder, true, true>(lds, g, S, E); }
    END_REP
    SEAM(7);
    BEGIN_REP(8)
    if (false && IN(8)) adaln_rows<1>(OUT, args.in[I_GFFN], MOD + 3072, MOD + 4096, 6144, H, nullptr, nullptr, nullptr, nullptr, nullptr, gw, NGW, lane);
    END_REP
    BEGIN_REP(9)
    if (IN(9)) { pg8::Gemm g{H, WguT, M, 2 * FF, D}; pg8::StaticOrder S; S.init(M, 2 * FF, G, bx); pg8::EpiSwiglu E{ACT, FF};
        pg8::gemm_phase<pg8::EpiSwiglu, pg8::StaticOrder, true, true>(lds, g, S, E); }
    END_REP
    SEAM(9);
    BEGIN_REP(10)
    if (IN(10)) { pg8::Gemm g{ACT, WdT, M, D, FF}; pg8::StaticOrder S; S.init(M, D, G, bx);
        pg8::EpiResGateNorm<false> E{OUT, OUT, nullptr, MOD + 5120, 6144, args.in[I_GFIN], MOD + 4 * 6144, MOD + 4 * 6144 + 1024, 2048, (float*)(ws + WS_EGL), (unsigned*)(ws + 32768), lds + 131072};
        pg8::gemm_phase<pg8::EpiResGateNorm<false>, pg8::StaticOrder, true, true>(lds, g, S, E); }
    END_REP
    LAUNDER();
    if (IN(11) && G != 256) adaln_rows<2>(OUT, args.in[I_GFIN], MOD + 4 * 6144, MOD + 4 * 6144 + 1024, 2048, nullptr, OUT, nullptr, nullptr, nullptr, nullptr, gw, NGW, lane);
#undef IN
#undef SEAM
}

extern "C" void kernel_launch(void* const* d_in, const int* in_sizes, int n_in, void* d_out, int out_size, void* d_ws, size_t ws_size, hipStream_t stream) {
    static int grid = 0;
    if (grid == 0) {
        if (n_in != 19 || out_size != M * D || ws_size < WS_END) { fprintf(stderr, "kernel_launch: unexpected shapes (n_in %d, out %d, ws %zu)\n", n_in, out_size, ws_size); grid = -1; return; }
        int dev = 0, cus = 0;
        if (hipGetDevice(&dev) != hipSuccess || hipDeviceGetAttribute(&cus, hipDeviceAttributeMultiprocessorCount, dev) != hipSuccess) { grid = -1; return; }
        if (hipFuncSetAttribute((const void*)fwd, hipFuncAttributeMaxDynamicSharedMemorySize, LDS_BYTES) != hipSuccess) { fprintf(stderr, "kernel_launch: hipFuncSetAttribute failed\n"); grid = -1; return; }
        int per_cu = 0;
        if (hipOccupancyMaxActiveBlocksPerMultiprocessor(&per_cu, (const void*)fwd, NWAVES * 64, LDS_BYTES) != hipSuccess || per_cu < 1) { fprintf(stderr, "kernel_launch: occupancy query says %d blocks per CU\n", per_cu); }
        (void)hipGetLastError();
        grid = cus;
    }
    if (grid < 0) return;
    Args a{};
    for (int i = 0; i < 19; ++i) a.in[i] = (const float*)d_in[i];
    a.out = (float*)d_out; a.ws = (unsigned char*)d_ws;
#if MK_N_LAUNCHES == 1
    if (hipMemsetAsync(d_ws, 0, 49152, stream) != hipSuccess) { fprintf(stderr, "kernel_launch: memset of the barrier words failed\n"); return; }
    a.ph_lo = 0; a.ph_hi = PH_END;
    void* kargs[] = {&a};
    hipError_t e = hipLaunchCooperativeKernel((const void*)fwd, dim3(grid), dim3(NWAVES * 64), kargs, LDS_BYTES, stream);
    if (e != hipSuccess) fprintf(stderr, "kernel_launch: cooperative launch failed: %s (grid %d)\n", hipGetErrorString(e), grid);
#else
    for (int ph = 0; ph < PH_END; ++ph) { a.ph_lo = ph; a.ph_hi = ph + 1; hipLaunchKernelGGL(fwd, dim3(grid), dim3(NWAVES * 64), LDS_BYTES, stream, a); }
#endif
}
```

```cpp
#include <hip/hip_runtime.h>
#include <hip/hip_cooperative_groups.h>
#include <cstdio>
#include <cstdint>
namespace cg = cooperative_groups;
#ifndef MK_N_LAUNCHES
#define MK_N_LAUNCHES 1
#endif
#ifndef DN_NAIVE
#define DN_NAIVE 0
#endif
namespace pg8 {
#define PG8_LAS __attribute__((address_space(3)))
typedef unsigned short bf16_t;
typedef short bf16x8 __attribute__((ext_vector_type(8)));
typedef float f32x4 __attribute__((ext_vector_type(4)));
typedef unsigned u32x4 __attribute__((ext_vector_type(4)));
constexpr int BM = 256, BK = 64, HALF = 128, HTB = HALF * BK * 2  , STAGE_BYTES = 8 * HTB, NXCD = 8, WGM = 8;

__host__ __device__ __forceinline__ int lds_byte(int r, int c) { const int st = (r >> 4) * 2 + (c >> 5), rr = r & 15, cc = c & 31, ob = rr * 64 + cc * 2; return st * 1024 + (ob ^ (((ob >> 9) & 1) << 5)); }
__host__ __device__ __forceinline__ void stage_rc(int b, int& R, int& C) { const int st = b / 1024, sb = b % 1024, swz = sb ^ (((sb >> 9) & 1) << 5); R = (st >> 1) * 16 + swz / 64; C = (st & 1) * 32 + (swz % 64) / 2; }
__host__ __device__ __forceinline__ int perm32(int rho) { const int n = rho >> 4, i = rho & 15; return 8 * (i >> 2) + 4 * n + (i & 3); }

struct Unit { int pm, pn; };
struct Gemm { const bf16_t* A; const bf16_t* Bt; int M, N, K; };

struct StaticOrder {
    int nM, nN, nwg, G, c;
    __host__ __device__ void init(int M, int N, int G_, int c_) { nM = M / BM; nN = N / BM; nwg = nM * nN; G = G_; c = c_; }
    __host__ __device__ bool next(int i, Unit& u) const {
        const long L = (long)i * G + c; if (L >= nwg) return false;
        int wgid = (int)L; { const int q = nwg / NXCD, r = nwg % NXCD, xcd = wgid % NXCD, off = wgid / NXCD; wgid = (xcd < r ? xcd * (q + 1) : r * (q + 1) + (xcd - r) * q) + off; }
        const int nig = WGM * nN, gid = wgid / nig, fm = gid * WGM, gsz = (nM - fm) < WGM ? (nM - fm) : WGM;
        u.pm = fm + ((wgid % nig) % gsz); u.pn = (wgid % nig) / gsz; return true;
    }
    __device__ __forceinline__ void a_ready(const Unit&) const {}
    __device__ __forceinline__ void done(const Unit&) const {}
};

typedef float f32x2 __attribute__((ext_vector_type(2)));
typedef __bf16 bf16x2v __attribute__((ext_vector_type(2)));
__device__ __forceinline__ unsigned cvt_pk_bf16(float lo, float hi) { f32x2 v = {lo, hi}; bf16x2v r = __builtin_convertvector(v, bf16x2v); return __builtin_bit_cast(unsigned, r); }
__device__ __forceinline__ float silu_f(float x) { return x * __builtin_amdgcn_rcpf(1.0f + __builtin_amdgcn_exp2f(-1.4426950408889634f * x)); }

struct EpiBf16 {
    static constexpr bool PERM = true, AFTER_DRAIN = false;
    bf16_t* O; int ldc;
    __device__ __forceinline__ void operator()(const f32x4 (&acc)[2][2][4][2], const Unit& u, int wr, int wc, int fr, int fq) const {
        const int row0 = u.pm * BM + wr * 64 + fr; const int col0 = u.pn * BM + wc * 32 + 8 * fq;
#pragma unroll
        for (int ai = 0; ai < 2; ++ai)
#pragma unroll
            for (int m = 0; m < 4; ++m) { bf16_t* rowp = O + (size_t)(row0 + ai * HALF + m * 16) * ldc + col0;
#pragma unroll
                for (int bj = 0; bj < 2; ++bj) { const f32x4 v0 = acc[ai][bj][m][0], v1 = acc[ai][bj][m][1];
                    u32x4 w; w.x = cvt_pk_bf16(v0[0], v0[1]); w.y = cvt_pk_bf16(v0[2], v0[3]); w.z = cvt_pk_bf16(v1[0], v1[1]); w.w = cvt_pk_bf16(v1[2], v1[3]);
                    *(u32x4*)(rowp + bj * HALF) = w; } }
    }
};
struct EpiSwiglu {
    static constexpr bool PERM = true, AFTER_DRAIN = false;
    bf16_t* O; int ldc;
    __device__ __forceinline__ void operator()(const f32x4 (&acc)[2][2][4][2], const Unit& u, int wr, int wc, int fr, int fq) const {
        const int row0 = u.pm * BM + wr * 64 + fr; const int col0 = u.pn * HALF + wc * 32 + 8 * fq;
#pragma unroll
        for (int ai = 0; ai < 2; ++ai)
#pragma unroll
            for (int m = 0; m < 4; ++m) { bf16_t* rowp = O + (size_t)(row0 + ai * HALF + m * 16) * ldc + col0;
                const f32x4 g0 = acc[ai][0][m][0], g1 = acc[ai][0][m][1], u0 = acc[ai][1][m][0], u1 = acc[ai][1][m][1];
                u32x4 w; w.x = cvt_pk_bf16(silu_f(g0[0]) * u0[0], silu_f(g0[1]) * u0[1]); w.y = cvt_pk_bf16(silu_f(g0[2]) * u0[2], silu_f(g0[3]) * u0[3]);
                w.z = cvt_pk_bf16(silu_f(g1[0]) * u1[0], silu_f(g1[1]) * u1[1]); w.w = cvt_pk_bf16(silu_f(g1[2]) * u1[2], silu_f(g1[3]) * u1[3]);
                *(u32x4*)rowp = w; }
    }
};
struct EpiResGate {
    static constexpr bool PERM = false, AFTER_DRAIN = false;
    const float* base; float* out; const float* gate;
    int gstride;
    __device__ __forceinline__ void operator()(const f32x4 (&acc)[2][2][4][2], const Unit& u, int wr, int wc, int fr, int fq) const {
        const int b = u.pm >> 5;
        const int col0 = u.pn * BM + wc * 32 + 4 * fq; const float* gp = gate + (size_t)b * gstride + col0;
        f32x4 gv[2][2];
#pragma unroll
        for (int bj = 0; bj < 2; ++bj)
#pragma unroll
            for (int n = 0; n < 2; ++n) gv[bj][n] = *(const f32x4*)(gp + bj * HALF + n * 16);
#pragma unroll
        for (int ai = 0; ai < 2; ++ai)
#pragma unroll
            for (int m = 0; m < 4; ++m) { const size_t off = (size_t)(u.pm * BM + ai * HALF + wr * 64 + m * 16 + fr) * 1024 + col0;
#pragma unroll
                for (int bj = 0; bj < 2; ++bj)
#pragma unroll
                    for (int n = 0; n < 2; ++n) { const f32x4 bs = *(const f32x4*)(base + off + bj * HALF + n * 16);
                        *(f32x4*)(out + off + bj * HALF + n * 16) = bs + gv[bj][n] * acc[ai][bj][m][n]; } }
    }
};

template <bool MID> struct EpiResGateNorm {
    static constexpr bool PERM = false, AFTER_DRAIN = false;
    const float* base; float* out; bf16_t* hb; const float* gate; int gstride;
    const float* gain; const float* shiftp; const float* scalep; int mstride;
    float* SS; unsigned* cnt; PG8_LAS unsigned char* xl;
    __device__ __forceinline__ void operator()(f32x4 (&acc)[2][2][4][2], const Unit& u, int wr, int wc, int fr, int fq) const {
        const int tid = threadIdx.x, lane = tid & 63, wid = __builtin_amdgcn_readfirstlane(tid >> 6);
        const int b = u.pm >> 5;
        const int col0 = u.pn * BM + wc * 32 + 4 * fq; const float* gp = gate + (size_t)b * gstride + col0;
        PG8_LAS float* Pt = (PG8_LAS float*)xl; PG8_LAS float* St = (PG8_LAS float*)(xl + 4096);
        f32x4 gv[2][2];
#pragma unroll
        for (int bj = 0; bj < 2; ++bj)
#pragma unroll
            for (int n = 0; n < 2; ++n) gv[bj][n] = *(const f32x4*)(gp + bj * HALF + n * 16);
#pragma unroll
        for (int ai = 0; ai < 2; ++ai)
#pragma unroll
            for (int m = 0; m < 4; ++m) { const size_t off = (size_t)(u.pm * BM + ai * HALF + wr * 64 + m * 16 + fr) * 1024 + col0; float s = 0.f;
#pragma unroll
                for (int bj = 0; bj < 2; ++bj)
#pragma unroll
                    for (int n = 0; n < 2; ++n) { const f32x4 v = *(const f32x4*)(base + off + bj * HALF + n * 16) + gv[bj][n] * acc[ai][bj][m][n]; acc[ai][bj][m][n] = v; if (MID) *(f32x4*)(out + off + bj * HALF + n * 16) = v; s += (v.x * v.x + v.y * v.y) + (v.z * v.z + v.w * v.w); }
                s += __shfl_xor(s, 16); s += __shfl_xor(s, 32);
                if (fq == 0) Pt[(ai * HALF + wr * 64 + m * 16 + fr) * 4 + wc] = s; }
        asm volatile("s_waitcnt lgkmcnt(0)" ::: "memory"); __builtin_amdgcn_s_barrier(); asm volatile("" ::: "memory");
        if (tid < 256) { const f32x4 p = *(const PG8_LAS f32x4*)(Pt + tid * 4); const float part = (p.x + p.y) + (p.z + p.w);
            float* slot = SS + (size_t)(u.pm * BM + tid) * 4 + u.pn; asm volatile("global_store_dword %0, %1, off sc1\n\ts_nop 1" :: "v"(slot), "v"(part) : "memory"); }
        asm volatile("s_waitcnt vmcnt(0)" ::: "memory"); __builtin_amdgcn_s_barrier(); asm volatile("" ::: "memory");
        if (wid == 0) { unsigned* c = cnt + u.pm * 16;
            if (lane == 0) __hip_atomic_fetch_add(c, 1u, __ATOMIC_RELAXED, __HIP_MEMORY_SCOPE_AGENT);
            unsigned spins = 0;
            while ((unsigned)__builtin_amdgcn_readfirstlane(__hip_atomic_load(c, __ATOMIC_RELAXED, __HIP_MEMORY_SCOPE_AGENT)) < 4u && ++spins < 4000000u) __builtin_amdgcn_s_sleep(2);
            __builtin_amdgcn_fence(__ATOMIC_ACQUIRE, "agent"); asm volatile("s_waitcnt vmcnt(0)" ::: "memory"); }
        __builtin_amdgcn_s_barrier(); asm volatile("" ::: "memory");
        if (tid < 256) { const f32x4 q = *(const f32x4*)(SS + (size_t)(u.pm * BM + tid) * 4); St[tid] = 1.0f / sqrtf(((q.x + q.y) + (q.z + q.w)) * (1.0f / 1024.0f) + 1e-6f); }
        asm volatile("s_waitcnt lgkmcnt(0)" ::: "memory"); __builtin_amdgcn_s_barrier(); asm volatile("" ::: "memory");
        float rinv[2][4];
#pragma unroll
        for (int ai = 0; ai < 2; ++ai)
#pragma unroll
            for (int m = 0; m < 4; ++m) rinv[ai][m] = St[ai * HALF + wr * 64 + m * 16 + fr];
#pragma unroll
        for (int bj = 0; bj < 2; ++bj)
#pragma unroll
            for (int n = 0; n < 2; ++n) { const int c = col0 + bj * HALF + n * 16;
                const f32x4 gs = *(const f32x4*)(gain + c) * (1.0f + *(const f32x4*)(scalep + (size_t)b * mstride + c)), sh = *(const f32x4*)(shiftp + (size_t)b * mstride + c);
#pragma unroll
                for (int ai = 0; ai < 2; ++ai)
#pragma unroll
                    for (int m = 0; m < 4; ++m) { const size_t off = (size_t)(u.pm * BM + ai * HALF + wr * 64 + m * 16 + fr) * 1024 + c; const f32x4 o = (acc[ai][bj][m][n] * rinv[ai][m]) * gs + sh;
                        if (MID) { typedef unsigned u32x2v __attribute__((ext_vector_type(2))); u32x2v w; w.x = cvt_pk_bf16(o.x, o.y); w.y = cvt_pk_bf16(o.z, o.w); *(u32x2v*)(hb + off) = w; }
                        else *(f32x4*)(out + off) = o; }
                asm volatile("" ::: "memory"); }
        asm volatile("s_waitcnt lgkmcnt(0)" ::: "memory"); __builtin_amdgcn_s_barrier(); asm volatile("" ::: "memory");
    }
};

template <class Epi, class Sched, bool ALIGN_EPI = false, bool SP2 = false>
__device__ __forceinline__ void gemm_phase(PG8_LAS unsigned char* lds, const Gemm g, const Sched& S, const Epi& E) {
    const int tid = threadIdx.x, wid = __builtin_amdgcn_readfirstlane(tid >> 6), lane = tid & 63, wr = wid >> 2, wc = wid & 3, fr = lane & 15, fq = lane >> 4;
    const int K = g.K, nt = K / BK;
    unsigned voffA[2], voffB[2];
#pragma unroll
    for (int i = 0; i < 2; ++i) { int R, C; stage_rc(tid * 16 + i * 8192, R, C); const int Rb = Epi::PERM ? ((R & ~31) + perm32(R & 31)) : R;
        voffA[i] = (unsigned)(R * K + C) * 2u; voffB[i] = (unsigned)(Rb * K + C) * 2u; }
    const size_t kstep = (size_t)(BK * 2);
    const size_t hstep = (size_t)HALF * K * 2;
    const size_t tstep = 2 * hstep;
    const unsigned ldsw = (unsigned)wid * 1024u;
    const int aoff = lds_byte(wr * 64 + fr, fq * 8), boff = lds_byte(wc * 32 + fr, fq * 8);
#define PG8_SA(b, h) (((b) * 2 + (h)) * HTB)
#define PG8_SB(b, h) ((4 + (b) * 2 + (h)) * HTB)
#define PG8_STAGE(bufoff, gbase, voff) do { _Pragma("unroll") for (int _i = 0; _i < 2; ++_i) \
        __builtin_amdgcn_global_load_lds((const unsigned*)((const char*)(gbase) + (voff)[_i]), (PG8_LAS unsigned*)(lds + (bufoff) + ldsw + _i * 8192), 16, 0, 0); } while (0)
#define PG8_LDA(dst, b, h) do { _Pragma("unroll") for (int m = 0; m < 4; ++m) _Pragma("unroll") for (int k = 0; k < 2; ++k) dst[m][k] = *(const PG8_LAS bf16x8*)(lds + PG8_SA(b, h) + aoff + m * 2048 + k * 1024); } while (0)
#define PG8_LDB(dst, b, h) do { _Pragma("unroll") for (int n = 0; n < 2; ++n) _Pragma("unroll") for (int k = 0; k < 2; ++k) dst[n][k] = *(const PG8_LAS bf16x8*)(lds + PG8_SB(b, h) + boff + n * 2048 + k * 1024); } while (0)
#define PG8_MMA(ai, bj, At, Bt) do { __builtin_amdgcn_s_setprio(1); _Pragma("unroll") for (int m = 0; m < 4; ++m) _Pragma("unroll") for (int n = 0; n < 2; ++n) _Pragma("unroll") for (int k = 0; k < 2; ++k) \
        acc[ai][bj][m][n] = __builtin_amdgcn_mfma_f32_16x16x32_bf16(Bt[n][k], At[m][k], acc[ai][bj][m][n], 0, 0, 0); __builtin_amdgcn_s_setprio(0); } while (0)
#define PG8_WAIT_V(n) asm volatile("s_waitcnt vmcnt(" #n ")" ::: "memory")
#define PG8_WAIT_L(n) asm volatile("s_waitcnt lgkmcnt(" #n ")" ::: "memory")
#define PG8_BAR __builtin_amdgcn_s_barrier()
#define PG8_SCHED __builtin_amdgcn_sched_barrier(0)
    Unit cur, nxt; int ui = 0;
    if (!S.next(0, cur)) return;
    f32x4 acc[2][2][4][2];
#pragma unroll
    for (int a = 0; a < 2; ++a)
#pragma unroll
        for (int b = 0; b < 2; ++b)
#pragma unroll
            for (int m = 0; m < 4; ++m)
#pragma unroll
                for (int n = 0; n < 2; ++n) acc[a][b][m][n] = (f32x4){0.f, 0.f, 0.f, 0.f};
    bf16x8 At[4][2], B0[2][2], B1[2][2];
    const char* cA = (const char*)g.A + (size_t)cur.pm * tstep; const char* cB = (const char*)g.Bt + (size_t)cur.pn * tstep;
    S.a_ready(cur);
    if constexpr (SP2) {
        PG8_STAGE(PG8_SB(0, 0), cB, voffB); PG8_STAGE(PG8_SB(0, 1), cB + hstep, voffB); PG8_STAGE(PG8_SA(0, 0), cA, voffA); PG8_STAGE(PG8_SA(0, 1), cA + hstep, voffA);
        if (wr == 1) PG8_BAR;
        PG8_WAIT_V(2); PG8_BAR;
        PG8_STAGE(PG8_SB(1, 0), cB + kstep, voffB); PG8_STAGE(PG8_SA(1, 0), cA + kstep, voffA); PG8_STAGE(PG8_SB(1, 1), cB + hstep + kstep, voffB);
        PG8_WAIT_V(6); PG8_BAR;
    } else {
        PG8_STAGE(PG8_SB(0, 0), cB, voffB); PG8_STAGE(PG8_SA(0, 0), cA, voffA); PG8_STAGE(PG8_SB(0, 1), cB + hstep, voffB); PG8_STAGE(PG8_SA(0, 1), cA + hstep, voffA);
        if (wr == 1) PG8_BAR;
        PG8_WAIT_V(4); PG8_BAR;
        PG8_STAGE(PG8_SB(1, 0), cB + kstep, voffB); PG8_STAGE(PG8_SA(1, 0), cA + kstep, voffA); PG8_STAGE(PG8_SB(1, 1), cB + hstep + kstep, voffB);
        PG8_WAIT_V(6); PG8_BAR;
    }
    for (;;) {
        const bool has_next = S.next(ui + 1, nxt);
        const char* nA = has_next ? (const char*)g.A + (size_t)nxt.pm * tstep : cA; const char* nB = has_next ? (const char*)g.Bt + (size_t)nxt.pn * tstep : cB;
        for (int t = 0; t < nt; t += 2) {
            const bool last = (t == nt - 2);
            const char* a1 = cA + (size_t)(t + 1) * kstep;
            const char* a2 = last ? nA : cA + (size_t)(t + 2) * kstep; const char* b2 = last ? nB : cB + (size_t)(t + 2) * kstep;
            const char* a3 = a2 + kstep; const char* b3 = b2 + kstep;
            if (last && has_next) S.a_ready(nxt);
            if constexpr (SP2) {
            PG8_LDB(B0, 0, 0); PG8_LDB(B1, 0, 1); PG8_SCHED; PG8_LDA(At, 0, 0); PG8_STAGE(PG8_SA(1, 1), a1 + hstep, voffA);
            PG8_WAIT_V(8); PG8_WAIT_L(0); PG8_BAR; PG8_MMA(0, 0, At, B0); PG8_MMA(0, 1, At, B1); PG8_BAR; PG8_SCHED;
            PG8_LDA(At, 0, 1); PG8_STAGE(PG8_SB(0, 0), b2, voffB); PG8_STAGE(PG8_SB(0, 1), b2 + hstep, voffB); PG8_STAGE(PG8_SA(0, 0), a2, voffA);
            PG8_WAIT_V(8); PG8_WAIT_L(0); PG8_BAR; PG8_MMA(1, 0, At, B0); PG8_MMA(1, 1, At, B1); PG8_BAR; PG8_SCHED;
            PG8_LDB(B0, 1, 0); PG8_LDB(B1, 1, 1); PG8_SCHED; PG8_LDA(At, 1, 0); PG8_STAGE(PG8_SA(0, 1), a2 + hstep, voffA);
            PG8_WAIT_V(8); PG8_WAIT_L(0); PG8_BAR; PG8_MMA(0, 0, At, B0); PG8_MMA(0, 1, At, B1); PG8_BAR; PG8_SCHED;
            PG8_LDA(At, 1, 1); PG8_STAGE(PG8_SB(1, 0), b3, voffB); PG8_STAGE(PG8_SB(1, 1), b3 + hstep, voffB); PG8_STAGE(PG8_SA(1, 0), a3, voffA);
            PG8_WAIT_V(8); PG8_WAIT_L(0); PG8_BAR; PG8_MMA(1, 0, At, B0); PG8_MMA(1, 1, At, B1); PG8_BAR; PG8_SCHED;
            } else {
            PG8_LDB(B0, 0, 0); PG8_SCHED; PG8_LDA(At, 0, 0); PG8_STAGE(PG8_SA(1, 1), a1 + hstep, voffA);
            PG8_WAIT_L(8); PG8_BAR; PG8_WAIT_L(0); PG8_MMA(0, 0, At, B0); PG8_BAR; PG8_SCHED;
            PG8_LDB(B1, 0, 1); PG8_STAGE(PG8_SB(0, 0), b2, voffB);
            PG8_BAR; PG8_WAIT_L(0); PG8_MMA(0, 1, At, B1); PG8_BAR;
            PG8_LDA(At, 0, 1); PG8_STAGE(PG8_SA(0, 0), a2, voffA);
            PG8_BAR; PG8_WAIT_L(0); PG8_MMA(1, 0, At, B0); PG8_BAR; PG8_SCHED;
            PG8_STAGE(PG8_SB(0, 1), b2 + hstep, voffB);
            PG8_WAIT_V(6); PG8_BAR; PG8_MMA(1, 1, At, B1); PG8_BAR;
            PG8_LDB(B0, 1, 0); PG8_SCHED; PG8_LDA(At, 1, 0); PG8_STAGE(PG8_SA(0, 1), a2 + hstep, voffA);
            PG8_WAIT_L(8); PG8_BAR; PG8_WAIT_L(0); PG8_MMA(0, 0, At, B0); PG8_BAR; PG8_SCHED;
            PG8_LDB(B1, 1, 1); PG8_STAGE(PG8_SB(1, 0), b3, voffB);
            PG8_BAR; PG8_WAIT_L(0); PG8_MMA(0, 1, At, B1); PG8_BAR;
            PG8_LDA(At, 1, 1); PG8_STAGE(PG8_SA(1, 0), a3, voffA);
            PG8_BAR; PG8_WAIT_L(0); PG8_MMA(1, 0, At, B0); PG8_BAR; PG8_SCHED;
            PG8_STAGE(PG8_SB(1, 1), b3 + hstep, voffB);
            PG8_WAIT_V(6); PG8_BAR; PG8_MMA(1, 1, At, B1); PG8_BAR;
            }
        }
        if constexpr (ALIGN_EPI) { if (wr == 0) PG8_BAR; }
        if constexpr (!Epi::AFTER_DRAIN) { E(acc, cur, wr, wc, fr, fq); S.done(cur); }
        if (!has_next) break;
#pragma unroll
        for (int a = 0; a < 2; ++a)
#pragma unroll
            for (int b = 0; b < 2; ++b)
#pragma unroll
                for (int m = 0; m < 4; ++m)
#pragma unroll
                    for (int n = 0; n < 2; ++n) acc[a][b][m][n] = (f32x4){0.f, 0.f, 0.f, 0.f};
        cur = nxt; cA = nA; cB = nB; ++ui;
        if constexpr (ALIGN_EPI) { if (wr == 1) PG8_BAR; }
    }
    PG8_WAIT_V(0);
    if constexpr (!ALIGN_EPI) { if (wr == 0) PG8_BAR; }
    PG8_BAR;
    if constexpr (Epi::AFTER_DRAIN) { E.fused(acc, cur, wr, wc, fr, fq, lds, wid, lane); S.done(cur); }
#undef PG8_SA
#undef PG8_SB
#undef PG8_STAGE
#undef PG8_LDA
#undef PG8_LDB
#undef PG8_MMA
#undef PG8_WAIT_V
#undef PG8_WAIT_L
#undef PG8_BAR
#undef PG8_SCHED
}
}

constexpr int NWAVES = 8;
constexpr int BATCH = 4, SEQ = 8192, D = 1024, M = BATCH * SEQ;
constexpr int PIN = 3592, NP = 3584;
constexpr int FF = 2816, NCH = 128, NBH = 16;
constexpr int PH_END = 12;
constexpr float EPS = 1e-6f;
constexpr size_t MiB = 1u << 20;
constexpr size_t WS_MOD = 1 * MiB;
constexpr size_t WS_GB = 2 * MiB;
constexpr size_t WS_EGL = 3 * MiB;
constexpr size_t WS_WIN = 4 * MiB, WS_WO = 11 * MiB, WS_WGU = 13 * MiB, WS_WD = 24 * MiB;
constexpr size_t WS_H = 32 * MiB;
constexpr size_t WS_CH = 32 * MiB;
constexpr size_t WS_P = 208 * MiB;
constexpr size_t WS_YC = 432 * MiB;
constexpr size_t WS_END = 496 * MiB;
constexpr int REC = 74752;
constexpr int REC_A = 57344;
constexpr int LDS_BYTES = 155648;

#define LAS __attribute__((address_space(3)))
typedef unsigned short bf16;
typedef unsigned v4u __attribute__((ext_vector_type(4)));
typedef unsigned v2u __attribute__((ext_vector_type(2)));
typedef float f32x4 __attribute__((ext_vector_type(4)));
typedef float f32x16 __attribute__((ext_vector_type(16)));
typedef short bf16x8 __attribute__((ext_vector_type(8)));
#define LDS_WAIT() asm volatile("s_waitcnt lgkmcnt(0)" ::: "memory")
using pg8::cvt_pk_bf16; using pg8::silu_f;
__device__ __forceinline__ float bf2f(unsigned short u) { return __uint_as_float((unsigned)u << 16); }
__device__ __forceinline__ float bflo(unsigned w) { return __uint_as_float(w << 16); }
__device__ __forceinline__ float bfhi(unsigned w) { return __uint_as_float(w & 0xffff0000u); }
__device__ __forceinline__ float wave_sum(float v) {
#pragma unroll
    for (int o = 1; o < 64; o <<= 1) v += __shfl_xor(v, o);
    return v;
}
__device__ __forceinline__ void unpack8(v4u w, float (&f)[8]) { f[0] = bflo(w.x); f[1] = bfhi(w.x); f[2] = bflo(w.y); f[3] = bfhi(w.y); f[4] = bflo(w.z); f[5] = bfhi(w.z); f[6] = bflo(w.w); f[7] = bfhi(w.w); }
__device__ __forceinline__ v4u pack8(const float (&f)[8]) { v4u w; w.x = cvt_pk_bf16(f[0], f[1]); w.y = cvt_pk_bf16(f[2], f[3]); w.z = cvt_pk_bf16(f[4], f[5]); w.w = cvt_pk_bf16(f[6], f[7]); return w; }

struct Args { const float* in[19]; float* out; unsigned char* ws; int ph_lo, ph_hi; };
enum { I_X = 0, I_C, I_WADA, I_BADA, I_WADAF, I_BADAF, I_GMIX, I_GFFN, I_GFIN, I_WIN, I_CWM, I_CWQ, I_ALOG, I_DTB, I_GCO, I_GDN, I_WOUT, I_WGU, I_WDN };

template <int MODE>
__device__ __forceinline__ void p0_transpose_item(const float* W, int K, int ld, int nblk, bf16* WT, LAS float* scr, int item, int lane) {
    const int kb = item / nblk, nb = item % nblk, k0 = 64 * kb, n0 = 32 * nb;
    f32x4 ld4[8];
#pragma unroll
    for (int i = 0; i < 8; ++i) ld4[i] = *(const f32x4*)(W + (size_t)(k0 + 8 * i + (lane >> 3)) * ld + n0 + 4 * (lane & 7));
#pragma unroll
    for (int i = 0; i < 8; ++i) { LAS float* d = scr + (8 * i + (lane >> 3)) * 33 + 4 * (lane & 7); d[0] = ld4[i].x; d[1] = ld4[i].y; d[2] = ld4[i].z; d[3] = ld4[i].w; }
    LDS_WAIT(); asm volatile("" ::: "memory");
    int r0 = n0;
    if (MODE == 1) { r0 = n0 < FF ? 256 * (n0 / 128) + (n0 % 128) : 256 * ((n0 - FF) / 128) + 128 + ((n0 - FF) % 128); }
    const int c = lane & 7;
#pragma unroll
    for (int j = 0; j < 4; ++j) { const int n = (lane >> 3) + 8 * j; const LAS float* s = scr + (8 * c) * 33 + n;
        v4u o; o.x = cvt_pk_bf16(s[0 * 33], s[1 * 33]); o.y = cvt_pk_bf16(s[2 * 33], s[3 * 33]); o.z = cvt_pk_bf16(s[4 * 33], s[5 * 33]); o.w = cvt_pk_bf16(s[6 * 33], s[7 * 33]);
        *(v4u*)(WT + (size_t)(r0 + n) * K + k0 + 8 * c) = o; }
    LDS_WAIT(); asm volatile("" ::: "memory");
}
__device__ __forceinline__ void p0_mod_item(const Args& a, float* MOD, const LAS float* SC, LAS float* red, int item, int tid) {
    const int c4 = tid & 7, ks = tid >> 3, col0 = item * 32;
    const bool fin = col0 >= 6144; const float* W = fin ? a.in[I_WADAF] : a.in[I_WADA]; const int ld = fin ? 2048 : 6144, cb = (fin ? col0 - 6144 : col0);
    f32x4 w[16];
#pragma unroll
    for (int kk = 0; kk < 16; ++kk) w[kk] = *(const f32x4*)(W + (size_t)(16 * ks + kk) * ld + cb + 4 * c4);
    f32x4 acc[4];
#pragma unroll
    for (int b = 0; b < 4; ++b) acc[b] = (f32x4){0.f, 0.f, 0.f, 0.f};
#pragma unroll
    for (int kk = 0; kk < 16; ++kk) { const f32x4 s = *(const LAS f32x4*)(SC + (16 * ks + kk) * 4); acc[0] += s.x * w[kk]; acc[1] += s.y * w[kk]; acc[2] += s.z * w[kk]; acc[3] += s.w * w[kk]; }
#pragma unroll
    for (int b = 0; b < 4; ++b) *(LAS f32x4*)(red + (ks * 4 + b) * 32 + 4 * c4) = acc[b];
    __syncthreads();
    if (tid < 128) { const int b = tid >> 5, cl = tid & 31; float s = 0.f;
#pragma unroll 16
        for (int k = 0; k < 64; ++k) s += red[(k * 4 + b) * 32 + cl];
        const int c = cb + cl;
        s += fin ? a.in[I_BADAF][c] : a.in[I_BADA][c];
        if (fin) MOD[4 * 6144 + b * 2048 + c] = s; else MOD[b * 6144 + c] = s; }
    __syncthreads();
}

template <int MODE>
__device__ __forceinline__ void adaln_one(const f32x4 (&xin)[4], const f32x4 (&gs)[4], const f32x4 (&sh)[4], int m, bf16* Hout, float* Fout, const LAS float* TT, const float* a_log, const float* dt_bias, float* GB, int lane) {
    f32x4 v[4]; float ss = 0.f;
#pragma unroll
    for (int j = 0; j < 4; ++j) { v[j] = xin[j]; ss += (v[j].x * v[j].x + v[j].y * v[j].y) + (v[j].z * v[j].z + v[j].w * v[j].w); }
    const float rinv = 1.0f / sqrtf(wave_sum(ss) * (1.0f / D) + EPS);
#pragma unroll
    for (int j = 0; j < 4; ++j) v[j] = (v[j] * rinv) * gs[j] + sh[j];
    if (MODE == 2) { f32x4* o = (f32x4*)(Fout + (size_t)m * D) + lane;
#pragma unroll
        for (int j = 0; j < 4; ++j) o[64 * j] = v[j];
    } else { v2u* o = (v2u*)(Hout + (size_t)m * D) + lane;
#pragma unroll
        for (int j = 0; j < 4; ++j) { v2u w; w.x = cvt_pk_bf16(v[j].x, v[j].y); w.y = cvt_pk_bf16(v[j].z, v[j].w); o[64 * j] = w; } }
    if (MODE == 0) {
        float d[8];
#pragma unroll
        for (int e = 0; e < 8; ++e) { float s = 0.f;
#pragma unroll
            for (int j = 0; j < 4; ++j) { const f32x4 t = *(const LAS f32x4*)(TT + e * 1024 + 4 * (lane + 64 * j)); s += (v[j].x * t.x + v[j].y * t.y) + (v[j].z * t.z + v[j].w * t.w); }
            asm volatile("" : "+v"(s) :: "memory"); d[e] = s; }
        float k4[4], k2[2], k1;
        { const bool hi = (lane & 32) != 0;
#pragma unroll
          for (int i = 0; i < 4; ++i) { const float snd = hi ? d[i] : d[4 + i]; const float kp = hi ? d[4 + i] : d[i]; k4[i] = kp + __shfl_xor(snd, 32); } }
        { const bool hi = (lane & 16) != 0;
#pragma unroll
          for (int i = 0; i < 2; ++i) { const float snd = hi ? k4[i] : k4[2 + i]; const float kp = hi ? k4[2 + i] : k4[i]; k2[i] = kp + __shfl_xor(snd, 16); } }
        { const bool hi = (lane & 8) != 0; const float snd = hi ? k2[0] : k2[1]; const float kp = hi ? k2[1] : k2[0]; k1 = kp + __shfl_xor(snd, 8); }
        k1 += __shfl_xor(k1, 4); k1 += __shfl_xor(k1, 2); k1 += __shfl_xor(k1, 1);
        if ((lane & 7) == 0) { const int e = lane >> 3; float r;
            if (e < 4) { const float xx = k1 + dt_bias[e]; const float sp = fmaxf(xx, 0.f) + log1pf(__expf(-fabsf(xx))); r = -__expf(a_log[e]) * sp; }
            else r = 1.0f / (1.0f + __expf(-k1));
            GB[(size_t)m * 8 + e] = r; }
    }
}
template <int MODE>
__device__ __forceinline__ void adaln_rows(const float* X, const float* gain, const float* shiftp, const float* scalep, int mstride, bf16* Hout, float* Fout,
                                           const LAS float* TT, const float* a_log, const float* dt_bias, float* GB, int gw, int NGW, int lane) {
    for (int blk = gw; blk < M / 16; blk += NGW) {
        const int m0 = blk * 16, b = m0 >> 13;
        f32x4 gs[4], sh[4];
        { const f32x4* g4 = (const f32x4*)gain + lane; const f32x4* sh4 = (const f32x4*)(shiftp + (size_t)b * mstride) + lane; const f32x4* sc4 = (const f32x4*)(scalep + (size_t)b * mstride) + lane;
#pragma unroll
          for (int j = 0; j < 4; ++j) { gs[j] = g4[64 * j] * (1.0f + sc4[64 * j]); sh[j] = sh4[64 * j]; } }
        f32x4 c0[4], c1[4];
        { const f32x4* xr = (const f32x4*)(X + (size_t)m0 * D) + lane;
#pragma unroll
          for (int j = 0; j < 4; ++j) { c0[j] = xr[64 * j]; c1[j] = xr[256 + 64 * j]; } }
#pragma unroll 1
        for (int i = 0; i < 16; i += 2) {
            f32x4 n0[4], n1[4];
            { const int mn = (i + 2 < 16) ? m0 + i + 2 : m0; const f32x4* xr = (const f32x4*)(X + (size_t)mn * D) + lane;
#pragma unroll
              for (int j = 0; j < 4; ++j) { n0[j] = xr[64 * j]; n1[j] = xr[256 + 64 * j]; } }
            adaln_one<MODE>(c0, gs, sh, m0 + i, Hout, Fout, TT, a_log, dt_bias, GB, lane);
            adaln_one<MODE>(c1, gs, sh, m0 + i + 1, Hout, Fout, TT, a_log, dt_bias, GB, lane);
#pragma unroll
            for (int j = 0; j < 4; ++j) { c0[j] = n0[j]; c1[j] = n1[j]; }
        }
    }
}

__device__ __forceinline__ void conv_qkv(const bf16* P, const float* cwq, bf16* QKV, int X, int t0, bool first, int lane) {
    const int colp = 1536 + 512 * X + 8 * lane, colo = 512 * X + 8 * lane;
    v4u raw[19];
#pragma unroll
    for (int t = 0; t < 19; ++t) { raw[t] = (v4u){0u, 0u, 0u, 0u}; if (t >= 3 || !first) raw[t] = *(const v4u*)(P + (size_t)(t0 - 3 + t) * NP + colp); }
    float w0[8], w1[8], w2[8], w3[8], h3[8], h2[8], h1[8];
#pragma unroll
    for (int e = 0; e < 8; ++e) { w0[e] = cwq[0 * 1536 + colo + e]; w1[e] = cwq[1 * 1536 + colo + e]; w2[e] = cwq[2 * 1536 + colo + e]; w3[e] = cwq[3 * 1536 + colo + e]; }
    unpack8(raw[0], h3); unpack8(raw[1], h2); unpack8(raw[2], h1);
#pragma unroll
    for (int t = 0; t < 16; ++t) { const int m = t0 + t; float x[8], y[8]; unpack8(raw[3 + t], x); float ss = 0.f;
#pragma unroll
        for (int e = 0; e < 8; ++e) { const float c = w0[e] * h3[e] + w1[e] * h2[e] + w2[e] * h1[e] + w3[e] * x[e]; y[e] = silu_f(c); ss += y[e] * y[e]; h3[e] = h2[e]; h2[e] = h1[e]; h1[e] = x[e]; }
        if (X < 2) { ss += __shfl_xor(ss, 1); ss += __shfl_xor(ss, 2); ss += __shfl_xor(ss, 4); ss += __shfl_xor(ss, 8);
            float r = 1.0f / sqrtf(ss + EPS); if (X == 0) r *= 0.08838834764831845f;
#pragma unroll
            for (int e = 0; e < 8; ++e) y[e] *= r; }
        *(v4u*)(QKV + (size_t)m * 1536 + colo) = pack8(y); }
}
__device__ __forceinline__ void conv_pass(const bf16* P, const float* cwm, const float* cwq, const float* gco, bf16* YC, bf16* QKV, int gw, int NGW, int lane) {
    for (int run = gw; run < M / 16; run += NGW) {
        const int t0 = run * 16; const bool first = (t0 & (SEQ - 1)) == 0;
        { float w0[8], w1[8], w2[8], gc[8], u2[8], u1[8]; const int c0 = 8 * lane;
#pragma unroll
          for (int e = 0; e < 8; ++e) { w0[e] = cwm[c0 + e]; w1[e] = cwm[512 + c0 + e]; w2[e] = cwm[1024 + c0 + e]; gc[e] = gco[c0 + e]; u2[e] = 0.f; u1[e] = 0.f; }
          if (!first) { float a[8], b[8]; unpack8(*(const v4u*)(P + (size_t)(t0 - 2) * NP + 512 + c0), a); unpack8(*(const v4u*)(P + (size_t)(t0 - 2) * NP + 1024 + c0), b);
#pragma unroll
              for (int e = 0; e < 8; ++e) u2[e] = a[e] * b[e];
              unpack8(*(const v4u*)(P + (size_t)(t0 - 1) * NP + 512 + c0), a); unpack8(*(const v4u*)(P + (size_t)(t0 - 1) * NP + 1024 + c0), b);
#pragma unroll
              for (int e = 0; e < 8; ++e) u1[e] = a[e] * b[e]; }
#pragma unroll 1
          for (int tb = 0; tb < 16; tb += 8) {
              v4u rb[8], rc[8], rh[8];
#pragma unroll
              for (int t = 0; t < 8; ++t) { const bf16* pr = P + (size_t)(t0 + tb + t) * NP + c0; rb[t] = *(const v4u*)pr; rc[t] = *(const v4u*)(pr + 512); rh[t] = *(const v4u*)(pr + 1024); }
#pragma unroll
              for (int t = 0; t < 8; ++t) { const int m = t0 + tb + t; float gb[8], a[8], b[8], y[8]; unpack8(rb[t], gb); unpack8(rc[t], a); unpack8(rh[t], b); float ss = 0.f;
#pragma unroll
                  for (int e = 0; e < 8; ++e) { const float u0 = a[e] * b[e]; y[e] = gb[e] * (w0[e] * u2[e] + w1[e] * u1[e] + w2[e] * u0); ss += y[e] * y[e]; u2[e] = u1[e]; u1[e] = u0; }
                  ss += __shfl_xor(ss, 1); ss += __shfl_xor(ss, 2); ss += __shfl_xor(ss, 4);
                  const float r = 1.0f / sqrtf(ss * (1.0f / 64.0f) + EPS);
#pragma unroll
                  for (int e = 0; e < 8; ++e) y[e] = y[e] * r * gc[e];
                  *(v4u*)(YC + (size_t)m * D + c0) = pack8(y); } } }
    }
}


constexpr int PREP_HALF = 69632, PK_KN = 0, PK_QN = 17408, PK_VV = 34816, PK_LM = 52224, PK_GC = 68608, PK_BT = 68864, PK_EG = 69120, PROW = 272;
template <bool SC>
__device__ __forceinline__ v4u afrag_piece_rows(const LAS unsigned char* tile, const LAS float* sc, int p) {
    const int f = p >> 6, ln = p & 63, mt = f >> 3, kt = (f >> 1) & 3, s = f & 1, r = ln & 31, hh = ln >> 5, row = 32 * mt + r, kb = 32 * kt + 16 * s + 4 * hh;
    const v2u a = *(const LAS v2u*)(tile + row * PROW + kb * 2), b = *(const LAS v2u*)(tile + row * PROW + (kb + 8) * 2);
    float scv = 1.0f; if (SC) scv = sc[row];
    v4u o; o.x = cvt_pk_bf16(bflo(a.x) * scv, bfhi(a.x) * scv); o.y = cvt_pk_bf16(bflo(a.y) * scv, bfhi(a.y) * scv); o.z = cvt_pk_bf16(bflo(b.x) * scv, bfhi(b.x) * scv); o.w = cvt_pk_bf16(bflo(b.y) * scv, bfhi(b.y) * scv);
    return o;
}
#define LBAR() do { asm volatile("s_waitcnt lgkmcnt(0)" ::: "memory"); __builtin_amdgcn_s_barrier(); asm volatile("" ::: "memory"); } while (0)
__device__ __forceinline__ void st_wt16(void* p, v4u v) { asm volatile("global_store_dwordx4 %0, %1, off sc1\n\ts_nop 1" :: "v"(p), "v"(v) : "memory"); }
__device__ __forceinline__ void st_wt4(void* p, float v) { asm volatile("global_store_dword %0, %1, off sc1\n\ts_nop 1" :: "v"(p), "v"(v) : "memory"); }
__device__ __forceinline__ void prep_phase(LAS unsigned char* lds, const bf16* P, const float* cwq, const float* GB, float* EGL, unsigned char* CH, unsigned* FLG, int ublk, int nblk, int tid) {
    const int half = tid >> 8, t = tid & 255, lane = tid & 63, w = (tid >> 6) & 3, r = lane & 31, hh = lane >> 5;
    LAS unsigned char* L = lds + half * PREP_HALF;
    LAS float* LM = (LAS float*)(L + PK_LM); LAS float* GC = (LAS float*)(L + PK_GC); LAS float* BT = (LAS float*)(L + PK_BT); LAS float* EG = (LAS float*)(L + PK_EG);
    for (int pu = ublk; pu < NBH * NCH / 2; pu += nblk) {
        const int n = pu >> 3, bh = 2 * (pu & 7) + half, cid = bh * NCH + n, b = bh >> 2, h = bh & 3, m0 = b * SEQ + n * 64;
        unsigned char* rec = CH + (size_t)cid * REC;
        LBAR();
        { const int c8 = t & 15, tg = t >> 4;
#pragma unroll
          for (int X = 0; X < 3; ++X) {
              const int colp = 1536 + 512 * X + 128 * h + 8 * c8, colw = 512 * X + 128 * h + 8 * c8;
              v4u raw[7];
#pragma unroll
              for (int i = 0; i < 7; ++i) { const int tok = 4 * tg - 3 + i; raw[i] = (v4u){0u, 0u, 0u, 0u}; if (tok >= 0 || n > 0) raw[i] = *(const v4u*)(P + (size_t)(m0 + tok) * NP + colp); }
              float w0[8], w1[8], w2[8], w3[8], h3[8], h2[8], h1[8];
#pragma unroll
              for (int e = 0; e < 8; ++e) { w0[e] = cwq[0 * 1536 + colw + e]; w1[e] = cwq[1 * 1536 + colw + e]; w2[e] = cwq[2 * 1536 + colw + e]; w3[e] = cwq[3 * 1536 + colw + e]; }
              unpack8(raw[0], h3); unpack8(raw[1], h2); unpack8(raw[2], h1);
#pragma unroll
              for (int i = 0; i < 4; ++i) { float x[8], y[8]; unpack8(raw[3 + i], x); float ss = 0.f;
#pragma unroll
                  for (int e = 0; e < 8; ++e) { const float c = w0[e] * h3[e] + w1[e] * h2[e] + w2[e] * h1[e] + w3[e] * x[e]; y[e] = silu_f(c); ss += y[e] * y[e]; h3[e] = h2[e]; h2[e] = h1[e]; h1[e] = x[e]; }
                  if (X < 2) { ss += __shfl_xor(ss, 1); ss += __shfl_xor(ss, 2); ss += __shfl_xor(ss, 4); ss += __shfl_xor(ss, 8);
                      float rr = 1.0f / sqrtf(ss + EPS); if (X == 0) rr *= 0.08838834764831845f;
#pragma unroll
                      for (int e = 0; e < 8; ++e) y[e] *= rr; }
                  *(LAS v4u*)(L + (X == 0 ? PK_QN : (X == 1 ? PK_KN : PK_VV)) + (4 * tg + i) * PROW + c8 * 16) = pack8(y); } } }
        if (w == 0) { float g = GB[(size_t)(m0 + lane) * 8 + h];
#pragma unroll
            for (int d = 1; d < 64; d <<= 1) { const float o = __shfl_up(g, d); if (lane >= d) g += o; }
            GC[lane] = g; EG[lane] = __expf(g); BT[lane] = GB[(size_t)(m0 + lane) * 8 + 4 + h];
            if (lane == 63) st_wt4(rec + 73728, __expf(g)); }
        LBAR();
        { const int mi = w >> 1, nj = w & 1;
          f32x16 kk, qk;
#pragma unroll
          for (int i = 0; i < 16; ++i) { kk[i] = 0.f; qk[i] = 0.f; }
#pragma unroll
          for (int st = 0; st < 8; ++st) {
              const bf16x8 ka = *(const LAS bf16x8*)(L + PK_KN + (32 * mi + r) * PROW + (16 * st + 8 * hh) * 2);
              const bf16x8 kb = *(const LAS bf16x8*)(L + PK_KN + (32 * nj + r) * PROW + (16 * st + 8 * hh) * 2);
              const bf16x8 qb = *(const LAS bf16x8*)(L + PK_QN + (32 * mi + r) * PROW + (16 * st + 8 * hh) * 2);
              kk = __builtin_amdgcn_mfma_f32_32x32x16_bf16(ka, kb, kk, 0, 0, 0);
              qk = __builtin_amdgcn_mfma_f32_32x32x16_bf16(kb, qb, qk, 0, 0, 0);
          }
          const float gj = GC[32 * nj + r], gq = GC[32 * mi + r];
          float av[16];
#pragma unroll
          for (int reg = 0; reg < 16; ++reg) { const int cr = (reg & 3) + 8 * (reg >> 2) + 4 * hh;
              const int i = 32 * mi + cr, j = 32 * nj + r;
              LM[i * 64 + j] = (i > j) ? BT[i] * kk[reg] * __expf(GC[i] - gj) : 0.f;
              const int key = 32 * nj + cr, qr = 32 * mi + r;
              av[reg] = (qr >= key) ? qk[reg] * __expf(gq - GC[key]) : 0.f; }
#pragma unroll
          for (int s = 0; s < 2; ++s) { v4u o; o.x = cvt_pk_bf16(av[8 * s], av[8 * s + 1]); o.y = cvt_pk_bf16(av[8 * s + 2], av[8 * s + 3]); o.z = cvt_pk_bf16(av[8 * s + 4], av[8 * s + 5]); o.w = cvt_pk_bf16(av[8 * s + 6], av[8 * s + 7]);
              st_wt16(rec + 49152 + ((mi * 2 + nj) * 2 + s) * 1024 + lane * 16, o); }
        }
#pragma unroll
        for (int i = 0; i < 4; ++i) { const int p = t + 256 * i; st_wt16(rec + 16384 + p * 16, afrag_piece_rows<true>(L + PK_QN, EG, p)); }
        { const float gl = GC[63];
#pragma unroll
          for (int i = 0; i < 4; ++i) { const int p = t + 256 * i, f = p >> 6, ln = p & 63, mt = f >> 2, ct = (f >> 1) & 1, s = f & 1, dk = 32 * mt + (ln & 31), cb = 32 * ct + 16 * s + 4 * (ln >> 5);
              float e[8];
#pragma unroll
              for (int j = 0; j < 8; ++j) { const int c = cb + 8 * (j >> 2) + (j & 3); e[j] = bf2f(*(const LAS unsigned short*)(L + PK_KN + c * PROW + dk * 2)) * __expf(gl - GC[c]); }
              st_wt16(rec + 32768 + p * 16, pack8(e)); } }
        LBAR();
        { float X[64]; const bool isu = t < 128; const int col = t & 127;
          const LAS unsigned char* src = L + (isu ? PK_VV : PK_KN) + col * 2;
#pragma unroll
          for (int i = 0; i < 64; ++i) {
              f32x4 lc[12];
#pragma unroll
              for (int j4 = 0; j4 < 12; ++j4) if (j4 < (i + 3) / 4) lc[j4] = *(const LAS f32x4*)(LM + i * 64 + 4 * j4);
              const float egi = EG[i]; const float rhs = bf2f(*(const LAS unsigned short*)(src + i * PROW)) * BT[i] * (isu ? 1.0f : egi);
              __builtin_amdgcn_sched_barrier(0);
              float a0 = 0.f, a1 = 0.f, a2 = 0.f, a3 = 0.f;
#pragma unroll
              for (int j4 = 0; j4 < (i + 3) / 4; ++j4) { f32x4 l; if (j4 < 12) l = lc[j4]; else l = *(const LAS f32x4*)(LM + i * 64 + 4 * j4);
                  if (4 * j4 + 0 < i) a0 += l.x * X[4 * j4 + 0]; if (4 * j4 + 1 < i) a1 += l.y * X[4 * j4 + 1]; if (4 * j4 + 2 < i) a2 += l.z * X[4 * j4 + 2]; if (4 * j4 + 3 < i) a3 += l.w * X[4 * j4 + 3]; }
              X[i] = rhs - ((a0 + a1) + (a2 + a3)); asm volatile("" : "+v"(X[i]) :: "memory");
              __builtin_amdgcn_sched_barrier(0); }
          LBAR();
          if (isu) { const int vs = col >> 5, dvl = col & 31;
#pragma unroll
              for (int mt = 0; mt < 2; ++mt)
#pragma unroll
                  for (int h2 = 0; h2 < 2; ++h2) { v4u* dst = (v4u*)(rec + REC_A + (size_t)(((vs * 2 + mt) * 64 + dvl + 32 * h2) * 32));
#pragma unroll
                      for (int a2 = 0; a2 < 2; ++a2) { const int i0 = 32 * mt + 4 * h2 + 16 * a2; v4u w;
                          w.x = cvt_pk_bf16(X[i0], X[i0 + 1]); w.y = cvt_pk_bf16(X[i0 + 2], X[i0 + 3]); w.z = cvt_pk_bf16(X[i0 + 8], X[i0 + 9]); w.w = cvt_pk_bf16(X[i0 + 10], X[i0 + 11]); st_wt16(dst + a2, w); } }
          } else {
#pragma unroll
              for (int i = 0; i < 64; ++i) *(LAS unsigned short*)(L + PK_VV + i * PROW + col * 2) = (unsigned short)(cvt_pk_bf16(-X[i], 0.f) & 0xffffu);
          }
        }
        LBAR();
#pragma unroll
        for (int i = 0; i < 4; ++i) { const int p = t + 256 * i; st_wt16(rec + p * 16, afrag_piece_rows<false>(L + PK_VV, EG, p)); }
        asm volatile("s_waitcnt vmcnt(0)" ::: "memory"); __syncthreads();
        if (tid == 0) {
            __hip_atomic_store(FLG + (2 * (pu & 7)) * NCH + n, 1u, __ATOMIC_RELAXED, __HIP_MEMORY_SCOPE_AGENT); __hip_atomic_store(FLG + (2 * (pu & 7) + 1) * NCH + n, 1u, __ATOMIC_RELAXED, __HIP_MEMORY_SCOPE_AGENT); }
    }
}

__device__ __forceinline__ bf16x8 pack_acc(const f32x16& x, int s) {
    v4u p; p.x = cvt_pk_bf16(x[8 * s], x[8 * s + 1]); p.y = cvt_pk_bf16(x[8 * s + 2], x[8 * s + 3]); p.z = cvt_pk_bf16(x[8 * s + 4], x[8 * s + 5]); p.w = cvt_pk_bf16(x[8 * s + 6], x[8 * s + 7]);
    return __builtin_bit_cast(bf16x8, p);
}
#define MFMA32(a, b, c) __builtin_amdgcn_mfma_f32_32x32x16_bf16((a), (b), (c), 0, 0, 0)
#define PIN_SCHED() __builtin_amdgcn_sched_barrier(0)
__device__ __forceinline__ int chain_ready(const unsigned* fl, int have, int lane) {
    for (;;) {
        const int idx = have + 1 + lane;
        const unsigned f = (idx < NCH) ? __hip_atomic_load(fl + idx, __ATOMIC_RELAXED, __HIP_MEMORY_SCOPE_AGENT) : 0u;
        const unsigned long long m = __ballot(f != 0u);
        const int pre = (m == ~0ull) ? 64 : __builtin_ctzll(~m);
        if (pre > 0) { __builtin_amdgcn_fence(__ATOMIC_ACQUIRE, "agent"); asm volatile("s_waitcnt vmcnt(0)" ::: "memory"); return have + pre; }
        __builtin_amdgcn_s_sleep(16);
    }
}
__device__ __forceinline__ void chain_phase(LAS unsigned char* lds, const unsigned char* CH, const unsigned* FLG, bf16* Oraw, int bh, int tid) {
    const int wid = __builtin_amdgcn_readfirstlane(tid >> 6), lane = tid & 63, b = bh >> 2, h = bh & 3, vs = wid & 3;
    const unsigned char* rec0 = CH + (size_t)bh * NCH * REC;
    const bool comp = wid < 4, stager = (wid >= 4);
    const int hw = wid - 4;
#define CH_MOVE(n, dstbase) do { _Pragma("unroll") for (int _i = 0; _i < 19; ++_i) { const int _pc = hw * 19 + _i; if (_pc < 73) \
        __builtin_amdgcn_global_load_lds((const unsigned*)(rec0 + (size_t)(n) * REC + _pc * 1024 + lane * 16), (LAS unsigned*)((dstbase) + _pc * 1024), 16, 0, 0); } } while (0)
#define CH_WARM(n) do { _Pragma("unroll") for (int _i = 0; _i < 10; ++_i) { const int _o = (_i * 64 + lane) * 128; \
        __builtin_amdgcn_global_load_lds((const unsigned*)(rec0 + (size_t)(n) * REC + (_o < REC ? _o : 0)), (LAS unsigned*)(dummy), 4, 0, 0); } } while (0)
    constexpr int WARM_AHEAD = 8;
    LAS unsigned char* dummy = lds + 2 * REC;
    f32x16 S[4], o0, o1;
#pragma unroll
    for (int k = 0; k < 4; ++k)
#pragma unroll
        for (int i = 0; i < 16; ++i) S[k][i] = 0.f;
#pragma unroll
    for (int i = 0; i < 16; ++i) { o0[i] = 0.f; o1[i] = 0.f; }
    const unsigned* fl = FLG + bh * NCH; int have = -1;
    if (stager) { while (have < 0) have = chain_ready(fl, have, lane); CH_MOVE(0, lds); }
    if (!comp) asm volatile("s_waitcnt vmcnt(0)" ::: "memory");
    __builtin_amdgcn_s_barrier(); asm volatile("" ::: "memory");
    for (int n = 0; n < NCH; ++n) {
        const int buf = n & 1;
        if (!comp) {
            if (stager) { if (n + 1 < NCH) { while (have < n + 1) have = chain_ready(fl, have, lane); CH_MOVE(n + 1, lds + (buf ^ 1) * REC); } asm volatile("s_waitcnt vmcnt(0)" ::: "memory"); }
            else { const int wn = n + 1 + WARM_AHEAD; if (wn < NCH) { if (have < wn) { const int idx = have + 1 + lane; const unsigned f = (idx < NCH) ? __hip_atomic_load(fl + idx, __ATOMIC_RELAXED, __HIP_MEMORY_SCOPE_AGENT) : 0u;
                        const unsigned long long m = __ballot(f != 0u); const int pre = (m == ~0ull) ? 64 : __builtin_ctzll(~m); if (pre > 0) { __builtin_amdgcn_fence(__ATOMIC_ACQUIRE, "agent"); have += pre; } }
                    if (have >= wn) CH_WARM(wn); }
                   asm volatile("s_waitcnt vmcnt(20)" ::: "memory"); }
        } else {
            const LAS unsigned char* B = lds + buf * REC + lane * 16;
            const unsigned Baddr = (unsigned)(unsigned long long)B;
            const float egl = *(const LAS float*)(lds + buf * REC + 73728);
            f32x16 v0, v1;
            { const LAS v4u* ul = (const LAS v4u*)(lds + buf * REC + 57344 + ((vs * 2) * 64 + lane) * 32);
              const v4u a0 = ul[0], a1 = ul[1], b0 = ul[128], b1 = ul[129];
              v0[0] = bflo(a0.x); v0[1] = bfhi(a0.x); v0[2] = bflo(a0.y); v0[3] = bfhi(a0.y); v0[4] = bflo(a0.z); v0[5] = bfhi(a0.z); v0[6] = bflo(a0.w); v0[7] = bfhi(a0.w);
              v0[8] = bflo(a1.x); v0[9] = bfhi(a1.x); v0[10] = bflo(a1.y); v0[11] = bfhi(a1.y); v0[12] = bflo(a1.z); v0[13] = bfhi(a1.z); v0[14] = bflo(a1.w); v0[15] = bfhi(a1.w);
              v1[0] = bflo(b0.x); v1[1] = bfhi(b0.x); v1[2] = bflo(b0.y); v1[3] = bfhi(b0.y); v1[4] = bflo(b0.z); v1[5] = bfhi(b0.z); v1[6] = bflo(b0.w); v1[7] = bfhi(b0.w);
              v1[8] = bflo(b1.x); v1[9] = bfhi(b1.x); v1[10] = bflo(b1.y); v1[11] = bfhi(b1.y); v1[12] = bflo(b1.z); v1[13] = bfhi(b1.z); v1[14] = bflo(b1.w); v1[15] = bfhi(b1.w); }
#pragma unroll
            for (int i = 0; i < 16; ++i) { o0[i] = 0.f; o1[i] = 0.f; }
#define LDF(dst, off) asm volatile("ds_read_b128 %0, %1 offset:%2" : "=v"(dst) : "v"(Baddr), "i"(off))
#define WN(x, n) asm volatile("s_waitcnt lgkmcnt(" #n ")" : "+v"(x))
#define OWQ(i, kt, s) ((((i) >> 1) * 16384) + ((((i) & 1) * 4 + (kt)) * 2 + (s)) * 1024)
#define OAT(i, ct) (49152 + ((((i) & 1) * 2 + (ct)) * 2 + ((i) >> 1)) * 1024)
#define OKD(i, ct, s) (32768 + (((i) * 2 + (ct)) * 2 + (s)) * 1024)
#define RUN4(...) RUN4_(__VA_ARGS__)
#define RUN4_(F, G, q0, q1, q2, q3, M0, M1, M2, M3) do { \
                WN(F[0], 3); PIN_SCHED(); M0; LDF(G[0], q0); PIN_SCHED(); \
                WN(F[1], 3); PIN_SCHED(); M1; LDF(G[1], q1); PIN_SCHED(); \
                WN(F[2], 3); PIN_SCHED(); M2; LDF(G[2], q2); PIN_SCHED(); \
                WN(F[3], 3); PIN_SCHED(); M3; LDF(G[3], q3); PIN_SCHED(); } while (0)
#define RUN_WQ(F, G, kt, s, ...) do { const bf16x8 sb = pack_acc(S[kt], s); \
                RUN4(F, G, __VA_ARGS__, v0 = MFMA32(F[0], sb, v0), v1 = MFMA32(F[1], sb, v1), o0 = MFMA32(F[2], sb, o0), o1 = MFMA32(F[3], sb, o1)); asm volatile("" : "+v"(o0), "+v"(o1)); } while (0)
#define NX_WQ(kt, s) OWQ(0, kt, s), OWQ(1, kt, s), OWQ(2, kt, s), OWQ(3, kt, s)
#define NX_AT(ct) OAT(0, ct), OAT(1, ct), OAT(2, ct), OAT(3, ct)
#define NX_KD(ct, s) OKD(0, ct, s), OKD(1, ct, s), OKD(2, ct, s), OKD(3, ct, s)
            bf16x8 FA[4], FB[4];
            LDF(FA[0], OWQ(0, 0, 0)); LDF(FA[1], OWQ(1, 0, 0)); LDF(FA[2], OWQ(2, 0, 0)); LDF(FA[3], OWQ(3, 0, 0)); PIN_SCHED();
            RUN_WQ(FA, FB, 0, 0, NX_WQ(0, 1));
            RUN_WQ(FB, FA, 0, 1, NX_WQ(1, 0));
            RUN_WQ(FA, FB, 1, 0, NX_WQ(1, 1));
            RUN_WQ(FB, FA, 1, 1, NX_WQ(2, 0));
            RUN_WQ(FA, FB, 2, 0, NX_WQ(2, 1));
            RUN_WQ(FB, FA, 2, 1, NX_WQ(3, 0));
            RUN_WQ(FA, FB, 3, 0, NX_WQ(3, 1));
            RUN_WQ(FB, FA, 3, 1, NX_AT(0));
            bf16x8 vb[2][2];
            vb[0][0] = pack_acc(v0, 0); vb[0][1] = pack_acc(v0, 1); vb[1][0] = pack_acc(v1, 0); vb[1][1] = pack_acc(v1, 1);
            RUN4(FA, FB, NX_AT(1), o0 = MFMA32(FA[0], vb[0][0], o0), o1 = MFMA32(FA[1], vb[0][0], o1), o0 = MFMA32(FA[2], vb[0][1], o0), o1 = MFMA32(FA[3], vb[0][1], o1));
#define SCALE_S(kt) do { _Pragma("unroll") for (int i = 0; i < 16; ++i) S[kt][i] *= egl; } while (0)
            RUN4(FB, FA, NX_KD(0, 0), { o0 = MFMA32(FB[0], vb[1][0], o0); SCALE_S(0); }, { o1 = MFMA32(FB[1], vb[1][0], o1); SCALE_S(1); }, { o0 = MFMA32(FB[2], vb[1][1], o0); SCALE_S(2); }, { o1 = MFMA32(FB[3], vb[1][1], o1); SCALE_S(3); });
#define OSTORE() do { bf16* op = Oraw + (size_t)(b * SEQ + n * 64 + 4 * (lane >> 5)) * 512 + h * 128 + vs * 32 + (lane & 31); asm volatile("" : "+v"(op)); \
              _Pragma("unroll") for (int reg = 0; reg < 16; ++reg) { const int cr = (reg & 3) + 8 * (reg >> 2); const unsigned pk = cvt_pk_bf16(o0[reg], o1[reg]); op[cr * 512] = (bf16)(pk & 0xffffu); op[(32 + cr) * 512] = (bf16)(pk >> 16); } } while (0)
            RUN4(FA, FB, NX_KD(0, 1), S[0] = MFMA32(FA[0], vb[0][0], S[0]), { S[1] = MFMA32(FA[1], vb[0][0], S[1]); OSTORE(); }, S[2] = MFMA32(FA[2], vb[0][0], S[2]), S[3] = MFMA32(FA[3], vb[0][0], S[3]));
            RUN4(FB, FA, NX_KD(1, 0), S[0] = MFMA32(FB[0], vb[0][1], S[0]), S[1] = MFMA32(FB[1], vb[0][1], S[1]), S[2] = MFMA32(FB[2], vb[0][1], S[2]), S[3] = MFMA32(FB[3], vb[0][1], S[3]));
            RUN4(FA, FB, NX_KD(1, 1), S[0] = MFMA32(FA[0], vb[1][0], S[0]), S[1] = MFMA32(FA[1], vb[1][0], S[1]), S[2] = MFMA32(FA[2], vb[1][0], S[2]), S[3] = MFMA32(FA[3], vb[1][0], S[3]));
            WN(FB[0], 3); PIN_SCHED(); S[0] = MFMA32(FB[0], vb[1][1], S[0]); WN(FB[1], 2); PIN_SCHED(); S[1] = MFMA32(FB[1], vb[1][1], S[1]);
            WN(FB[2], 1); PIN_SCHED(); S[2] = MFMA32(FB[2], vb[1][1], S[2]); WN(FB[3], 0); PIN_SCHED(); S[3] = MFMA32(FB[3], vb[1][1], S[3]);
#undef RUN4
#undef RUN4_
#undef RUN_WQ
#undef NX_WQ
#undef NX_AT
#undef NX_KD
#undef OWQ
#undef OAT
#undef OKD
#undef WN
#undef SCALE_S
#undef OSTORE
#undef MM_AT
#undef MM_KD
#undef LDF
#undef WAITF
#undef LD_WQ
#undef MM_WQ
#undef LD_AT
#undef LD_KD
            asm volatile("s_waitcnt lgkmcnt(0)" ::: "memory");
        }
        __builtin_amdgcn_s_barrier(); asm volatile("" ::: "memory");
    }
    asm volatile("s_waitcnt vmcnt(0)" ::: "memory");
#undef CH_MOVE
#undef CH_WARM
}
#if DN_NAIVE
__device__ __forceinline__ void naive_dn(const bf16* QKV, const float* GB, float* Oraw, int unit, int lane) {
    const int bh = unit >> 1, dv = (unit & 1) * 64 + lane, b = bh >> 2, h = bh & 3;
    float S[128];
#pragma unroll
    for (int i = 0; i < 128; ++i) S[i] = 0.f;
    for (int t = 0; t < SEQ; ++t) { const size_t m = (size_t)b * SEQ + t;
        const float al = __expf(GB[m * 8 + h]), be = GB[m * 8 + 4 + h];
        const bf16* qp = QKV + m * 1536 + h * 128; const bf16* kp = qp + 512; const float v = bf2f(qp[1024 + dv]);
        float r = 0.f;
#pragma unroll
        for (int i = 0; i < 128; ++i) { S[i] *= al; r += bf2f(kp[i]) * S[i]; if ((i & 15) == 15) asm volatile("" : "+v"(r) :: "memory"); }
        const float d = be * (v - r); float o = 0.f;
#pragma unroll
        for (int i = 0; i < 128; ++i) { S[i] += bf2f(kp[i]) * d; o += bf2f(qp[i]) * S[i]; if ((i & 15) == 15) asm volatile("" : "+v"(o) :: "memory"); }
        Oraw[m * 512 + h * 128 + dv] = o; }
}
#endif
template <bool OB16>
__device__ __forceinline__ void opost_rows(const void* Oraw_, const bf16* P, const float* gdn, bf16* YC, int gw, int NGW, int lane) {
    const float* Oraw = (const float*)Oraw_; const bf16* Ob = (const bf16*)Oraw_;
    float gd[8];
#pragma unroll
    for (int e = 0; e < 8; ++e) gd[e] = gdn[(8 * lane + e) & 127];
    for (int blk = gw; blk < M / 16; blk += NGW) { const int m0 = blk * 16;
#pragma unroll 1
        for (int i = 0; i < 16; i += 8) {
            f32x4 oa[8], ob[8]; v4u zz[8];
#pragma unroll
            for (int t = 0; t < 8; ++t) { const int m = m0 + i + t;
                if (OB16) { float f[8]; unpack8(*(const v4u*)(Ob + (size_t)m * 512 + 8 * lane), f); oa[t] = (f32x4){f[0], f[1], f[2], f[3]}; ob[t] = (f32x4){f[4], f[5], f[6], f[7]}; }
                else { const f32x4* op = (const f32x4*)(Oraw + (size_t)m * 512 + 8 * lane); oa[t] = op[0]; ob[t] = op[1]; }
                zz[t] = *(const v4u*)(P + (size_t)m * NP + 3072 + 8 * lane); }
#pragma unroll
            for (int t = 0; t < 8; ++t) { const int m = m0 + i + t; float z[8]; unpack8(zz[t], z);
                float o[8] = {oa[t].x, oa[t].y, oa[t].z, oa[t].w, ob[t].x, ob[t].y, ob[t].z, ob[t].w}; float ss = 0.f;
#pragma unroll
                for (int e = 0; e < 8; ++e) ss += o[e] * o[e];
                ss += __shfl_xor(ss, 1); ss += __shfl_xor(ss, 2); ss += __shfl_xor(ss, 4); ss += __shfl_xor(ss, 8);
                const float r = 1.0f / sqrtf(ss * (1.0f / 128.0f) + EPS);
#pragma unroll
                for (int e = 0; e < 8; ++e) o[e] = o[e] * r * gd[e] * silu_f(z[e]);
                *(v4u*)(YC + (size_t)m * D + 512 + 8 * lane) = pack8(o); } } }
}

typedef __attribute__((address_space(1))) unsigned gu32;
#define XB_TMO      128
#define XB_XCNT(j)  (256  + 64 * (j))
#define XB_XSUB(j)  (1280 + 64 * (j))
#define XB_XGEN(j)  (2304 + 64 * (j))
#define XB_TOP      3328
#define XB_TOPGEN   3392
#define XCD_BAR_WORDS 3456
#define XB_SPIN_CAP (1u << 18)

__device__ __forceinline__ unsigned xb_ld(unsigned* p)              { return __hip_atomic_load(p, __ATOMIC_RELAXED, __HIP_MEMORY_SCOPE_AGENT); }
__device__ __forceinline__ unsigned xb_add(unsigned* p, unsigned v) { return __hip_atomic_fetch_add(p, v, __ATOMIC_RELAXED, __HIP_MEMORY_SCOPE_AGENT); }
__device__ __forceinline__ unsigned xb_xcc_id() { return (unsigned)__builtin_amdgcn_s_getreg((3 << 11) | 20) & 0xFu; }
#define XB_SPIN(cond, bar) do { unsigned _sp = 0; while (cond) { __builtin_amdgcn_s_sleep(1); \
    if ((++_sp & 255u) == 0u) { if (xb_ld(&(bar)[XB_TMO])) break; if (_sp > XB_SPIN_CAP) { atomicAdd(&(bar)[XB_TMO], 1u); break; } } } } while (0)

struct XcdBarrier {
    unsigned* bar; unsigned x;
    volatile LAS unsigned* st;
};

__device__ __forceinline__ XcdBarrier xcd_barrier_post(unsigned* bar, volatile LAS unsigned* st) {
    XcdBarrier b; b.bar = bar; b.x = xb_xcc_id(); b.st = st;
    if (threadIdx.x == 0) (void)xb_add(&bar[XB_XCNT(b.x)], 1u);
    return b;
}
__device__ __forceinline__ void xcd_barrier_complete(unsigned* bar, unsigned x, unsigned& nloc, unsigned& nx) {
    const unsigned G = gridDim.x * gridDim.y * gridDim.z;
    unsigned sum, cnt, mine, sp = 0u;
    for (;;) {
        sum = 0u; cnt = 0u; mine = 0u;
#pragma unroll
        for (unsigned j = 0; j < 16; ++j) { const unsigned c = xb_ld(&bar[XB_XCNT(j)]); sum += c; cnt += (c > 0u) ? 1u : 0u; mine = (j == x) ? c : mine; }
        if (sum == G) break;
        __builtin_amdgcn_s_sleep(1);
        if ((++sp & 255u) == 0u) { if (xb_ld(&bar[XB_TMO])) break; if (sp > XB_SPIN_CAP) { atomicAdd(&bar[XB_TMO], 1u); break; } }
    }
    nloc = mine > 0u ? mine : 1u; nx = cnt > 0u ? cnt : 1u;
}

__device__ __forceinline__ void xcd_barrier(const XcdBarrier& b) {
    asm volatile("s_waitcnt vmcnt(0)" ::: "memory");
    __syncthreads();
    if (threadIdx.x == 0) {
        unsigned* bar = b.bar;
        __builtin_amdgcn_s_waitcnt(0);
        unsigned nloc = b.st[0], nx = b.st[1];
        if (nloc == 0u) { xcd_barrier_complete(bar, b.x, nloc, nx); b.st[0] = nloc; b.st[1] = nx; }
        const unsigned old = xb_add(&bar[XB_XSUB(b.x)], 1u);
        const unsigned gen = old / nloc;
        if (old + 1u == (gen + 1u) * nloc) {
            __builtin_amdgcn_fence(__ATOMIC_RELEASE, "agent");
            asm volatile("s_waitcnt vmcnt(0)" ::: "memory");
            const unsigned og = xb_add(&bar[XB_TOP], 1u);
            const unsigned tg = og / nx;
            if (og + 1u == (tg + 1u) * nx) xb_add(&bar[XB_TOPGEN], 1u);
            else XB_SPIN(xb_ld(&bar[XB_TOPGEN]) == tg, bar);
            __builtin_amdgcn_fence(__ATOMIC_ACQUIRE, "agent");
            xb_add(&bar[XB_XGEN(b.x)], 1u);
            asm volatile("s_waitcnt vmcnt(0)" ::: "memory");
        } else {
            XB_SPIN(xb_ld(&bar[XB_XGEN(b.x)]) == gen, bar);
            __builtin_amdgcn_fence(__ATOMIC_ACQUIRE, "agent");
            asm volatile("s_waitcnt vmcnt(0)" ::: "memory");
        }
    }
    __syncthreads();
}

__global__ void __launch_bounds__(NWAVES * 64, 2) fwd(Args args) {
    extern __shared__ __attribute__((aligned(16))) unsigned char lds_raw[];
    LAS unsigned char* lds = (LAS unsigned char*)lds_raw;
    int tid = threadIdx.x, lane = tid & 63, wave = __builtin_amdgcn_readfirstlane(tid >> 6);
    const int G = gridDim.x; const int bx = blockIdx.x; const int vcu = (G % 8 == 0) ? (bx % 8) * (G / 8) + bx / 8 : bx;
    int gw = vcu * NWAVES + wave; const int NGW = G * NWAVES;
#define LAUNDER() do { int tv_ = threadIdx.x; asm volatile("" : "+v"(tv_)); tid = tv_; lane = tid & 63; wave = __builtin_amdgcn_readfirstlane(tid >> 6); gw = vcu * NWAVES + wave; } while (0)
    unsigned char* ws = args.ws;
    float* MOD = (float*)(ws + WS_MOD); float* GB = (float*)(ws + WS_GB); float* EGL = (float*)(ws + WS_EGL);
    bf16* WinT = (bf16*)(ws + WS_WIN); bf16* WoT = (bf16*)(ws + WS_WO); bf16* WguT = (bf16*)(ws + WS_WGU); bf16* WdT = (bf16*)(ws + WS_WD);
    bf16* H = (bf16*)(ws + WS_H); unsigned char* CH = ws + WS_CH; bf16* P = (bf16*)(ws + WS_P); bf16* ACT = (bf16*)(ws + WS_P); bf16* YC = (bf16*)(ws + WS_YC);
    bf16* QKV = (bf16*)args.out; bf16* Oraw = (bf16*)((unsigned char*)args.out + 96 * MiB); float* OUT = args.out;
    const int lo = args.ph_lo, hi = args.ph_hi;
    volatile LAS unsigned* MISC = (volatile LAS unsigned*)(lds + LDS_BYTES - 64);
    if (tid < 16) MISC[tid] = 0u;
    __syncthreads();
    XcdBarrier bar = xcd_barrier_post((unsigned*)ws, MISC);
    if (lo < 0) cg::this_grid().sync();
#ifndef PH_MASK
#define PH_MASK 0xFFF
#endif
#define IN(k) (((PH_MASK >> (k)) & 1) && lo <= (k) && (k) < hi)
#if MK_N_LAUNCHES == 1
#define SEAM(k) do { if (IN(k) && IN((k) + 1) && (k) != 5) xcd_barrier(bar); } while (0)
#else
#define SEAM(k) do { } while (0)
#endif
#ifndef REP_MASK
#define REP_MASK 0
#endif
#define BEGIN_REP(k) for (int rep_ = 0; rep_ <= ((REP_MASK >> (k)) & 1); ++rep_) { if (rep_) xcd_barrier(bar); LAUNDER();
#define END_REP }
    BEGIN_REP(0)
    if (IN(0)) {
        LAS float* scr = (LAS float*)(lds + wave * 16384);
        constexpr int I_IN = 16 * 112, I_O = 16 * 32, I_GU = 16 * 176, I_DN = 44 * 32, NITEMS = I_IN + I_O + I_GU + I_DN;
        for (int it = gw; it < NITEMS; it += NGW) { int r = it;
            if (r < I_IN) { p0_transpose_item<0>(args.in[I_WIN], D, PIN, 112, WinT, scr, r, lane); continue; } r -= I_IN;
            if (r < I_O) { p0_transpose_item<0>(args.in[I_WOUT], D, D, 32, WoT, scr, r, lane); continue; } r -= I_O;
            if (r < I_GU) { p0_transpose_item<1>(args.in[I_WGU], D, 2 * FF, 176, WguT, scr, r, lane); continue; } r -= I_GU;
            p0_transpose_item<0>(args.in[I_WDN], FF, D, 32, WdT, scr, r, lane); }
        __syncthreads();
        { LAS float* SC = (LAS float*)lds; const float* cin = args.in[I_C];
          for (int idx = tid; idx < 4096; idx += NWAVES * 64) { const int b = idx >> 10, k = idx & 1023; const float cv = cin[idx]; SC[k * 4 + b] = cv / (1.0f + __expf(-cv)); }
          __syncthreads();
          for (int it = bx; it < 256; it += G) p0_mod_item(args, MOD, SC, (LAS float*)(lds + 16384), it, tid); }
    }
    END_REP
    SEAM(0);
    BEGIN_REP(1)
    if (IN(1)) { LAS float* TT = (LAS float*)lds; const float* wi = args.in[I_WIN];
        for (int idx = tid; idx < 8192; idx += NWAVES * 64) { const int k = idx >> 3, e = idx & 7; TT[e * 1024 + k] = wi[(size_t)k * PIN + NP + e]; }
        __syncthreads();
        adaln_rows<0>(args.in[I_X], args.in[I_GMIX], MOD + 0, MOD + 1024, 6144, H, nullptr, TT, args.in[I_ALOG], args.in[I_DTB], GB, gw, NGW, lane);
        __syncthreads(); }
    END_REP
    SEAM(1);
    BEGIN_REP(2)
    if (IN(2)) { pg8::Gemm g{H, WinT, M, NP, D}; pg8::StaticOrder S; S.init(M, NP, G, bx); pg8::EpiBf16 E{P, NP};
        pg8::gemm_phase<pg8::EpiBf16, pg8::StaticOrder, true, true>(lds, g, S, E); }
    END_REP
    SEAM(2);
    BEGIN_REP(3)
    if (IN(3)) conv_pass(P, args.in[I_CWM], args.in[I_CWQ], args.in[I_GCO], YC, QKV, gw, NGW, lane);
    END_REP
#if DN_NAIVE
    SEAM(4);
    if (IN(5)) { if (bx < 32 && wave == 0) naive_dn(QKV, GB, (float*)(ws + WS_CH), bx, lane); }
    SEAM(5);
    if (IN(6)) opost_rows<false>((const float*)(ws + WS_CH), P, args.in[I_GDN], YC, gw, NGW, lane);
#else
    BEGIN_REP(4)
    if (IN(4)) { unsigned* FLG = (unsigned*)(ws + 16384);
        if (bx < NBH) chain_phase(lds, CH, FLG, Oraw, bx, tid); else prep_phase(lds, P, args.in[I_CWQ], GB, EGL, CH, FLG, bx - NBH, G - NBH, tid); }
    END_REP
    SEAM(4);
    BEGIN_REP(6)
    if (IN(6)) opost_rows<true>(Oraw, P, args.in[I_GDN], YC, gw, NGW, lane);
    END_REP
#endif
    SEAM(6);
    BEGIN_REP(7)
    if (IN(7)) { pg8::Gemm g{YC, WoT, M, D, D}; pg8::StaticOrder S; S.init(M, D, G, bx);
        pg8::EpiResGateNorm<true> E{args.in[I_X], OUT, H, MOD + 2048, 6144, args.in[I_GFFN], MOD + 3072, MOD + 4096, 6144, (float*)(ws + WS_EGL + 524288), (unsigned*)(ws + 32768 + 8192), lds + 131072};
        pg8::gemm_phase<pg8::EpiResGateNorm<true>, pg8::StaticOrder, true, true>(lds, g, S, E); }
    END_REP
    SEAM(7);
    BEGIN_REP(8)
    if (false && IN(8)) adaln_rows<1>(OUT, args.in[I_GFFN], MOD + 3072, MOD + 4096, 6144, H, nullptr, nullptr, nullptr, nullptr, nullptr, gw, NGW, lane);
    END_REP
    BEGIN_REP(9)
    if (IN(9)) { pg8::Gemm g{H, WguT, M, 2 * FF, D}; pg8::StaticOrder S; S.init(M, 2 * FF, G, bx); pg8::EpiSwiglu E{ACT, FF};
        pg8::gemm_phase<pg8::EpiSwiglu, pg8::StaticOrder, true, true>(lds, g, S, E); }
    END_REP
    SEAM(9);
    BEGIN_REP(10)
    if (IN(10)) { pg8::Gemm g{ACT, WdT, M, D, FF}; pg8::StaticOrder S; S.init(M, D, G, bx);
        pg8::EpiResGateNorm<false> E{OUT, OUT, nullptr, MOD + 5120, 6144, args.in[I_GFIN], MOD + 4 * 6144, MOD + 4 * 6144 + 1024, 2048, (float*)(ws + WS_EGL), (unsigned*)(ws + 32768), lds + 131072};
        pg8::gemm_phase<pg8::EpiResGateNorm<false>, pg8::StaticOrder, true, true>(lds, g, S, E); }
    END_REP
    LAUNDER();
    if (IN(11) && G != 256) adaln_rows<2>(OUT, args.in[I_GFIN], MOD + 4 * 6144, MOD + 4 * 6144 + 1024, 2048, nullptr, OUT, nullptr, nullptr, nullptr, nullptr, gw, NGW, lane);
#undef IN
#undef SEAM
}

extern "C" void kernel_launch(void* const* d_in, const int* in_sizes, int n_in, void* d_out, int out_size, void* d_ws, size_t ws_size, hipStream_t stream) {
    static int grid = 0;
    if (grid == 0) {
        if (n_in != 19 || out_size != M * D || ws_size < WS_END) { fprintf(stderr, "kernel_launch: unexpected shapes (n_in %d, out %d, ws %zu)\n", n_in, out_size, ws_size); grid = -1; return; }
        int dev = 0, cus = 0;
        if (hipGetDevice(&dev) != hipSuccess || hipDeviceGetAttribute(&cus, hipDeviceAttributeMultiprocessorCount, dev) != hipSuccess) { grid = -1; return; }
        if (hipFuncSetAttribute((const void*)fwd, hipFuncAttributeMaxDynamicSharedMemorySize, LDS_BYTES) != hipSuccess) { fprintf(stderr, "kernel_launch: hipFuncSetAttribute failed\n"); grid = -1; return; }
        int per_cu = 0;
        if (hipOccupancyMaxActiveBlocksPerMultiprocessor(&per_cu, (const void*)fwd, NWAVES * 64, LDS_BYTES) != hipSuccess || per_cu < 1) { fprintf(stderr, "kernel_launch: occupancy query says %d blocks per CU\n", per_cu); }
        (void)hipGetLastError();
        grid = cus;
    }
    if (grid < 0) return;
    Args a{};
    for (int i = 0; i < 19; ++i) a.in[i] = (const float*)d_in[i];
    a.out = (float*)d_out; a.ws = (unsigned char*)d_ws;
#if MK_N_LAUNCHES == 1
    if (hipMemsetAsync(d_ws, 0, 49152, stream) != hipSuccess) { fprintf(stderr, "kernel_launch: memset of the barrier words failed\n"); return; }
    a.ph_lo = 0; a.ph_hi = PH_END;
    void* kargs[] = {&a};
    hipError_t e = hipLaunchCooperativeKernel((const void*)fwd, dim3(grid), dim3(NWAVES * 64), kargs, LDS_BYTES, stream);
    if (e != hipSuccess) fprintf(stderr, "kernel_launch: cooperative launch failed: %s (grid %d)\n", hipGetErrorString(e), grid);
#else
    for (int ph = 0; ph < PH_END; ++ph) { a.ph_lo = ph; a.ph_hi = ph + 1; hipLaunchKernelGGL(fwd, dim3(grid), dim3(NWAVES * 64), LDS_BYTES, stream, a); }
#endif
}
```
